# Optimizing an MI355X kernel written in HIP

```python
import math
import jax, jax.numpy as jnp
from jax import lax
import numpy as np

D_MODEL = 1024
BATCH = 8
SEQ = 4096
DEPTH = 2

GRID_W = 64
PLE_DIM = 256

HEAD_DIM = 64
ROPE_THETA = 10000.0
Q_BLOCK = 128
EPS = 1e-6

HA = 6
Q_LORA = 256
KV_LORA = 128
NOPE_A = 64
ROPE_A = 32
V_A = 64
A_COLS = Q_LORA + KV_LORA + ROPE_A

HB = 6
KVB = 2
B_COLS = (HB + 2 * KVB) * HEAD_DIM

HC = 4
KVC = 2
WINDOW = 128
C_COLS = (HC + 2 * KVC) * HEAD_DIM

IN_COLS = A_COLS + B_COLS + C_COLS
MIX_WIDTH = HA * V_A + HB * HEAD_DIM + HC * HEAD_DIM

N_EXPERTS = 32
TOP_K = 4
D_FF = D_MODEL
SWIGLU_LIMIT = 7.0
SWIGLU_ALPHA = 1.702

kernel_name = "hybrid_mla_axialgqa_swa_sink_moe_encoder"


def rms_norm(x, g):
    xf = x.astype(jnp.float32)
    y = xf * lax.rsqrt(jnp.mean(xf * xf, axis=-1, keepdims=True) + EPS)
    return (y * g.astype(jnp.float32)).astype(x.dtype)


def rope_cos_sin(pos, dim):
    inv = 1.0 / (ROPE_THETA ** (jnp.arange(0, dim, 2, dtype=jnp.float32) / dim))
    ang = pos.astype(jnp.float32)[:, None] * inv[None, :]
    return jnp.cos(ang), jnp.sin(ang)


def apply_rope(x, cos, sin):
    xf = x.astype(jnp.float32)
    half = x.shape[-1] // 2
    x1, x2 = xf[..., :half], xf[..., half:]
    c, s = cos[None, :, None, :], sin[None, :, None, :]
    return jnp.concatenate([x1 * c - x2 * s, x2 * c + x1 * s], axis=-1).astype(x.dtype)


def apply_axial_rope(x, cos_r, sin_r, cos_w, sin_w):
    half = x.shape[-1] // 2
    return jnp.concatenate([apply_rope(x[..., :half], cos_r, sin_r),
                            apply_rope(x[..., half:], cos_w, sin_w)], axis=-1)


def dense_block_attention(q, k, v, scale):
    B, S, H, dk = q.shape
    G, dv = k.shape[2], v.shape[-1]
    R = H // G
    nb = S // Q_BLOCK
    qb = q.reshape(B, nb, Q_BLOCK, G, R, dk).transpose(1, 0, 2, 3, 4, 5)

    def one_block(qblk):
        s = jnp.einsum('bqgrd,bkgd->bgrqk', qblk, k).astype(jnp.float32) * scale
        pr = jax.nn.softmax(s, axis=-1).astype(v.dtype)
        return jnp.einsum('bgrqk,bkgd->bqgrd', pr, v)

    o = lax.map(one_block, qb)
    return o.transpose(1, 0, 2, 3, 4, 5).reshape(B, S, H, dv)


def banded_sink_attention(q, k, v, sink, scale):
    B, S, H, d = q.shape
    G = k.shape[2]
    R = H // G
    nb = S // WINDOW
    pad = ((0, 0), (WINDOW, WINDOW), (0, 0), (0, 0))
    kp = jnp.pad(k, pad).reshape(B, nb + 2, WINDOW, G, d)
    vp = jnp.pad(v, pad).reshape(B, nb + 2, WINDOW, G, d)
    kw = jnp.concatenate([kp[:, :-2], kp[:, 1:-1], kp[:, 2:]], axis=2)
    vw = jnp.concatenate([vp[:, :-2], vp[:, 1:-1], vp[:, 2:]], axis=2)
    qb = q.reshape(B, nb, WINDOW, G, R, d)
    s = jnp.einsum('bnqgrd,bnkgd->bngrqk', qb, kw).astype(jnp.float32) * scale
    rel = jnp.arange(3 * WINDOW)[None, :] - jnp.arange(WINDOW)[:, None]
    band = (rel >= 0) & (rel <= 2 * WINDOW)
    kpos = (jnp.arange(nb)[:, None] - 1) * WINDOW + jnp.arange(3 * WINDOW)[None, :]
    inb = (kpos >= 0) & (kpos < S)
    mask = band[None, :, :] & inb[:, None, :]
    s = jnp.where(mask[None, :, None, None, :, :], s, -1e30)
    sk = sink.astype(jnp.float32).reshape(1, 1, G, R, 1, 1)
    m = jnp.maximum(jnp.max(s, axis=-1, keepdims=True), sk)
    e = jnp.exp(s - m)
    pr = e / (jnp.sum(e, axis=-1, keepdims=True) + jnp.exp(sk - m))
    o = jnp.einsum('bngrqk,bnkgd->bnqgrd', pr.astype(v.dtype), vw)
    return o.reshape(B, S, H, d)


def mla_mixer(z, q_norm, wq_up, kv_norm, wkv_up, cos, sin):
    B, S, _ = z.shape
    c_q = rms_norm(z[..., :Q_LORA], q_norm)
    c_kv = rms_norm(z[..., Q_LORA:Q_LORA + KV_LORA], kv_norm)
    k_rope = z[..., Q_LORA + KV_LORA:].reshape(B, S, 1, ROPE_A)
    q = (c_q @ wq_up).reshape(B, S, HA, NOPE_A + ROPE_A)
    q = jnp.concatenate([q[..., :NOPE_A], apply_rope(q[..., NOPE_A:], cos, sin)], axis=-1)
    kv = (c_kv @ wkv_up).reshape(B, S, HA, NOPE_A + V_A)
    k_rope = jnp.broadcast_to(apply_rope(k_rope, cos, sin), (B, S, HA, ROPE_A))
    k = jnp.concatenate([kv[..., :NOPE_A], k_rope], axis=-1)
    v = kv[..., NOPE_A:]
    o = dense_block_attention(q, k, v, (NOPE_A + ROPE_A) ** -0.5)
    return o.reshape(B, S, HA * V_A)


def axial_gqa_mixer(z, q_norm, k_norm, cos_r, sin_r, cos_w, sin_w):
    B, S, _ = z.shape
    nq, nk = HB * HEAD_DIM, KVB * HEAD_DIM
    q = rms_norm(z[..., :nq].reshape(B, S, HB, HEAD_DIM), q_norm)
    k = rms_norm(z[..., nq:nq + nk].reshape(B, S, KVB, HEAD_DIM), k_norm)
    v = z[..., nq + nk:].reshape(B, S, KVB, HEAD_DIM)
    q = apply_axial_rope(q, cos_r, sin_r, cos_w, sin_w)
    k = apply_axial_rope(k, cos_r, sin_r, cos_w, sin_w)
    o = dense_block_attention(q, k, v, HEAD_DIM ** -0.5)
    return o.reshape(B, S, HB * HEAD_DIM)


def window_sink_mixer(z, sink, cos, sin):
    B, S, _ = z.shape
    nq, nk = HC * HEAD_DIM, KVC * HEAD_DIM
    q = apply_rope(z[..., :nq].reshape(B, S, HC, HEAD_DIM), cos, sin)
    k = apply_rope(z[..., nq:nq + nk].reshape(B, S, KVC, HEAD_DIM), cos, sin)
    v = z[..., nq + nk:].reshape(B, S, KVC, HEAD_DIM)
    o = banded_sink_attention(q, k, v, sink, HEAD_DIM ** -0.5)
    return o.reshape(B, S, HC * HEAD_DIM)


def moe(h, router_w, router_b, w_up, b_up, w_down, b_down):
    B, S, D = h.shape
    T = B * S
    hf = h.reshape(T, D)
    logits = (hf @ router_w + router_b).astype(jnp.float32)
    top_vals, top_idx = lax.top_k(logits, TOP_K)
    gates = jax.nn.softmax(top_vals, axis=-1).astype(h.dtype)
    flat_e = top_idx.reshape(-1)
    order = jnp.argsort(flat_e)
    sorted_e = flat_e[order]
    tok = order // TOP_K
    xs = hf[tok]
    group_sizes = jnp.bincount(flat_e, length=N_EXPERTS).astype(jnp.int32)
    gu = lax.ragged_dot(xs, w_up, group_sizes) + b_up[sorted_e]
    x_glu = jnp.minimum(gu[..., :D_FF], SWIGLU_LIMIT)
    x_lin = jnp.clip(gu[..., D_FF:], -SWIGLU_LIMIT, SWIGLU_LIMIT)
    act = x_glu * jax.nn.sigmoid(SWIGLU_ALPHA * x_glu) * (x_lin + 1.0)
    out = lax.ragged_dot(act, w_down, group_sizes) + b_down[sorted_e]
    out = out * gates.reshape(-1)[order][:, None]
    y = jax.ops.segment_sum(out, tok, num_segments=T)
    return y.reshape(B, S, D)


def setup_inputs(seed: int = 0) -> dict:
    key = jax.random.key(seed)
    ks = jax.random.split(key, 24)
    f32 = jnp.float32

    def nrm(k, shape, scale):
        return jax.random.normal(k, shape, f32) * scale

    def gain(k, shape):
        return 1.0 + 0.02 * jax.random.normal(k, shape, f32)

    L, D = DEPTH, D_MODEL
    return {
        "x": nrm(ks[0], (BATCH, SEQ, D), 1.0),
        "p": nrm(ks[1], (DEPTH, BATCH, SEQ, PLE_DIM), 1.0),
        "attn_norm": gain(ks[2], (L, D)),
        "w_in": nrm(ks[3], (L, D, IN_COLS), D ** -0.5),
        "mla_q_norm": gain(ks[4], (L, Q_LORA)),
        "mla_wq_up": nrm(ks[5], (L, Q_LORA, HA * (NOPE_A + ROPE_A)), Q_LORA ** -0.5),
        "mla_kv_norm": gain(ks[6], (L, KV_LORA)),
        "mla_wkv_up": nrm(ks[7], (L, KV_LORA, HA * (NOPE_A + V_A)), KV_LORA ** -0.5),
        "gqa_q_norm": gain(ks[8], (L, HEAD_DIM)),
        "gqa_k_norm": gain(ks[9], (L, HEAD_DIM)),
        "swa_sink": nrm(ks[10], (L, HC), 0.5),
        "w_out": nrm(ks[11], (L, MIX_WIDTH, D), MIX_WIDTH ** -0.5),
        "moe_norm": gain(ks[12], (L, D)),
        "router_w": nrm(ks[13], (L, D, N_EXPERTS), D ** -0.5),
        "router_b": nrm(ks[14], (L, N_EXPERTS), 0.01),
        "w_up": nrm(ks[15], (L, N_EXPERTS, D, 2 * D_FF), D ** -0.5),
        "b_up": nrm(ks[16], (L, N_EXPERTS, 2 * D_FF), 0.01),
        "w_down": nrm(ks[17], (L, N_EXPERTS, D_FF, D), D_FF ** -0.5),
        "b_down": nrm(ks[18], (L, N_EXPERTS, D), 0.01),
        "ple_norm": gain(ks[19], (L, D)),
        "w_ple": nrm(ks[20], (L, PLE_DIM, D), PLE_DIM ** -0.5),
        "w_ple_gate": nrm(ks[21], (L, D, D), D ** -0.5),
        "final_norm": gain(ks[22], (D,)),
    }


def reference(x, p, attn_norm, w_in, mla_q_norm, mla_wq_up, mla_kv_norm, mla_wkv_up,
              gqa_q_norm, gqa_k_norm, swa_sink, w_out, moe_norm, router_w, router_b,
              w_up, b_up, w_down, b_down, ple_norm, w_ple, w_ple_gate, final_norm):
    B, S, _ = x.shape
    ROWS = S // GRID_W
    pos = jnp.arange(S, dtype=jnp.int32)
    cos_a, sin_a = rope_cos_sin(pos, ROPE_A)
    cos_c, sin_c = rope_cos_sin(pos, HEAD_DIM)
    rows = jnp.repeat(jnp.arange(ROWS, dtype=jnp.int32), GRID_W)
    cols = jnp.tile(jnp.arange(GRID_W, dtype=jnp.int32), ROWS)
    cos_r, sin_r = rope_cos_sin(rows, HEAD_DIM // 2)
    cos_w, sin_w = rope_cos_sin(cols, HEAD_DIM // 2)

    for i in range(DEPTH):
        h = rms_norm(x, attn_norm[i])
        z = h @ w_in[i]
        z_a, z_b, z_c = jnp.split(z, [A_COLS, A_COLS + B_COLS], axis=-1)
        o_a = mla_mixer(z_a, mla_q_norm[i], mla_wq_up[i], mla_kv_norm[i], mla_wkv_up[i], cos_a, sin_a)
        o_b = axial_gqa_mixer(z_b, gqa_q_norm[i], gqa_k_norm[i], cos_r, sin_r, cos_w, sin_w)
        o_c = window_sink_mixer(z_c, swa_sink[i], cos_c, sin_c)
        mix = jnp.concatenate([o_a, o_b, o_c], axis=-1)
        x = x + mix @ w_out[i]
        x = x + moe(rms_norm(x, moe_norm[i]), router_w[i], router_b[i],
                    w_up[i], b_up[i], w_down[i], b_down[i])
        gate = jax.nn.sigmoid(rms_norm(x, ple_norm[i]) @ w_ple_gate[i])
        x = x + (p[i] @ w_ple[i]) * gate
    return rms_norm(x, final_norm)
```

```cpp
#include <hip/hip_runtime.h>
#include <cstdio>
#include <cstdint>

#define GAS __attribute__((address_space(1)))
#define LAS __attribute__((address_space(3)))
typedef unsigned short bf16;
typedef short bf16x8 __attribute__((ext_vector_type(8)));
typedef short s16x4 __attribute__((ext_vector_type(4)));
typedef float f32x2 __attribute__((ext_vector_type(2)));
typedef float f32x4 __attribute__((ext_vector_type(4)));
typedef float f32x16 __attribute__((ext_vector_type(16)));
typedef unsigned u32x2 __attribute__((ext_vector_type(2)));
typedef unsigned u32x4 __attribute__((ext_vector_type(4)));

constexpr int NB = 8, SEQ = 4096, T = NB * SEQ, D = 1024, NL = 2;
constexpr int ZP = 1792;
constexpr int A_COLS = 416, B_COLS = 640;
constexpr int ZB = A_COLS, ZC = A_COLS + B_COLS;
constexpr int QAP = 576, KAP = 576, VAP = 384, QBP = 384, KBP = 128, VBP = 128, QCP = 256, KCP = 128, VCP = 128;
constexpr int NE = 32, TOPK = 4, ECAP = T;
constexpr int ACT_ROWS = T * TOPK + NE * 256;
constexpr float EPS = 1e-6f, LOG2E = 1.4426950408889634f;
constexpr float C2A = 0.10206207261596577f * LOG2E;
constexpr float C2B = 0.125f * LOG2E;

constexpr size_t MiB = 1u << 20;
constexpr size_t WS_CTL = 0, CTL_ZERO_BYTES = 4 * MiB;
constexpr int CW_BAR = 4096;
constexpr int CW_CNT = 16384;
constexpr int CW_SS = 65536;
static_assert(CW_SS * 4 + NL * 4 * T * 8 <= (int)CTL_ZERO_BYTES, "ctl");
constexpr size_t WS_TAB32 = 4 * MiB;
constexpr size_t WS_TAB64 = 5 * MiB;
constexpr size_t WS_WR = 6 * MiB;
constexpr size_t WS_BUP = 7 * MiB;
constexpr size_t WS_SS0 = 8 * MiB;
constexpr size_t WS_RS2 = 8 * MiB + 512 * 1024;
constexpr size_t WS_GATES = 9 * MiB;
constexpr size_t WS_PERM = 10 * MiB;
constexpr size_t WS_WIN = 16 * MiB;
constexpr size_t WS_WQ = 24 * MiB;
constexpr size_t WS_WKV = 25 * MiB;
constexpr size_t WS_WOUT = 26 * MiB;
constexpr size_t WS_WG = 30 * MiB;
constexpr size_t WS_WPLE = 34 * MiB;
constexpr size_t WS_WUP = 36 * MiB;
constexpr size_t WS_WDN = 292 * MiB;
constexpr size_t WS_XB = 420 * MiB;
constexpr size_t WS_X1B = 484 * MiB;
constexpr size_t WS_X2B = 548 * MiB;
constexpr size_t WS_XF = 612 * MiB;
constexpr size_t WS_PB = 740 * MiB;
constexpr size_t WS_Z = 772 * MiB;
constexpr size_t WS_QA = 884 * MiB;
constexpr size_t WS_KA = 920 * MiB;
constexpr size_t WS_VA = 956 * MiB;
constexpr size_t WS_QB = 980 * MiB;
constexpr size_t WS_KB = 1004 * MiB;
constexpr size_t WS_VB = 1012 * MiB;
constexpr size_t WS_QC = 1020 * MiB;
constexpr size_t WS_KC = 1036 * MiB;
constexpr size_t WS_VC = 1044 * MiB;
constexpr size_t WS_MIX = 1052 * MiB;
constexpr size_t WS_EB = 1116 * MiB;
constexpr size_t WS_ACT = 1180 * MiB;
constexpr size_t WS_Y = 1452 * MiB;
constexpr size_t WS_END = 1708 * MiB;

constexpr int RING_BYTES = 131072;
constexpr int MISC_OFF = RING_BYTES;
constexpr int LDS_BYTES = 147456;
constexpr int NWAVES = 8;

#define RLX_AGENT __ATOMIC_RELAXED, __HIP_MEMORY_SCOPE_AGENT
#define LDS_WAIT() asm volatile("s_waitcnt lgkmcnt(0)" ::: "memory")
#define VM_WAIT() asm volatile("s_waitcnt vmcnt(0)" ::: "memory")
__device__ __forceinline__ unsigned cvt_pk_bf16(float lo, float hi) { unsigned r; asm volatile("v_cvt_pk_bf16_f32 %0, %1, %2" : "=v"(r) : "v"(lo), "v"(hi)); return r; }
__device__ __forceinline__ float bf2f(unsigned short b) { return __uint_as_float((unsigned)b << 16); }
__device__ __forceinline__ float bflo(unsigned w) { return __uint_as_float(w << 16); }
__device__ __forceinline__ float bfhi(unsigned w) { return __uint_as_float(w & 0xffff0000u); }
typedef unsigned long long u64;
__device__ __forceinline__ u64 fx_enc(float v) { return (u64)__float2ll_rn(v * 1048576.0f); }
__device__ __forceinline__ void atomic_addf(u64* p, float v) { (void)__hip_atomic_fetch_add(p, fx_enc(v), __ATOMIC_RELAXED, __HIP_MEMORY_SCOPE_AGENT); }
__device__ __forceinline__ float fx_load(const u64* p) { return (float)(long long)(*p) * (1.0f / 1048576.0f); }
__device__ __forceinline__ float wave_sum(float v) {
#pragma unroll
    for (int o = 1; o < 64; o <<= 1) v += __shfl_xor(v, o);
    return v;
}
__device__ __forceinline__ float sigmoidf_fast(float x) { return __builtin_amdgcn_rcpf(1.0f + __builtin_amdgcn_exp2f(-x * LOG2E)); }

__device__ __forceinline__ unsigned char* launder(unsigned char* p) { GAS unsigned char* g = (GAS unsigned char*)p; asm volatile("" : "+s"(g)); return (unsigned char*)g; }
__device__ __forceinline__ int opaque_tid() { int t = threadIdx.x; asm volatile("" : "+v"(t)); return t; }
#ifndef PHMASK
#define PHMASK 0xffff
#endif
#define PH(k) if ((PHMASK >> (k)) & 1)

#define XB_TMO      128
#define XB_XCNT(j)  (256  + 64 * (j))
#define XB_XSUB(j)  (1280 + 64 * (j))
#define XB_XGEN(j)  (2304 + 64 * (j))
#define XB_TOP      3328
#define XB_TOPGEN   3392
#define XCD_BAR_WORDS 3456
#define XB_SPIN_CAP (1u << 18)
__device__ __forceinline__ unsigned xb_ld(unsigned* p)              { return __hip_atomic_load(p, __ATOMIC_RELAXED, __HIP_MEMORY_SCOPE_AGENT); }
__device__ __forceinline__ unsigned xb_add(unsigned* p, unsigned v) { return __hip_atomic_fetch_add(p, v, __ATOMIC_RELAXED, __HIP_MEMORY_SCOPE_AGENT); }
__device__ __forceinline__ unsigned xb_xcc_id() { return (unsigned)__builtin_amdgcn_s_getreg((3 << 11) | 20) & 0xFu; }
#define XB_SPIN(cond, bar) do { unsigned _sp = 0; while (cond) { __builtin_amdgcn_s_sleep(1); \
    if ((++_sp & 255u) == 0u) { if (xb_ld(&(bar)[XB_TMO])) break; if (_sp > XB_SPIN_CAP) { atomicAdd(&(bar)[XB_TMO], 1u); break; } } } } while (0)
struct XcdBarrier { unsigned* bar; unsigned x; volatile LAS unsigned* st; };
__device__ __forceinline__ XcdBarrier xcd_barrier_post(unsigned* bar, volatile LAS unsigned* st) {
    XcdBarrier b; b.bar = bar; b.x = xb_xcc_id(); b.st = st;
    if (threadIdx.x == 0) (void)xb_add(&bar[XB_XCNT(b.x)], 1u);
    return b;
}
__device__ __forceinline__ void xcd_barrier_complete(unsigned* bar, unsigned x, unsigned& nloc, unsigned& nx) {
    const unsigned G = gridDim.x * gridDim.y * gridDim.z;
    unsigned sum, cnt, mine, sp = 0u;
    for (;;) {
        sum = 0u; cnt = 0u; mine = 0u;
#pragma unroll
        for (unsigned j = 0; j < 16; ++j) { const unsigned c = xb_ld(&bar[XB_XCNT(j)]); sum += c; cnt += (c > 0u) ? 1u : 0u; mine = (j == x) ? c : mine; }
        if (sum == G) break;
        __builtin_amdgcn_s_sleep(1);
        if ((++sp & 255u) == 0u) { if (xb_ld(&bar[XB_TMO])) break; if (sp > XB_SPIN_CAP) { atomicAdd(&bar[XB_TMO], 1u); break; } }
    }
    nloc = mine > 0u ? mine : 1u; nx = cnt > 0u ? cnt : 1u;
}
__device__ __forceinline__ void xcd_barrier(const XcdBarrier& b) {
    asm volatile("s_waitcnt vmcnt(0)" ::: "memory");
    __syncthreads();
    if (threadIdx.x == 0) {
        unsigned* bar = b.bar;
        __builtin_amdgcn_s_waitcnt(0);
        unsigned nloc = b.st[0], nx = b.st[1];
        if (nloc == 0u) { xcd_barrier_complete(bar, b.x, nloc, nx); b.st[0] = nloc; b.st[1] = nx; }
        const unsigned old = xb_add(&bar[XB_XSUB(b.x)], 1u);
        const unsigned gen = old / nloc;
        if (old + 1u == (gen + 1u) * nloc) {
            __builtin_amdgcn_fence(__ATOMIC_RELEASE, "agent");
            asm volatile("s_waitcnt vmcnt(0)" ::: "memory");
            const unsigned og = xb_add(&bar[XB_TOP], 1u);
            const unsigned tg = og / nx;
            if (og + 1u == (tg + 1u) * nx) xb_add(&bar[XB_TOPGEN], 1u);
            else XB_SPIN(xb_ld(&bar[XB_TOPGEN]) == tg, bar);
            __builtin_amdgcn_fence(__ATOMIC_ACQUIRE, "agent");
            xb_add(&bar[XB_XGEN(b.x)], 1u);
            asm volatile("s_waitcnt vmcnt(0)" ::: "memory");
        } else {
            XB_SPIN(xb_ld(&bar[XB_XGEN(b.x)]) == gen, bar);
            __builtin_amdgcn_fence(__ATOMIC_ACQUIRE, "agent");
            asm volatile("s_waitcnt vmcnt(0)" ::: "memory");
        }
    }
    __syncthreads();
}

namespace gp {
constexpr int BM = 256, BK = 64, HALF = 128, HTB = HALF * BK * 2, STAGE_BYTES = 8 * HTB, NXCD = 8, WGM = 8;
__host__ __device__ __forceinline__ int lds_byte(int r, int c) { const int st = (r >> 4) * 2 + (c >> 5), rr = r & 15, cc = c & 31, ob = rr * 64 + cc * 2; return st * 1024 + (ob ^ (((ob >> 9) & 1) << 5)); }
__host__ __device__ __forceinline__ void stage_rc(int b, int& R, int& C) { const int st = b / 1024, sb = b % 1024, swz = sb ^ (((sb >> 9) & 1) << 5); R = (st >> 1) * 16 + swz / 64; C = (st & 1) * 32 + (swz % 64) / 2; }
__host__ __device__ __forceinline__ int perm32(int rho) { const int n = rho >> 4, i = rho & 15; return 8 * (i >> 2) + 4 * n + (i & 3); }

struct Unit { int pm, pn, aux; const char* A; const char* B; };

struct TileOrder {
    int nM, nN, nwg, G, c;
    __device__ __forceinline__ void init(int nM_, int nN_, int G_, int c_) { nM = nM_; nN = nN_; nwg = nM * nN; G = G_; c = c_; }
    __device__ __forceinline__ bool tile(int i, int& pm, int& pn) const {
        const long L = (long)i * G + c; if (L >= nwg) return false;
        int wgid = (int)L; { const int q = nwg / NXCD, r = nwg % NXCD, xcd = wgid % NXCD, off = wgid / NXCD; wgid = (xcd < r ? xcd * (q + 1) : r * (q + 1) + (xcd - r) * q) + off; }
        const int nig = WGM * nN, gid = wgid / nig, fm = gid * WGM, gsz = (nM - fm) < WGM ? (nM - fm) : WGM;
        pm = fm + ((wgid % nig) % gsz); pn = (wgid % nig) / gsz; return true;
    }
};
struct DenseSched {
    TileOrder o; const char* A; const char* B; int lda, K;
    __device__ __forceinline__ void init(const void* A_, int lda_, const void* B_, int K_, int M, int N, int G, int c) { A = (const char*)A_; B = (const char*)B_; lda = lda_; K = K_; o.init(M / BM, N / BM, G, c); }
    __device__ __forceinline__ bool next(int i, Unit& u) const { int pm, pn; if (!o.tile(i, pm, pn)) return false; u.pm = pm; u.pn = pn; u.aux = 0;
        u.A = A + (size_t)pm * BM * lda * 2; u.B = B + (size_t)pn * BM * K * 2; return true; }
    __device__ __forceinline__ unsigned rowoff(const Unit&, int r) const { return (unsigned)(r * lda * 2); }
};

template <class Epi, class Sched, bool ALIGN_EPI>
__device__ __forceinline__ void gemm_phase(LAS unsigned char* lds, const int K, const Sched& S, const Epi& E) {
    const int tid = opaque_tid(), wid = __builtin_amdgcn_readfirstlane(tid >> 6), lane = tid & 63, wr = wid >> 2, wc = wid & 3, fr = lane & 15, fq = lane >> 4;
    const int nt = K / BK;
    int Rr[2], Cc[2]; unsigned voffB[2];
#pragma unroll
    for (int i = 0; i < 2; ++i) { int R, C; stage_rc(tid * 16 + i * 8192, R, C); const int Rb = Epi::PERM ? ((R & ~31) + perm32(R & 31)) : R;
        Rr[i] = R; Cc[i] = C * 2; voffB[i] = (unsigned)(Rb * K + C) * 2u; }
    const size_t kstep = (size_t)(BK * 2);
    const size_t hstepB = (size_t)HALF * K * 2;
    const unsigned ldsw = (unsigned)wid * 1024u;
    const int aoff = lds_byte(wr * 64 + fr, fq * 8), boff = lds_byte(wc * 32 + fr, fq * 8);
#define GP_SA(b, h) (((b) * 2 + (h)) * HTB)
#define GP_SB(b, h) ((4 + (b) * 2 + (h)) * HTB)
#define GP_STAGE(bufoff, gbase, voff) do { _Pragma("unroll") for (int _i = 0; _i < 2; ++_i) \
        __builtin_amdgcn_global_load_lds((const unsigned*)((const char*)(gbase) + (voff)[_i]), (LAS unsigned*)(lds + (bufoff) + ldsw + _i * 8192), 16, 0, 0); } while (0)
#define GP_LDA(dst, b, h) do { _Pragma("unroll") for (int m = 0; m < 4; ++m) _Pragma("unroll") for (int k = 0; k < 2; ++k) dst[m][k] = *(const LAS bf16x8*)(lds + GP_SA(b, h) + aoff + m * 2048 + k * 1024); } while (0)
#define GP_LDB(dst, b, h) do { _Pragma("unroll") for (int n = 0; n < 2; ++n) _Pragma("unroll") for (int k = 0; k < 2; ++k) dst[n][k] = *(const LAS bf16x8*)(lds + GP_SB(b, h) + boff + n * 2048 + k * 1024); } while (0)
#define GP_MMA(ai, bj, At, Bt) do { __builtin_amdgcn_s_setprio(1); _Pragma("unroll") for (int m = 0; m < 4; ++m) _Pragma("unroll") for (int n = 0; n < 2; ++n) _Pragma("unroll") for (int k = 0; k < 2; ++k) \
        acc[ai][bj][m][n] = __builtin_amdgcn_mfma_f32_16x16x32_bf16(Bt[n][k], At[m][k], acc[ai][bj][m][n], 0, 0, 0); __builtin_amdgcn_s_setprio(0); } while (0)
#define GP_WAIT_V(n) asm volatile("s_waitcnt vmcnt(" #n ")" ::: "memory")
#define GP_WAIT_L(n) asm volatile("s_waitcnt lgkmcnt(" #n ")" ::: "memory")
#define GP_BAR __builtin_amdgcn_s_barrier()
#define GP_SCHED __builtin_amdgcn_sched_barrier(0)
    Unit cur, nxt; int ui = 0;
    if (!S.next(0, cur)) return;
    unsigned vAc[2][2], vAn[2][2];
#pragma unroll
    for (int h = 0; h < 2; ++h)
#pragma unroll
        for (int i = 0; i < 2; ++i) vAc[h][i] = S.rowoff(cur, h * HALF + Rr[i]) + (unsigned)Cc[i];
    f32x4 acc[2][2][4][2];
#pragma unroll
    for (int a = 0; a < 2; ++a)
#pragma unroll
        for (int b = 0; b < 2; ++b)
#pragma unroll
            for (int m = 0; m < 4; ++m)
#pragma unroll
                for (int n = 0; n < 2; ++n) acc[a][b][m][n] = (f32x4){0.f, 0.f, 0.f, 0.f};
    bf16x8 At[4][2], B0[2][2], B1[2][2];
    const char* cA = cur.A; const char* cB = cur.B;
    GP_STAGE(GP_SB(0, 0), cB, voffB); GP_STAGE(GP_SB(0, 1), cB + hstepB, voffB); GP_STAGE(GP_SA(0, 0), cA, vAc[0]); GP_STAGE(GP_SA(0, 1), cA, vAc[1]);
    if (wr == 1) GP_BAR;
    GP_WAIT_V(2); GP_BAR;
    GP_STAGE(GP_SB(1, 0), cB + kstep, voffB); GP_STAGE(GP_SA(1, 0), cA + kstep, vAc[0]); GP_STAGE(GP_SB(1, 1), cB + hstepB + kstep, voffB);
    GP_WAIT_V(6); GP_BAR;
    for (;;) {
        const bool has_next = S.next(ui + 1, nxt);
        const char* nA = has_next ? nxt.A : cA; const char* nB = has_next ? nxt.B : cB;
#pragma unroll
        for (int h = 0; h < 2; ++h)
#pragma unroll
            for (int i = 0; i < 2; ++i) vAn[h][i] = has_next ? (S.rowoff(nxt, h * HALF + Rr[i]) + (unsigned)Cc[i]) : vAc[h][i];
#pragma unroll 1
        for (int t = 0; t < nt; t += 2) {
            const bool last = (t == nt - 2);
            const char* a1 = cA + (size_t)(t + 1) * kstep;
            const char* a2 = last ? nA : cA + (size_t)(t + 2) * kstep; const char* b2 = last ? nB : cB + (size_t)(t + 2) * kstep;
            const char* a3 = a2 + kstep; const char* b3 = b2 + kstep;
            unsigned v2[2][2];
#pragma unroll
            for (int h = 0; h < 2; ++h)
#pragma unroll
                for (int i = 0; i < 2; ++i) v2[h][i] = last ? vAn[h][i] : vAc[h][i];
            GP_LDB(B0, 0, 0); GP_LDB(B1, 0, 1); GP_SCHED; GP_LDA(At, 0, 0); GP_STAGE(GP_SA(1, 1), a1, vAc[1]);
            GP_WAIT_V(8); GP_WAIT_L(0); GP_BAR; GP_MMA(0, 0, At, B0); GP_MMA(0, 1, At, B1); GP_BAR; GP_SCHED;
            GP_LDA(At, 0, 1); GP_STAGE(GP_SB(0, 0), b2, voffB); GP_STAGE(GP_SB(0, 1), b2 + hstepB, voffB); GP_STAGE(GP_SA(0, 0), a2, v2[0]);
            GP_WAIT_V(8); GP_WAIT_L(0); GP_BAR; GP_MMA(1, 0, At, B0); GP_MMA(1, 1, At, B1); GP_BAR; GP_SCHED;
            GP_LDB(B0, 1, 0); GP_LDB(B1, 1, 1); GP_SCHED; GP_LDA(At, 1, 0); GP_STAGE(GP_SA(0, 1), a2, v2[1]);
            GP_WAIT_V(8); GP_WAIT_L(0); GP_BAR; GP_MMA(0, 0, At, B0); GP_MMA(0, 1, At, B1); GP_BAR; GP_SCHED;
            GP_LDA(At, 1, 1); GP_STAGE(GP_SB(1, 0), b3, voffB); GP_STAGE(GP_SB(1, 1), b3 + hstepB, voffB); GP_STAGE(GP_SA(1, 0), a3, v2[0]);
            GP_WAIT_V(8); GP_WAIT_L(0); GP_BAR; GP_MMA(1, 0, At, B0); GP_MMA(1, 1, At, B1); GP_BAR; GP_SCHED;
        }
        if constexpr (ALIGN_EPI) { if (wr == 0) GP_BAR; }
        E(acc, cur, wr, wc, fr, fq);
        if (!has_next) break;
#pragma unroll
        for (int a = 0; a < 2; ++a)
#pragma unroll
            for (int b = 0; b < 2; ++b)
#pragma unroll
                for (int m = 0; m < 4; ++m)
#pragma unroll
                    for (int n = 0; n < 2; ++n) acc[a][b][m][n] = (f32x4){0.f, 0.f, 0.f, 0.f};
        cur = nxt; cA = nA; cB = nB; ++ui;
#pragma unroll
        for (int h = 0; h < 2; ++h)
#pragma unroll
            for (int i = 0; i < 2; ++i) vAc[h][i] = vAn[h][i];
        if constexpr (ALIGN_EPI) { if (wr == 1) GP_BAR; }
    }
    GP_WAIT_V(0);
    if constexpr (!ALIGN_EPI) { if (wr == 0) GP_BAR; }
    GP_BAR;
#undef GP_SA
#undef GP_SB
#undef GP_STAGE
#undef GP_LDA
#undef GP_LDB
#undef GP_MMA
#undef GP_WAIT_V
#undef GP_WAIT_L
#undef GP_BAR
#undef GP_SCHED
}

typedef f32x4 Acc[2][2][4][2];
__device__ __forceinline__ u32x4 pack8(f32x4 v0, f32x4 v1) { u32x4 w; w.x = cvt_pk_bf16(v0[0], v0[1]); w.y = cvt_pk_bf16(v0[2], v0[3]); w.z = cvt_pk_bf16(v1[0], v1[1]); w.w = cvt_pk_bf16(v1[2], v1[3]); return w; }
__device__ __forceinline__ float sq4(f32x4 v) { return (v[0] * v[0] + v[1] * v[1]) + (v[2] * v[2] + v[3] * v[3]); }
__device__ __forceinline__ float fq_sum(float s) { s += __shfl_xor(s, 16); s += __shfl_xor(s, 32); return s; }

struct EpiPlain {
    static constexpr bool PERM = true;
    bf16* O; int ldc;
    __device__ __forceinline__ void operator()(const Acc& acc, const Unit& u, int wr, int wc, int fr, int fq) const {
        const int row0 = u.pm * BM + wr * 64 + fr, col0 = u.pn * BM + wc * 32 + 8 * fq;
#pragma unroll
        for (int ai = 0; ai < 2; ++ai)
#pragma unroll
            for (int m = 0; m < 4; ++m) { bf16* rowp = O + (size_t)(row0 + ai * HALF + m * 16) * ldc + col0;
#pragma unroll
                for (int bj = 0; bj < 2; ++bj) *(u32x4*)(rowp + bj * HALF) = pack8(acc[ai][bj][m][0], acc[ai][bj][m][1]); }
    }
};
struct EpiZ {
    static constexpr bool PERM = true;
    bf16* Z; const u64* ssin; u64* ssq; u64* sskv;
    __device__ __forceinline__ void operator()(const Acc& acc, const Unit& u, int wr, int wc, int fr, int fq) const {
        const int row0 = u.pm * BM + wr * 64 + fr, col0 = u.pn * BM + wc * 32 + 8 * fq;
#pragma unroll
        for (int ai = 0; ai < 2; ++ai)
#pragma unroll
            for (int m = 0; m < 4; ++m) { const int row = row0 + ai * HALF + m * 16; const float rs = __builtin_amdgcn_rsqf(fx_load(ssin + row) * (1.0f / D) + EPS);
                bf16* rowp = Z + (size_t)row * ZP + col0; float sq[2];
#pragma unroll
                for (int bj = 0; bj < 2; ++bj) { const f32x4 v0 = acc[ai][bj][m][0] * rs, v1 = acc[ai][bj][m][1] * rs; sq[bj] = sq4(v0) + sq4(v1); *(u32x4*)(rowp + bj * HALF) = pack8(v0, v1); }
                if (u.pn == 0) { const float s = fq_sum(sq[0] + sq[1]); if (fq == 0) atomic_addf(ssq + row, s); }
                else if (u.pn == 1) { const float s = fq_sum(sq[0]); if (fq == 0) atomic_addf(sskv + row, s); } }
    }
};
struct EpiMla {
    static constexpr bool PERM = true;
    bf16 *QA, *KA, *VA; const u64* ssq; const u64* sskv; const f32x2* tab32;
    __device__ __forceinline__ void operator()(const Acc& acc, const Unit& u, int wr, int wc, int fr, int fq) const {
        const int row0 = u.pm * BM + wr * 64 + fr, colw = u.pn * BM + wc * 32 + 8 * fq; const bool kv = (u.aux != 0);
#pragma unroll
        for (int ai = 0; ai < 2; ++ai)
#pragma unroll
            for (int m = 0; m < 4; ++m) { const int row = row0 + ai * HALF + m * 16;
                const float rs = kv ? __builtin_amdgcn_rsqf(fx_load(sskv + row) * (1.0f / 128) + EPS) : __builtin_amdgcn_rsqf(fx_load(ssq + row) * (1.0f / 256) + EPS);
#pragma unroll
                for (int bj = 0; bj < 2; ++bj) { const int n0 = colw + bj * HALF; f32x4 v0 = acc[ai][bj][m][0] * rs, v1 = acc[ai][bj][m][1] * rs;
                    if (kv) { const int h = n0 >> 7, d = n0 & 127; bf16* dst = (d < 64) ? KA + (size_t)row * KAP + h * 96 + d : VA + (size_t)row * VAP + h * 64 + (d - 64); *(u32x4*)dst = pack8(v0, v1); }
                    else if (n0 < 576) { const int h = n0 / 96, d = n0 - h * 96;
                        if (d >= 64) { const f32x2* cs = tab32 + (size_t)(row & (SEQ - 1)) * 16 + ((d - 64) >> 1); const f32x2 c0 = cs[0], c1 = cs[1], c2 = cs[2], c3 = cs[3];
                            f32x4 r0, r1; r0[0] = v0[0] * c0.x - v0[1] * c0.y; r0[1] = v0[1] * c0.x + v0[0] * c0.y; r0[2] = v0[2] * c1.x - v0[3] * c1.y; r0[3] = v0[3] * c1.x + v0[2] * c1.y;
                            r1[0] = v1[0] * c2.x - v1[1] * c2.y; r1[1] = v1[1] * c2.x + v1[0] * c2.y; r1[2] = v1[2] * c3.x - v1[3] * c3.y; r1[3] = v1[3] * c3.x + v1[2] * c3.y; v0 = r0; v1 = r1; }
                        *(u32x4*)(QA + (size_t)row * QAP + n0) = pack8(v0 * C2A, v1 * C2A); } } }
    }
};
struct EpiRes {
    static constexpr bool PERM = false;
    const float* base; float* XF; bf16* XB; u64* ss;
    __device__ __forceinline__ void operator()(const Acc& acc, const Unit& u, int wr, int wc, int fr, int fq) const {
        const int row0 = u.pm * BM + wr * 64 + fr, col0 = u.pn * BM + wc * 32 + 4 * fq;
#pragma unroll
        for (int ai = 0; ai < 2; ++ai)
#pragma unroll
            for (int m = 0; m < 4; ++m) { const int row = row0 + ai * HALF + m * 16; const size_t off = (size_t)row * D + col0; float s = 0.f;
#pragma unroll
                for (int bj = 0; bj < 2; ++bj)
#pragma unroll
                    for (int n = 0; n < 2; ++n) { const size_t o = off + bj * HALF + n * 16; const f32x4 v = *(const f32x4*)(base + o) + acc[ai][bj][m][n]; *(f32x4*)(XF + o) = v;
                        u32x2 w; w.x = cvt_pk_bf16(v[0], v[1]); w.y = cvt_pk_bf16(v[2], v[3]); *(u32x2*)(XB + o) = w; s += sq4(v); }
                s = fq_sum(s); if (fq == 0) atomic_addf(ss + row, s); }
    }
};
struct EpiGate {
    static constexpr bool PERM = false;
    float* XF; bf16* XB; const bf16* EB; const float* rs2; u64* ss;
    __device__ __forceinline__ void operator()(const Acc& acc, const Unit& u, int wr, int wc, int fr, int fq) const {
        const int row0 = u.pm * BM + wr * 64 + fr, col0 = u.pn * BM + wc * 32 + 4 * fq;
#pragma unroll
        for (int ai = 0; ai < 2; ++ai)
#pragma unroll
            for (int m = 0; m < 4; ++m) { const int row = row0 + ai * HALF + m * 16; const size_t off = (size_t)row * D + col0; const float rs = rs2[row]; float s = 0.f;
#pragma unroll
                for (int bj = 0; bj < 2; ++bj)
#pragma unroll
                    for (int n = 0; n < 2; ++n) { const size_t o = off + bj * HALF + n * 16; const f32x4 x2 = *(const f32x4*)(XF + o); const u32x2 e = *(const u32x2*)(EB + o); const f32x4 a = acc[ai][bj][m][n] * rs;
                        f32x4 v; v[0] = x2[0] + bflo(e.x) * sigmoidf_fast(a[0]); v[1] = x2[1] + bfhi(e.x) * sigmoidf_fast(a[1]); v[2] = x2[2] + bflo(e.y) * sigmoidf_fast(a[2]); v[3] = x2[3] + bfhi(e.y) * sigmoidf_fast(a[3]);
                        *(f32x4*)(XF + o) = v; u32x2 w; w.x = cvt_pk_bf16(v[0], v[1]); w.y = cvt_pk_bf16(v[2], v[3]); *(u32x2*)(XB + o) = w; s += sq4(v); }
                s = fq_sum(s); if (fq == 0) atomic_addf(ss + row, s); }
    }
};
struct MoeTab { LAS int* P; LAS int* C; };
__device__ __forceinline__ int ldsu(LAS int* p) { return __builtin_amdgcn_readfirstlane(*(volatile LAS int*)p); }
struct UpSched {
    MoeTab tb; const int* perm; const char* A; const char* B; int G, c;
    __device__ __forceinline__ bool next(int i, Unit& u) const {
        const int L = i * G + c, tot = ldsu(tb.P + NE) * 8; if (L >= tot) return false;
        const int rt = L >> 3, pn = L & 7; int e = 0;
        for (int j = 1; j < NE; ++j) e = (ldsu(tb.P + j) <= rt) ? j : e;
        u.pm = rt; u.pn = pn; u.aux = e | ((rt - ldsu(tb.P + e)) << 8); u.A = A; u.B = B + ((size_t)e * 2048 + (size_t)pn * BM) * D * 2; return true; }
    __device__ __forceinline__ unsigned rowoff(const Unit& u, int r) const { const int e = u.aux & 255, slot = (u.aux >> 8) * BM + r; int tok = 0; if (slot < ldsu(tb.C + e)) tok = perm[e * ECAP + slot] >> 2; return (unsigned)tok * (unsigned)(D * 2); }
};
struct DownSched {
    MoeTab tb; const char* A; const char* B; int G, c;
    __device__ __forceinline__ bool next(int i, Unit& u) const {
        const int L = i * G + c, tot = ldsu(tb.P + NE) * 4; if (L >= tot) return false;
        const int rt = L >> 2, pn = L & 3; int e = 0;
        for (int j = 1; j < NE; ++j) e = (ldsu(tb.P + j) <= rt) ? j : e;
        u.pm = rt; u.pn = pn; u.aux = e | ((rt - ldsu(tb.P + e)) << 8); u.A = A + (size_t)rt * BM * D * 2; u.B = B + ((size_t)e * D + (size_t)pn * BM) * D * 2; return true; }
    __device__ __forceinline__ unsigned rowoff(const Unit&, int r) const { return (unsigned)(r * D * 2); }
};
struct EpiUp {
    static constexpr bool PERM = true;
    bf16* ACT; const u64* ss1; const float* bup; const int* perm; MoeTab tb;
    __device__ __forceinline__ void operator()(const Acc& acc, const Unit& u, int wr, int wc, int fr, int fq) const {
        const int e = u.aux & 255, mt = u.aux >> 8, cnt = ldsu(tb.C + e); const int colh = wc * 32 + 8 * fq;
        const float* bp = bup + (size_t)e * 2048 + u.pn * BM + colh; const f32x4 bg0 = *(const f32x4*)bp, bg1 = *(const f32x4*)(bp + 4), bl0 = *(const f32x4*)(bp + HALF), bl1 = *(const f32x4*)(bp + HALF + 4);
#pragma unroll
        for (int ai = 0; ai < 2; ++ai)
#pragma unroll
            for (int m = 0; m < 4; ++m) { const int r = ai * HALF + wr * 64 + m * 16 + fr, slot = mt * BM + r; int tok = 0; if (slot < cnt) tok = perm[e * ECAP + slot] >> 2;
                const float rs = __builtin_amdgcn_rsqf(fx_load(ss1 + tok) * (1.0f / D) + EPS);
                f32x4 g[2], li[2], o[2]; g[0] = acc[ai][0][m][0] * rs + bg0; g[1] = acc[ai][0][m][1] * rs + bg1; li[0] = acc[ai][1][m][0] * rs + bl0; li[1] = acc[ai][1][m][1] * rs + bl1;
#pragma unroll
                for (int n = 0; n < 2; ++n)
#pragma unroll
                    for (int i = 0; i < 4; ++i) { const float xg = fminf(g[n][i], 7.0f), xl = fminf(fmaxf(li[n][i], -7.0f), 7.0f); o[n][i] = xg * sigmoidf_fast(1.702f * xg) * (xl + 1.0f); }
                *(u32x4*)(ACT + (size_t)(u.pm * BM + r) * D + u.pn * HALF + colh) = pack8(o[0], o[1]); }
    }
};
struct EpiDown {
    static constexpr bool PERM = true;
    bf16* Y; const float* bdn; const float* gates; const int* perm; MoeTab tb;
    __device__ __forceinline__ void operator()(const Acc& acc, const Unit& u, int wr, int wc, int fr, int fq) const {
        const int e = u.aux & 255, mt = u.aux >> 8, cnt = ldsu(tb.C + e); const int col0 = u.pn * BM + wc * 32 + 8 * fq;
        const float* bp = bdn + (size_t)e * D + col0; f32x4 b[2][2];
#pragma unroll
        for (int bj = 0; bj < 2; ++bj) { b[bj][0] = *(const f32x4*)(bp + bj * HALF); b[bj][1] = *(const f32x4*)(bp + bj * HALF + 4); }
#pragma unroll
        for (int ai = 0; ai < 2; ++ai)
#pragma unroll
            for (int m = 0; m < 4; ++m) { const int r = ai * HALF + wr * 64 + m * 16 + fr, slot = mt * BM + r;
                if (slot < cnt) { const int pair = perm[e * ECAP + slot]; const float gt = gates[pair]; bf16* rowp = Y + (size_t)pair * D + col0;
#pragma unroll
                    for (int bj = 0; bj < 2; ++bj) *(u32x4*)(rowp + bj * HALF) = pack8((acc[ai][bj][m][0] + b[bj][0]) * gt, (acc[ai][bj][m][1] + b[bj][1]) * gt); } }
    }
};
struct MlaSched {
    const char* Z; const char* Wq; const char* Wkv; int G, c;
    __device__ __forceinline__ bool next(int i, Unit& u) const {
        const int L = i * G + c; if (L >= 768) return false;
        const int kind = L / 384, rem = L - kind * 384, pm = rem / 3, pn = rem - pm * 3;
        u.pm = pm; u.pn = pn; u.aux = kind; u.A = Z + (size_t)pm * BM * ZP * 2 + (kind ? 256 : 0); u.B = (kind ? Wkv : Wq) + (size_t)pn * BM * 256 * 2; return true; }
    __device__ __forceinline__ unsigned rowoff(const Unit&, int r) const { return (unsigned)(r * ZP * 2); }
};
}

namespace at {
typedef LAS const char* lds_cptr;
__device__ __forceinline__ int crow(int r, int hi) { return (r & 3) + 8 * (r >> 2) + 4 * hi; }
__device__ __forceinline__ void glds16(const void* gsrc, unsigned lds_dst) { unsigned keep;
    asm volatile("s_mov_b32 %0, m0\n\ts_mov_b32 m0, %2\n\ts_nop 0\n\tglobal_load_lds_dwordx4 %1, off\n\ts_mov_b32 m0, %0" : "=&s"(keep) : "v"(gsrc), "s"(lds_dst) : "memory"); }
#define AT_WAIT_BAR(N) asm volatile("s_waitcnt vmcnt(" #N ") lgkmcnt(0)\n\ts_barrier" ::: "memory")
#define AT_MX3(a, b, c) __builtin_fmaxf(__builtin_fmaxf((a), (b)), (c))
__device__ __forceinline__ float rowmax(const f32x16& p0, const f32x16& p1) {
    float a = AT_MX3(p0[0], p0[1], p1[0]), b = AT_MX3(p0[2], p0[3], p1[1]); a = AT_MX3(a, p1[2], p1[3]);
#pragma unroll
    for (int r = 4; r < 16; r += 4) { a = AT_MX3(a, p0[r], p0[r + 1]); b = AT_MX3(b, p0[r + 2], p0[r + 3]); a = AT_MX3(a, p1[r], p1[r + 1]); b = AT_MX3(b, p1[r + 2], p1[r + 3]); }
    const float m = __builtin_fmaxf(a, b); auto rr = __builtin_amdgcn_permlane32_swap(__float_as_uint(m), __float_as_uint(m), false, false);
    return __builtin_fmaxf(__uint_as_float(rr[0]), __uint_as_float(rr[1]));
}
template <int DKC> __device__ __forceinline__ void qkt(f32x16& p0, f32x16& p1, lds_cptr Kslot, const bf16x8* qr, int r32, int hi) {
    lds_cptr kb = Kslot + hi * 1024 + r32 * 16; const f32x16 z = {};
#pragma unroll
    for (int d0 = 0; d0 < DKC; ++d0) {
        const bf16x8 b0 = *(const LAS bf16x8*)(kb + d0 * 2048), b1 = *(const LAS bf16x8*)(kb + d0 * 2048 + 512);
        if (d0 == 0) { p0 = __builtin_amdgcn_mfma_f32_32x32x16_bf16(b0, qr[0], z, 0, 0, 0); p1 = __builtin_amdgcn_mfma_f32_32x32x16_bf16(b1, qr[0], z, 0, 0, 0); }
        else { p0 = __builtin_amdgcn_mfma_f32_32x32x16_bf16(b0, qr[d0], p0, 0, 0, 0); p1 = __builtin_amdgcn_mfma_f32_32x32x16_bf16(b1, qr[d0], p1, 0, 0, 0); } }
}
__device__ __forceinline__ void pv(f32x16* o, int vb, bf16x8 pa0, bf16x8 pa1, bf16x8 pa2, bf16x8 pa3) {
#pragma unroll
    for (int d0 = 0; d0 < 2; ++d0) { s16x4 lo[4], hi[4];
#pragma unroll
        for (int ks = 0; ks < 4; ++ks) {
            asm volatile("ds_read_b64_tr_b16 %0,%1 offset:%c2" : "=&v"(lo[ks]) : "v"(vb), "i"(d0 * 4096 + ks * 1024) : "memory");
            asm volatile("ds_read_b64_tr_b16 %0,%1 offset:%c2" : "=&v"(hi[ks]) : "v"(vb), "i"(d0 * 4096 + ks * 1024 + 512) : "memory"); }
        asm volatile("s_waitcnt lgkmcnt(0)" ::: "memory"); __builtin_amdgcn_sched_barrier(0);
#define AT_PK(k) (bf16x8){lo[k][0], lo[k][1], lo[k][2], lo[k][3], hi[k][0], hi[k][1], hi[k][2], hi[k][3]}
        o[d0] = __builtin_amdgcn_mfma_f32_32x32x16_bf16(pa0, AT_PK(0), o[d0], 0, 0, 0);
        o[d0] = __builtin_amdgcn_mfma_f32_32x32x16_bf16(pa1, AT_PK(1), o[d0], 0, 0, 0);
        o[d0] = __builtin_amdgcn_mfma_f32_32x32x16_bf16(pa2, AT_PK(2), o[d0], 0, 0, 0);
        o[d0] = __builtin_amdgcn_mfma_f32_32x32x16_bf16(pa3, AT_PK(3), o[d0], 0, 0, 0);
#undef AT_PK
    }
}
template <int DKC> struct Lay { static constexpr int KSLOT = DKC * 2048, LDS_K = 0, LDS_V = 3 * KSLOT, LDS_WS = LDS_V + 3 * 8192, LDS_OST = LDS_WS + NWAVES * 256, BYTES = LDS_OST + NWAVES * 4096; };
template <int DKC, int MODE>
__device__ __forceinline__ void attn_unit(const bf16* Qu, int qp, const bf16* Kh, int kp, const bf16* Vh, int vp, bf16* Ou, int op, int t0, int t1, int qpos0, float sinkl2, char* shm) {
    typedef Lay<DKC> LY;
    const int tid = opaque_tid(), lane = tid & 63, r32 = lane & 31, hi = lane >> 5; const int wid = __builtin_amdgcn_readfirstlane(tid >> 6);
    const unsigned lds0 = (unsigned)(uintptr_t)shm;
    const lds_cptr shm3 = (lds_cptr)shm;
    LAS float* wsf = (LAS float*)(shm3 + LY::LDS_WS) + wid * 64;
    const bf16* Qw = Qu + (size_t)(wid * 32) * qp;
    const bool k2 = (wid + 8 < 2 * DKC);
    const bf16* ksrc = Kh + (size_t)lane * kp + wid * 8;
    const bf16* vsrc = Vh + (size_t)(16 * (wid & 3) + (lane >> 2)) * vp + (wid >> 2) * 32 + (lane & 3) * 8;
    const unsigned kdst = lds0 + LY::LDS_K + wid * 1024, vdst = lds0 + LY::LDS_V + wid * 1024;
#define AT_DMA(t, s) do { glds16(ksrc + (size_t)(t) * 64 * kp, (unsigned)__builtin_amdgcn_readfirstlane(kdst + (s) * LY::KSLOT)); \
        if (k2) glds16(ksrc + (size_t)(t) * 64 * kp + 64, (unsigned)__builtin_amdgcn_readfirstlane(kdst + (s) * LY::KSLOT + 8192)); \
        glds16(vsrc + (size_t)(t) * 64 * vp, (unsigned)__builtin_amdgcn_readfirstlane(vdst + (s) * 8192)); } while (0)
    const int vb0 = (int)(lds0 + LY::LDS_V) + ((lane >> 4) & 1) * 32 + (lane & 3) * 8 + (4 * hi + ((lane & 15) >> 2)) * 64;
    bf16x8 qr[DKC];
#pragma unroll
    for (int d0 = 0; d0 < DKC; ++d0) qr[d0] = *(const bf16x8*)(Qw + (size_t)r32 * qp + d0 * 16 + hi * 8);
    AT_DMA(t0, 0);
    float mrun = -INFINITY, l = 0.f; f32x16 o[2]; o[0] = f32x16{}; o[1] = f32x16{};
    const int qpos = qpos0 + wid * 32 + r32;
    int sl = 0;
    for (int t = t0; t < t1; ++t) {
        const bool more = (t + 1 < t1); const int sn = (sl == 2) ? 0 : sl + 1;
        if (more) { AT_DMA(t + 1, sn); if (k2) AT_WAIT_BAR(3); else AT_WAIT_BAR(2); } else AT_WAIT_BAR(0);
        f32x16 p0, p1;
        qkt<DKC>(p0, p1, shm3 + LY::LDS_K + sl * LY::KSLOT, qr, r32, hi);
        if (MODE == 1) { const int kb = t * 64 + 4 * hi;
#pragma unroll
            for (int r = 0; r < 16; ++r) { const int d0 = kb + (r & 3) + 8 * (r >> 2) - qpos, d1 = d0 + 32; if (d0 > 128 || d0 < -128) p0[r] = -INFINITY; if (d1 > 128 || d1 < -128) p1[r] = -INFINITY; } }
        const float rm = rowmax(p0, p1), mnew = __builtin_fmaxf(mrun, rm), mref = (mnew == -INFINITY) ? 0.f : mnew;
        const float alpha = __builtin_amdgcn_exp2f(mrun - mref); mrun = mnew;
        float s = 0.f;
#pragma unroll
        for (int r = 0; r < 16; ++r) { p0[r] = __builtin_amdgcn_exp2f(p0[r] - mref); p1[r] = __builtin_amdgcn_exp2f(p1[r] - mref); s += p0[r] + p1[r]; }
        l = l * alpha + s;
        if (__any(alpha != 1.0f)) { if (hi == 0) wsf[r32] = alpha; LDS_WAIT();
#pragma unroll
            for (int r = 0; r < 16; ++r) { const float f = wsf[crow(r, hi)]; o[0][r] *= f; o[1][r] *= f; } }
        u32x4 pw0, pw1, pw2, pw3;
        pw0 = (u32x4){cvt_pk_bf16(p0[0], p0[1]), cvt_pk_bf16(p0[2], p0[3]), cvt_pk_bf16(p0[4], p0[5]), cvt_pk_bf16(p0[6], p0[7])};
        pw1 = (u32x4){cvt_pk_bf16(p0[8], p0[9]), cvt_pk_bf16(p0[10], p0[11]), cvt_pk_bf16(p0[12], p0[13]), cvt_pk_bf16(p0[14], p0[15])};
        pw2 = (u32x4){cvt_pk_bf16(p1[0], p1[1]), cvt_pk_bf16(p1[2], p1[3]), cvt_pk_bf16(p1[4], p1[5]), cvt_pk_bf16(p1[6], p1[7])};
        pw3 = (u32x4){cvt_pk_bf16(p1[8], p1[9]), cvt_pk_bf16(p1[10], p1[11]), cvt_pk_bf16(p1[12], p1[13]), cvt_pk_bf16(p1[14], p1[15])};
        __builtin_amdgcn_sched_barrier(0);
        pv(o, vb0 + sl * 8192, __builtin_bit_cast(bf16x8, pw0), __builtin_bit_cast(bf16x8, pw1), __builtin_bit_cast(bf16x8, pw2), __builtin_bit_cast(bf16x8, pw3));
        sl = sn;
    }
    { auto rr = __builtin_amdgcn_permlane32_swap(__float_as_uint(l), __float_as_uint(l), false, false); l = __uint_as_float(rr[0]) + __uint_as_float(rr[1]); }
    if (MODE == 1) l += __builtin_amdgcn_exp2f(sinkl2 - mrun);
    if (hi == 0) wsf[32 + r32] = l; LDS_WAIT();
    float rli[16];
#pragma unroll
    for (int r = 0; r < 16; ++r) rli[r] = __builtin_amdgcn_rcpf(wsf[32 + crow(r, hi)]);
    bf16* Ow = Ou + (size_t)(wid * 32) * op;
    { LAS bf16* stg = (LAS bf16*)(shm3 + LY::LDS_OST) + wid * 2048;
#pragma unroll
        for (int r = 0; r < 16; ++r) { const int orow = crow(r, hi);
#pragma unroll
            for (int d0 = 0; d0 < 2; ++d0) stg[orow * 64 + d0 * 32 + r32] = (bf16)(cvt_pk_bf16(o[d0][r] * rli[r], 0.f) & 0xffffu); }
        LDS_WAIT();
#pragma unroll
        for (int i = 0; i < 4; ++i) { const int row = i * 8 + (lane >> 3), ch = lane & 7; const u32x4 v = *(const LAS u32x4*)(stg + row * 64 + ch * 8); *(u32x4*)(Ow + (size_t)row * op + ch * 8) = v; } }
    asm volatile("s_waitcnt lgkmcnt(0)\n\ts_barrier" ::: "memory");
#undef AT_DMA
}
}

struct Args {
    const float *x, *p, *attn_norm, *w_in, *mla_q_norm, *mla_wq_up, *mla_kv_norm, *mla_wkv_up, *gqa_q_norm, *gqa_k_norm, *swa_sink, *w_out, *moe_norm, *router_w, *router_b,
        *w_up, *b_up, *w_down, *b_down, *ple_norm, *w_ple, *w_ple_gate, *final_norm;
    float* out; unsigned char* ws;
};
struct Ctx { LAS unsigned char* lds; int tid, lane, wave, vcu, G, gw, NGW; };

template <class RMap>
__device__ __forceinline__ void tr_item(const float* W, int N, bf16* WT, int ldo, int kofs, const float* gain, RMap rmap, LAS float* scr, int kb, int nb, int lane) {
    const int k0 = 64 * kb, n0 = 32 * nb;
#pragma unroll 8
    for (int i = 0; i < 32; ++i) { const int kk = 2 * i + (lane >> 5); float w = W[(size_t)(k0 + kk) * N + n0 + (lane & 31)]; if (gain) w *= gain[k0 + kk]; scr[kk * 33 + (lane & 31)] = w; }
    LDS_WAIT(); asm volatile("" ::: "memory");
    const int c = lane & 7;
#pragma unroll
    for (int j = 0; j < 4; ++j) { const int n = (lane >> 3) + 8 * j; const LAS float* s = scr + (8 * c) * 33 + n;
        u32x4 o; o.x = cvt_pk_bf16(s[0 * 33], s[1 * 33]); o.y = cvt_pk_bf16(s[2 * 33], s[3 * 33]); o.z = cvt_pk_bf16(s[4 * 33], s[5 * 33]); o.w = cvt_pk_bf16(s[6 * 33], s[7 * 33]);
        *(u32x4*)(WT + (size_t)rmap(n0 + n) * ldo + kofs + k0 + 8 * c) = o; }
    LDS_WAIT(); asm volatile("" ::: "memory");
}
struct MapId { __device__ __forceinline__ int operator()(int n) const { return n; } };
struct MapQ { __device__ __forceinline__ int operator()(int n) const { const int h = n / 96, d = n - h * 96; if (d < 64) return n; const int j = d - 64; return h * 96 + 64 + ((j < 16) ? 2 * j : 2 * (j - 16) + 1); } };
struct MapUp { __device__ __forceinline__ int operator()(int n) const { if (n < 1024) return (n >> 7) * 256 + (n & 127); const int m = n - 1024; return (m >> 7) * 256 + 128 + (m & 127); } };

__device__ __forceinline__ void zero16(bf16* base, size_t n16, const Ctx& C) {
    const u32x4 z = {0u, 0u, 0u, 0u};
    for (size_t i = (size_t)C.gw * 64 + C.lane; i < n16; i += (size_t)C.NGW * 64) ((u32x4*)base)[i] = z;
}

__device__ __forceinline__ void prologue(const Args& a, const Ctx& C) {
    unsigned char* ws = launder(a.ws);
    LAS float* scr = (LAS float*)(C.lds + C.wave * 16384);
    constexpr int I_UP = 16 * 64, I_DN = 16 * 32, I_IN = 16 * 49, I_OUT = 16 * 32, I_G = 16 * 32, I_Q = 4 * 18, I_KV = 2 * 24, I_PLE = 4 * 32;
    constexpr int N_UP = NL * NE * I_UP, N_DN = NL * NE * I_DN, N_IN = NL * I_IN, N_OUT = NL * I_OUT, N_G = NL * I_G, N_Q = NL * I_Q, N_KV = NL * I_KV, N_PLE = NL * I_PLE;
    constexpr int NITEMS = N_UP + N_DN + N_IN + N_OUT + N_G + N_Q + N_KV + N_PLE;
    for (int it = C.gw; it < NITEMS; it += C.NGW) {
        int r = it;
        if (r < N_UP) { const int le = r / I_UP, q = r - le * I_UP, l = le / NE; tr_item(a.w_up + (size_t)le * D * 2048, 2048, (bf16*)(ws + WS_WUP) + (size_t)le * 2048 * D, D, 0, a.moe_norm + l * D, MapUp(), scr, q / 64, q % 64, C.lane); continue; } r -= N_UP;
        if (r < N_DN) { const int le = r / I_DN, q = r - le * I_DN; tr_item(a.w_down + (size_t)le * D * D, D, (bf16*)(ws + WS_WDN) + (size_t)le * D * D, D, 0, nullptr, MapId(), scr, q / 32, q % 32, C.lane); continue; } r -= N_DN;
        if (r < N_IN) { const int l = r / I_IN, q = r - l * I_IN; tr_item(a.w_in + (size_t)l * D * 1568, 1568, (bf16*)(ws + WS_WIN) + (size_t)l * ZP * D, D, 0, a.attn_norm + l * D, MapId(), scr, q / 49, q % 49, C.lane); continue; } r -= N_IN;
        if (r < N_OUT) { const int l = r / I_OUT, q = r - l * I_OUT; tr_item(a.w_out + (size_t)l * D * D, D, (bf16*)(ws + WS_WOUT) + (size_t)l * D * D, D, 0, nullptr, MapId(), scr, q / 32, q % 32, C.lane); continue; } r -= N_OUT;
        if (r < N_G) { const int l = r / I_G, q = r - l * I_G; tr_item(a.w_ple_gate + (size_t)l * D * D, D, (bf16*)(ws + WS_WG) + (size_t)l * D * D, D, 0, a.ple_norm + l * D, MapId(), scr, q / 32, q % 32, C.lane); continue; } r -= N_G;
        if (r < N_Q) { const int l = r / I_Q, q = r - l * I_Q; tr_item(a.mla_wq_up + (size_t)l * 256 * 576, 576, (bf16*)(ws + WS_WQ) + (size_t)l * 768 * 256, 256, 0, a.mla_q_norm + l * 256, MapQ(), scr, q / 18, q % 18, C.lane); continue; } r -= N_Q;
        if (r < N_KV) { const int l = r / I_KV, q = r - l * I_KV; tr_item(a.mla_wkv_up + (size_t)l * 128 * 768, 768, (bf16*)(ws + WS_WKV) + (size_t)l * 768 * 256, 256, 128, a.mla_kv_norm + l * 128, MapId(), scr, q / 24, q % 24, C.lane); continue; } r -= N_KV;
        { const int l = r / I_PLE, q = r - l * I_PLE; tr_item(a.w_ple + (size_t)l * 256 * D, D, (bf16*)(ws + WS_WPLE) + (size_t)l * D * 256, 256, 0, nullptr, MapId(), scr, q / 32, q % 32, C.lane); }
    }
    for (int l = 0; l < NL; ++l) {
        zero16((bf16*)(ws + WS_WIN) + ((size_t)l * ZP + 1568) * D, (size_t)(ZP - 1568) * D / 8, C);
        zero16((bf16*)(ws + WS_WQ) + ((size_t)l * 768 + 576) * 256, (size_t)192 * 256 / 8, C);
    }
    for (int i = C.gw * 64 + C.lane; i < NL * 768 * 16; i += C.NGW * 64) { const int row = i >> 4, pc = i & 15; *(u32x4*)((bf16*)(ws + WS_WKV) + (size_t)row * 256 + pc * 8) = (u32x4){0u, 0u, 0u, 0u}; }
    for (int m = C.gw; m < T; m += C.NGW) {
        const f32x4* xr = (const f32x4*)(a.x + (size_t)m * D) + C.lane; f32x4 v[4]; float s = 0.f;
#pragma unroll
        for (int j = 0; j < 4; ++j) { v[j] = xr[64 * j]; s += (v[j][0] * v[j][0] + v[j][1] * v[j][1]) + (v[j][2] * v[j][2] + v[j][3] * v[j][3]); }
        s = wave_sum(s);
        u32x2* o8 = (u32x2*)((bf16*)(ws + WS_XB) + (size_t)m * D) + C.lane;
#pragma unroll
        for (int j = 0; j < 4; ++j) { u32x2 w; w.x = cvt_pk_bf16(v[j][0], v[j][1]); w.y = cvt_pk_bf16(v[j][2], v[j][3]); o8[64 * j] = w; }
        if (C.lane == 0) __hip_atomic_store((u64*)(ws + WS_SS0) + m, fx_enc(s), RLX_AGENT);
    }
    for (size_t i = (size_t)C.gw * 64 + C.lane; i < (size_t)NL * T * 256 / 8; i += (size_t)C.NGW * 64) {
        const f32x4 v0 = ((const f32x4*)a.p)[2 * i], v1 = ((const f32x4*)a.p)[2 * i + 1];
        u32x4 w; w.x = cvt_pk_bf16(v0[0], v0[1]); w.y = cvt_pk_bf16(v0[2], v0[3]); w.z = cvt_pk_bf16(v1[0], v1[1]); w.w = cvt_pk_bf16(v1[2], v1[3]); ((u32x4*)(ws + WS_PB))[i] = w; }
    for (int i = C.gw * 64 + C.lane; i < SEQ * 48; i += C.NGW * 64) {
        int pos, j; double ex; f32x2* dst;
        if (i < SEQ * 16) { pos = i >> 4; j = i & 15; ex = (double)j / 16.0; dst = (f32x2*)(ws + WS_TAB32) + i; }
        else { const int q = i - SEQ * 16; pos = q >> 5; j = q & 31; ex = (double)j / 32.0; dst = (f32x2*)(ws + WS_TAB64) + q; }
        const float inv = (float)exp2(-13.287712379549449 * ex);
        const float angf = (float)pos * inv;
        const double rev = (double)angf * 0.15915494309189535; const float fr = (float)(rev - floor(rev));
        *dst = (f32x2){__builtin_amdgcn_cosf(fr), __builtin_amdgcn_sinf(fr)};
    }
    for (int i = C.gw * 64 + C.lane; i < NL * D * NE; i += C.NGW * 64) { const int l = i / (D * NE), k = (i / NE) % D; ((float*)(ws + WS_WR))[i] = a.router_w[i] * a.moe_norm[l * D + k]; }
    for (int i = C.gw * 64 + C.lane; i < NL * NE * 2048; i += C.NGW * 64) { const int le = i / 2048, n = i % 2048; ((float*)(ws + WS_BUP))[(size_t)le * 2048 + MapUp()(n)] = a.b_up[i]; }
}
namespace gp { }
__device__ __forceinline__ float sq4g(f32x4 v) { return (v[0] * v[0] + v[1] * v[1]) + (v[2] * v[2] + v[3] * v[3]); }

__device__ __forceinline__ void rope_phase(const Args& a, const Ctx& C, int l) {
    unsigned char* ws = launder(a.ws);
    const bf16* Z = (const bf16*)(ws + WS_Z); const f32x2* tab32 = (const f32x2*)(ws + WS_TAB32); const f32x2* tab64 = (const f32x2*)(ws + WS_TAB64);
    bf16 *KA = (bf16*)(ws + WS_KA), *QB = (bf16*)(ws + WS_QB), *KB = (bf16*)(ws + WS_KB), *VB = (bf16*)(ws + WS_VB), *QC = (bf16*)(ws + WS_QC), *KC = (bf16*)(ws + WS_KC), *VC = (bf16*)(ws + WS_VC);
    const int lane = C.lane;
    const float gq = a.gqa_q_norm[l * 64 + lane], gk = a.gqa_k_norm[l * 64 + lane];
    for (int t = C.gw; t < T; t += C.NGW) {
        const int pos = t & (SEQ - 1), prow = pos >> 6, pcol = pos & 63; const bf16* zr = Z + (size_t)t * ZP;
        {
            const float v = bf2f(zr[384 + (lane & 31)]); const float pr = __shfl_xor(v, 16); const int j = lane & 15; const f32x2 cs = tab32[pos * 16 + j];
            const float o = (lane & 16) ? (v * cs.x + pr * cs.y) : (v * cs.x - pr * cs.y); const bf16 ob = (bf16)(cvt_pk_bf16(o, 0.f) & 0xffffu);
            if (lane < 32) { const int dest = 64 + 2 * j + ((lane >> 4) & 1);
#pragma unroll
                for (int h = 0; h < 6; ++h) KA[(size_t)t * KAP + h * 96 + dest] = ob; }
        }
#pragma unroll
        for (int hb = 0; hb < 10; ++hb) {
            float v = bf2f(zr[ZB + hb * 64 + lane]);
            if (hb < 8) { const float ss = wave_sum(v * v); const float n = v * __builtin_amdgcn_rsqf(ss * (1.0f / 64) + EPS) * (hb < 6 ? gq : gk);
                const float pr = __shfl_xor(n, 16); const int j = lane & 15; const f32x2 cs = tab32[((lane & 32) ? pcol : prow) * 16 + j];
                v = (lane & 16) ? (n * cs.x + pr * cs.y) : (n * cs.x - pr * cs.y); if (hb < 6) v *= C2B; }
            const bf16 ob = (bf16)(cvt_pk_bf16(v, 0.f) & 0xffffu);
            if (hb < 6) QB[(size_t)t * QBP + hb * 64 + lane] = ob; else if (hb < 8) KB[(size_t)t * KBP + (hb - 6) * 64 + lane] = ob; else VB[(size_t)t * VBP + (hb - 8) * 64 + lane] = ob;
        }
#pragma unroll
        for (int hc = 0; hc < 8; ++hc) {
            float v = bf2f(zr[ZC + hc * 64 + lane]);
            if (hc < 6) { const float pr = __shfl_xor(v, 32); const f32x2 cs = tab64[pos * 32 + (lane & 31)]; v = (lane & 32) ? (v * cs.x + pr * cs.y) : (v * cs.x - pr * cs.y); if (hc < 4) v *= C2B; }
            const bf16 ob = (bf16)(cvt_pk_bf16(v, 0.f) & 0xffffu);
            if (hc < 4) QC[(size_t)t * QCP + hc * 64 + lane] = ob; else if (hc < 6) KC[(size_t)t * KCP + (hc - 4) * 64 + lane] = ob; else VC[(size_t)t * VCP + (hc - 6) * 64 + lane] = ob;
        }
    }
}

__device__ __forceinline__ void router_phase(const Args& a, const Ctx& C, int l) {
    unsigned char* ws = launder(a.ws);
    const float* XF = (const float*)(ws + WS_XF); const float* WR = (const float*)(ws + WS_WR) + (size_t)l * D * NE; const u64* ss1 = (const u64*)(ws + WS_CTL + (size_t)CW_SS * 4) + (size_t)(l * 4 + 2) * T;
    int* cnt = (int*)(ws + WS_CTL) + CW_CNT + l * NE; int* perm = (int*)(ws + WS_PERM); float* gates = (float*)(ws + WS_GATES);
    LAS float* part = (LAS float*)C.lds;
    LAS int* hist = (LAS int*)(C.lds + MISC_OFF + 1024); LAS int* base = hist + NE;
    const int lane = C.lane, r32 = lane & 31, hi = lane >> 5, tg = C.wave & 3, kh = C.wave >> 2;
    for (int blk = C.vcu; blk < T / 128; blk += C.G) {
        const int t0 = blk * 128;
        if (C.tid < NE) hist[C.tid] = 0;
        f32x16 acc = {};
        const float* xr = XF + (size_t)(t0 + tg * 32 + r32) * D + kh * 512 + hi * 4; const float* wr = WR + (size_t)(kh * 512 + hi * 4) * NE + r32;
#pragma unroll 4
        for (int ks = 0; ks < 64; ++ks) { const f32x4 xv = *(const f32x4*)(xr + ks * 8);
#pragma unroll
            for (int i = 0; i < 4; ++i) acc = __builtin_amdgcn_mfma_f32_32x32x2f32(wr[(ks * 8 + i) * NE], xv[i], acc, 0, 0, 0); }
#pragma unroll
        for (int r = 0; r < 16; ++r) part[(kh * 128 + tg * 32 + r32) * 33 + at::crow(r, hi)] = acc[r];
        __syncthreads();
        int ek[4]; float wk[4]; int rk[4]; const int t = t0 + C.tid;
        if (C.tid < 128) {
            const float rs = __builtin_amdgcn_rsqf(fx_load(ss1 + t) * (1.0f / D) + EPS); float v[NE];
#pragma unroll
            for (int e = 0; e < NE; ++e) v[e] = (part[C.tid * 33 + e] + part[(128 + C.tid) * 33 + e]) * rs + a.router_b[l * NE + e];
            unsigned used = 0u; float tv[4];
#pragma unroll
            for (int k = 0; k < 4; ++k) { float best = -INFINITY; int bi = 0;
#pragma unroll
                for (int e = 0; e < NE; ++e) { const bool ok = !((used >> e) & 1u) && (v[e] > best); best = ok ? v[e] : best; bi = ok ? e : bi; }
                used |= 1u << bi; ek[k] = bi; tv[k] = best; }
            float den = 0.f;
#pragma unroll
            for (int k = 0; k < 4; ++k) { wk[k] = __expf(tv[k] - tv[0]); den += wk[k]; }
            const float rd = 1.0f / den;
#pragma unroll
            for (int k = 0; k < 4; ++k) { wk[k] *= rd; rk[k] = atomicAdd((int*)(hist + ek[k]), 1); }
        }
        __syncthreads();
        if (C.tid < NE) base[C.tid] = atomicAdd(cnt + C.tid, hist[C.tid]);
        __syncthreads();
        if (C.tid < 128) {
#pragma unroll
            for (int k = 0; k < 4; ++k) { __hip_atomic_store(perm + ek[k] * ECAP + base[ek[k]] + rk[k], t * 4 + k, RLX_AGENT); __hip_atomic_store(gates + t * 4 + k, wk[k], RLX_AGENT); }
        }
        __syncthreads();
    }
}

__device__ __forceinline__ void combine_phase(const Args& a, const Ctx& C) {
    unsigned char* ws = launder(a.ws); float* XF = (float*)(ws + WS_XF); const bf16* Y = (const bf16*)(ws + WS_Y); bf16* X2B = (bf16*)(ws + WS_X2B); float* rs2 = (float*)(ws + WS_RS2);
    for (int t = C.gw; t < T; t += C.NGW) {
        f32x4* xr = (f32x4*)(XF + (size_t)t * D) + C.lane; f32x4 v[4]; float s = 0.f;
#pragma unroll
        for (int j = 0; j < 4; ++j) v[j] = xr[64 * j];
#pragma unroll
        for (int k = 0; k < 4; ++k) { const u32x2* yr = (const u32x2*)(Y + (size_t)(t * 4 + k) * D) + C.lane;
#pragma unroll
            for (int j = 0; j < 4; ++j) { const u32x2 w = yr[64 * j]; v[j][0] += bflo(w.x); v[j][1] += bfhi(w.x); v[j][2] += bflo(w.y); v[j][3] += bfhi(w.y); } }
        u32x2* o8 = (u32x2*)(X2B + (size_t)t * D) + C.lane;
#pragma unroll
        for (int j = 0; j < 4; ++j) { xr[64 * j] = v[j]; u32x2 w; w.x = cvt_pk_bf16(v[j][0], v[j][1]); w.y = cvt_pk_bf16(v[j][2], v[j][3]); o8[64 * j] = w; s += sq4g(v[j]); }
        s = wave_sum(s);
        if (C.lane == 0) __hip_atomic_store(rs2 + t, __builtin_amdgcn_rsqf(s * (1.0f / D) + EPS), RLX_AGENT);
    }
}
__device__ __forceinline__ void final_phase(const Args& a, const Ctx& C) {
    const float* XF = (const float*)(launder(a.ws) + WS_XF);
    for (int t = C.gw; t < T; t += C.NGW) {
        const f32x4* xr = (const f32x4*)(XF + (size_t)t * D) + C.lane; f32x4 v[4]; float s = 0.f;
#pragma unroll
        for (int j = 0; j < 4; ++j) { v[j] = xr[64 * j]; s += sq4g(v[j]); }
        s = wave_sum(s); const float rs = 1.0f / sqrtf(s * (1.0f / D) + EPS);
        f32x4* o = (f32x4*)(a.out + (size_t)t * D) + C.lane; const f32x4* g = (const f32x4*)a.final_norm + C.lane;
#pragma unroll
        for (int j = 0; j < 4; ++j) o[64 * j] = v[j] * rs * g[64 * j];
    }
}

__device__ __forceinline__ Ctx make_ctx(LAS unsigned char* lds) {
    Ctx C; C.lds = lds; C.tid = opaque_tid(); C.lane = C.tid & 63; C.wave = __builtin_amdgcn_readfirstlane(C.tid >> 6);
    C.G = gridDim.x; const int bx = blockIdx.x; C.vcu = (C.G % 8 == 0) ? (bx % 8) * (C.G / 8) + bx / 8 : bx; C.gw = C.vcu * NWAVES + C.wave; C.NGW = C.G * NWAVES; return C;
}
#define GRID_BAR() do { XcdBarrier b_; b_.bar = (unsigned*)(launder(a.ws) + WS_CTL) + CW_BAR; b_.x = xb_xcc_id(); b_.st = (volatile LAS unsigned*)(lds + MISC_OFF); xcd_barrier(b_); } while (0)
__global__ void __launch_bounds__(NWAVES * 64, 2) fwd(Args a) {
    extern __shared__ __attribute__((aligned(16))) unsigned char lds_raw[];
    LAS unsigned char* lds = (LAS unsigned char*)lds_raw;
    for (int u = threadIdx.x; u < (LDS_BYTES - MISC_OFF) / 4; u += NWAVES * 64) ((LAS unsigned*)(lds + MISC_OFF))[u] = 0u;
    __syncthreads();
    (void)xcd_barrier_post((unsigned*)(launder(a.ws) + WS_CTL) + CW_BAR, (volatile LAS unsigned*)(lds + MISC_OFF));
    const int bx = blockIdx.x;

    PH(0) { const Ctx C = make_ctx(lds); prologue(a, C); }
    GRID_BAR();

#pragma unroll 1
    for (int l = 0; l < NL; ++l) {
        PH(1) { unsigned char* ws = launder(a.ws); u64* ssb = (u64*)(ws + WS_CTL + (size_t)CW_SS * 4) + (size_t)l * 4 * T;
          const u64* ssin = (l == 0) ? (const u64*)(ws + WS_SS0) : (const u64*)(ws + WS_CTL + (size_t)CW_SS * 4) + (size_t)((l - 1) * 4 + 3) * T;
          gp::DenseSched S; S.init(ws + WS_XB, D, (bf16*)(ws + WS_WIN) + (size_t)l * ZP * D, D, T, ZP, gridDim.x, bx);
          gp::EpiZ E{(bf16*)(ws + WS_Z), ssin, ssb, ssb + T};
          gp::gemm_phase<gp::EpiZ, gp::DenseSched, true>(lds, D, S, E); }
        GRID_BAR();
        PH(2) { const Ctx C = make_ctx(lds); rope_phase(a, C, l); }
        PH(3) { unsigned char* ws = launder(a.ws); u64* ssb = (u64*)(ws + WS_CTL + (size_t)CW_SS * 4) + (size_t)l * 4 * T;
          gp::MlaSched S{(const char*)(ws + WS_Z), (const char*)((bf16*)(ws + WS_WQ) + (size_t)l * 768 * 256), (const char*)((bf16*)(ws + WS_WKV) + (size_t)l * 768 * 256), (int)gridDim.x, bx};
          gp::EpiMla E{(bf16*)(ws + WS_QA), (bf16*)(ws + WS_KA), (bf16*)(ws + WS_VA), ssb, ssb + T, (const f32x2*)(ws + WS_TAB32)};
          gp::gemm_phase<gp::EpiMla, gp::MlaSched, true>(lds, 256, S, E); }
        GRID_BAR();
        {
            char* shm = (char*)lds_raw; const int G = gridDim.x, vcu = (G % 8 == 0) ? (bx % 8) * (G / 8) + bx / 8 : bx;
            PH(4) { unsigned char* ws = launder(a.ws); bf16 *QA = (bf16*)(ws + WS_QA), *KA = (bf16*)(ws + WS_KA), *VA = (bf16*)(ws + WS_VA), *MIX = (bf16*)(ws + WS_MIX);
              for (int idx = vcu; idx < NB * 6 * 16; idx += G) { const int b = idx / 96, h = (idx >> 4) % 6, qb = idx & 15; const size_t rb = (size_t)b * SEQ, rq = rb + qb * 256;
                at::attn_unit<6, 0>(QA + rq * QAP + h * 96, QAP, KA + rb * KAP + h * 96, KAP, VA + rb * VAP + h * 64, VAP, MIX + rq * D + h * 64, D, 0, SEQ / 64, qb * 256, 0.f, shm); } }
            PH(5) { unsigned char* ws = launder(a.ws); bf16 *QB = (bf16*)(ws + WS_QB), *KB = (bf16*)(ws + WS_KB), *VB = (bf16*)(ws + WS_VB), *MIX = (bf16*)(ws + WS_MIX);
              for (int idx = vcu; idx < NB * 6 * 16; idx += G) { const int b = idx / 96, h = (idx >> 4) % 6, qb = idx & 15, hk = h / 3; const size_t rb = (size_t)b * SEQ, rq = rb + qb * 256;
                at::attn_unit<4, 0>(QB + rq * QBP + h * 64, QBP, KB + rb * KBP + hk * 64, KBP, VB + rb * VBP + hk * 64, VBP, MIX + rq * D + 384 + h * 64, D, 0, SEQ / 64, qb * 256, 0.f, shm); } }
            PH(6) { unsigned char* ws = launder(a.ws); bf16 *QC = (bf16*)(ws + WS_QC), *KC = (bf16*)(ws + WS_KC), *VC = (bf16*)(ws + WS_VC), *MIX = (bf16*)(ws + WS_MIX);
              for (int idx = vcu; idx < NB * 4 * 16; idx += G) { const int b = idx / 64, h = (idx >> 4) & 3, qb = idx & 15, hk = h >> 1; const size_t rb = (size_t)b * SEQ, rq = rb + qb * 256;
                const int t0 = (qb * 4 - 2 < 0) ? 0 : qb * 4 - 2, t1 = (qb * 4 + 6 > SEQ / 64) ? SEQ / 64 : qb * 4 + 6;
                at::attn_unit<4, 1>(QC + rq * QCP + h * 64, QCP, KC + rb * KCP + hk * 64, KCP, VC + rb * VCP + hk * 64, VCP, MIX + rq * D + 768 + h * 64, D, t0, t1, qb * 256, a.swa_sink[l * 4 + h] * LOG2E, shm); } }
        }
        GRID_BAR();
        PH(7) { unsigned char* ws = launder(a.ws); u64* ssb = (u64*)(ws + WS_CTL + (size_t)CW_SS * 4) + (size_t)l * 4 * T; float* XF = (float*)(ws + WS_XF);
          gp::DenseSched S; S.init(ws + WS_MIX, D, (bf16*)(ws + WS_WOUT) + (size_t)l * D * D, D, T, D, gridDim.x, bx);
          gp::EpiRes E{(l == 0) ? a.x : (const float*)XF, XF, (bf16*)(ws + WS_X1B), ssb + 2 * T};
          gp::gemm_phase<gp::EpiRes, gp::DenseSched, true>(lds, D, S, E); }
        GRID_BAR();
        PH(8) { const Ctx C = make_ctx(lds); router_phase(a, C, l); }
        PH(9) { unsigned char* ws = launder(a.ws);
          gp::DenseSched S; S.init((bf16*)(ws + WS_PB) + (size_t)l * T * 256, 256, (bf16*)(ws + WS_WPLE) + (size_t)l * D * 256, 256, T, D, gridDim.x, bx);
          gp::EpiPlain E{(bf16*)(ws + WS_EB), D};
          gp::gemm_phase<gp::EpiPlain, gp::DenseSched, true>(lds, 256, S, E); }
        GRID_BAR();
        gp::MoeTab tb; tb.P = (LAS int*)(lds + MISC_OFF + 2048); tb.C = tb.P + 64;
        if (threadIdx.x == 0) { const int* cnt = (const int*)(launder(a.ws) + WS_CTL) + CW_CNT + l * NE; int accp = 0;
            for (int e = 0; e < NE; ++e) { const int c = cnt[e]; tb.C[e] = c; tb.P[e] = accp; accp += (c + 255) >> 8; } tb.P[NE] = accp; }
        __syncthreads();
        PH(10) { unsigned char* ws = launder(a.ws); u64* ssb = (u64*)(ws + WS_CTL + (size_t)CW_SS * 4) + (size_t)l * 4 * T; const int* perm = (const int*)(ws + WS_PERM);
          gp::UpSched S{tb, perm, (const char*)(ws + WS_X1B), (const char*)((bf16*)(ws + WS_WUP) + (size_t)l * NE * 2048 * D), (int)gridDim.x, bx};
          gp::EpiUp E{(bf16*)(ws + WS_ACT), ssb + 2 * T, (const float*)(ws + WS_BUP) + (size_t)l * NE * 2048, perm, tb};
          gp::gemm_phase<gp::EpiUp, gp::UpSched, true>(lds, D, S, E); }
        GRID_BAR();
        PH(11) { unsigned char* ws = launder(a.ws); const int* perm = (const int*)(ws + WS_PERM);
          gp::DownSched S{tb, (const char*)(ws + WS_ACT), (const char*)((bf16*)(ws + WS_WDN) + (size_t)l * NE * D * D), (int)gridDim.x, bx};
          gp::EpiDown E{(bf16*)(ws + WS_Y), a.b_down + (size_t)l * NE * D, (const float*)(ws + WS_GATES), perm, tb};
          gp::gemm_phase<gp::EpiDown, gp::DownSched, true>(lds, D, S, E); }
        GRID_BAR();
        PH(12) { const Ctx C = make_ctx(lds); combine_phase(a, C); }
        GRID_BAR();
        PH(13) { unsigned char* ws = launder(a.ws); u64* ssb = (u64*)(ws + WS_CTL + (size_t)CW_SS * 4) + (size_t)l * 4 * T;
          gp::DenseSched S; S.init(ws + WS_X2B, D, (bf16*)(ws + WS_WG) + (size_t)l * D * D, D, T, D, gridDim.x, bx);
          gp::EpiGate E{(float*)(ws + WS_XF), (bf16*)(ws + WS_XB), (const bf16*)(ws + WS_EB), (const float*)(ws + WS_RS2), ssb + 3 * T};
          gp::gemm_phase<gp::EpiGate, gp::DenseSched, true>(lds, D, S, E); }
        GRID_BAR();
    }
    PH(14) { const Ctx C = make_ctx(lds); final_phase(a, C); }
}

extern "C" void kernel_launch(void* const* d_in, const int* in_sizes, int n_in, void* d_out, int out_size, void* d_ws, size_t ws_size, hipStream_t stream) {
    static int grid = 0;
    if (grid == 0) {
        if (n_in != 23 || out_size != T * D || ws_size < WS_END) { fprintf(stderr, "kernel_launch: unexpected shapes (n_in %d out %d ws %zu)\n", n_in, out_size, ws_size); grid = -1; return; }
        int dev = 0, cus = 0, per_cu = 0;
        if (hipGetDevice(&dev) != hipSuccess || hipDeviceGetAttribute(&cus, hipDeviceAttributeMultiprocessorCount, dev) != hipSuccess) { grid = -1; return; }
        if (hipFuncSetAttribute((const void*)fwd, hipFuncAttributeMaxDynamicSharedMemorySize, LDS_BYTES) != hipSuccess) { fprintf(stderr, "kernel_launch: hipFuncSetAttribute failed\n"); grid = -1; return; }
        if (hipOccupancyMaxActiveBlocksPerMultiprocessor(&per_cu, (const void*)fwd, NWAVES * 64, LDS_BYTES) != hipSuccess || per_cu < 1) fprintf(stderr, "kernel_launch: occupancy query reports %d\n", per_cu);
        (void)hipGetLastError();
        grid = cus;
    }
    if (grid < 0) return;
    if (hipMemsetAsync((char*)d_ws + WS_CTL, 0, CTL_ZERO_BYTES, stream) != hipSuccess) return;
    Args a{};
    const float** ap = (const float**)&a;
    for (int i = 0; i < 23; ++i) ap[i] = (const float*)d_in[i];
    a.out = (float*)d_out; a.ws = (unsigned char*)d_ws;
    hipLaunchKernelGGL(fwd, dim3(grid), dim3(NWAVES * 64), LDS_BYTES, stream, a);
}
```

```cpp
#include <hip/hip_runtime.h>
#include <cstdio>
#include <cstdint>
#include <type_traits>

#define GAS __attribute__((address_space(1)))
#define LAS __attribute__((address_space(3)))
typedef unsigned short bf16;
typedef short bf16x8 __attribute__((ext_vector_type(8)));
typedef short s16x4 __attribute__((ext_vector_type(4)));
typedef float f32x2 __attribute__((ext_vector_type(2)));
typedef float f32x4 __attribute__((ext_vector_type(4)));
typedef float f32x16 __attribute__((ext_vector_type(16)));
typedef unsigned u32x2 __attribute__((ext_vector_type(2)));
typedef unsigned u32x4 __attribute__((ext_vector_type(4)));

constexpr int NB = 8, SEQ = 4096, T = NB * SEQ, D = 1024, NL = 2;
constexpr int ZP = 1792;
constexpr int ZQ = 384;
constexpr int A_COLS = 416, B_COLS = 640;
constexpr int ZB = A_COLS, ZC = A_COLS + B_COLS;
constexpr int QAP = 576, KAP = 576, VAP = 384, QBP = 384, KBP = 128, VBP = 128, QCP = 256, KCP = 128, VCP = 128;
constexpr int NE = 32, TOPK = 4, ECAP = T;
constexpr int ACT_ROWS = T * TOPK + NE * 256;
constexpr float EPS = 1e-6f, LOG2E = 1.4426950408889634f;
constexpr float C2A = 0.10206207261596577f * LOG2E;
constexpr float C2B = 0.125f * LOG2E;

#ifndef ATT_F8
#define ATT_F8 1
#endif
#ifndef X1_BF16
#define X1_BF16 1
#endif
#ifndef MOE_F8
#define MOE_F8 1
#endif
constexpr int MOE_ES = MOE_F8 ? 1 : 2;
constexpr float WSC = 64.0f, WSC_INV = 1.0f / 64.0f;

constexpr size_t MiB = 1u << 20;
constexpr size_t WS_CTL = 0, CTL_ZERO_BYTES = 4 * MiB;
constexpr int CW_BAR = 4096;
constexpr int CW_CNT = 16384;
constexpr int CW_SS = 65536;
static_assert(CW_SS * 4 + NL * 4 * T * 8 <= (int)CTL_ZERO_BYTES, "ctl");
constexpr size_t WS_TAB32 = 4 * MiB;
constexpr size_t WS_TAB64 = 5 * MiB;
constexpr size_t WS_WR = 6 * MiB;
constexpr size_t WS_BUP = 7 * MiB;
constexpr size_t WS_SS0 = 8 * MiB;
constexpr size_t WS_RS2 = 8 * MiB + 512 * 1024;
constexpr size_t WS_GATES = 9 * MiB;
constexpr size_t WS_PERM = 10 * MiB;
constexpr size_t WS_WIN = 16 * MiB;
constexpr size_t WS_WQ = 24 * MiB;
constexpr size_t WS_WKV = 25 * MiB;
constexpr size_t WS_WOUT = 26 * MiB;
constexpr size_t WS_WG = 30 * MiB;
constexpr size_t WS_WPLE = 34 * MiB;
constexpr size_t WS_WUP = 36 * MiB;
constexpr size_t WS_WDN = 292 * MiB;
constexpr size_t WS_XB = 420 * MiB;
constexpr size_t WS_X1B = 484 * MiB;
constexpr size_t WS_X2B = 548 * MiB;
constexpr size_t WS_XF = 612 * MiB;
constexpr size_t WS_PB = 740 * MiB;
constexpr size_t WS_Z = 772 * MiB;
constexpr size_t WS_QA = 884 * MiB;
constexpr size_t WS_KA = 920 * MiB;
constexpr size_t WS_VA = 956 * MiB;
constexpr size_t WS_QB = 980 * MiB;
constexpr size_t WS_KB = 1004 * MiB;
constexpr size_t WS_VB = 1012 * MiB;
constexpr size_t WS_QC = 1020 * MiB;
constexpr size_t WS_KC = 1036 * MiB;
constexpr size_t WS_VC = 1044 * MiB;
constexpr size_t WS_MIX = 1052 * MiB;
constexpr size_t WS_EB = 1116 * MiB;
constexpr size_t WS_ACT = 1180 * MiB;
constexpr size_t WS_Y = 1452 * MiB;
constexpr size_t WS_RSL = 1708 * MiB;
constexpr size_t WS_GSL = 1712 * MiB;
constexpr size_t WS_X1Q = 1716 * MiB;
constexpr size_t WS_END = 1748 * MiB;

constexpr int RING_BYTES = 131072;
constexpr int MISC_OFF = RING_BYTES;
constexpr int LDS_BYTES = 147456;
constexpr int NWAVES = 8;

#define RLX_AGENT __ATOMIC_RELAXED, __HIP_MEMORY_SCOPE_AGENT
#define LDS_WAIT() asm volatile("s_waitcnt lgkmcnt(0)" ::: "memory")
#define VM_WAIT() asm volatile("s_waitcnt vmcnt(0)" ::: "memory")
__device__ __forceinline__ unsigned cvt_pk_bf16(float lo, float hi) { unsigned r; asm volatile("v_cvt_pk_bf16_f32 %0, %1, %2" : "=v"(r) : "v"(lo), "v"(hi)); return r; }
__device__ __forceinline__ unsigned pk4_fp8(float a, float b, float c, float d) { int w = 0; w = __builtin_amdgcn_cvt_pk_fp8_f32(a, b, w, false); w = __builtin_amdgcn_cvt_pk_fp8_f32(c, d, w, true); return (unsigned)w; }
__device__ __forceinline__ u32x2 pk8_fp8(f32x4 a, f32x4 b) { u32x2 w; w.x = pk4_fp8(a[0], a[1], a[2], a[3]); w.y = pk4_fp8(b[0], b[1], b[2], b[3]); return w; }
__device__ __forceinline__ float bf2f(unsigned short b) { return __uint_as_float((unsigned)b << 16); }
__device__ __forceinline__ float bflo(unsigned w) { return __uint_as_float(w << 16); }
__device__ __forceinline__ float bfhi(unsigned w) { return __uint_as_float(w & 0xffff0000u); }
typedef unsigned long long u64;
__device__ __forceinline__ u64 fx_enc(float v) { return (u64)__float2ll_rn(v * 1048576.0f); }
__device__ __forceinline__ void atomic_addf(u64* p, float v) { (void)__hip_atomic_fetch_add(p, fx_enc(v), __ATOMIC_RELAXED, __HIP_MEMORY_SCOPE_AGENT); }
__device__ __forceinline__ float fx_load(const u64* p) { return (float)(long long)(*p) * (1.0f / 1048576.0f); }
__device__ __forceinline__ float wave_sum(float v) {
#pragma unroll
    for (int o = 1; o < 64; o <<= 1) v += __shfl_xor(v, o);
    return v;
}
__device__ __forceinline__ float sigmoidf_fast(float x) { return __builtin_amdgcn_rcpf(1.0f + __builtin_amdgcn_exp2f(-x * LOG2E)); }

__device__ __forceinline__ unsigned char* launder(unsigned char* p) { GAS unsigned char* g = (GAS unsigned char*)p; asm volatile("" : "+s"(g)); return (unsigned char*)g; }
__device__ __forceinline__ int opaque_tid() { int t = threadIdx.x; asm volatile("" : "+v"(t)); return t; }
#ifndef REPMASK
#define REPMASK 0
#endif
#define PH(k) for (int rep_ = 0; rep_ < 1 + ((REPMASK >> (k)) & 1); ++rep_)

#define XB_TMO      128
#define XB_XCNT(j)  (256  + 64 * (j))
#define XB_XSUB(j)  (1280 + 64 * (j))
#define XB_XGEN(j)  (2304 + 64 * (j))
#define XB_TOP      3328
#define XB_TOPGEN   3392
#define XCD_BAR_WORDS 3456
#define XB_SPIN_CAP (1u << 18)
__device__ __forceinline__ unsigned xb_ld(unsigned* p)              { return __hip_atomic_load(p, __ATOMIC_RELAXED, __HIP_MEMORY_SCOPE_AGENT); }
__device__ __forceinline__ unsigned xb_add(unsigned* p, unsigned v) { return __hip_atomic_fetch_add(p, v, __ATOMIC_RELAXED, __HIP_MEMORY_SCOPE_AGENT); }
__device__ __forceinline__ unsigned xb_xcc_id() { return (unsigned)__builtin_amdgcn_s_getreg((3 << 11) | 20) & 0xFu; }
#define XB_SPIN(cond, bar) do { unsigned _sp = 0; while (cond) { __builtin_amdgcn_s_sleep(1); \
    if ((++_sp & 255u) == 0u) { if (xb_ld(&(bar)[XB_TMO])) break; if (_sp > XB_SPIN_CAP) { atomicAdd(&(bar)[XB_TMO], 1u); break; } } } } while (0)
struct XcdBarrier { unsigned* bar; unsigned x; volatile LAS unsigned* st; };
__device__ __forceinline__ XcdBarrier xcd_barrier_post(unsigned* bar, volatile LAS unsigned* st) {
    XcdBarrier b; b.bar = bar; b.x = xb_xcc_id(); b.st = st;
    if (threadIdx.x == 0) (void)xb_add(&bar[XB_XCNT(b.x)], 1u);
    return b;
}
__device__ __forceinline__ void xcd_barrier_complete(unsigned* bar, unsigned x, unsigned& nloc, unsigned& nx) {
    const unsigned G = gridDim.x * gridDim.y * gridDim.z;
    unsigned sum, cnt, mine, sp = 0u;
    for (;;) {
        sum = 0u; cnt = 0u; mine = 0u;
#pragma unroll
        for (unsigned j = 0; j < 16; ++j) { const unsigned c = xb_ld(&bar[XB_XCNT(j)]); sum += c; cnt += (c > 0u) ? 1u : 0u; mine = (j == x) ? c : mine; }
        if (sum == G) break;
        __builtin_amdgcn_s_sleep(1);
        if ((++sp & 255u) == 0u) { if (xb_ld(&bar[XB_TMO])) break; if (sp > XB_SPIN_CAP) { atomicAdd(&bar[XB_TMO], 1u); break; } }
    }
    nloc = mine > 0u ? mine : 1u; nx = cnt > 0u ? cnt : 1u;
}
__device__ __forceinline__ void xcd_barrier(const XcdBarrier& b) {
    asm volatile("s_waitcnt vmcnt(0)" ::: "memory");
    __syncthreads();
    if (threadIdx.x == 0) {
        unsigned* bar = b.bar;
        __builtin_amdgcn_s_waitcnt(0);
        unsigned nloc = b.st[0], nx = b.st[1];
        if (nloc == 0u) { xcd_barrier_complete(bar, b.x, nloc, nx); b.st[0] = nloc; b.st[1] = nx; }
        const unsigned old = xb_add(&bar[XB_XSUB(b.x)], 1u);
        const unsigned gen = old / nloc;
        if (old + 1u == (gen + 1u) * nloc) {
            __builtin_amdgcn_fence(__ATOMIC_RELEASE, "agent");
            asm volatile("s_waitcnt vmcnt(0)" ::: "memory");
            const unsigned og = xb_add(&bar[XB_TOP], 1u);
            const unsigned tg = og / nx;
            if (og + 1u == (tg + 1u) * nx) xb_add(&bar[XB_TOPGEN], 1u);
            else XB_SPIN(xb_ld(&bar[XB_TOPGEN]) == tg, bar);
            __builtin_amdgcn_fence(__ATOMIC_ACQUIRE, "agent");
            xb_add(&bar[XB_XGEN(b.x)], 1u);
            asm volatile("s_waitcnt vmcnt(0)" ::: "memory");
        } else {
            XB_SPIN(xb_ld(&bar[XB_XGEN(b.x)]) == gen, bar);
            __builtin_amdgcn_fence(__ATOMIC_ACQUIRE, "agent");
            asm volatile("s_waitcnt vmcnt(0)" ::: "memory");
        }
    }
    __syncthreads();
}

namespace gp {
constexpr int BM = 256, BK = 64, HALF = 128, HTB = HALF * BK * 2, STAGE_BYTES = 8 * HTB, NXCD = 8, WGM = 24;
__host__ __device__ __forceinline__ int lds_byte(int r, int c) { const int st = (r >> 4) * 2 + (c >> 5), rr = r & 15, cc = c & 31, ob = rr * 64 + cc * 2; return st * 1024 + (ob ^ (((ob >> 9) & 1) << 5)); }
__host__ __device__ __forceinline__ void stage_rc(int b, int& R, int& C) { const int st = b / 1024, sb = b % 1024, swz = sb ^ (((sb >> 9) & 1) << 5); R = (st >> 1) * 16 + swz / 64; C = (st & 1) * 32 + (swz % 64) / 2; }
__host__ __device__ __forceinline__ int perm32(int rho) { const int n = rho >> 4, i = rho & 15; return 8 * (i >> 2) + 4 * n + (i & 3); }

struct Unit { int pm, pn, aux; const char* A; const char* B; };

struct TileOrder {
    int nM, nN, nwg, G, c;
    __device__ __forceinline__ void init(int nM_, int nN_, int G_, int c_) { nM = nM_; nN = nN_; nwg = nM * nN; G = G_; c = c_; }
    __device__ __forceinline__ bool tile(int i, int& pm, int& pn) const {
        const long L = (long)i * G + c; if (L >= nwg) return false;
        int wgid = (int)L; { const int q = nwg / NXCD, r = nwg % NXCD, xcd = wgid % NXCD, off = wgid / NXCD; wgid = (xcd < r ? xcd * (q + 1) : r * (q + 1) + (xcd - r) * q) + off; }
        const int nig = WGM * nN, gid = wgid / nig, fm = gid * WGM, gsz = (nM - fm) < WGM ? (nM - fm) : WGM;
        pm = fm + ((wgid % nig) % gsz); pn = (wgid % nig) / gsz; return true;
    }
};
struct DenseSched {
    TileOrder o; const char* A; const char* B; int lda, K;
    __device__ __forceinline__ void init(const void* A_, int lda_, const void* B_, int K_, int M, int N, int G, int c) { A = (const char*)A_; B = (const char*)B_; lda = lda_; K = K_; o.init(M / BM, N / BM, G, c); }
    __device__ __forceinline__ bool next(int i, Unit& u) const { int pm, pn; if (!o.tile(i, pm, pn)) return false; u.pm = pm; u.pn = pn; u.aux = 0;
        u.A = A + (size_t)pm * BM * lda * 2; u.B = B + (size_t)pn * BM * K * 2; return true; }
    __device__ __forceinline__ unsigned rowoff(const Unit&, int r) const { return (unsigned)(r * lda * 2); }
    __device__ __forceinline__ unsigned rowraw(const Unit&, int r) const { return (unsigned)(r * lda * 2); }
    __device__ __forceinline__ unsigned rawoff(unsigned raw) const { return raw; }
};

typedef int i32x8 __attribute__((ext_vector_type(8)));
template <class Epi, class Sched, bool ALIGN_EPI, bool F8 = false>
__device__ __forceinline__ void gemm_phase(LAS unsigned char* lds, const int Kel, const Sched& S, const Epi& E) {
    const int K = F8 ? (Kel >> 1) : Kel;
    const int tid = opaque_tid(), wid = __builtin_amdgcn_readfirstlane(tid >> 6), lane = tid & 63, wr = wid >> 2, wc = wid & 3, fr = lane & 15, fq = lane >> 4;
    const int nt = K / BK;
    int Rr[2], Cc[2]; unsigned voffB[2];
#pragma unroll
    for (int i = 0; i < 2; ++i) { int R, C; stage_rc(tid * 16 + i * 8192, R, C); const int Rb = Epi::PERM ? ((R & ~31) + perm32(R & 31)) : R;
        Rr[i] = R; Cc[i] = C * 2; voffB[i] = (unsigned)(Rb * K + C) * 2u; }
    const size_t kstep = (size_t)(BK * 2);
    const size_t hstepB = (size_t)HALF * K * 2;
    const unsigned ldsw = (unsigned)wid * 1024u;
    const int aoff = lds_byte(wr * 64 + fr, fq * (F8 ? 16 : 8)), boff = lds_byte(wc * 32 + fr, fq * (F8 ? 16 : 8));
#define GP_SA(b, h) (((b) * 2 + (h)) * HTB)
#define GP_SB(b, h) ((4 + (b) * 2 + (h)) * HTB)
#define GP_STAGE(bufoff, gbase, voff) do { _Pragma("unroll") for (int _i = 0; _i < 2; ++_i) \
        __builtin_amdgcn_global_load_lds((const unsigned*)((const char*)(gbase) + (voff)[_i]), (LAS unsigned*)(lds + (bufoff) + ldsw + _i * 8192), 16, 0, 0); } while (0)
#define GP_LD1(dst, base) do { if constexpr (F8) { const u32x4 lo_ = *(const LAS u32x4*)(base), hi_ = *(const LAS u32x4*)((base) + 16); (dst)[0] = __builtin_bit_cast(i32x8, __builtin_shufflevector(lo_, hi_, 0, 1, 2, 3, 4, 5, 6, 7)); } \
        else { _Pragma("unroll") for (int k = 0; k < NK; ++k) (dst)[k] = __builtin_bit_cast(frag_t, *(const LAS typename std::conditional<F8, i32x8, bf16x8>::type*)((base) + k * 1024)); } } while (0)
#define GP_LDA(dst, b, h) do { _Pragma("unroll") for (int m = 0; m < 4; ++m) GP_LD1(dst[m], lds + GP_SA(b, h) + aoff + m * 2048); } while (0)
#define GP_LDB(dst, b, h) do { _Pragma("unroll") for (int n = 0; n < 2; ++n) GP_LD1(dst[n], lds + GP_SB(b, h) + boff + n * 2048); } while (0)
#define GP_MMA(ai, bj, At, Bt) do { __builtin_amdgcn_s_setprio(1); \
        if constexpr (F8) { _Pragma("unroll") for (int m = 0; m < 4; ++m) _Pragma("unroll") for (int n = 0; n < 2; ++n) \
            asm volatile("v_mfma_scale_f32_16x16x128_f8f6f4 %0, %1, %2, %0, %3, %3 op_sel_hi:[0,0,0]" : "+v"(acc[ai][bj][m][n]) : "v"(Bt[n][0]), "v"(At[m][0]), "v"(one_sc)); } \
        else { _Pragma("unroll") for (int m = 0; m < 4; ++m) _Pragma("unroll") for (int n = 0; n < 2; ++n) _Pragma("unroll") for (int k = 0; k < NK; ++k) \
            acc[ai][bj][m][n] = __builtin_amdgcn_mfma_f32_16x16x32_bf16(__builtin_bit_cast(bf16x8, Bt[n][k]), __builtin_bit_cast(bf16x8, At[m][k]), acc[ai][bj][m][n], 0, 0, 0); } \
        __builtin_amdgcn_s_setprio(0); } while (0)
#define GP_WAIT_V(n) asm volatile("s_waitcnt vmcnt(" #n ")" ::: "memory")
#define GP_WAIT_L(n) asm volatile("s_waitcnt lgkmcnt(" #n ")" ::: "memory")
#define GP_BAR __builtin_amdgcn_s_barrier()
#define GP_SCHED __builtin_amdgcn_sched_barrier(0)
    Unit cur, nxt; int ui = 0;
    if (!S.next(0, cur)) return;
    unsigned vAc[2][2], vAn[2][2];
#pragma unroll
    for (int h = 0; h < 2; ++h)
#pragma unroll
        for (int i = 0; i < 2; ++i) vAc[h][i] = S.rowoff(cur, h * HALF + Rr[i]) + (unsigned)Cc[i];
    f32x4 acc[2][2][4][2];
#pragma unroll
    for (int a = 0; a < 2; ++a)
#pragma unroll
        for (int b = 0; b < 2; ++b)
#pragma unroll
            for (int m = 0; m < 4; ++m)
#pragma unroll
                for (int n = 0; n < 2; ++n) acc[a][b][m][n] = (f32x4){0.f, 0.f, 0.f, 0.f};
    typedef typename std::conditional<F8, i32x8, bf16x8>::type frag_t; constexpr int NK = F8 ? 1 : 2;
    frag_t At[4][NK], B0[2][NK], B1[2][NK]; const unsigned one_sc = 0x7f7f7f7fu;
    const char* cA = cur.A; const char* cB = cur.B;
    GP_STAGE(GP_SB(0, 0), cB, voffB); GP_STAGE(GP_SB(0, 1), cB + hstepB, voffB); GP_STAGE(GP_SA(0, 0), cA, vAc[0]); GP_STAGE(GP_SA(0, 1), cA, vAc[1]);
    if (wr == 1) GP_BAR;
    GP_WAIT_V(2); GP_BAR;
    GP_STAGE(GP_SB(1, 0), cB + kstep, voffB); GP_STAGE(GP_SA(1, 0), cA + kstep, vAc[0]); GP_STAGE(GP_SB(1, 1), cB + hstepB + kstep, voffB);
    GP_WAIT_V(6); GP_BAR;
    for (;;) {
        const bool has_next = S.next(ui + 1, nxt);
        const char* nA = has_next ? nxt.A : cA; const char* nB = has_next ? nxt.B : cB;
#pragma unroll
        for (int h = 0; h < 2; ++h)
#pragma unroll
            for (int i = 0; i < 2; ++i) vAn[h][i] = has_next ? S.rowraw(nxt, h * HALF + Rr[i]) : 0u;
#pragma unroll 1
        for (int t = 0; t < nt; t += 2) {
            const bool last = (t == nt - 2);
            const char* a1 = cA + (size_t)(t + 1) * kstep;
            const char* a2 = last ? nA : cA + (size_t)(t + 2) * kstep; const char* b2 = last ? nB : cB + (size_t)(t + 2) * kstep;
            const char* a3 = a2 + kstep; const char* b3 = b2 + kstep;
            GP_LDB(B0, 0, 0); GP_LDB(B1, 0, 1); GP_SCHED; GP_LDA(At, 0, 0); GP_STAGE(GP_SA(1, 1), a1, vAc[1]);
            if (last && has_next) {
#pragma unroll
                for (int h = 0; h < 2; ++h)
#pragma unroll
                    for (int i = 0; i < 2; ++i) { unsigned r_ = vAn[h][i]; asm volatile("" : "+v"(r_)); vAc[h][i] = S.rawoff(r_) + (unsigned)Cc[i]; } }
            GP_WAIT_V(8); GP_WAIT_L(0); GP_BAR; GP_MMA(0, 0, At, B0); GP_MMA(0, 1, At, B1); GP_BAR; GP_SCHED;
            GP_LDA(At, 0, 1); GP_STAGE(GP_SB(0, 0), b2, voffB); GP_STAGE(GP_SB(0, 1), b2 + hstepB, voffB); GP_STAGE(GP_SA(0, 0), a2, vAc[0]);
            GP_WAIT_V(8); GP_WAIT_L(0); GP_BAR; GP_MMA(1, 0, At, B0); GP_MMA(1, 1, At, B1); GP_BAR; GP_SCHED;
            GP_LDB(B0, 1, 0); GP_LDB(B1, 1, 1); GP_SCHED; GP_LDA(At, 1, 0); GP_STAGE(GP_SA(0, 1), a2, vAc[1]);
            GP_WAIT_V(8); GP_WAIT_L(0); GP_BAR; GP_MMA(0, 0, At, B0); GP_MMA(0, 1, At, B1); GP_BAR; GP_SCHED;
            GP_LDA(At, 1, 1); GP_STAGE(GP_SB(1, 0), b3, voffB); GP_STAGE(GP_SB(1, 1), b3 + hstepB, voffB); GP_STAGE(GP_SA(1, 0), a3, vAc[0]);
            GP_WAIT_V(8); GP_WAIT_L(0); GP_BAR; GP_MMA(1, 0, At, B0); GP_MMA(1, 1, At, B1); GP_BAR; GP_SCHED;
        }
        if constexpr (ALIGN_EPI) { if (wr == 0) GP_BAR; }
        if constexpr (F8) asm volatile("s_nop 15\n\ts_nop 15" ::: "memory");
        E(acc, cur, wr, wc, fr, fq);
        if (!has_next) break;
#pragma unroll
        for (int a = 0; a < 2; ++a)
#pragma unroll
            for (int b = 0; b < 2; ++b)
#pragma unroll
                for (int m = 0; m < 4; ++m)
#pragma unroll
                    for (int n = 0; n < 2; ++n) acc[a][b][m][n] = (f32x4){0.f, 0.f, 0.f, 0.f};
        cur = nxt; cA = nA; cB = nB; ++ui;
        if constexpr (ALIGN_EPI) { if (wr == 1) GP_BAR; }
    }
    GP_WAIT_V(0);
    if constexpr (!ALIGN_EPI) { if (wr == 0) GP_BAR; }
    GP_BAR;
#undef GP_SA
#undef GP_SB
#undef GP_STAGE
#undef GP_LDA
#undef GP_LDB
#undef GP_MMA
#undef GP_LD1
#undef GP_WAIT_V
#undef GP_WAIT_L
#undef GP_BAR
#undef GP_SCHED
}

typedef f32x4 Acc[2][2][4][2];
__device__ __forceinline__ u32x4 pack8(f32x4 v0, f32x4 v1) { u32x4 w; w.x = cvt_pk_bf16(v0[0], v0[1]); w.y = cvt_pk_bf16(v0[2], v0[3]); w.z = cvt_pk_bf16(v1[0], v1[1]); w.w = cvt_pk_bf16(v1[2], v1[3]); return w; }
__device__ __forceinline__ float sq4(f32x4 v) { return (v[0] * v[0] + v[1] * v[1]) + (v[2] * v[2] + v[3] * v[3]); }
__device__ __forceinline__ float fq_sum(float s) { s += __shfl_xor(s, 16); s += __shfl_xor(s, 32); return s; }

struct EpiPlain {
    static constexpr bool PERM = true;
    bf16* O; int ldc;
    __device__ __forceinline__ void operator()(const Acc& acc, const Unit& u, int wr, int wc, int fr, int fq) const {
        const int row0 = u.pm * BM + wr * 64 + fr, col0 = u.pn * BM + wc * 32 + 8 * fq;
#pragma unroll
        for (int ai = 0; ai < 2; ++ai)
#pragma unroll
            for (int m = 0; m < 4; ++m) { bf16* rowp = O + (size_t)(row0 + ai * HALF + m * 16) * ldc + col0;
#pragma unroll
                for (int bj = 0; bj < 2; ++bj) *(u32x4*)(rowp + bj * HALF) = pack8(acc[ai][bj][m][0], acc[ai][bj][m][1]); }
    }
};
struct EpiIn {
    static constexpr bool PERM = true;
    bf16* Z; const u64* ssin; u64* ssq; u64* sskv; bool accum;
    bf16 *KA, *QB, *KB, *VB, *QC, *KC, *VC; const f32x2* tab32; const f32x2* tab64; const float* gq; const float* gk;
    __device__ __forceinline__ void operator()(const Acc& acc, const Unit& u, int wr, int wc, int fr, int fq) const {
        const int row0 = u.pm * BM + wr * 64 + fr;
        if (u.pn < 2) {
#pragma unroll
            for (int ai = 0; ai < 2; ++ai)
#pragma unroll
                for (int m = 0; m < 4; ++m) { const int row = row0 + ai * HALF + m * 16; const float rs = __builtin_amdgcn_rsqf(fx_load(ssin + row) * (1.0f / D) + EPS);
                    const f32x4 a0 = acc[ai][0][m][0] * rs, a1 = acc[ai][0][m][1] * rs, b0 = acc[ai][1][m][0] * rs, b1 = acc[ai][1][m][1] * rs;
                    bf16* rowp = Z + (size_t)row * ZQ + u.pn * BM + wc * 32 + 8 * fq;
                    *(u32x4*)rowp = pack8(a0, a1);
                    if (u.pn == 0) { *(u32x4*)(rowp + HALF) = pack8(b0, b1); const float s = fq_sum(sq4(a0) + sq4(a1) + sq4(b0) + sq4(b1)); if (fq == 0 && accum) atomic_addf(ssq + row, s); }
                    else { const float s = fq_sum(sq4(a0) + sq4(a1)); if (fq == 0 && accum) atomic_addf(sskv + row, s);
                        if (wc == 0) { const f32x2* cs = tab32 + (size_t)(row & (SEQ - 1)) * 16 + 4 * fq; const f32x2 c0 = cs[0], c1 = cs[1], c2 = cs[2], c3 = cs[3];
                            f32x4 r0, r1; r0[0] = b0[0] * c0.x - b0[1] * c0.y; r0[1] = b0[1] * c0.x + b0[0] * c0.y; r0[2] = b0[2] * c1.x - b0[3] * c1.y; r0[3] = b0[3] * c1.x + b0[2] * c1.y;
                            r1[0] = b1[0] * c2.x - b1[1] * c2.y; r1[1] = b1[1] * c2.x + b1[0] * c2.y; r1[2] = b1[2] * c3.x - b1[3] * c3.y; r1[3] = b1[3] * c3.x + b1[2] * c3.y;
                            if (ATT_F8) { const u32x2 w = pk8_fp8(r0, r1); unsigned char* kp = (unsigned char*)KA + (size_t)row * KAP + 64 + 8 * fq;
#pragma unroll
                                for (int h = 0; h < 6; ++h) *(u32x2*)(kp + h * 96) = w; }
                            else { const u32x4 w = pack8(r0, r1); bf16* kp = KA + (size_t)row * KAP + 64 + 8 * fq;
#pragma unroll
                                for (int h = 0; h < 6; ++h) *(u32x4*)(kp + h * 96) = w; } } } }
            return;
        }
        const int hs = 4 * (u.pn - 2) + wc;
        if (hs >= 18) return;
        if (hs < 8) {
            const float* g = (hs < 6) ? gq : gk; float gn[2][2][4];
#pragma unroll
            for (int bj = 0; bj < 2; ++bj)
#pragma unroll
                for (int n = 0; n < 2; ++n)
#pragma unroll
                    for (int i = 0; i < 4; ++i) gn[bj][n][i] = g[32 * bj + (4 * fq + 2 * n + (i >> 1)) + 16 * (i & 1)];
            bf16* dst = (hs < 6) ? QB + hs * 64 : KB + (hs - 6) * 64; const int pitch = (hs < 6) ? QBP : KBP; const float osc = (hs < 6) ? C2B : 1.0f;
            unsigned char* dst8 = (hs < 6) ? (unsigned char*)QB + hs * 64 : (unsigned char*)KB + (hs - 6) * 64;
#pragma unroll
            for (int ai = 0; ai < 2; ++ai)
#pragma unroll
                for (int m = 0; m < 4; ++m) { const int row = row0 + ai * HALF + m * 16, pos = row & (SEQ - 1); const float rs = __builtin_amdgcn_rsqf(fx_load(ssin + row) * (1.0f / D) + EPS);
                    f32x4 v[2][2]; float s = 0.f;
#pragma unroll
                    for (int bj = 0; bj < 2; ++bj)
#pragma unroll
                        for (int n = 0; n < 2; ++n) { v[bj][n] = acc[ai][bj][m][n] * rs; s += sq4(v[bj][n]); }
                    const float nrm = __builtin_amdgcn_rsqf(fq_sum(s) * (1.0f / 64) + EPS) * osc;
#pragma unroll
                    for (int bj = 0; bj < 2; ++bj) { const f32x2* cs = tab32 + (size_t)(bj ? (pos & 63) : (pos >> 6)) * 16 + 4 * fq; f32x4 r[2];
#pragma unroll
                        for (int n = 0; n < 2; ++n) { const f32x2 ca = cs[2 * n], cb = cs[2 * n + 1];
                            const float x0 = v[bj][n][0] * nrm * gn[bj][n][0], x1 = v[bj][n][1] * nrm * gn[bj][n][1], x2 = v[bj][n][2] * nrm * gn[bj][n][2], x3 = v[bj][n][3] * nrm * gn[bj][n][3];
                            r[n][0] = x0 * ca.x - x1 * ca.y; r[n][1] = x1 * ca.x + x0 * ca.y; r[n][2] = x2 * cb.x - x3 * cb.y; r[n][3] = x3 * cb.x + x2 * cb.y; }
                        if (ATT_F8) *(u32x2*)((unsigned char*)dst8 + (size_t)row * pitch + 32 * bj + 8 * fq) = pk8_fp8(r[0], r[1]);
                        else *(u32x4*)(dst + (size_t)row * pitch + 32 * bj + 8 * fq) = pack8(r[0], r[1]); }
                    if (m & 1) asm volatile("" ::: "memory"); }
        } else if (hs >= 10 && hs < 16) {
            bf16* dst = (hs < 14) ? QC + (hs - 10) * 64 : KC + (hs - 14) * 64; const int pitch = (hs < 14) ? QCP : KCP; const float osc = (hs < 14) ? C2B : 1.0f;
#pragma unroll
            for (int ai = 0; ai < 2; ++ai)
#pragma unroll
                for (int m = 0; m < 4; ++m) { const int row = row0 + ai * HALF + m * 16, pos = row & (SEQ - 1); const float rs = __builtin_amdgcn_rsqf(fx_load(ssin + row) * (1.0f / D) + EPS) * osc;
                    const f32x2* cs = tab64 + (size_t)pos * 32 + 8 * fq; f32x4 lo[2], hh[2];
#pragma unroll
                    for (int n = 0; n < 2; ++n)
#pragma unroll
                        for (int i = 0; i < 4; ++i) { const f32x2 c = cs[4 * n + i]; const float x1 = acc[ai][0][m][n][i] * rs, x2 = acc[ai][1][m][n][i] * rs; lo[n][i] = x1 * c.x - x2 * c.y; hh[n][i] = x2 * c.x + x1 * c.y; }
                    if (ATT_F8) { unsigned char* rp = ((hs < 14) ? (unsigned char*)QC + (hs - 10) * 64 : (unsigned char*)KC + (hs - 14) * 64) + (size_t)row * pitch + 8 * fq; *(u32x2*)rp = pk8_fp8(lo[0], lo[1]); *(u32x2*)(rp + 32) = pk8_fp8(hh[0], hh[1]); }
                    else { bf16* rp = dst + (size_t)row * pitch + 8 * fq; *(u32x4*)rp = pack8(lo[0], lo[1]); *(u32x4*)(rp + 32) = pack8(hh[0], hh[1]); }
                    if (m & 1) asm volatile("" ::: "memory"); }
        } else {
            bf16* dst = (hs < 10) ? VB + (hs - 8) * 64 : VC + (hs - 16) * 64;
#pragma unroll
            for (int ai = 0; ai < 2; ++ai)
#pragma unroll
                for (int m = 0; m < 4; ++m) { const int row = row0 + ai * HALF + m * 16; const float rs = __builtin_amdgcn_rsqf(fx_load(ssin + row) * (1.0f / D) + EPS);
                    bf16* rp = dst + (size_t)row * 128 + 8 * fq; *(u32x4*)rp = pack8(acc[ai][0][m][0] * rs, acc[ai][0][m][1] * rs); *(u32x4*)(rp + 32) = pack8(acc[ai][1][m][0] * rs, acc[ai][1][m][1] * rs); }
        }
    }
};
struct EpiMla {
    static constexpr bool PERM = true;
    bf16 *QA, *KA, *VA; const u64* ssq; const u64* sskv; const f32x2* tab32;
    __device__ __forceinline__ void operator()(const Acc& acc, const Unit& u, int wr, int wc, int fr, int fq) const {
        const int row0 = u.pm * BM + wr * 64 + fr, colw = u.pn * BM + wc * 32 + 8 * fq; const bool kv = (u.aux != 0);
#pragma unroll
        for (int ai = 0; ai < 2; ++ai)
#pragma unroll
            for (int m = 0; m < 4; ++m) { const int row = row0 + ai * HALF + m * 16;
                const float rs = kv ? __builtin_amdgcn_rsqf(fx_load(sskv + row) * (1.0f / 128) + EPS) : __builtin_amdgcn_rsqf(fx_load(ssq + row) * (1.0f / 256) + EPS);
#pragma unroll
                for (int bj = 0; bj < 2; ++bj) { const int n0 = colw + bj * HALF; f32x4 v0 = acc[ai][bj][m][0] * rs, v1 = acc[ai][bj][m][1] * rs;
                    if (kv) { const int h = n0 >> 7, d = n0 & 127;
                        if (ATT_F8 && d < 64) *(u32x2*)((unsigned char*)KA + (size_t)row * KAP + h * 96 + d) = pk8_fp8(v0, v1);
                        else { bf16* dst = (d < 64) ? KA + (size_t)row * KAP + h * 96 + d : VA + (size_t)row * VAP + h * 64 + (d - 64); *(u32x4*)dst = pack8(v0, v1); } }
                    else if (n0 < 576) { const int h = n0 / 96, d = n0 - h * 96;
                        if (d >= 64) { const f32x2* cs = tab32 + (size_t)(row & (SEQ - 1)) * 16 + ((d - 64) >> 1); const f32x2 c0 = cs[0], c1 = cs[1], c2 = cs[2], c3 = cs[3];
                            f32x4 r0, r1; r0[0] = v0[0] * c0.x - v0[1] * c0.y; r0[1] = v0[1] * c0.x + v0[0] * c0.y; r0[2] = v0[2] * c1.x - v0[3] * c1.y; r0[3] = v0[3] * c1.x + v0[2] * c1.y;
                            r1[0] = v1[0] * c2.x - v1[1] * c2.y; r1[1] = v1[1] * c2.x + v1[0] * c2.y; r1[2] = v1[2] * c3.x - v1[3] * c3.y; r1[3] = v1[3] * c3.x + v1[2] * c3.y; v0 = r0; v1 = r1; }
                        if (ATT_F8) *(u32x2*)((unsigned char*)QA + (size_t)row * QAP + n0) = pk8_fp8(v0 * C2A, v1 * C2A);
                        else *(u32x4*)(QA + (size_t)row * QAP + n0) = pack8(v0 * C2A, v1 * C2A); } }
                if (m & 1) asm volatile("" ::: "memory"); }
    }
};
struct EpiRes {
    static constexpr bool PERM = false;
    const float* base; const bf16* baseb; float* XF; bf16* XB; u64* ss; bool accum; unsigned char* XQ;
    __device__ __forceinline__ void operator()(const Acc& acc, const Unit& u, int wr, int wc, int fr, int fq) const {
        const int row0 = u.pm * BM + wr * 64 + fr, col0 = u.pn * BM + wc * 32 + 4 * fq;
#pragma unroll
        for (int ai = 0; ai < 2; ++ai)
#pragma unroll
            for (int m = 0; m < 4; ++m) { const int row = row0 + ai * HALF + m * 16; const size_t off = (size_t)row * D + col0; float s = 0.f;
#pragma unroll
                for (int bj = 0; bj < 2; ++bj)
#pragma unroll
                    for (int n = 0; n < 2; ++n) { const size_t o = off + bj * HALF + n * 16; f32x4 b;
                        if (baseb) { const u32x2 w = *(const u32x2*)(baseb + o); b = (f32x4){bflo(w.x), bfhi(w.x), bflo(w.y), bfhi(w.y)}; } else b = *(const f32x4*)(base + o);
                        const f32x4 v = b + acc[ai][bj][m][n]; if (!X1_BF16) *(f32x4*)(XF + o) = v;
                        if (!MOE_F8 || X1_BF16) { u32x2 w; w.x = cvt_pk_bf16(v[0], v[1]); w.y = cvt_pk_bf16(v[2], v[3]); *(u32x2*)(XB + o) = w; }
                        s += sq4(v); }
                s = fq_sum(s); if (fq == 0 && accum) atomic_addf(ss + row, s);
                if (m == 3) asm volatile("" ::: "memory"); }
    }
};
struct EpiGate {
    static constexpr bool PERM = false;
    const bf16* X2; bf16* XB; const bf16* EB; const float* rs2; u64* ss; bool accum;
    __device__ __forceinline__ void operator()(const Acc& acc, const Unit& u, int wr, int wc, int fr, int fq) const {
        const int row0 = u.pm * BM + wr * 64 + fr, col0 = u.pn * BM + wc * 32 + 4 * fq;
#pragma unroll
        for (int ai = 0; ai < 2; ++ai)
#pragma unroll
            for (int m = 0; m < 4; ++m) { const int row = row0 + ai * HALF + m * 16; const size_t off = (size_t)row * D + col0; const float rs = rs2[row]; float s = 0.f;
#pragma unroll
                for (int bj = 0; bj < 2; ++bj)
#pragma unroll
                    for (int n = 0; n < 2; ++n) { const size_t o = off + bj * HALF + n * 16; const u32x2 x2 = *(const u32x2*)(X2 + o); const u32x2 e = *(const u32x2*)(EB + o); const f32x4 a = acc[ai][bj][m][n] * rs;
                        f32x4 v; v[0] = bflo(x2.x) + bflo(e.x) * sigmoidf_fast(a[0]); v[1] = bfhi(x2.x) + bfhi(e.x) * sigmoidf_fast(a[1]); v[2] = bflo(x2.y) + bflo(e.y) * sigmoidf_fast(a[2]); v[3] = bfhi(x2.y) + bfhi(e.y) * sigmoidf_fast(a[3]);
                        u32x2 w; w.x = cvt_pk_bf16(v[0], v[1]); w.y = cvt_pk_bf16(v[2], v[3]); *(u32x2*)(XB + o) = w; s += sq4(v); }
                s = fq_sum(s); if (fq == 0 && accum) atomic_addf(ss + row, s);
                if (m == 3) asm volatile("" ::: "memory"); }
    }
};
struct MoeTab { LAS int* P; LAS int* C; LAS int* R2E; };
__device__ __forceinline__ int ldsu(LAS int* p) { return __builtin_amdgcn_readfirstlane(*(volatile LAS int*)p); }
struct UpSched {
    MoeTab tb; const int* perm; const char* A; const char* B; int G, c;
    __device__ __forceinline__ bool next(int i, Unit& u) const {
        const int Lx = i * (G >> 3) + (c >> 3), rt = (Lx >> 3) * 8 + (c & 7), pn = Lx & 7; if (rt >= ldsu(tb.P + NE)) return false;
        const int e = ldsu(tb.R2E + rt);
        u.pm = rt; u.pn = pn; u.aux = e | ((rt - ldsu(tb.P + e)) << 8); u.A = A; u.B = B + ((size_t)e * 2048 + (size_t)pn * BM) * D * MOE_ES; return true; }
    __device__ __forceinline__ unsigned rowoff(const Unit& u, int r) const { const int e = u.aux & 255, slot = (u.aux >> 8) * BM + r; int tok = 0; if (slot < ldsu(tb.C + e)) tok = perm[e * ECAP + slot] >> 2; return (unsigned)tok * (unsigned)(D * MOE_ES); }
    __device__ __forceinline__ unsigned rowraw(const Unit& u, int r) const { const int e = u.aux & 255, slot = (u.aux >> 8) * BM + r; int pw = 0; if (slot < ldsu(tb.C + e)) pw = perm[e * ECAP + slot]; return (unsigned)pw; }
    __device__ __forceinline__ unsigned rawoff(unsigned raw) const { return (raw >> 2) * (unsigned)(D * MOE_ES); }
};
struct DownSched {
    MoeTab tb; const char* A; const char* B; int G, c;
    __device__ __forceinline__ bool next(int i, Unit& u) const {
        const int Lx = i * (G >> 3) + (c >> 3), rt = (Lx >> 2) * 8 + (c & 7), pn = Lx & 3; if (rt >= ldsu(tb.P + NE)) return false;
        const int e = ldsu(tb.R2E + rt);
        u.pm = rt; u.pn = pn; u.aux = e | ((rt - ldsu(tb.P + e)) << 8); u.A = A + (size_t)rt * BM * D * MOE_ES; u.B = B + ((size_t)e * D + (size_t)pn * BM) * D * MOE_ES; return true; }
    __device__ __forceinline__ unsigned rowoff(const Unit&, int r) const { return (unsigned)(r * D * MOE_ES); }
    __device__ __forceinline__ unsigned rowraw(const Unit&, int r) const { return (unsigned)(r * D * MOE_ES); }
    __device__ __forceinline__ unsigned rawoff(unsigned raw) const { return raw; }
};
struct EpiUp {
    static constexpr bool PERM = true;
    bf16* ACT; const float* rsl; const float* bup; MoeTab tb;
    __device__ __forceinline__ void operator()(const Acc& acc, const Unit& u, int wr, int wc, int fr, int fq) const {
        const int e = u.aux & 255, mt = u.aux >> 8, cnt = ldsu(tb.C + e); const int colh = wc * 32 + 8 * fq;
        const float* bp = bup + (size_t)e * 2048 + u.pn * BM + colh; const f32x4 bg0 = *(const f32x4*)bp, bg1 = *(const f32x4*)(bp + 4), bl0 = *(const f32x4*)(bp + HALF), bl1 = *(const f32x4*)(bp + HALF + 4);
#pragma unroll
        for (int ai = 0; ai < 2; ++ai)
#pragma unroll
            for (int m = 0; m < 4; ++m) { const int r = ai * HALF + wr * 64 + m * 16 + fr, slot = mt * BM + r; float rs = 1.0f; if (MOE_F8) rs = WSC_INV; else if (slot < cnt) rs = rsl[e * ECAP + slot];
                f32x4 g[2], li[2], o[2]; g[0] = acc[ai][0][m][0] * rs + bg0; g[1] = acc[ai][0][m][1] * rs + bg1; li[0] = acc[ai][1][m][0] * rs + bl0; li[1] = acc[ai][1][m][1] * rs + bl1;
#pragma unroll
                for (int n = 0; n < 2; ++n)
#pragma unroll
                    for (int i = 0; i < 4; ++i) { const float xg = fminf(g[n][i], 7.0f), xl = fminf(fmaxf(li[n][i], -7.0f), 7.0f); o[n][i] = xg * sigmoidf_fast(1.702f * xg) * (xl + 1.0f); }
                if (MOE_F8) { u32x2 w; w.x = pk4_fp8(o[0][0], o[0][1], o[0][2], o[0][3]); w.y = pk4_fp8(o[1][0], o[1][1], o[1][2], o[1][3]); *(u32x2*)((unsigned char*)ACT + (size_t)(u.pm * BM + r) * D + u.pn * HALF + colh) = w; }
                else *(u32x4*)(ACT + (size_t)(u.pm * BM + r) * D + u.pn * HALF + colh) = pack8(o[0], o[1]); }
    }
};
struct EpiDown {
    static constexpr bool PERM = true;
    bf16* Y; const float* bdn; const float* gsl; const int* perm; MoeTab tb;
    __device__ __forceinline__ void operator()(const Acc& acc, const Unit& u, int wr, int wc, int fr, int fq) const {
        const int e = u.aux & 255, mt = u.aux >> 8, cnt = ldsu(tb.C + e); const int col0 = u.pn * BM + wc * 32 + 8 * fq;
        const float* bp = bdn + (size_t)e * D + col0; f32x4 b[2][2];
#pragma unroll
        for (int bj = 0; bj < 2; ++bj) { b[bj][0] = *(const f32x4*)(bp + bj * HALF); b[bj][1] = *(const f32x4*)(bp + bj * HALF + 4); }
#pragma unroll
        for (int ai = 0; ai < 2; ++ai)
#pragma unroll
            for (int m = 0; m < 4; ++m) { const int r = ai * HALF + wr * 64 + m * 16 + fr, slot = mt * BM + r;
                if (slot < cnt) { const int pair = perm[e * ECAP + slot]; const float gt = gsl[e * ECAP + slot]; bf16* rowp = Y + (size_t)pair * D + col0;
#pragma unroll
                    for (int bj = 0; bj < 2; ++bj) { const float ws = MOE_F8 ? WSC_INV : 1.0f; *(u32x4*)(rowp + bj * HALF) = pack8((acc[ai][bj][m][0] * ws + b[bj][0]) * gt, (acc[ai][bj][m][1] * ws + b[bj][1]) * gt); } } }
    }
};
struct MlaSched {
    const char* Z; const char* Wq; const char* Wkv; int G, c;
    __device__ __forceinline__ bool next(int i, Unit& u) const {
        const int L = i * G + c; if (L >= 768) return false;
        const int kind = L / 384, rem = L - kind * 384, pm = rem / 3, pn = rem - pm * 3;
        u.pm = pm; u.pn = pn; u.aux = kind; u.A = Z + (size_t)pm * BM * ZQ * 2 + (kind ? 256 : 0); u.B = (kind ? Wkv : Wq) + (size_t)pn * BM * 256 * 2; return true; }
    __device__ __forceinline__ unsigned rowoff(const Unit&, int r) const { return (unsigned)(r * ZQ * 2); }
    __device__ __forceinline__ unsigned rowraw(const Unit&, int r) const { return (unsigned)(r * ZQ * 2); }
    __device__ __forceinline__ unsigned rawoff(unsigned raw) const { return raw; }
};
}

namespace at {
typedef LAS const char* lds_cptr;
__device__ __forceinline__ int crow(int r, int hi) { return (r & 3) + 8 * (r >> 2) + 4 * hi; }
__device__ __forceinline__ void glds16(const void* gsrc, unsigned lds_dst) { unsigned keep;
    asm volatile("s_mov_b32 %0, m0\n\ts_mov_b32 m0, %2\n\ts_nop 0\n\tglobal_load_lds_dwordx4 %1, off\n\ts_mov_b32 m0, %0" : "=&s"(keep) : "v"(gsrc), "s"(lds_dst) : "memory"); }
#define AT_WAIT_BAR(N) asm volatile("s_waitcnt vmcnt(" #N ") lgkmcnt(0)\n\ts_barrier" ::: "memory")
#define AT_MX3(a, b, c) __builtin_fmaxf(__builtin_fmaxf((a), (b)), (c))
__device__ __forceinline__ float rowmax(const f32x16& p0, const f32x16& p1) {
    float a = AT_MX3(p0[0], p0[1], p1[0]), b = AT_MX3(p0[2], p0[3], p1[1]); a = AT_MX3(a, p1[2], p1[3]);
#pragma unroll
    for (int r = 4; r < 16; r += 4) { a = AT_MX3(a, p0[r], p0[r + 1]); b = AT_MX3(b, p0[r + 2], p0[r + 3]); a = AT_MX3(a, p1[r], p1[r + 1]); b = AT_MX3(b, p1[r + 2], p1[r + 3]); }
    const float m = __builtin_fmaxf(a, b); auto rr = __builtin_amdgcn_permlane32_swap(__float_as_uint(m), __float_as_uint(m), false, false);
    return __builtin_fmaxf(__uint_as_float(rr[0]), __uint_as_float(rr[1]));
}
template <int DKC> __device__ __forceinline__ void qkt(f32x16& p0, f32x16& p1, lds_cptr Kslot, const bf16x8* qr, int r32, int hi) {
    lds_cptr kb = Kslot + hi * 1024 + r32 * 16; const f32x16 z = {};
#pragma unroll
    for (int d0 = 0; d0 < DKC; ++d0) {
        const bf16x8 b0 = *(const LAS bf16x8*)(kb + d0 * 2048), b1 = *(const LAS bf16x8*)(kb + d0 * 2048 + 512);
        if (d0 == 0) { p0 = __builtin_amdgcn_mfma_f32_32x32x16_bf16(b0, qr[0], z, 0, 0, 0); p1 = __builtin_amdgcn_mfma_f32_32x32x16_bf16(b1, qr[0], z, 0, 0, 0); }
        else { p0 = __builtin_amdgcn_mfma_f32_32x32x16_bf16(b0, qr[d0], p0, 0, 0, 0); p1 = __builtin_amdgcn_mfma_f32_32x32x16_bf16(b1, qr[d0], p1, 0, 0, 0); } }
}
__device__ __forceinline__ void pv(f32x16* o, int vb, bf16x8 pa0, bf16x8 pa1, bf16x8 pa2, bf16x8 pa3) {
#pragma unroll
    for (int d0 = 0; d0 < 2; ++d0) { s16x4 lo[4], hi[4];
#pragma unroll
        for (int ks = 0; ks < 4; ++ks) {
            asm volatile("ds_read_b64_tr_b16 %0,%1 offset:%c2" : "=&v"(lo[ks]) : "v"(vb), "i"(d0 * 4096 + ks * 1024) : "memory");
            asm volatile("ds_read_b64_tr_b16 %0,%1 offset:%c2" : "=&v"(hi[ks]) : "v"(vb), "i"(d0 * 4096 + ks * 1024 + 512) : "memory"); }
        asm volatile("s_waitcnt lgkmcnt(0)" ::: "memory"); __builtin_amdgcn_sched_barrier(0);
#define AT_PK(k) (bf16x8){lo[k][0], lo[k][1], lo[k][2], lo[k][3], hi[k][0], hi[k][1], hi[k][2], hi[k][3]}
        o[d0] = __builtin_amdgcn_mfma_f32_32x32x16_bf16(pa0, AT_PK(0), o[d0], 0, 0, 0);
        o[d0] = __builtin_amdgcn_mfma_f32_32x32x16_bf16(pa1, AT_PK(1), o[d0], 0, 0, 0);
        o[d0] = __builtin_amdgcn_mfma_f32_32x32x16_bf16(pa2, AT_PK(2), o[d0], 0, 0, 0);
        o[d0] = __builtin_amdgcn_mfma_f32_32x32x16_bf16(pa3, AT_PK(3), o[d0], 0, 0, 0);
#undef AT_PK
    }
}
template <int DKC> struct Lay { static constexpr int KSLOT = DKC * 2048, LDS_K = 0, LDS_V = 3 * KSLOT, LDS_WS = LDS_V + 3 * 8192, LDS_OST = LDS_WS + NWAVES * 256, BYTES = LDS_OST + NWAVES * 4096; };
template <int DKC, int MODE>
__device__ __forceinline__ void attn_unit(const bf16* Qu, int qp, const bf16* Kh, int kp, const bf16* Vh, int vp, bf16* Ou, int op, int t0, int t1, int qpos0, float sinkl2, char* shm) {
    typedef Lay<DKC> LY;
    const int tid = opaque_tid(), lane = tid & 63, r32 = lane & 31, hi = lane >> 5; const int wid = __builtin_amdgcn_readfirstlane(tid >> 6);
    const unsigned lds0 = (unsigned)(uintptr_t)shm;
    const lds_cptr shm3 = (lds_cptr)shm;
    LAS float* wsf = (LAS float*)(shm3 + LY::LDS_WS) + wid * 64;
    const bf16* Qw = Qu + (size_t)(wid * 32) * qp;
    const bool k2 = (wid + 8 < 2 * DKC);
    const bf16* ksrc = Kh + (size_t)lane * kp + wid * 8;
    const bf16* vsrc = Vh + (size_t)(16 * (wid & 3) + (lane >> 2)) * vp + (wid >> 2) * 32 + (lane & 3) * 8;
    const unsigned kdst = lds0 + LY::LDS_K + wid * 1024, vdst = lds0 + LY::LDS_V + wid * 1024;
#define AT_DMA(t, s) do { glds16(ksrc + (size_t)(t) * 64 * kp, (unsigned)__builtin_amdgcn_readfirstlane(kdst + (s) * LY::KSLOT)); \
        if (k2) glds16(ksrc + (size_t)(t) * 64 * kp + 64, (unsigned)__builtin_amdgcn_readfirstlane(kdst + (s) * LY::KSLOT + 8192)); \
        glds16(vsrc + (size_t)(t) * 64 * vp, (unsigned)__builtin_amdgcn_readfirstlane(vdst + (s) * 8192)); } while (0)
    const int vb0 = (int)(lds0 + LY::LDS_V) + ((lane >> 4) & 1) * 32 + (lane & 3) * 8 + (4 * hi + ((lane & 15) >> 2)) * 64;
    bf16x8 qr[DKC];
#pragma unroll
    for (int d0 = 0; d0 < DKC; ++d0) qr[d0] = *(const bf16x8*)(Qw + (size_t)r32 * qp + d0 * 16 + hi * 8);
    AT_DMA(t0, 0);
    float mrun = -INFINITY, l = 0.f; f32x16 o[2]; o[0] = f32x16{}; o[1] = f32x16{};
    const int qpos = qpos0 + wid * 32 + r32;
    int sl = 0;
    for (int t = t0; t < t1; ++t) {
        const bool more = (t + 1 < t1); const int sn = (sl == 2) ? 0 : sl + 1;
        if (more) { AT_DMA(t + 1, sn); if (k2) AT_WAIT_BAR(3); else AT_WAIT_BAR(2); } else AT_WAIT_BAR(0);
        f32x16 p0, p1;
        qkt<DKC>(p0, p1, shm3 + LY::LDS_K + sl * LY::KSLOT, qr, r32, hi);
        if (MODE == 1) { const int kb = t * 64 + 4 * hi;
#pragma unroll
            for (int r = 0; r < 16; ++r) { const int d0 = kb + (r & 3) + 8 * (r >> 2) - qpos, d1 = d0 + 32; if (d0 > 128 || d0 < -128) p0[r] = -INFINITY; if (d1 > 128 || d1 < -128) p1[r] = -INFINITY; } }
        const float rm = rowmax(p0, p1), mnew = __builtin_fmaxf(mrun, rm), mref = (mnew == -INFINITY) ? 0.f : mnew;
        const float alpha = __builtin_amdgcn_exp2f(mrun - mref); mrun = mnew;
        float s = 0.f;
#pragma unroll
        for (int r = 0; r < 16; ++r) { p0[r] = __builtin_amdgcn_exp2f(p0[r] - mref); p1[r] = __builtin_amdgcn_exp2f(p1[r] - mref); s += p0[r] + p1[r]; }
        l = l * alpha + s;
        if (__any(alpha != 1.0f)) { if (hi == 0) wsf[r32] = alpha; LDS_WAIT();
#pragma unroll
            for (int r = 0; r < 16; ++r) { const float f = wsf[crow(r, hi)]; o[0][r] *= f; o[1][r] *= f; } }
        u32x4 pw0, pw1, pw2, pw3;
        pw0 = (u32x4){cvt_pk_bf16(p0[0], p0[1]), cvt_pk_bf16(p0[2], p0[3]), cvt_pk_bf16(p0[4], p0[5]), cvt_pk_bf16(p0[6], p0[7])};
        pw1 = (u32x4){cvt_pk_bf16(p0[8], p0[9]), cvt_pk_bf16(p0[10], p0[11]), cvt_pk_bf16(p0[12], p0[13]), cvt_pk_bf16(p0[14], p0[15])};
        pw2 = (u32x4){cvt_pk_bf16(p1[0], p1[1]), cvt_pk_bf16(p1[2], p1[3]), cvt_pk_bf16(p1[4], p1[5]), cvt_pk_bf16(p1[6], p1[7])};
        pw3 = (u32x4){cvt_pk_bf16(p1[8], p1[9]), cvt_pk_bf16(p1[10], p1[11]), cvt_pk_bf16(p1[12], p1[13]), cvt_pk_bf16(p1[14], p1[15])};
        __builtin_amdgcn_sched_barrier(0);
        pv(o, vb0 + sl * 8192, __builtin_bit_cast(bf16x8, pw0), __builtin_bit_cast(bf16x8, pw1), __builtin_bit_cast(bf16x8, pw2), __builtin_bit_cast(bf16x8, pw3));
        sl = sn;
    }
    { auto rr = __builtin_amdgcn_permlane32_swap(__float_as_uint(l), __float_as_uint(l), false, false); l = __uint_as_float(rr[0]) + __uint_as_float(rr[1]); }
    if (MODE == 1) l += __builtin_amdgcn_exp2f(sinkl2 - mrun);
    if (hi == 0) wsf[32 + r32] = l; LDS_WAIT();
    float rli[16];
#pragma unroll
    for (int r = 0; r < 16; ++r) rli[r] = __builtin_amdgcn_rcpf(wsf[32 + crow(r, hi)]);
    bf16* Ow = Ou + (size_t)(wid * 32) * op;
    { LAS bf16* stg = (LAS bf16*)(shm3 + LY::LDS_OST) + wid * 2048;
#pragma unroll
        for (int r = 0; r < 16; ++r) { const int orow = crow(r, hi);
#pragma unroll
            for (int d0 = 0; d0 < 2; ++d0) stg[orow * 64 + d0 * 32 + r32] = (bf16)(cvt_pk_bf16(o[d0][r] * rli[r], 0.f) & 0xffffu); }
        LDS_WAIT();
#pragma unroll
        for (int i = 0; i < 4; ++i) { const int row = i * 8 + (lane >> 3), ch = lane & 7; const u32x4 v = *(const LAS u32x4*)(stg + row * 64 + ch * 8); *(u32x4*)(Ow + (size_t)row * op + ch * 8) = v; } }
    asm volatile("s_waitcnt lgkmcnt(0)\n\ts_barrier" ::: "memory");
#undef AT_DMA
}
typedef short v4i16_t __attribute__((ext_vector_type(4)));
__device__ __forceinline__ s16x4 vtr(lds_cptr p) { return __builtin_bit_cast(s16x4, __builtin_amdgcn_ds_read_tr16_b64_v4i16((LAS v4i16_t*)p)); }
template <int DKC> struct LayP { static constexpr int KSLOT = DKC * 2048, NS = 4, LDS_K = 0, LDS_V = NS * KSLOT, LDS_WS = LDS_V + NS * 8192, LDS_OST = LDS_WS + NWAVES * 256, BYTES = LDS_OST + NWAVES * 4096; };
#define AT_BAR_L() asm volatile("s_waitcnt lgkmcnt(0)\n\ts_barrier" ::: "memory")
template <int DKC, int MODE>
__device__ __forceinline__ void attn_unit_pp(const bf16* Qu, int qp, const bf16* Kh, int kp, const bf16* Vh, int vp, bf16* Ou, int op, int t0, int t1, int qpos0, float sinkl2, char* shm) {
    typedef LayP<DKC> LY; constexpr float THR = 8.0f;
    static_assert(LY::BYTES <= RING_BYTES, "attention LDS");
    const int tid = opaque_tid(), lane = tid & 63, r32 = lane & 31, hi = lane >> 5; const int wid = __builtin_amdgcn_readfirstlane(tid >> 6);
    const bool hb = (wid >= 4);
    const unsigned lds0 = (unsigned)(uintptr_t)shm;
    const lds_cptr shm3 = (lds_cptr)shm;
    LAS float* wsf = (LAS float*)(shm3 + LY::LDS_WS) + wid * 64;
    const bf16* Qw = Qu + (size_t)(wid * 32) * qp;
    const bool k2 = (wid + 8 < 2 * DKC);
    const bf16* ksrc = Kh + (size_t)lane * kp + wid * 8;
    const bf16* vsrc = Vh + (size_t)(16 * (wid & 3) + (lane >> 2)) * vp + (wid >> 2) * 32 + (lane & 3) * 8;
    const unsigned kdst = lds0 + LY::LDS_K + wid * 1024, vdst = lds0 + LY::LDS_V + wid * 1024;
#define AT_ISSUE(s) do { const int s_ = (s); if (s_ < t1) { const int sl_ = (s_ - t0) & 3; \
        glds16(ksrc + (size_t)s_ * 64 * kp, (unsigned)__builtin_amdgcn_readfirstlane(kdst + sl_ * LY::KSLOT)); \
        if (k2) glds16(ksrc + (size_t)s_ * 64 * kp + 64, (unsigned)__builtin_amdgcn_readfirstlane(kdst + sl_ * LY::KSLOT + 8192)); \
        glds16(vsrc + (size_t)s_ * 64 * vp, (unsigned)__builtin_amdgcn_readfirstlane(vdst + sl_ * 8192)); } } while (0)
#define AT_WAITBAR(young) do { if ((young) < t1) { if (k2) AT_WAIT_BAR(3); else AT_WAIT_BAR(2); } else AT_WAIT_BAR(0); } while (0)
    const int vb0 = (int)(lds0 + LY::LDS_V) + ((lane >> 4) & 1) * 32 + (lane & 3) * 8 + (4 * hi + ((lane & 15) >> 2)) * 64;
    bf16x8 qr[DKC];
#pragma unroll
    for (int d0 = 0; d0 < DKC; ++d0) qr[d0] = *(const bf16x8*)(Qw + (size_t)r32 * qp + d0 * 16 + hi * 8);
    AT_ISSUE(t0); AT_ISSUE(t0 + 1);
    float mhat = 0.f, l = 0.f; f32x16 o[2]; o[0] = f32x16{}; o[1] = f32x16{}; f32x16 negm = f32x16{};
    const int qpos = qpos0 + wid * 32 + r32;
    const int n = t1 - t0;
    AT_WAITBAR(t0 + 1);
    if (hb) { AT_ISSUE(t0 + 2); AT_BAR_L(); }
    u32x4 pw0 = {}, pw1 = {}, pw2 = {}, pw3 = {}; bf16x8 vf[8];
#pragma unroll
    for (int q = 0; q < 8; ++q) vf[q] = bf16x8{};
    for (int j = 0; j < n; ++j) {
        const int i = t0 + j, sl = j & 3;
        if (!hb) AT_ISSUE(i + 2);
        f32x16 p0, p1;
        { lds_cptr kb = shm3 + LY::LDS_K + sl * LY::KSLOT + hi * 1024 + r32 * 16; bf16x8 kf[2 * DKC];
#pragma unroll
          for (int d0 = 0; d0 < DKC; ++d0) { kf[2 * d0] = *(const LAS bf16x8*)(kb + d0 * 2048); kf[2 * d0 + 1] = *(const LAS bf16x8*)(kb + d0 * 2048 + 512); }
          __builtin_amdgcn_s_setprio(1);
          if (j > 0) {
#pragma unroll
              for (int ks = 0; ks < 4; ++ks) { const bf16x8 pa = __builtin_bit_cast(bf16x8, ks == 0 ? pw0 : ks == 1 ? pw1 : ks == 2 ? pw2 : pw3);
                  o[0] = __builtin_amdgcn_mfma_f32_32x32x16_bf16(pa, vf[ks], o[0], 0, 0, 0); o[1] = __builtin_amdgcn_mfma_f32_32x32x16_bf16(pa, vf[4 + ks], o[1], 0, 0, 0); } }
#pragma unroll
          for (int d0 = 0; d0 < DKC; ++d0) {
              if (d0 == 0) { p0 = __builtin_amdgcn_mfma_f32_32x32x16_bf16(kf[0], qr[0], negm, 0, 0, 0); p1 = __builtin_amdgcn_mfma_f32_32x32x16_bf16(kf[1], qr[0], negm, 0, 0, 0); }
              else { p0 = __builtin_amdgcn_mfma_f32_32x32x16_bf16(kf[2 * d0], qr[d0], p0, 0, 0, 0); p1 = __builtin_amdgcn_mfma_f32_32x32x16_bf16(kf[2 * d0 + 1], qr[d0], p1, 0, 0, 0); } }
          __builtin_amdgcn_s_setprio(0); }
        if (hb) AT_WAITBAR(i + 2); else AT_BAR_L();
        if (hb) AT_ISSUE(i + 3);
        { lds_cptr vp = shm3 + LY::LDS_V + sl * 8192 + ((lane >> 4) & 1) * 32 + (lane & 3) * 8 + (4 * hi + ((lane & 15) >> 2)) * 64;
#pragma unroll
          for (int q = 0; q < 8; ++q) { const s16x4 lo = vtr(vp + (q >> 2) * 4096 + (q & 3) * 1024), hh = vtr(vp + (q >> 2) * 4096 + (q & 3) * 1024 + 512); vf[q] = (bf16x8){lo[0], lo[1], lo[2], lo[3], hh[0], hh[1], hh[2], hh[3]}; } }
        if (MODE == 1) { const int kb = i * 64 + 4 * hi;
#pragma unroll
            for (int r = 0; r < 16; ++r) { const int d0 = kb + (r & 3) + 8 * (r >> 2) - qpos, d1 = d0 + 32; if (d0 > 128 || d0 < -128) p0[r] = -INFINITY; if (d1 > 128 || d1 < -128) p1[r] = -INFINITY; } }
        { const float rm = rowmax(p0, p1);
          if (j == 0 || __any(rm > THR)) {
              float dl = (j == 0) ? rm : __builtin_fmaxf(rm, 0.f); if (dl == -INFINITY) dl = 0.f;
              mhat += dl;
#pragma unroll
              for (int r = 0; r < 16; ++r) { p0[r] -= dl; p1[r] -= dl; }
#pragma unroll
              for (int r = 0; r < 16; ++r) negm[r] = -mhat;
              if (j > 0) { const float f = __builtin_amdgcn_exp2f(-dl); l *= f; if (hi == 0) wsf[r32] = f; LDS_WAIT();
#pragma unroll
                  for (int r = 0; r < 16; ++r) { const float g = wsf[crow(r, hi)]; o[0][r] *= g; o[1][r] *= g; } } } }
        { float sa = 0.f, sb = 0.f;
#pragma unroll
          for (int r = 0; r < 16; ++r) { p0[r] = __builtin_amdgcn_exp2f(p0[r]); p1[r] = __builtin_amdgcn_exp2f(p1[r]); sa += p0[r]; sb += p1[r]; }
          l += sa + sb; }
        pw0 = (u32x4){cvt_pk_bf16(p0[0], p0[1]), cvt_pk_bf16(p0[2], p0[3]), cvt_pk_bf16(p0[4], p0[5]), cvt_pk_bf16(p0[6], p0[7])};
        pw1 = (u32x4){cvt_pk_bf16(p0[8], p0[9]), cvt_pk_bf16(p0[10], p0[11]), cvt_pk_bf16(p0[12], p0[13]), cvt_pk_bf16(p0[14], p0[15])};
        pw2 = (u32x4){cvt_pk_bf16(p1[0], p1[1]), cvt_pk_bf16(p1[2], p1[3]), cvt_pk_bf16(p1[4], p1[5]), cvt_pk_bf16(p1[6], p1[7])};
        pw3 = (u32x4){cvt_pk_bf16(p1[8], p1[9]), cvt_pk_bf16(p1[10], p1[11]), cvt_pk_bf16(p1[12], p1[13]), cvt_pk_bf16(p1[14], p1[15])};
        if (!hb) AT_WAITBAR(i + 2); else AT_BAR_L();
    }
    __builtin_amdgcn_s_setprio(1);
#pragma unroll
    for (int ks = 0; ks < 4; ++ks) { const bf16x8 pa = __builtin_bit_cast(bf16x8, ks == 0 ? pw0 : ks == 1 ? pw1 : ks == 2 ? pw2 : pw3);
        o[0] = __builtin_amdgcn_mfma_f32_32x32x16_bf16(pa, vf[ks], o[0], 0, 0, 0); o[1] = __builtin_amdgcn_mfma_f32_32x32x16_bf16(pa, vf[4 + ks], o[1], 0, 0, 0); }
    __builtin_amdgcn_s_setprio(0);
    if (!hb) AT_BAR_L();
    { auto rr = __builtin_amdgcn_permlane32_swap(__float_as_uint(l), __float_as_uint(l), false, false); l = __uint_as_float(rr[0]) + __uint_as_float(rr[1]); }
    if (MODE == 1) l += __builtin_amdgcn_exp2f(sinkl2 - mhat);
    if (hi == 0) wsf[32 + r32] = l; LDS_WAIT();
    float rli[16];
#pragma unroll
    for (int r = 0; r < 16; ++r) rli[r] = __builtin_amdgcn_rcpf(wsf[32 + crow(r, hi)]);
    bf16* Ow = Ou + (size_t)(wid * 32) * op;
    { LAS bf16* stg = (LAS bf16*)(shm3 + LY::LDS_OST) + wid * 2048;
#pragma unroll
        for (int r = 0; r < 16; ++r) { const int orow = crow(r, hi);
#pragma unroll
            for (int d0 = 0; d0 < 2; ++d0) stg[orow * 64 + d0 * 32 + r32] = (bf16)(cvt_pk_bf16(o[d0][r] * rli[r], 0.f) & 0xffffu); }
        LDS_WAIT();
#pragma unroll
        for (int i = 0; i < 4; ++i) { const int row = i * 8 + (lane >> 3), ch = lane & 7; const u32x4 v = *(const LAS u32x4*)(stg + row * 64 + ch * 8); *(u32x4*)(Ow + (size_t)row * op + ch * 8) = v; } }
    AT_BAR_L();
#undef AT_ISSUE
#undef AT_WAITBAR
}
typedef int i32x8 __attribute__((ext_vector_type(8)));
template <int DKS> struct LayP8 { static constexpr int KSLOT = DKS * 4096, NS = 4, LDS_K = 0, LDS_V = NS * KSLOT, LDS_WS = LDS_V + NS * 8192, LDS_OST = LDS_WS + NWAVES * 256, BYTES = LDS_OST + NWAVES * 4096; };
template <int DKS, int NCH, int MODE>
__device__ __forceinline__ void attn_unit_f8(const unsigned char* Qu, int qp, const unsigned char* Kh, int kp, const bf16* Vh, int vp, bf16* Ou, int op, int t0, int t1, int qpos0, float sinkl2, char* shm) {
    typedef LayP8<DKS> LY; constexpr float THR = 8.0f;
    static_assert(LY::BYTES <= RING_BYTES, "attention LDS");
    const int tid = opaque_tid(), lane = tid & 63, r32 = lane & 31, hi = lane >> 5; const int wid = __builtin_amdgcn_readfirstlane(tid >> 6);
    const bool hb = (wid >= 4);
    const unsigned lds0 = (unsigned)(uintptr_t)shm;
    const lds_cptr shm3 = (lds_cptr)shm;
    LAS float* wsf = (LAS float*)(shm3 + LY::LDS_WS) + wid * 64;
    const unsigned char* Qw = Qu + (size_t)(wid * 32) * qp;
    const bool kw = (wid < NCH);
    const unsigned char* ksrc = Kh + (size_t)lane * kp + wid * 16;
    const bf16* vsrc = Vh + (size_t)(16 * (wid & 3) + (lane >> 2)) * vp + (wid >> 2) * 32 + (lane & 3) * 8;
    const unsigned kdst = lds0 + LY::LDS_K + wid * 1024, vdst = lds0 + LY::LDS_V + wid * 1024;
#define AT_ISSUE(s) do { const int s_ = (s); if (s_ < t1) { const int sl_ = (s_ - t0) & 3; \
        if (kw) glds16(ksrc + (size_t)s_ * 64 * kp, (unsigned)__builtin_amdgcn_readfirstlane(kdst + sl_ * LY::KSLOT)); \
        glds16(vsrc + (size_t)s_ * 64 * vp, (unsigned)__builtin_amdgcn_readfirstlane(vdst + sl_ * 8192)); } } while (0)
#define AT_WAITBAR(young) do { if ((young) < t1) { if (kw) AT_WAIT_BAR(2); else AT_WAIT_BAR(1); } else AT_WAIT_BAR(0); } while (0)
    if (NCH < DKS * 4) {
        for (int b = tid * 16; b < 4 * (DKS * 4 - NCH) * 1024; b += NWAVES * 64 * 16) { const int sl_ = b / ((DKS * 4 - NCH) * 1024), rem = b % ((DKS * 4 - NCH) * 1024);
            *(LAS u32x4*)(shm3 + LY::LDS_K + sl_ * LY::KSLOT + NCH * 1024 + rem) = (u32x4){0u, 0u, 0u, 0u}; } }
    i32x8 qf[DKS];
#pragma unroll
    for (int s = 0; s < DKS; ++s) { const unsigned char* qa = Qw + (size_t)r32 * qp + s * 64 + hi * 32;
        if (s * 64 + hi * 32 < NCH * 16) { const u32x4 lo = *(const u32x4*)qa, hh = *(const u32x4*)(qa + 16); qf[s] = __builtin_bit_cast(i32x8, __builtin_shufflevector(lo, hh, 0, 1, 2, 3, 4, 5, 6, 7)); }
        else qf[s] = i32x8{}; }
    AT_ISSUE(t0); AT_ISSUE(t0 + 1);
    float mhat = 0.f, l = 0.f; f32x16 o[2]; o[0] = f32x16{}; o[1] = f32x16{}; f32x16 negm = f32x16{};
    const unsigned one_sc = 0x7f7f7f7fu;
    const int qpos = qpos0 + wid * 32 + r32;
    const int n = t1 - t0;
    AT_WAITBAR(t0 + 1);
    if (hb) { AT_ISSUE(t0 + 2); AT_BAR_L(); }
    u32x4 pw0 = {}, pw1 = {}, pw2 = {}, pw3 = {}; bf16x8 vf[8];
#pragma unroll
    for (int q = 0; q < 8; ++q) vf[q] = bf16x8{};
    for (int j = 0; j < n; ++j) {
        const int i = t0 + j, sl = j & 3;
        if (!hb) AT_ISSUE(i + 2);
        f32x16 p0 = negm, p1 = negm;
        { lds_cptr kb = shm3 + LY::LDS_K + sl * LY::KSLOT + hi * 2048 + r32 * 16; i32x8 kf[DKS][2];
#pragma unroll
          for (int s = 0; s < DKS; ++s)
#pragma unroll
              for (int h2 = 0; h2 < 2; ++h2) { const u32x4 lo = *(const LAS u32x4*)(kb + s * 4096 + h2 * 512), hh = *(const LAS u32x4*)(kb + s * 4096 + 1024 + h2 * 512);
                  kf[s][h2] = __builtin_bit_cast(i32x8, __builtin_shufflevector(lo, hh, 0, 1, 2, 3, 4, 5, 6, 7)); }
          __builtin_amdgcn_s_setprio(1);
          if (j > 0) {
#pragma unroll
              for (int ks = 0; ks < 4; ++ks) { const bf16x8 pa = __builtin_bit_cast(bf16x8, ks == 0 ? pw0 : ks == 1 ? pw1 : ks == 2 ? pw2 : pw3);
                  o[0] = __builtin_amdgcn_mfma_f32_32x32x16_bf16(pa, vf[ks], o[0], 0, 0, 0); o[1] = __builtin_amdgcn_mfma_f32_32x32x16_bf16(pa, vf[4 + ks], o[1], 0, 0, 0); } }
#pragma unroll
          for (int s = 0; s < DKS; ++s) {
              asm volatile("v_mfma_scale_f32_32x32x64_f8f6f4 %0, %1, %2, %0, %3, %3 op_sel_hi:[0,0,0]" : "+v"(p0) : "v"(kf[s][0]), "v"(qf[s]), "v"(one_sc));
              asm volatile("v_mfma_scale_f32_32x32x64_f8f6f4 %0, %1, %2, %0, %3, %3 op_sel_hi:[0,0,0]" : "+v"(p1) : "v"(kf[s][1]), "v"(qf[s]), "v"(one_sc)); }
          __builtin_amdgcn_s_setprio(0); }
        if (hb) AT_WAITBAR(i + 2); else AT_BAR_L();
        if (hb) AT_ISSUE(i + 3);
        asm volatile("s_nop 15\n\ts_nop 3" : "+v"(p0), "+v"(p1));
        { lds_cptr vp_ = shm3 + LY::LDS_V + sl * 8192 + ((lane >> 4) & 1) * 32 + (lane & 3) * 8 + (4 * hi + ((lane & 15) >> 2)) * 64;
#pragma unroll
          for (int q = 0; q < 8; ++q) { const s16x4 lo = vtr(vp_ + (q >> 2) * 4096 + (q & 3) * 1024), hh = vtr(vp_ + (q >> 2) * 4096 + (q & 3) * 1024 + 512); vf[q] = (bf16x8){lo[0], lo[1], lo[2], lo[3], hh[0], hh[1], hh[2], hh[3]}; } }
        if (MODE == 1) { const int kb2 = i * 64 + 4 * hi;
#pragma unroll
            for (int r = 0; r < 16; ++r) { const int d0 = kb2 + (r & 3) + 8 * (r >> 2) - qpos, d1 = d0 + 32; if (d0 > 128 || d0 < -128) p0[r] = -INFINITY; if (d1 > 128 || d1 < -128) p1[r] = -INFINITY; } }
        { const float rm = rowmax(p0, p1);
          if (j == 0 || __any(rm > THR)) {
              float dl = (j == 0) ? rm : __builtin_fmaxf(rm, 0.f); if (dl == -INFINITY) dl = 0.f;
              mhat += dl;
#pragma unroll
              for (int r = 0; r < 16; ++r) { p0[r] -= dl; p1[r] -= dl; }
#pragma unroll
              for (int r = 0; r < 16; ++r) negm[r] = -mhat;
              if (j > 0) { const float f = __builtin_amdgcn_exp2f(-dl); l *= f; if (hi == 0) wsf[r32] = f; LDS_WAIT();
#pragma unroll
                  for (int r = 0; r < 16; ++r) { const float g = wsf[crow(r, hi)]; o[0][r] *= g; o[1][r] *= g; } } } }
        { float sa = 0.f, sb = 0.f;
#pragma unroll
          for (int r = 0; r < 16; ++r) { p0[r] = __builtin_amdgcn_exp2f(p0[r]); p1[r] = __builtin_amdgcn_exp2f(p1[r]); sa += p0[r]; sb += p1[r]; }
          l += sa + sb; }
        pw0 = (u32x4){cvt_pk_bf16(p0[0], p0[1]), cvt_pk_bf16(p0[2], p0[3]), cvt_pk_bf16(p0[4], p0[5]), cvt_pk_bf16(p0[6], p0[7])};
        pw1 = (u32x4){cvt_pk_bf16(p0[8], p0[9]), cvt_pk_bf16(p0[10], p0[11]), cvt_pk_bf16(p0[12], p0[13]), cvt_pk_bf16(p0[14], p0[15])};
        pw2 = (u32x4){cvt_pk_bf16(p1[0], p1[1]), cvt_pk_bf16(p1[2], p1[3]), cvt_pk_bf16(p1[4], p1[5]), cvt_pk_bf16(p1[6], p1[7])};
        pw3 = (u32x4){cvt_pk_bf16(p1[8], p1[9]), cvt_pk_bf16(p1[10], p1[11]), cvt_pk_bf16(p1[12], p1[13]), cvt_pk_bf16(p1[14], p1[15])};
        if (!hb) AT_WAITBAR(i + 2); else AT_BAR_L();
    }
    __builtin_amdgcn_s_setprio(1);
#pragma unroll
    for (int ks = 0; ks < 4; ++ks) { const bf16x8 pa = __builtin_bit_cast(bf16x8, ks == 0 ? pw0 : ks == 1 ? pw1 : ks == 2 ? pw2 : pw3);
        o[0] = __builtin_amdgcn_mfma_f32_32x32x16_bf16(pa, vf[ks], o[0], 0, 0, 0); o[1] = __builtin_amdgcn_mfma_f32_32x32x16_bf16(pa, vf[4 + ks], o[1], 0, 0, 0); }
    __builtin_amdgcn_s_setprio(0);
    if (!hb) AT_BAR_L();
    { auto rr = __builtin_amdgcn_permlane32_swap(__float_as_uint(l), __float_as_uint(l), false, false); l = __uint_as_float(rr[0]) + __uint_as_float(rr[1]); }
    if (MODE == 1) l += __builtin_amdgcn_exp2f(sinkl2 - mhat);
    if (hi == 0) wsf[32 + r32] = l; LDS_WAIT();
    float rli[16];
#pragma unroll
    for (int r = 0; r < 16; ++r) rli[r] = __builtin_amdgcn_rcpf(wsf[32 + crow(r, hi)]);
    bf16* Ow = Ou + (size_t)(wid * 32) * op;
    { LAS bf16* stg = (LAS bf16*)(shm3 + LY::LDS_OST) + wid * 2048;
#pragma unroll
        for (int r = 0; r < 16; ++r) { const int orow = crow(r, hi);
#pragma unroll
            for (int d0 = 0; d0 < 2; ++d0) stg[orow * 64 + d0 * 32 + r32] = (bf16)(cvt_pk_bf16(o[d0][r] * rli[r], 0.f) & 0xffffu); }
        LDS_WAIT();
#pragma unroll
        for (int i2 = 0; i2 < 4; ++i2) { const int row = i2 * 8 + (lane >> 3), ch = lane & 7; const u32x4 v = *(const LAS u32x4*)(stg + row * 64 + ch * 8); *(u32x4*)(Ow + (size_t)row * op + ch * 8) = v; } }
    AT_BAR_L();
#undef AT_ISSUE
#undef AT_WAITBAR
}
struct AUnit { const unsigned char* Qu; const unsigned char* Kh; const bf16* Vh; bf16* Ou; int t0, t1, qpos0; float sinkl2; };
template <int DKS, int NCH, int MODE, class Dec>
__device__ __forceinline__ void attn_loop_f8(int idx0, int idx_end, int G, const Dec& dec, int qp, int kp, int vp, int op, char* shm) {
    if (idx0 >= idx_end) return;
    typedef LayP8<DKS> LY; constexpr float THR = 8.0f;
    static_assert(LY::BYTES <= RING_BYTES, "attention LDS");
    const int tid = opaque_tid(), lane = tid & 63, r32 = lane & 31, hi = lane >> 5; const int wid = __builtin_amdgcn_readfirstlane(tid >> 6);
    const bool hb = (wid >= 4);
    const unsigned lds0 = (unsigned)(uintptr_t)shm;
    const lds_cptr shm3 = (lds_cptr)shm;
    LAS float* wsf = (LAS float*)(shm3 + LY::LDS_WS) + wid * 64;
    const bool kw = (wid < NCH);
    AUnit u = dec(idx0); int t0 = u.t0, t1 = u.t1;
    const size_t koff = (size_t)lane * kp + wid * 16, voff = (size_t)(16 * (wid & 3) + (lane >> 2)) * vp + (wid >> 2) * 32 + (lane & 3) * 8;
    const unsigned char* ksrc = u.Kh + koff; const bf16* vsrc = u.Vh + voff;
    const unsigned kdst = lds0 + LY::LDS_K + wid * 1024, vdst = lds0 + LY::LDS_V + wid * 1024;
#define AT_ISSUE(s) do { const int s_ = (s); if (s_ < t1) { const int sl_ = (s_ - t0) & 3; \
        if (kw) glds16(ksrc + (size_t)s_ * 64 * kp, (unsigned)__builtin_amdgcn_readfirstlane(kdst + sl_ * LY::KSLOT)); \
        glds16(vsrc + (size_t)s_ * 64 * vp, (unsigned)__builtin_amdgcn_readfirstlane(vdst + sl_ * 8192)); } } while (0)
#define AT_WAITBAR(young) do { if ((young) < t1) { if (kw) AT_WAIT_BAR(2); else AT_WAIT_BAR(1); } else AT_WAIT_BAR(0); } while (0)
    if (NCH < DKS * 4) {
        for (int b = tid * 16; b < 4 * (DKS * 4 - NCH) * 1024; b += NWAVES * 64 * 16) { const int sl_ = b / ((DKS * 4 - NCH) * 1024), rem = b % ((DKS * 4 - NCH) * 1024);
            *(LAS u32x4*)(shm3 + LY::LDS_K + sl_ * LY::KSLOT + NCH * 1024 + rem) = (u32x4){0u, 0u, 0u, 0u}; } }
    i32x8 qf[DKS], qfn[DKS];
#define AT_QLOAD(dst, Qu_) do { const unsigned char* Qw_ = (Qu_) + (size_t)(wid * 32) * qp; _Pragma("unroll") for (int s = 0; s < DKS; ++s) { const unsigned char* qa = Qw_ + (size_t)r32 * qp + s * 64 + hi * 32; \
        if (s * 64 + hi * 32 < NCH * 16) { const u32x4 lo = *(const u32x4*)qa, hh = *(const u32x4*)(qa + 16); (dst)[s] = __builtin_bit_cast(i32x8, __builtin_shufflevector(lo, hh, 0, 1, 2, 3, 4, 5, 6, 7)); } \
        else (dst)[s] = i32x8{}; } } while (0)
    AT_QLOAD(qf, u.Qu);
    AT_ISSUE(t0); AT_ISSUE(t0 + 1);
    const unsigned one_sc = 0x7f7f7f7fu;
    for (int idx = idx0;;) {
    const int idxn = idx + G; const bool has_next = idxn < idx_end; AUnit un = u;
    float mhat = 0.f, l = 0.f; f32x16 o[2]; o[0] = f32x16{}; o[1] = f32x16{}; f32x16 negm = f32x16{};
    const int qpos = u.qpos0 + wid * 32 + r32;
    const int n = t1 - t0;
    AT_WAITBAR(t0 + 1);
    if (hb) { AT_ISSUE(t0 + 2); AT_BAR_L(); }
    u32x4 pw0 = {}, pw1 = {}, pw2 = {}, pw3 = {}; bf16x8 vf[8];
#pragma unroll
    for (int q = 0; q < 8; ++q) vf[q] = bf16x8{};
    for (int j = 0; j < n; ++j) {
        const int i = t0 + j, sl = j & 3;
        if (!hb) AT_ISSUE(i + 2);
        f32x16 p0 = negm, p1 = negm;
        { lds_cptr kb = shm3 + LY::LDS_K + sl * LY::KSLOT + hi * 2048 + r32 * 16; i32x8 kf[DKS][2];
#pragma unroll
          for (int s = 0; s < DKS; ++s)
#pragma unroll
              for (int h2 = 0; h2 < 2; ++h2) { const u32x4 lo = *(const LAS u32x4*)(kb + s * 4096 + h2 * 512), hh = *(const LAS u32x4*)(kb + s * 4096 + 1024 + h2 * 512);
                  kf[s][h2] = __builtin_bit_cast(i32x8, __builtin_shufflevector(lo, hh, 0, 1, 2, 3, 4, 5, 6, 7)); }
          __builtin_amdgcn_s_setprio(1);
          if (j > 0) {
#pragma unroll
              for (int ks = 0; ks < 4; ++ks) { const bf16x8 pa = __builtin_bit_cast(bf16x8, ks == 0 ? pw0 : ks == 1 ? pw1 : ks == 2 ? pw2 : pw3);
                  o[0] = __builtin_amdgcn_mfma_f32_32x32x16_bf16(pa, vf[ks], o[0], 0, 0, 0); o[1] = __builtin_amdgcn_mfma_f32_32x32x16_bf16(pa, vf[4 + ks], o[1], 0, 0, 0); } }
#pragma unroll
          for (int s = 0; s < DKS; ++s) {
              asm volatile("v_mfma_scale_f32_32x32x64_f8f6f4 %0, %1, %2, %0, %3, %3 op_sel_hi:[0,0,0]" : "+v"(p0) : "v"(kf[s][0]), "v"(qf[s]), "v"(one_sc));
              asm volatile("v_mfma_scale_f32_32x32x64_f8f6f4 %0, %1, %2, %0, %3, %3 op_sel_hi:[0,0,0]" : "+v"(p1) : "v"(kf[s][1]), "v"(qf[s]), "v"(one_sc)); }
          __builtin_amdgcn_s_setprio(0); }
        if (hb) AT_WAITBAR(i + 2); else AT_BAR_L();
        if (hb) AT_ISSUE(i + 3);
        asm volatile("s_nop 15\n\ts_nop 3" : "+v"(p0), "+v"(p1));
        { lds_cptr vp_ = shm3 + LY::LDS_V + sl * 8192 + ((lane >> 4) & 1) * 32 + (lane & 3) * 8 + (4 * hi + ((lane & 15) >> 2)) * 64;
#pragma unroll
          for (int q = 0; q < 8; ++q) { const s16x4 lo = vtr(vp_ + (q >> 2) * 4096 + (q & 3) * 1024), hh = vtr(vp_ + (q >> 2) * 4096 + (q & 3) * 1024 + 512); vf[q] = (bf16x8){lo[0], lo[1], lo[2], lo[3], hh[0], hh[1], hh[2], hh[3]}; } }
        if (MODE == 1) { const int kb2 = i * 64 + 4 * hi;
#pragma unroll
            for (int r = 0; r < 16; ++r) { const int d0 = kb2 + (r & 3) + 8 * (r >> 2) - qpos, d1 = d0 + 32; if (d0 > 128 || d0 < -128) p0[r] = -INFINITY; if (d1 > 128 || d1 < -128) p1[r] = -INFINITY; } }
        { const float rm = rowmax(p0, p1);
          if (j == 0 || __any(rm > THR)) {
              float dl = (j == 0) ? rm : __builtin_fmaxf(rm, 0.f); if (dl == -INFINITY) dl = 0.f;
              mhat += dl;
#pragma unroll
              for (int r = 0; r < 16; ++r) { p0[r] -= dl; p1[r] -= dl; }
#pragma unroll
              for (int r = 0; r < 16; ++r) negm[r] = -mhat;
              if (j > 0) { const float f = __builtin_amdgcn_exp2f(-dl); l *= f; if (hi == 0) wsf[r32] = f; LDS_WAIT();
#pragma unroll
                  for (int r = 0; r < 16; ++r) { const float g = wsf[crow(r, hi)]; o[0][r] *= g; o[1][r] *= g; } } } }
        { float sa = 0.f, sb = 0.f;
#pragma unroll
          for (int r = 0; r < 16; ++r) { p0[r] = __builtin_amdgcn_exp2f(p0[r]); p1[r] = __builtin_amdgcn_exp2f(p1[r]); sa += p0[r]; sb += p1[r]; }
          l += sa + sb; }
        pw0 = (u32x4){cvt_pk_bf16(p0[0], p0[1]), cvt_pk_bf16(p0[2], p0[3]), cvt_pk_bf16(p0[4], p0[5]), cvt_pk_bf16(p0[6], p0[7])};
        pw1 = (u32x4){cvt_pk_bf16(p0[8], p0[9]), cvt_pk_bf16(p0[10], p0[11]), cvt_pk_bf16(p0[12], p0[13]), cvt_pk_bf16(p0[14], p0[15])};
        pw2 = (u32x4){cvt_pk_bf16(p1[0], p1[1]), cvt_pk_bf16(p1[2], p1[3]), cvt_pk_bf16(p1[4], p1[5]), cvt_pk_bf16(p1[6], p1[7])};
        pw3 = (u32x4){cvt_pk_bf16(p1[8], p1[9]), cvt_pk_bf16(p1[10], p1[11]), cvt_pk_bf16(p1[12], p1[13]), cvt_pk_bf16(p1[14], p1[15])};
        if (!hb) AT_WAITBAR(i + 2); else AT_BAR_L();
    }
#define AT_SEAM() do { if (has_next) { un = dec(idxn); ksrc = un.Kh + koff; vsrc = un.Vh + voff; t0 = un.t0; t1 = un.t1; AT_ISSUE(t0); AT_ISSUE(t0 + 1); AT_QLOAD(qfn, un.Qu); } } while (0)
    if (hb) AT_SEAM();
    __builtin_amdgcn_s_setprio(1);
#pragma unroll
    for (int ks = 0; ks < 4; ++ks) { const bf16x8 pa = __builtin_bit_cast(bf16x8, ks == 0 ? pw0 : ks == 1 ? pw1 : ks == 2 ? pw2 : pw3);
        o[0] = __builtin_amdgcn_mfma_f32_32x32x16_bf16(pa, vf[ks], o[0], 0, 0, 0); o[1] = __builtin_amdgcn_mfma_f32_32x32x16_bf16(pa, vf[4 + ks], o[1], 0, 0, 0); }
    __builtin_amdgcn_s_setprio(0);
    if (!hb) { AT_BAR_L(); AT_SEAM(); }
    { auto rr = __builtin_amdgcn_permlane32_swap(__float_as_uint(l), __float_as_uint(l), false, false); l = __uint_as_float(rr[0]) + __uint_as_float(rr[1]); }
    if (MODE == 1) l += __builtin_amdgcn_exp2f(u.sinkl2 - mhat);
    if (hi == 0) wsf[32 + r32] = l; LDS_WAIT();
    float rli[16];
#pragma unroll
    for (int r = 0; r < 16; ++r) rli[r] = __builtin_amdgcn_rcpf(wsf[32 + crow(r, hi)]);
    bf16* Ow = u.Ou + (size_t)(wid * 32) * op;
    { LAS bf16* stg = (LAS bf16*)(shm3 + LY::LDS_OST) + wid * 2048;
#pragma unroll
        for (int r = 0; r < 16; ++r) { const int orow = crow(r, hi);
#pragma unroll
            for (int d0 = 0; d0 < 2; ++d0) stg[orow * 64 + d0 * 32 + r32] = (bf16)(cvt_pk_bf16(o[d0][r] * rli[r], 0.f) & 0xffffu); }
        LDS_WAIT();
#pragma unroll
        for (int i2 = 0; i2 < 4; ++i2) { const int row = i2 * 8 + (lane >> 3), ch = lane & 7; const u32x4 v = *(const LAS u32x4*)(stg + row * 64 + ch * 8); *(u32x4*)(Ow + (size_t)row * op + ch * 8) = v; } }
    AT_BAR_L();
    if (!has_next) break;
    u = un; idx = idxn;
#pragma unroll
    for (int s = 0; s < DKS; ++s) qf[s] = qfn[s];
    }
#undef AT_SEAM
#undef AT_QLOAD
#undef AT_ISSUE
#undef AT_WAITBAR
}
struct DecA { const unsigned char* Q; const unsigned char* K; const bf16* V; bf16* MIX;
    __device__ __forceinline__ AUnit operator()(int idx) const { const int b = idx / 96, h = (idx >> 4) % 6, qb = idx & 15; const size_t rb = (size_t)b * SEQ, rq = rb + qb * 256;
        AUnit u; u.Qu = Q + rq * QAP + h * 96; u.Kh = K + rb * KAP + h * 96; u.Vh = V + rb * VAP + h * 64; u.Ou = MIX + rq * D + h * 64; u.t0 = 0; u.t1 = SEQ / 64; u.qpos0 = qb * 256; u.sinkl2 = 0.f; return u; } };
struct DecB { const unsigned char* Q; const unsigned char* K; const bf16* V; bf16* MIX;
    __device__ __forceinline__ AUnit operator()(int idx) const { const int b = idx / 96, h = (idx >> 4) % 6, qb = idx & 15, hk = h / 3; const size_t rb = (size_t)b * SEQ, rq = rb + qb * 256;
        AUnit u; u.Qu = Q + rq * QBP + h * 64; u.Kh = K + rb * KBP + hk * 64; u.Vh = V + rb * VBP + hk * 64; u.Ou = MIX + rq * D + 384 + h * 64; u.t0 = 0; u.t1 = SEQ / 64; u.qpos0 = qb * 256; u.sinkl2 = 0.f; return u; } };
struct DecC { const unsigned char* Q; const unsigned char* K; const bf16* V; bf16* MIX; const float* sink;
    __device__ __forceinline__ AUnit operator()(int idx) const { const int b = idx / 64, h = (idx >> 4) & 3, qb = idx & 15, hk = h >> 1; const size_t rb = (size_t)b * SEQ, rq = rb + qb * 256;
        AUnit u; u.Qu = Q + rq * QCP + h * 64; u.Kh = K + rb * KCP + hk * 64; u.Vh = V + rb * VCP + hk * 64; u.Ou = MIX + rq * D + 768 + h * 64;
        u.t0 = (qb * 4 - 2 < 0) ? 0 : qb * 4 - 2; u.t1 = (qb * 4 + 6 > SEQ / 64) ? SEQ / 64 : qb * 4 + 6; u.qpos0 = qb * 256; u.sinkl2 = sink[h] * LOG2E; return u; } };
}

struct Args {
    const float *x, *p, *attn_norm, *w_in, *mla_q_norm, *mla_wq_up, *mla_kv_norm, *mla_wkv_up, *gqa_q_norm, *gqa_k_norm, *swa_sink, *w_out, *moe_norm, *router_w, *router_b,
        *w_up, *b_up, *w_down, *b_down, *ple_norm, *w_ple, *w_ple_gate, *final_norm;
    float* out; unsigned char* ws;
};
struct Ctx { LAS unsigned char* lds; int tid, lane, wave, vcu, G, gw, NGW; };

template <bool F8OUT = false, class RMap>
__device__ __forceinline__ void tr_item(const float* W, int N, bf16* WT, int ldo, int kofs, const float* gain, RMap rmap, LAS float* scr, int kb, int nb, int lane, float wsc = 1.0f) {
    const int k0 = 64 * kb, n0 = 32 * nb;
    float wv[32]; const float* src = W + (size_t)(k0 + (lane >> 5)) * N + n0 + (lane & 31);
#pragma unroll
    for (int i = 0; i < 32; ++i) wv[i] = src[(size_t)(2 * i) * N];
#pragma unroll
    for (int i = 0; i < 32; ++i) scr[(2 * i + (lane >> 5)) * 33 + (lane & 31)] = wv[i];
    LDS_WAIT(); asm volatile("" ::: "memory");
    const int c = lane & 7; float gs[8];
#pragma unroll
    for (int q = 0; q < 8; ++q) gs[q] = (gain ? gain[k0 + 8 * c + q] : 1.0f) * wsc;
#pragma unroll
    for (int j = 0; j < 4; ++j) { const int n = (lane >> 3) + 8 * j; const LAS float* s = scr + (8 * c) * 33 + n;
        if (F8OUT) { u32x2 o; o.x = pk4_fp8(s[0 * 33] * gs[0], s[1 * 33] * gs[1], s[2 * 33] * gs[2], s[3 * 33] * gs[3]); o.y = pk4_fp8(s[4 * 33] * gs[4], s[5 * 33] * gs[5], s[6 * 33] * gs[6], s[7 * 33] * gs[7]);
            *(u32x2*)((unsigned char*)WT + (size_t)rmap(n0 + n) * ldo + kofs + k0 + 8 * c) = o; }
        else { u32x4 o; o.x = cvt_pk_bf16(s[0 * 33] * gs[0], s[1 * 33] * gs[1]); o.y = cvt_pk_bf16(s[2 * 33] * gs[2], s[3 * 33] * gs[3]); o.z = cvt_pk_bf16(s[4 * 33] * gs[4], s[5 * 33] * gs[5]); o.w = cvt_pk_bf16(s[6 * 33] * gs[6], s[7 * 33] * gs[7]);
            *(u32x4*)(WT + (size_t)rmap(n0 + n) * ldo + kofs + k0 + 8 * c) = o; } }
    LDS_WAIT(); asm volatile("" ::: "memory");
}
struct MapId { __device__ __forceinline__ int operator()(int n) const { return n; } };
struct MapIn { __device__ __forceinline__ int operator()(int n) const {
    if (n < 384) return n;
    if (n < 416) { const int j = n - 384; return 384 + ((j < 16) ? 2 * j : 2 * (j - 16) + 1); }
    int hs, d; bool pairs; if (n < ZC) { const int q = n - ZB; hs = q >> 6; d = q & 63; pairs = (hs < 8); } else { const int q = n - ZC; hs = 10 + (q >> 6); d = q & 63; pairs = false; }
    const int bj = d >> 5, dd = d & 31, p = pairs ? ((dd & 15) * 2 + (dd >> 4)) : dd;
    return 256 * (2 + (hs >> 2)) + 128 * bj + 32 * (hs & 3) + p; } };
struct MapQ { __device__ __forceinline__ int operator()(int n) const { const int h = n / 96, d = n - h * 96; if (d < 64) return n; const int j = d - 64; return h * 96 + 64 + ((j < 16) ? 2 * j : 2 * (j - 16) + 1); } };
struct MapUp { __device__ __forceinline__ int operator()(int n) const { if (n < 1024) return (n >> 7) * 256 + (n & 127); const int m = n - 1024; return (m >> 7) * 256 + 128 + (m & 127); } };

__device__ __forceinline__ void zero16(bf16* base, size_t n16, const Ctx& C) {
    const u32x4 z = {0u, 0u, 0u, 0u};
    for (size_t i = (size_t)C.gw * 64 + C.lane; i < n16; i += (size_t)C.NGW * 64) ((u32x4*)base)[i] = z;
}

__device__ __forceinline__ void prologue(const Args& a, const Ctx& C) {
    unsigned char* ws = launder(a.ws);
    LAS float* scr = (LAS float*)(C.lds + C.wave * 16384);
    constexpr int I_UP = 16 * 64, I_DN = 16 * 32, I_IN = 16 * 49, I_OUT = 16 * 32, I_G = 16 * 32, I_Q = 4 * 18, I_KV = 2 * 24, I_PLE = 4 * 32;
    constexpr int N_UP = NL * NE * I_UP, N_DN = NL * NE * I_DN, N_IN = NL * I_IN, N_OUT = NL * I_OUT, N_G = NL * I_G, N_Q = NL * I_Q, N_KV = NL * I_KV, N_PLE = NL * I_PLE;
    constexpr int NITEMS = N_UP + N_DN + N_IN + N_OUT + N_G + N_Q + N_KV + N_PLE;
    for (int it = C.gw; it < NITEMS; it += C.NGW) {
        int r = it;
        if (r < N_UP) { const int le = r / I_UP, q = r - le * I_UP, l = le / NE; tr_item<MOE_F8 != 0>(a.w_up + (size_t)le * D * 2048, 2048, (bf16*)(ws + WS_WUP + (size_t)le * 2048 * D * MOE_ES), D, 0, a.moe_norm + l * D, MapUp(), scr, q / 64, q % 64, C.lane, WSC); continue; } r -= N_UP;
        if (r < N_DN) { const int le = r / I_DN, q = r - le * I_DN; tr_item<MOE_F8 != 0>(a.w_down + (size_t)le * D * D, D, (bf16*)(ws + WS_WDN + (size_t)le * D * D * MOE_ES), D, 0, nullptr, MapId(), scr, q / 32, q % 32, C.lane, WSC); continue; } r -= N_DN;
        if (r < N_IN) { const int l = r / I_IN, q = r - l * I_IN; tr_item(a.w_in + (size_t)l * D * 1568, 1568, (bf16*)(ws + WS_WIN) + (size_t)l * ZP * D, D, 0, a.attn_norm + l * D, MapIn(), scr, q / 49, q % 49, C.lane); continue; } r -= N_IN;
        if (r < N_OUT) { const int l = r / I_OUT, q = r - l * I_OUT; tr_item(a.w_out + (size_t)l * D * D, D, (bf16*)(ws + WS_WOUT) + (size_t)l * D * D, D, 0, nullptr, MapId(), scr, q / 32, q % 32, C.lane); continue; } r -= N_OUT;
        if (r < N_G) { const int l = r / I_G, q = r - l * I_G; tr_item(a.w_ple_gate + (size_t)l * D * D, D, (bf16*)(ws + WS_WG) + (size_t)l * D * D, D, 0, a.ple_norm + l * D, MapId(), scr, q / 32, q % 32, C.lane); continue; } r -= N_G;
        if (r < N_Q) { const int l = r / I_Q, q = r - l * I_Q; tr_item(a.mla_wq_up + (size_t)l * 256 * 576, 576, (bf16*)(ws + WS_WQ) + (size_t)l * 768 * 256, 256, 0, a.mla_q_norm + l * 256, MapQ(), scr, q / 18, q % 18, C.lane); continue; } r -= N_Q;
        if (r < N_KV) { const int l = r / I_KV, q = r - l * I_KV; tr_item(a.mla_wkv_up + (size_t)l * 128 * 768, 768, (bf16*)(ws + WS_WKV) + (size_t)l * 768 * 256, 256, 128, a.mla_kv_norm + l * 128, MapId(), scr, q / 24, q % 24, C.lane); continue; } r -= N_KV;
        { const int l = r / I_PLE, q = r - l * I_PLE; tr_item(a.w_ple + (size_t)l * 256 * D, D, (bf16*)(ws + WS_WPLE) + (size_t)l * D * 256, 256, 0, nullptr, MapId(), scr, q / 32, q % 32, C.lane); }
    }
    for (int l = 0; l < NL; ++l) {
        zero16((bf16*)(ws + WS_WIN) + ((size_t)l * ZP + 416) * D, (size_t)96 * D / 8, C);
        zero16((bf16*)(ws + WS_WIN) + ((size_t)l * ZP + 1600) * D, (size_t)64 * D / 8, C);
        zero16((bf16*)(ws + WS_WIN) + ((size_t)l * ZP + 1728) * D, (size_t)64 * D / 8, C);
        zero16((bf16*)(ws + WS_WQ) + ((size_t)l * 768 + 576) * 256, (size_t)192 * 256 / 8, C);
    }
    for (int i = C.gw * 64 + C.lane; i < NL * 768 * 16; i += C.NGW * 64) { const int row = i >> 4, pc = i & 15; *(u32x4*)((bf16*)(ws + WS_WKV) + (size_t)row * 256 + pc * 8) = (u32x4){0u, 0u, 0u, 0u}; }
    for (int m = 4 * C.gw; m < T; m += 4 * C.NGW) {
        f32x4 v[4][4]; float s[4];
#pragma unroll
        for (int q = 0; q < 4; ++q) { const f32x4* xr = (const f32x4*)(a.x + (size_t)(m + q) * D) + C.lane;
#pragma unroll
            for (int j = 0; j < 4; ++j) v[q][j] = xr[64 * j]; }
#pragma unroll
        for (int q = 0; q < 4; ++q) { s[q] = 0.f;
#pragma unroll
            for (int j = 0; j < 4; ++j) s[q] += (v[q][j][0] * v[q][j][0] + v[q][j][1] * v[q][j][1]) + (v[q][j][2] * v[q][j][2] + v[q][j][3] * v[q][j][3]);
            s[q] = wave_sum(s[q]);
            u32x2* o8 = (u32x2*)((bf16*)(ws + WS_XB) + (size_t)(m + q) * D) + C.lane;
#pragma unroll
            for (int j = 0; j < 4; ++j) { u32x2 w; w.x = cvt_pk_bf16(v[q][j][0], v[q][j][1]); w.y = cvt_pk_bf16(v[q][j][2], v[q][j][3]); o8[64 * j] = w; }
            if (C.lane == 0) __hip_atomic_store((u64*)(ws + WS_SS0) + m + q, fx_enc(s[q]), RLX_AGENT); }
    }
    for (size_t i0 = (size_t)C.gw * 256; i0 < (size_t)NL * T * 256 / 8; i0 += (size_t)C.NGW * 256) {
        f32x4 v[4][2];
#pragma unroll
        for (int q = 0; q < 4; ++q) { const size_t i = i0 + q * 64 + C.lane; v[q][0] = ((const f32x4*)a.p)[2 * i]; v[q][1] = ((const f32x4*)a.p)[2 * i + 1]; }
#pragma unroll
        for (int q = 0; q < 4; ++q) { const size_t i = i0 + q * 64 + C.lane;
            u32x4 w; w.x = cvt_pk_bf16(v[q][0][0], v[q][0][1]); w.y = cvt_pk_bf16(v[q][0][2], v[q][0][3]); w.z = cvt_pk_bf16(v[q][1][0], v[q][1][1]); w.w = cvt_pk_bf16(v[q][1][2], v[q][1][3]); ((u32x4*)(ws + WS_PB))[i] = w; }
    }
    for (int i = C.gw * 64 + C.lane; i < SEQ * 48; i += C.NGW * 64) {
        int pos, j; double ex; f32x2* dst;
        if (i < SEQ * 16) { pos = i >> 4; j = i & 15; ex = (double)j / 16.0; dst = (f32x2*)(ws + WS_TAB32) + i; }
        else { const int q = i - SEQ * 16; pos = q >> 5; j = q & 31; ex = (double)j / 32.0; dst = (f32x2*)(ws + WS_TAB64) + q; }
        const float inv = (float)exp2(-13.287712379549449 * ex);
        const float angf = (float)pos * inv;
        const double rev = (double)angf * 0.15915494309189535; const float fr = (float)(rev - floor(rev));
        *dst = (f32x2){__builtin_amdgcn_cosf(fr), __builtin_amdgcn_sinf(fr)};
    }
    for (int i = C.gw * 64 + C.lane; i < NL * D * NE; i += C.NGW * 64) { const int l = i / (D * NE), k = (i / NE) % D; ((float*)(ws + WS_WR))[i] = a.router_w[i] * a.moe_norm[l * D + k]; }
    for (int i = C.gw * 64 + C.lane; i < NL * NE * D; i += C.NGW * 64) { const int l = i / (NE * D), e = (i / D) % NE, k = i % D; const float w = a.router_w[((size_t)l * D + k) * NE + e] * a.moe_norm[l * D + k];
        const unsigned h = cvt_pk_bf16(w, 0.f) & 0xffffu; const float lo = w - __uint_as_float(h << 16);
        ((bf16*)(ws + WS_WR + 512 * 1024))[i] = (bf16)h; ((bf16*)(ws + WS_WR + 768 * 1024))[i] = (bf16)(cvt_pk_bf16(lo, 0.f) & 0xffffu); }
    for (int i = C.gw * 64 + C.lane; i < NL * NE * 2048; i += C.NGW * 64) { const int le = i / 2048, n = i % 2048; ((float*)(ws + WS_BUP))[(size_t)le * 2048 + MapUp()(n)] = a.b_up[i]; }
}
namespace gp { }
__device__ __forceinline__ float sq4g(f32x4 v) { return (v[0] * v[0] + v[1] * v[1]) + (v[2] * v[2] + v[3] * v[3]); }

__device__ __forceinline__ void rope_phase(const Args& a, const Ctx& C, int l) {
    unsigned char* ws = launder(a.ws);
    const bf16* Z = (const bf16*)(ws + WS_Z); const f32x2* tab32 = (const f32x2*)(ws + WS_TAB32); const f32x2* tab64 = (const f32x2*)(ws + WS_TAB64);
    bf16 *KA = (bf16*)(ws + WS_KA), *QB = (bf16*)(ws + WS_QB), *KB = (bf16*)(ws + WS_KB), *VB = (bf16*)(ws + WS_VB), *QC = (bf16*)(ws + WS_QC), *KC = (bf16*)(ws + WS_KC), *VC = (bf16*)(ws + WS_VC);
    const int lane = C.lane;
    const float gq = a.gqa_q_norm[l * 64 + lane], gk = a.gqa_k_norm[l * 64 + lane];
    for (int t = C.gw; t < T; t += C.NGW) {
        const int pos = t & (SEQ - 1), prow = pos >> 6, pcol = pos & 63; const bf16* zr = Z + (size_t)t * ZP;
        {
            const float v = bf2f(zr[384 + (lane & 31)]); const float pr = __shfl_xor(v, 16); const int j = lane & 15; const f32x2 cs = tab32[pos * 16 + j];
            const float o = (lane & 16) ? (v * cs.x + pr * cs.y) : (v * cs.x - pr * cs.y); const bf16 ob = (bf16)(cvt_pk_bf16(o, 0.f) & 0xffffu);
            if (lane < 32) { const int dest = 64 + 2 * j + ((lane >> 4) & 1);
#pragma unroll
                for (int h = 0; h < 6; ++h) KA[(size_t)t * KAP + h * 96 + dest] = ob; }
        }
#pragma unroll
        for (int hb = 0; hb < 10; ++hb) {
            float v = bf2f(zr[ZB + hb * 64 + lane]);
            if (hb < 8) { const float ss = wave_sum(v * v); const float n = v * __builtin_amdgcn_rsqf(ss * (1.0f / 64) + EPS) * (hb < 6 ? gq : gk);
                const float pr = __shfl_xor(n, 16); const int j = lane & 15; const f32x2 cs = tab32[((lane & 32) ? pcol : prow) * 16 + j];
                v = (lane & 16) ? (n * cs.x + pr * cs.y) : (n * cs.x - pr * cs.y); if (hb < 6) v *= C2B; }
            const bf16 ob = (bf16)(cvt_pk_bf16(v, 0.f) & 0xffffu);
            if (hb < 6) QB[(size_t)t * QBP + hb * 64 + lane] = ob; else if (hb < 8) KB[(size_t)t * KBP + (hb - 6) * 64 + lane] = ob; else VB[(size_t)t * VBP + (hb - 8) * 64 + lane] = ob;
        }
#pragma unroll
        for (int hc = 0; hc < 8; ++hc) {
            float v = bf2f(zr[ZC + hc * 64 + lane]);
            if (hc < 6) { const float pr = __shfl_xor(v, 32); const f32x2 cs = tab64[pos * 32 + (lane & 31)]; v = (lane & 32) ? (v * cs.x + pr * cs.y) : (v * cs.x - pr * cs.y); if (hc < 4) v *= C2B; }
            const bf16 ob = (bf16)(cvt_pk_bf16(v, 0.f) & 0xffffu);
            if (hc < 4) QC[(size_t)t * QCP + hc * 64 + lane] = ob; else if (hc < 6) KC[(size_t)t * KCP + (hc - 4) * 64 + lane] = ob; else VC[(size_t)t * VCP + (hc - 6) * 64 + lane] = ob;
        }
    }
}

__device__ __forceinline__ void router_phase(const Args& a, const Ctx& C, int l, bool commit) {
    unsigned char* ws = launder(a.ws);
    const float* XF = (const float*)(ws + WS_XF); const float* WR = (const float*)(ws + WS_WR) + (size_t)l * D * NE; const u64* ss1 = (const u64*)(ws + WS_CTL + (size_t)CW_SS * 4) + (size_t)(l * 4 + 2) * T;
    int* cnt = (int*)(ws + WS_CTL) + CW_CNT + l * NE; int* perm = (int*)(ws + WS_PERM); float* rsl = (float*)(ws + WS_RSL); float* gsl = (float*)(ws + WS_GSL);
    LAS float* part = (LAS float*)C.lds;
    LAS int* hist = (LAS int*)(C.lds + MISC_OFF + 1024); LAS int* base = hist + NE;
    const int lane = C.lane, r32 = lane & 31, hi = lane >> 5, tg = C.wave & 3, kh = C.wave >> 2;
    for (int blk = C.vcu; blk < T / 128; blk += C.G) {
        const int t0 = blk * 128;
        if (C.tid < NE) hist[C.tid] = 0;
        f32x16 acc = {};
        const float* xr = XF + (size_t)(t0 + tg * 32 + r32) * D + kh * 512 + hi * 4; const bf16* xrb = (const bf16*)(ws + WS_X1B) + (size_t)(t0 + tg * 32 + r32) * D + kh * 512 + hi * 4; const float* wr = WR + (size_t)(kh * 512 + hi * 4) * NE + r32;
        const float rs_l = __builtin_amdgcn_rsqf(fx_load(ss1 + t0 + tg * 32 + r32) * (1.0f / D) + EPS);
        unsigned char* xq = ws + WS_X1Q + (size_t)(t0 + tg * 32 + r32) * D + kh * 512 + hi * 4;
        if (X1_BF16) {
            const bf16* xb_ = (const bf16*)(ws + WS_X1B) + (size_t)(t0 + tg * 32 + r32) * D + kh * 512 + hi * 8;
            const bf16* wh_ = (const bf16*)(ws + WS_WR + 512 * 1024) + ((size_t)l * NE + r32) * D + kh * 512 + hi * 8; const bf16* wl_ = wh_ + (256 * 1024) / 2;
            unsigned char* xq8 = ws + WS_X1Q + (size_t)(t0 + tg * 32 + r32) * D + kh * 512 + hi * 8;
#pragma unroll 1
            for (int kb = 0; kb < 32; kb += 8) { u32x4 xb[8], ah[8], al[8];
#pragma unroll
                for (int q = 0; q < 8; ++q) { xb[q] = *(const u32x4*)(xb_ + (kb + q) * 16); ah[q] = *(const u32x4*)(wh_ + (kb + q) * 16); al[q] = *(const u32x4*)(wl_ + (kb + q) * 16); }
                __builtin_amdgcn_sched_barrier(0);
                if (MOE_F8) {
#pragma unroll
                    for (int q = 0; q < 8; ++q) { const u32x4 w = xb[q]; u32x2 o; o.x = pk4_fp8(bflo(w.x) * rs_l, bfhi(w.x) * rs_l, bflo(w.y) * rs_l, bfhi(w.y) * rs_l); o.y = pk4_fp8(bflo(w.z) * rs_l, bfhi(w.z) * rs_l, bflo(w.w) * rs_l, bfhi(w.w) * rs_l);
                        *(u32x2*)(xq8 + (kb + q) * 16) = o; } }
#pragma unroll
                for (int q = 0; q < 8; ++q) { acc = __builtin_amdgcn_mfma_f32_32x32x16_bf16(__builtin_bit_cast(bf16x8, ah[q]), __builtin_bit_cast(bf16x8, xb[q]), acc, 0, 0, 0);
                    acc = __builtin_amdgcn_mfma_f32_32x32x16_bf16(__builtin_bit_cast(bf16x8, al[q]), __builtin_bit_cast(bf16x8, xb[q]), acc, 0, 0, 0); } }
        } else {
#pragma unroll 1
        for (int kb = 0; kb < 64; kb += 8) { f32x4 xv[8]; float wv[8][4];
#pragma unroll
            for (int q = 0; q < 8; ++q) { if (X1_BF16) { const u32x2 w = *(const u32x2*)(xrb + (kb + q) * 8); xv[q] = (f32x4){bflo(w.x), bfhi(w.x), bflo(w.y), bfhi(w.y)}; } else xv[q] = *(const f32x4*)(xr + (kb + q) * 8);
#pragma unroll
                for (int i = 0; i < 4; ++i) wv[q][i] = wr[((kb + q) * 8 + i) * NE]; }
            __builtin_amdgcn_sched_barrier(0);
            if (MOE_F8) {
#pragma unroll
                for (int q = 0; q < 8; ++q) *(unsigned*)(xq + (kb + q) * 8) = pk4_fp8(xv[q][0] * rs_l, xv[q][1] * rs_l, xv[q][2] * rs_l, xv[q][3] * rs_l); }
#pragma unroll
            for (int q = 0; q < 8; ++q)
#pragma unroll
                for (int i = 0; i < 4; ++i) acc = __builtin_amdgcn_mfma_f32_32x32x2f32(wv[q][i], xv[q][i], acc, 0, 0, 0); }
        }
#pragma unroll
        for (int r = 0; r < 16; ++r) part[(kh * 128 + tg * 32 + r32) * 33 + at::crow(r, hi)] = acc[r];
        __syncthreads();
        int ek[4]; float wk[4]; int rk[4]; float rs_t = 1.0f; const int t = t0 + C.tid;
        if (C.tid < 128) {
            const float rs = __builtin_amdgcn_rsqf(fx_load(ss1 + t) * (1.0f / D) + EPS); float v[NE]; rs_t = rs;
#pragma unroll
            for (int e = 0; e < NE; ++e) v[e] = (part[C.tid * 33 + e] + part[(128 + C.tid) * 33 + e]) * rs + a.router_b[l * NE + e];
            unsigned used = 0u; float tv[4];
#pragma unroll
            for (int k = 0; k < 4; ++k) { float best = -INFINITY; int bi = 0;
#pragma unroll
                for (int e = 0; e < NE; ++e) { const bool ok = !((used >> e) & 1u) && (v[e] > best); best = ok ? v[e] : best; bi = ok ? e : bi; }
                used |= 1u << bi; ek[k] = bi; tv[k] = best; }
            float den = 0.f;
#pragma unroll
            for (int k = 0; k < 4; ++k) { wk[k] = __expf(tv[k] - tv[0]); den += wk[k]; }
            const float rd = 1.0f / den;
#pragma unroll
            for (int k = 0; k < 4; ++k) { wk[k] *= rd; rk[k] = commit ? atomicAdd((int*)(hist + ek[k]), 1) : 0; }
        }
        __syncthreads();
        if (C.tid < NE && commit) base[C.tid] = atomicAdd(cnt + C.tid, hist[C.tid]);
        __syncthreads();
        if (C.tid < 128 && commit) {
#pragma unroll
            for (int k = 0; k < 4; ++k) { const int sidx = ek[k] * ECAP + base[ek[k]] + rk[k]; __hip_atomic_store(perm + sidx, t * 4 + k, RLX_AGENT); __hip_atomic_store(rsl + sidx, rs_t, RLX_AGENT); __hip_atomic_store(gsl + sidx, wk[k], RLX_AGENT); }
        }
        __syncthreads();
    }
}

__device__ __forceinline__ void combine_phase(const Args& a, const Ctx& C) {
    unsigned char* ws = launder(a.ws); const float* XF = (const float*)(ws + WS_XF); const bf16* Y = (const bf16*)(ws + WS_Y); bf16* X2B = (bf16*)(ws + WS_X2B); float* rs2 = (float*)(ws + WS_RS2);
    for (int t0 = 2 * C.gw; t0 < T; t0 += 2 * C.NGW) {
        f32x4 v[2][4]; u32x2 y[2][4][4];
#pragma unroll
        for (int q = 0; q < 2; ++q) { const f32x4* xr = (const f32x4*)(XF + (size_t)(t0 + q) * D) + C.lane; const u32x2* xrb = (const u32x2*)((const bf16*)(ws + WS_X1B) + (size_t)(t0 + q) * D) + C.lane;
#pragma unroll
            for (int j = 0; j < 4; ++j) { if (X1_BF16) { const u32x2 w = xrb[64 * j]; v[q][j] = (f32x4){bflo(w.x), bfhi(w.x), bflo(w.y), bfhi(w.y)}; } else v[q][j] = xr[64 * j]; }
#pragma unroll
            for (int k = 0; k < 4; ++k) { const u32x2* yr = (const u32x2*)(Y + (size_t)((t0 + q) * 4 + k) * D) + C.lane;
#pragma unroll
                for (int j = 0; j < 4; ++j) y[q][k][j] = yr[64 * j]; } }
#pragma unroll
        for (int q = 0; q < 2; ++q) { float s = 0.f;
#pragma unroll
            for (int k = 0; k < 4; ++k)
#pragma unroll
                for (int j = 0; j < 4; ++j) { const u32x2 w = y[q][k][j]; v[q][j][0] += bflo(w.x); v[q][j][1] += bfhi(w.x); v[q][j][2] += bflo(w.y); v[q][j][3] += bfhi(w.y); }
            u32x2* o8 = (u32x2*)(X2B + (size_t)(t0 + q) * D) + C.lane;
#pragma unroll
            for (int j = 0; j < 4; ++j) { u32x2 w; w.x = cvt_pk_bf16(v[q][j][0], v[q][j][1]); w.y = cvt_pk_bf16(v[q][j][2], v[q][j][3]); o8[64 * j] = w; s += sq4g(v[q][j]); }
            s = wave_sum(s);
            if (C.lane == 0) __hip_atomic_store(rs2 + t0 + q, __builtin_amdgcn_rsqf(s * (1.0f / D) + EPS), RLX_AGENT); }
    }
}
__device__ __forceinline__ void final_phase(const Args& a, const Ctx& C) {
    const bf16* XB = (const bf16*)(launder(a.ws) + WS_XB);
    const f32x4* g = (const f32x4*)a.final_norm + C.lane; f32x4 gv[4];
#pragma unroll
    for (int j = 0; j < 4; ++j) gv[j] = g[64 * j];
    for (int t0 = 4 * C.gw; t0 < T; t0 += 4 * C.NGW) {
        u32x2 w[4][4];
#pragma unroll
        for (int q = 0; q < 4; ++q) { const u32x2* xr = (const u32x2*)(XB + (size_t)(t0 + q) * D) + C.lane;
#pragma unroll
            for (int j = 0; j < 4; ++j) w[q][j] = xr[64 * j]; }
#pragma unroll
        for (int q = 0; q < 4; ++q) { f32x4 v[4]; float s = 0.f;
#pragma unroll
            for (int j = 0; j < 4; ++j) { v[j] = (f32x4){bflo(w[q][j].x), bfhi(w[q][j].x), bflo(w[q][j].y), bfhi(w[q][j].y)}; s += sq4g(v[j]); }
            s = wave_sum(s); const float rs = 1.0f / sqrtf(s * (1.0f / D) + EPS);
            f32x4* o = (f32x4*)(a.out + (size_t)(t0 + q) * D) + C.lane;
#pragma unroll
            for (int j = 0; j < 4; ++j) o[64 * j] = v[j] * rs * gv[j]; }
    }
}
__device__ __forceinline__ Ctx make_ctx(LAS unsigned char* lds) {
    Ctx C; C.lds = lds; C.tid = opaque_tid(); C.lane = C.tid & 63; C.wave = __builtin_amdgcn_readfirstlane(C.tid >> 6);
    C.G = gridDim.x; const int bx = blockIdx.x; C.vcu = (C.G % 8 == 0) ? (bx % 8) * (C.G / 8) + bx / 8 : bx; C.gw = C.vcu * NWAVES + C.wave; C.NGW = C.G * NWAVES; return C;
}
#ifdef PROBE_A
#define STAMP(i) do { if (blockIdx.x == 0 && threadIdx.x == 0) ((LAS u64*)(lds + MISC_OFF + 3072))[(i)] = __builtin_amdgcn_s_memrealtime(); } while (0)
#else
#define STAMP(i) do { } while (0)
#endif
#define GRID_BAR() do { XcdBarrier b_; b_.bar = (unsigned*)(launder(a.ws) + WS_CTL) + CW_BAR; b_.x = xb_xcc_id(); b_.st = (volatile LAS unsigned*)(lds + MISC_OFF); xcd_barrier(b_); } while (0)
__global__ void __launch_bounds__(NWAVES * 64, 2) fwd(Args a) {
    extern __shared__ __attribute__((aligned(16))) unsigned char lds_raw[];
    LAS unsigned char* lds = (LAS unsigned char*)lds_raw;
    for (int u = threadIdx.x; u < (LDS_BYTES - MISC_OFF) / 4; u += NWAVES * 64) ((LAS unsigned*)(lds + MISC_OFF))[u] = 0u;
    __syncthreads();
    (void)xcd_barrier_post((unsigned*)(launder(a.ws) + WS_CTL) + CW_BAR, (volatile LAS unsigned*)(lds + MISC_OFF));
    const int bx = blockIdx.x;
    STAMP(0);
    PH(0) { const Ctx C = make_ctx(lds); prologue(a, C); }
    GRID_BAR(); STAMP(1);

#pragma unroll 1
    for (int l = 0; l < NL; ++l) {
        PH(1) { unsigned char* ws = launder(a.ws); u64* ssb = (u64*)(ws + WS_CTL + (size_t)CW_SS * 4) + (size_t)l * 4 * T;
          const u64* ssin = (l == 0) ? (const u64*)(ws + WS_SS0) : (const u64*)(ws + WS_CTL + (size_t)CW_SS * 4) + (size_t)((l - 1) * 4 + 3) * T;
          gp::DenseSched S; S.init(ws + WS_XB, D, (bf16*)(ws + WS_WIN) + (size_t)l * ZP * D, D, T, ZP, gridDim.x, bx);
          gp::EpiIn E{(bf16*)(ws + WS_Z), ssin, ssb, ssb + T, rep_ == 0, (bf16*)(ws + WS_KA), (bf16*)(ws + WS_QB), (bf16*)(ws + WS_KB), (bf16*)(ws + WS_VB), (bf16*)(ws + WS_QC), (bf16*)(ws + WS_KC), (bf16*)(ws + WS_VC),
                       (const f32x2*)(ws + WS_TAB32), (const f32x2*)(ws + WS_TAB64), a.gqa_q_norm + l * 64, a.gqa_k_norm + l * 64};
          gp::gemm_phase<gp::EpiIn, gp::DenseSched, true>(lds, D, S, E); }
        GRID_BAR(); STAMP(2 + l * 9 + 0);
        PH(3) { unsigned char* ws = launder(a.ws); u64* ssb = (u64*)(ws + WS_CTL + (size_t)CW_SS * 4) + (size_t)l * 4 * T;
          gp::MlaSched S{(const char*)(ws + WS_Z), (const char*)((bf16*)(ws + WS_WQ) + (size_t)l * 768 * 256), (const char*)((bf16*)(ws + WS_WKV) + (size_t)l * 768 * 256), (int)gridDim.x, bx};
          gp::EpiMla E{(bf16*)(ws + WS_QA), (bf16*)(ws + WS_KA), (bf16*)(ws + WS_VA), ssb, ssb + T, (const f32x2*)(ws + WS_TAB32)};
          gp::gemm_phase<gp::EpiMla, gp::MlaSched, true>(lds, 256, S, E); }
        GRID_BAR(); STAMP(2 + l * 9 + 1);
        {
            char* shm = (char*)lds_raw; const int G = gridDim.x, vcu = (G % 8 == 0) ? (bx % 8) * (G / 8) + bx / 8 : bx;
            PH(4) { unsigned char* ws = launder(a.ws); at::DecA dec{ws + WS_QA, ws + WS_KA, (const bf16*)(ws + WS_VA), (bf16*)(ws + WS_MIX)};
              at::attn_loop_f8<2, 6, 0>(vcu, NB * 6 * 16, G, dec, QAP, KAP, VAP, D, shm); }
            PH(5) { unsigned char* ws = launder(a.ws); at::DecB dec{ws + WS_QB, ws + WS_KB, (const bf16*)(ws + WS_VB), (bf16*)(ws + WS_MIX)};
              at::attn_loop_f8<1, 4, 0>(vcu, NB * 6 * 16, G, dec, QBP, KBP, VBP, D, shm); }
            PH(6) { unsigned char* ws = launder(a.ws); at::DecC dec{ws + WS_QC, ws + WS_KC, (const bf16*)(ws + WS_VC), (bf16*)(ws + WS_MIX), a.swa_sink + l * 4};
              at::attn_loop_f8<1, 4, 1>(vcu, NB * 4 * 16, G, dec, QCP, KCP, VCP, D, shm); }
        }
        GRID_BAR(); STAMP(2 + l * 9 + 2);
        for (int rep_ = 0; rep_ < 1 + (((REPMASK >> 7) & 1) && l == 0); ++rep_) { unsigned char* ws = launder(a.ws); u64* ssb = (u64*)(ws + WS_CTL + (size_t)CW_SS * 4) + (size_t)l * 4 * T; float* XF = (float*)(ws + WS_XF);
          gp::DenseSched S; S.init(ws + WS_MIX, D, (bf16*)(ws + WS_WOUT) + (size_t)l * D * D, D, T, D, gridDim.x, bx);
          gp::EpiRes E{a.x, (l == 0) ? (const bf16*)nullptr : (const bf16*)(ws + WS_XB), XF, (bf16*)(ws + WS_X1B), ssb + 2 * T, rep_ == 0, ws + WS_X1Q};
          gp::gemm_phase<gp::EpiRes, gp::DenseSched, true>(lds, D, S, E); }
        GRID_BAR(); STAMP(2 + l * 9 + 3);
        PH(8) { const Ctx C = make_ctx(lds); router_phase(a, C, l, rep_ == 0); }
        PH(9) { unsigned char* ws = launder(a.ws);
          gp::DenseSched S; S.init((bf16*)(ws + WS_PB) + (size_t)l * T * 256, 256, (bf16*)(ws + WS_WPLE) + (size_t)l * D * 256, 256, T, D, gridDim.x, bx);
          gp::EpiPlain E{(bf16*)(ws + WS_EB), D};
          gp::gemm_phase<gp::EpiPlain, gp::DenseSched, true>(lds, 256, S, E); }
        GRID_BAR(); STAMP(2 + l * 9 + 4);
        gp::MoeTab tb; tb.P = (LAS int*)(lds + MISC_OFF + 2048); tb.C = tb.P + 64; tb.R2E = (LAS int*)(lds + MISC_OFF + 4096);
        if (threadIdx.x == 0) { const int* cnt = (const int*)(launder(a.ws) + WS_CTL) + CW_CNT + l * NE; int accp = 0;
            for (int e = 0; e < NE; ++e) { const int c = cnt[e]; tb.C[e] = c; tb.P[e] = accp; accp += (c + 255) >> 8; } tb.P[NE] = accp; }
        __syncthreads();
        { const int nrt = tb.P[NE];
#pragma unroll 1
          for (int rt = opaque_tid(); rt < nrt; rt += NWAVES * 64) { int e = 0;
#pragma unroll 1
              for (int j = 1; j < NE; ++j) e = (tb.P[j] <= rt) ? j : e;
              tb.R2E[rt] = e; } }
        __syncthreads();
        PH(10) { unsigned char* ws = launder(a.ws); u64* ssb = (u64*)(ws + WS_CTL + (size_t)CW_SS * 4) + (size_t)l * 4 * T; const int* perm = (const int*)(ws + WS_PERM);
          gp::UpSched S{tb, perm, (const char*)(ws + (MOE_F8 ? WS_X1Q : WS_X1B)), (const char*)(ws + WS_WUP + (size_t)l * NE * 2048 * D * MOE_ES), (int)gridDim.x, bx};
          gp::EpiUp E{(bf16*)(ws + WS_ACT), (const float*)(ws + WS_RSL), (const float*)(ws + WS_BUP) + (size_t)l * NE * 2048, tb};
          gp::gemm_phase<gp::EpiUp, gp::UpSched, true, MOE_F8 != 0>(lds, D, S, E); }
        GRID_BAR(); STAMP(2 + l * 9 + 5);
        PH(11) { unsigned char* ws = launder(a.ws); const int* perm = (const int*)(ws + WS_PERM);
          gp::DownSched S{tb, (const char*)(ws + WS_ACT), (const char*)(ws + WS_WDN + (size_t)l * NE * D * D * MOE_ES), (int)gridDim.x, bx};
          gp::EpiDown E{(bf16*)(ws + WS_Y), a.b_down + (size_t)l * NE * D, (const float*)(ws + WS_GSL), perm, tb};
          gp::gemm_phase<gp::EpiDown, gp::DownSched, true, MOE_F8 != 0>(lds, D, S, E); }
        GRID_BAR(); STAMP(2 + l * 9 + 6);
        PH(12) { const Ctx C = make_ctx(lds); combine_phase(a, C); }
        GRID_BAR(); STAMP(2 + l * 9 + 7);
        PH(13) { unsigned char* ws = launder(a.ws); u64* ssb = (u64*)(ws + WS_CTL + (size_t)CW_SS * 4) + (size_t)l * 4 * T;
          gp::DenseSched S; S.init(ws + WS_X2B, D, (bf16*)(ws + WS_WG) + (size_t)l * D * D, D, T, D, gridDim.x, bx);
          gp::EpiGate E{(const bf16*)(ws + WS_X2B), (bf16*)(ws + WS_XB), (const bf16*)(ws + WS_EB), (const float*)(ws + WS_RS2), ssb + 3 * T, rep_ == 0};
          gp::gemm_phase<gp::EpiGate, gp::DenseSched, true>(lds, D, S, E); }
        GRID_BAR(); STAMP(2 + l * 9 + 8);
    }
#ifdef PROBE_A
    if (blockIdx.x == 0 && threadIdx.x == 0) { LAS u64* st = (LAS u64*)(lds + MISC_OFF + 3072); const float ms = (float)(long long)(st[PROBE_B] - st[PROBE_A]) * 1e-5f;
        __hip_atomic_store((float*)(launder(a.ws) + WS_RS2) + T, 1.0f + ms, RLX_AGENT); }
    GRID_BAR();
#endif
    PH(14) { const Ctx C = make_ctx(lds); final_phase(a, C); }
}

extern "C" void kernel_launch(void* const* d_in, const int* in_sizes, int n_in, void* d_out, int out_size, void* d_ws, size_t ws_size, hipStream_t stream) {
    static int grid = 0;
    if (grid == 0) {
        if (n_in != 23 || out_size != T * D || ws_size < WS_END) { fprintf(stderr, "kernel_launch: unexpected shapes (n_in %d out %d ws %zu)\n", n_in, out_size, ws_size); grid = -1; return; }
        int dev = 0, cus = 0, per_cu = 0;
        if (hipGetDevice(&dev) != hipSuccess || hipDeviceGetAttribute(&cus, hipDeviceAttributeMultiprocessorCount, dev) != hipSuccess) { grid = -1; return; }
        if (hipFuncSetAttribute((const void*)fwd, hipFuncAttributeMaxDynamicSharedMemorySize, LDS_BYTES) != hipSuccess) { fprintf(stderr, "kernel_launch: hipFuncSetAttribute failed\n"); grid = -1; return; }
        if (hipOccupancyMaxActiveBlocksPerMultiprocessor(&per_cu, (const void*)fwd, NWAVES * 64, LDS_BYTES) != hipSuccess || per_cu < 1) fprintf(stderr, "kernel_launch: occupancy query reports %d\n", per_cu);
        (void)hipGetLastError();
        grid = cus;
    }
    if (grid < 0) return;
    if (hipMemsetAsync((char*)d_ws + WS_CTL, 0, CTL_ZERO_BYTES, stream) != hipSuccess) return;
    Args a{};
    const float** ap = (const float**)&a;
    for (int i = 0; i < 23; ++i) ap[i] = (const float*)d_in[i];
    a.out = (float*)d_out; a.ws = (unsigned char*)d_ws;
    hipLaunchKernelGGL(fwd, dim3(grid), dim3(NWAVES * 64), LDS_BYTES, stream, a);
}
```

```cpp
#include <hip/hip_runtime.h>
#include <cstdio>
#include <cstdint>
#include <type_traits>

#define GAS __attribute__((address_space(1)))
#define LAS __attribute__((address_space(3)))
typedef unsigned short bf16;
typedef short bf16x8 __attribute__((ext_vector_type(8)));
typedef short s16x4 __attribute__((ext_vector_type(4)));
typedef float f32x2 __attribute__((ext_vector_type(2)));
typedef float f32x4 __attribute__((ext_vector_type(4)));
typedef float f32x16 __attribute__((ext_vector_type(16)));
typedef unsigned u32x2 __attribute__((ext_vector_type(2)));
typedef unsigned u32x4 __attribute__((ext_vector_type(4)));

constexpr int NB = 8, SEQ = 4096, T = NB * SEQ, D = 1024, NL = 2;
constexpr int ZP = 1792;
constexpr int ZQ = 384;
constexpr int A_COLS = 416, B_COLS = 640;
constexpr int ZB = A_COLS, ZC = A_COLS + B_COLS;
constexpr int QAP = 576, KAP = 576, VAP = 384, QBP = 384, KBP = 128, VBP = 128, QCP = 256, KCP = 128, VCP = 128;
constexpr int NE = 32, TOPK = 4, ECAP = T;
constexpr int ACT_ROWS = T * TOPK + NE * 256;
constexpr float EPS = 1e-6f, LOG2E = 1.4426950408889634f;
constexpr float C2A = 0.10206207261596577f * LOG2E;
constexpr float C2B = 0.125f * LOG2E;

#ifndef P1_F8
#define P1_F8 1
#endif
#ifndef P4_F8
#define P4_F8 1
#endif
constexpr float MSC = 64.0f;
#ifndef PV_CHECK
#define PV_CHECK 0
#endif
#ifndef PV_LOW
#define PV_LOW 0.0f
#endif
#ifndef PV_TOL
#define PV_TOL 0.02f
#endif
#ifndef PV_F8
#define PV_F8 1
#endif
constexpr float VSC = 8.0f;
#ifndef ATT_F8
#define ATT_F8 1
#endif
#ifndef X1_BF16
#define X1_BF16 1
#endif
#ifndef MOE_F8
#define MOE_F8 1
#endif
constexpr int MOE_ES = MOE_F8 ? 1 : 2;
constexpr float WSC = 64.0f, WSC_INV = 1.0f / 64.0f;

constexpr size_t MiB = 1u << 20;
constexpr size_t WS_CTL = 0, CTL_ZERO_BYTES = 4 * MiB;
constexpr int CW_BAR = 4096;
constexpr int CW_CNT = 16384;
constexpr int CW_SS = 65536;
static_assert(CW_SS * 4 + NL * 4 * T * 8 <= (int)CTL_ZERO_BYTES, "ctl");
constexpr size_t WS_TAB32 = 4 * MiB;
constexpr size_t WS_TAB64 = 5 * MiB;
constexpr size_t WS_WR = 6 * MiB;
constexpr size_t WS_BUP = 7 * MiB;
constexpr size_t WS_SS0 = 8 * MiB;
constexpr size_t WS_RS2 = 8 * MiB + 512 * 1024;
constexpr size_t WS_GATES = 9 * MiB;
constexpr size_t WS_PERM = 10 * MiB;
constexpr size_t WS_WIN = 16 * MiB;
constexpr size_t WS_WQ = 24 * MiB;
constexpr size_t WS_WKV = 25 * MiB;
constexpr size_t WS_WOUT = 26 * MiB;
constexpr size_t WS_WG = 30 * MiB;
constexpr size_t WS_WPLE = 34 * MiB;
constexpr size_t WS_WUP = 36 * MiB;
constexpr size_t WS_WDN = 292 * MiB;
constexpr size_t WS_XB = 420 * MiB;
constexpr size_t WS_X1B = 484 * MiB;
constexpr size_t WS_X2B = 548 * MiB;
constexpr size_t WS_XF = 612 * MiB;
constexpr size_t WS_PB = 740 * MiB;
constexpr size_t WS_Z = 772 * MiB;
constexpr size_t WS_QA = 884 * MiB;
constexpr size_t WS_KA = 920 * MiB;
constexpr size_t WS_VA = 956 * MiB;
constexpr size_t WS_QB = 980 * MiB;
constexpr size_t WS_KB = 1004 * MiB;
constexpr size_t WS_VB = 1012 * MiB;
constexpr size_t WS_QC = 1020 * MiB;
constexpr size_t WS_KC = 1036 * MiB;
constexpr size_t WS_VC = 1044 * MiB;
constexpr size_t WS_MIX = 1052 * MiB;
constexpr size_t WS_EB = 1116 * MiB;
constexpr size_t WS_ACT = 1180 * MiB;
constexpr size_t WS_Y = 1452 * MiB;
constexpr size_t WS_RSL = 1708 * MiB;
constexpr size_t WS_GSL = 1712 * MiB;
constexpr size_t WS_X1Q = 1716 * MiB;
constexpr size_t WS_END = 1748 * MiB;
constexpr size_t WS_XQ = WS_XF;
static_assert(X1_BF16 || !P1_F8, "XQ aliases XF");
constexpr size_t WS_VTA = PV_CHECK ? WS_Y : WS_VA, WS_VTB = PV_CHECK ? WS_Y + 16 * MiB : WS_VB, WS_VTC = PV_CHECK ? WS_Y + 24 * MiB : WS_VC, WS_MIX2 = WS_Y + 32 * MiB;
constexpr int CW_CHK = CW_CNT + 1024;

constexpr int RING_BYTES = 131072;
constexpr int MISC_OFF = RING_BYTES;
constexpr int LDS_BYTES = 147456;
constexpr int NWAVES = 8;

#define RLX_AGENT __ATOMIC_RELAXED, __HIP_MEMORY_SCOPE_AGENT
#define LDS_WAIT() asm volatile("s_waitcnt lgkmcnt(0)" ::: "memory")
#define VM_WAIT() asm volatile("s_waitcnt vmcnt(0)" ::: "memory")
__device__ __forceinline__ unsigned cvt_pk_bf16(float lo, float hi) { unsigned r; asm volatile("v_cvt_pk_bf16_f32 %0, %1, %2" : "=v"(r) : "v"(lo), "v"(hi)); return r; }
__device__ __forceinline__ unsigned pk4_fp8(float a, float b, float c, float d) { int w = 0; w = __builtin_amdgcn_cvt_pk_fp8_f32(a, b, w, false); w = __builtin_amdgcn_cvt_pk_fp8_f32(c, d, w, true); return (unsigned)w; }
__device__ __forceinline__ u32x2 pk8_fp8(f32x4 a, f32x4 b) { u32x2 w; w.x = pk4_fp8(a[0], a[1], a[2], a[3]); w.y = pk4_fp8(b[0], b[1], b[2], b[3]); return w; }
__device__ __forceinline__ float bf2f(unsigned short b) { return __uint_as_float((unsigned)b << 16); }
__device__ __forceinline__ float bflo(unsigned w) { return __uint_as_float(w << 16); }
__device__ __forceinline__ float bfhi(unsigned w) { return __uint_as_float(w & 0xffff0000u); }
typedef unsigned long long u64;
__device__ __forceinline__ u64 fx_enc(float v) { return (u64)__float2ll_rn(v * 1048576.0f); }
__device__ __forceinline__ void atomic_addf(u64* p, float v) { (void)__hip_atomic_fetch_add(p, fx_enc(v), __ATOMIC_RELAXED, __HIP_MEMORY_SCOPE_AGENT); }
__device__ __forceinline__ float fx_load(const u64* p) { return (float)(long long)(*p) * (1.0f / 1048576.0f); }
__device__ __forceinline__ float wave_sum(float v) {
#pragma unroll
    for (int o = 1; o < 64; o <<= 1) v += __shfl_xor(v, o);
    return v;
}
__device__ __forceinline__ float sigmoidf_fast(float x) { return __builtin_amdgcn_rcpf(1.0f + __builtin_amdgcn_exp2f(-x * LOG2E)); }

__device__ __forceinline__ unsigned char* launder(unsigned char* p) { GAS unsigned char* g = (GAS unsigned char*)p; asm volatile("" : "+s"(g)); return (unsigned char*)g; }
__device__ __forceinline__ int opaque_tid() { int t = threadIdx.x; asm volatile("" : "+v"(t)); return t; }
#ifndef REPMASK
#define REPMASK 0
#endif
#define PH(k) for (int rep_ = 0; rep_ < 1 + ((REPMASK >> (k)) & 1); ++rep_)

#define XB_TMO      128
#define XB_XCNT(j)  (256  + 64 * (j))
#define XB_XSUB(j)  (1280 + 64 * (j))
#define XB_XGEN(j)  (2304 + 64 * (j))
#define XB_TOP      3328
#define XB_TOPGEN   3392
#define XCD_BAR_WORDS 3456
#define XB_SPIN_CAP (1u << 18)
__device__ __forceinline__ unsigned xb_ld(unsigned* p)              { return __hip_atomic_load(p, __ATOMIC_RELAXED, __HIP_MEMORY_SCOPE_AGENT); }
__device__ __forceinline__ unsigned xb_add(unsigned* p, unsigned v) { return __hip_atomic_fetch_add(p, v, __ATOMIC_RELAXED, __HIP_MEMORY_SCOPE_AGENT); }
__device__ __forceinline__ unsigned xb_xcc_id() { return (unsigned)__builtin_amdgcn_s_getreg((3 << 11) | 20) & 0xFu; }
#define XB_SPIN(cond, bar) do { unsigned _sp = 0; while (cond) { __builtin_amdgcn_s_sleep(1); \
    if ((++_sp & 255u) == 0u) { if (xb_ld(&(bar)[XB_TMO])) break; if (_sp > XB_SPIN_CAP) { atomicAdd(&(bar)[XB_TMO], 1u); break; } } } } while (0)
struct XcdBarrier { unsigned* bar; unsigned x; volatile LAS unsigned* st; };
__device__ __forceinline__ XcdBarrier xcd_barrier_post(unsigned* bar, volatile LAS unsigned* st) {
    XcdBarrier b; b.bar = bar; b.x = xb_xcc_id(); b.st = st;
    if (threadIdx.x == 0) (void)xb_add(&bar[XB_XCNT(b.x)], 1u);
    return b;
}
__device__ __forceinline__ void xcd_barrier_complete(unsigned* bar, unsigned x, unsigned& nloc, unsigned& nx) {
    const unsigned G = gridDim.x * gridDim.y * gridDim.z;
    unsigned sum, cnt, mine, sp = 0u;
    for (;;) {
        sum = 0u; cnt = 0u; mine = 0u;
#pragma unroll
        for (unsigned j = 0; j < 16; ++j) { const unsigned c = xb_ld(&bar[XB_XCNT(j)]); sum += c; cnt += (c > 0u) ? 1u : 0u; mine = (j == x) ? c : mine; }
        if (sum == G) break;
        __builtin_amdgcn_s_sleep(1);
        if ((++sp & 255u) == 0u) { if (xb_ld(&bar[XB_TMO])) break; if (sp > XB_SPIN_CAP) { atomicAdd(&bar[XB_TMO], 1u); break; } }
    }
    nloc = mine > 0u ? mine : 1u; nx = cnt > 0u ? cnt : 1u;
}
__device__ __forceinline__ void xcd_barrier(const XcdBarrier& b) {
    asm volatile("s_waitcnt vmcnt(0)" ::: "memory");
    __syncthreads();
    if (threadIdx.x == 0) {
        unsigned* bar = b.bar;
        __builtin_amdgcn_s_waitcnt(0);
        unsigned nloc = b.st[0], nx = b.st[1];
        if (nloc == 0u) { xcd_barrier_complete(bar, b.x, nloc, nx); b.st[0] = nloc; b.st[1] = nx; }
        const unsigned old = xb_add(&bar[XB_XSUB(b.x)], 1u);
        const unsigned gen = old / nloc;
        if (old + 1u == (gen + 1u) * nloc) {
            __builtin_amdgcn_fence(__ATOMIC_RELEASE, "agent");
            asm volatile("s_waitcnt vmcnt(0)" ::: "memory");
            const unsigned og = xb_add(&bar[XB_TOP], 1u);
            const unsigned tg = og / nx;
            if (og + 1u == (tg + 1u) * nx) xb_add(&bar[XB_TOPGEN], 1u);
            else XB_SPIN(xb_ld(&bar[XB_TOPGEN]) == tg, bar);
            __builtin_amdgcn_fence(__ATOMIC_ACQUIRE, "agent");
            xb_add(&bar[XB_XGEN(b.x)], 1u);
            asm volatile("s_waitcnt vmcnt(0)" ::: "memory");
        } else {
            XB_SPIN(xb_ld(&bar[XB_XGEN(b.x)]) == gen, bar);
            __builtin_amdgcn_fence(__ATOMIC_ACQUIRE, "agent");
            asm volatile("s_waitcnt vmcnt(0)" ::: "memory");
        }
    }
    __syncthreads();
}

namespace gp {
constexpr int BM = 256, BK = 64, HALF = 128, HTB = HALF * BK * 2, STAGE_BYTES = 8 * HTB, NXCD = 8, WGM = 16;
__host__ __device__ __forceinline__ int lds_byte(int r, int c) { const int st = (r >> 4) * 2 + (c >> 5), rr = r & 15, cc = c & 31, ob = rr * 64 + cc * 2; return st * 1024 + (ob ^ (((ob >> 9) & 1) << 5)); }
__host__ __device__ __forceinline__ void stage_rc(int b, int& R, int& C) { const int st = b / 1024, sb = b % 1024, swz = sb ^ (((sb >> 9) & 1) << 5); R = (st >> 1) * 16 + swz / 64; C = (st & 1) * 32 + (swz % 64) / 2; }
__host__ __device__ __forceinline__ int perm32(int rho) { const int n = rho >> 4, i = rho & 15; return 8 * (i >> 2) + 4 * n + (i & 3); }

struct Unit { int pm, pn, aux; const char* A; const char* B; };

struct TileOrder {
    int nM, nN, nwg, G, c;
    __device__ __forceinline__ void init(int nM_, int nN_, int G_, int c_) { nM = nM_; nN = nN_; nwg = nM * nN; G = G_; c = c_; }
    __device__ __forceinline__ bool tile(int i, int& pm, int& pn) const {
        const long L = (long)i * G + c; if (L >= nwg) return false;
        int wgid = (int)L; { const int q = nwg / NXCD, r = nwg % NXCD, xcd = wgid % NXCD, off = wgid / NXCD; wgid = (xcd < r ? xcd * (q + 1) : r * (q + 1) + (xcd - r) * q) + off; }
        const int nig = WGM * nN, gid = wgid / nig, fm = gid * WGM, gsz = (nM - fm) < WGM ? (nM - fm) : WGM;
        pm = fm + ((wgid % nig) % gsz); pn = (wgid % nig) / gsz; return true;
    }
};
struct DenseSched {
    TileOrder o; const char* A; const char* B; int lda, K;
    __device__ __forceinline__ void init(const void* A_, int lda_, const void* B_, int K_, int M, int N, int G, int c) { A = (const char*)A_; B = (const char*)B_; lda = lda_; K = K_; o.init(M / BM, N / BM, G, c); }
    __device__ __forceinline__ bool next(int i, Unit& u) const { int pm, pn; if (!o.tile(i, pm, pn)) return false; u.pm = pm; u.pn = pn; u.aux = 0;
        u.A = A + (size_t)pm * BM * lda * 2; u.B = B + (size_t)pn * BM * K * 2; return true; }
    __device__ __forceinline__ unsigned rowoff(const Unit&, int r) const { return (unsigned)(r * lda * 2); }
    __device__ __forceinline__ unsigned rowraw(const Unit&, int r) const { return (unsigned)(r * lda * 2); }
    __device__ __forceinline__ unsigned rawoff(unsigned raw) const { return raw; }
};

typedef int i32x8 __attribute__((ext_vector_type(8)));
template <class Epi, class Sched, bool ALIGN_EPI, bool F8 = false>
__device__ __forceinline__ void gemm_phase(LAS unsigned char* lds, const int Kel, const Sched& S, const Epi& E) {
    const int K = F8 ? (Kel >> 1) : Kel;
    const int tid = opaque_tid(), wid = __builtin_amdgcn_readfirstlane(tid >> 6), lane = tid & 63, wr = wid >> 2, wc = wid & 3, fr = lane & 15, fq = lane >> 4;
    const int nt = K / BK;
    int Rr[2], Cc[2]; unsigned voffB[2];
#pragma unroll
    for (int i = 0; i < 2; ++i) { int R, C; stage_rc(tid * 16 + i * 8192, R, C); const int Rb = Epi::PERM ? ((R & ~31) + perm32(R & 31)) : R;
        Rr[i] = R; Cc[i] = C * 2; voffB[i] = (unsigned)(Rb * K + C) * 2u; }
    const size_t kstep = (size_t)(BK * 2);
    const size_t hstepB = (size_t)HALF * K * 2;
    const unsigned ldsw = (unsigned)wid * 1024u;
    const int aoff = lds_byte(wr * 64 + fr, fq * (F8 ? 16 : 8)), boff = lds_byte(wc * 32 + fr, fq * (F8 ? 16 : 8));
#define GP_SA(b, h) (((b) * 2 + (h)) * HTB)
#define GP_SB(b, h) ((4 + (b) * 2 + (h)) * HTB)
#define GP_STAGE(bufoff, gbase, voff) do { _Pragma("unroll") for (int _i = 0; _i < 2; ++_i) \
        __builtin_amdgcn_global_load_lds((const unsigned*)((const char*)(gbase) + (voff)[_i]), (LAS unsigned*)(lds + (bufoff) + ldsw + _i * 8192), 16, 0, 0); } while (0)
#define GP_LD1(dst, base) do { if constexpr (F8) { const u32x4 lo_ = *(const LAS u32x4*)(base), hi_ = *(const LAS u32x4*)((base) + 16); (dst)[0] = __builtin_bit_cast(i32x8, __builtin_shufflevector(lo_, hi_, 0, 1, 2, 3, 4, 5, 6, 7)); } \
        else { _Pragma("unroll") for (int k = 0; k < NK; ++k) (dst)[k] = __builtin_bit_cast(frag_t, *(const LAS typename std::conditional<F8, i32x8, bf16x8>::type*)((base) + k * 1024)); } } while (0)
#define GP_LDA(dst, b, h) do { _Pragma("unroll") for (int m = 0; m < 4; ++m) GP_LD1(dst[m], lds + GP_SA(b, h) + aoff + m * 2048); } while (0)
#define GP_LDB(dst, b, h) do { _Pragma("unroll") for (int n = 0; n < 2; ++n) GP_LD1(dst[n], lds + GP_SB(b, h) + boff + n * 2048); } while (0)
#define GP_MMA(ai, bj, At, Bt) do { __builtin_amdgcn_s_setprio(1); \
        if constexpr (F8) { _Pragma("unroll") for (int m = 0; m < 4; ++m) _Pragma("unroll") for (int n = 0; n < 2; ++n) \
            asm volatile("v_mfma_scale_f32_16x16x128_f8f6f4 %0, %1, %2, %0, %3, %3 op_sel_hi:[0,0,0]" : "+v"(acc[ai][bj][m][n]) : "v"(Bt[n][0]), "v"(At[m][0]), "v"(one_sc)); } \
        else { _Pragma("unroll") for (int m = 0; m < 4; ++m) _Pragma("unroll") for (int n = 0; n < 2; ++n) _Pragma("unroll") for (int k = 0; k < NK; ++k) \
            acc[ai][bj][m][n] = __builtin_amdgcn_mfma_f32_16x16x32_bf16(__builtin_bit_cast(bf16x8, Bt[n][k]), __builtin_bit_cast(bf16x8, At[m][k]), acc[ai][bj][m][n], 0, 0, 0); } \
        __builtin_amdgcn_s_setprio(0); } while (0)
#define GP_WAIT_V(n) asm volatile("s_waitcnt vmcnt(" #n ")" ::: "memory")
#define GP_WAIT_L(n) asm volatile("s_waitcnt lgkmcnt(" #n ")" ::: "memory")
#define GP_BAR __builtin_amdgcn_s_barrier()
#define GP_SCHED __builtin_amdgcn_sched_barrier(0)
    Unit cur, nxt; int ui = 0;
    if (!S.next(0, cur)) return;
    unsigned vAc[2][2], vAn[2][2];
#pragma unroll
    for (int h = 0; h < 2; ++h)
#pragma unroll
        for (int i = 0; i < 2; ++i) vAc[h][i] = S.rowoff(cur, h * HALF + Rr[i]) + (unsigned)Cc[i];
    f32x4 acc[2][2][4][2];
#pragma unroll
    for (int a = 0; a < 2; ++a)
#pragma unroll
        for (int b = 0; b < 2; ++b)
#pragma unroll
            for (int m = 0; m < 4; ++m)
#pragma unroll
                for (int n = 0; n < 2; ++n) acc[a][b][m][n] = (f32x4){0.f, 0.f, 0.f, 0.f};
    typedef typename std::conditional<F8, i32x8, bf16x8>::type frag_t; constexpr int NK = F8 ? 1 : 2;
    frag_t At[4][NK], B0[2][NK], B1[2][NK]; const unsigned one_sc = 0x7f7f7f7fu;
    const char* cA = cur.A; const char* cB = cur.B;
    GP_STAGE(GP_SB(0, 0), cB, voffB); GP_STAGE(GP_SB(0, 1), cB + hstepB, voffB); GP_STAGE(GP_SA(0, 0), cA, vAc[0]); GP_STAGE(GP_SA(0, 1), cA, vAc[1]);
    if (wr == 1) GP_BAR;
    GP_WAIT_V(2); GP_BAR;
    GP_STAGE(GP_SB(1, 0), cB + kstep, voffB); GP_STAGE(GP_SA(1, 0), cA + kstep, vAc[0]); GP_STAGE(GP_SB(1, 1), cB + hstepB + kstep, voffB);
    GP_WAIT_V(6); GP_BAR;
    for (;;) {
        const bool has_next = S.next(ui + 1, nxt);
        const char* nA = has_next ? nxt.A : cA; const char* nB = has_next ? nxt.B : cB;
#pragma unroll
        for (int h = 0; h < 2; ++h)
#pragma unroll
            for (int i = 0; i < 2; ++i) vAn[h][i] = has_next ? S.rowraw(nxt, h * HALF + Rr[i]) : 0u;
#pragma unroll 1
        for (int t = 0; t < nt; t += 2) {
            const bool last = (t == nt - 2);
            const char* a1 = cA + (size_t)(t + 1) * kstep;
            const char* a2 = last ? nA : cA + (size_t)(t + 2) * kstep; const char* b2 = last ? nB : cB + (size_t)(t + 2) * kstep;
            const char* a3 = a2 + kstep; const char* b3 = b2 + kstep;
            GP_LDB(B0, 0, 0); GP_LDB(B1, 0, 1); GP_SCHED; GP_LDA(At, 0, 0); GP_STAGE(GP_SA(1, 1), a1, vAc[1]);
            if (last && has_next) {
#pragma unroll
                for (int h = 0; h < 2; ++h)
#pragma unroll
                    for (int i = 0; i < 2; ++i) { unsigned r_ = vAn[h][i]; asm volatile("" : "+v"(r_)); vAc[h][i] = S.rawoff(r_) + (unsigned)Cc[i]; } }
            GP_WAIT_V(8); GP_WAIT_L(0); GP_BAR; GP_MMA(0, 0, At, B0); GP_MMA(0, 1, At, B1); GP_BAR; GP_SCHED;
            GP_LDA(At, 0, 1); GP_STAGE(GP_SB(0, 0), b2, voffB); GP_STAGE(GP_SB(0, 1), b2 + hstepB, voffB); GP_STAGE(GP_SA(0, 0), a2, vAc[0]);
            GP_WAIT_V(8); GP_WAIT_L(0); GP_BAR; GP_MMA(1, 0, At, B0); GP_MMA(1, 1, At, B1); GP_BAR; GP_SCHED;
            GP_LDB(B0, 1, 0); GP_LDB(B1, 1, 1); GP_SCHED; GP_LDA(At, 1, 0); GP_STAGE(GP_SA(0, 1), a2, vAc[1]);
            GP_WAIT_V(8); GP_WAIT_L(0); GP_BAR; GP_MMA(0, 0, At, B0); GP_MMA(0, 1, At, B1); GP_BAR; GP_SCHED;
            GP_LDA(At, 1, 1); GP_STAGE(GP_SB(1, 0), b3, voffB); GP_STAGE(GP_SB(1, 1), b3 + hstepB, voffB); GP_STAGE(GP_SA(1, 0), a3, vAc[0]);
            GP_WAIT_V(8); GP_WAIT_L(0); GP_BAR; GP_MMA(1, 0, At, B0); GP_MMA(1, 1, At, B1); GP_BAR; GP_SCHED;
        }
        if constexpr (ALIGN_EPI) { if (wr == 0) GP_BAR; }
        if constexpr (F8) asm volatile("s_nop 15\n\ts_nop 15" ::: "memory");
        E(acc, cur, wr, wc, fr, fq);
        if (!has_next) break;
#pragma unroll
        for (int a = 0; a < 2; ++a)
#pragma unroll
            for (int b = 0; b < 2; ++b)
#pragma unroll
                for (int m = 0; m < 4; ++m)
#pragma unroll
                    for (int n = 0; n < 2; ++n) acc[a][b][m][n] = (f32x4){0.f, 0.f, 0.f, 0.f};
        cur = nxt; cA = nA; cB = nB; ++ui;
        if constexpr (ALIGN_EPI) { if (wr == 1) GP_BAR; }
    }
    GP_WAIT_V(0);
    if constexpr (!ALIGN_EPI) { if (wr == 0) GP_BAR; }
    GP_BAR;
#undef GP_SA
#undef GP_SB
#undef GP_STAGE
#undef GP_LDA
#undef GP_LDB
#undef GP_MMA
#undef GP_LD1
#undef GP_WAIT_V
#undef GP_WAIT_L
#undef GP_BAR
#undef GP_SCHED
}

typedef f32x4 Acc[2][2][4][2];
__device__ __forceinline__ u32x4 pack8(f32x4 v0, f32x4 v1) { u32x4 w; w.x = cvt_pk_bf16(v0[0], v0[1]); w.y = cvt_pk_bf16(v0[2], v0[3]); w.z = cvt_pk_bf16(v1[0], v1[1]); w.w = cvt_pk_bf16(v1[2], v1[3]); return w; }
__device__ __forceinline__ float sq4(f32x4 v) { return (v[0] * v[0] + v[1] * v[1]) + (v[2] * v[2] + v[3] * v[3]); }
__device__ __forceinline__ float fq_sum(float s) { s += __shfl_xor(s, 16); s += __shfl_xor(s, 32); return s; }

struct EpiPlain {
    static constexpr bool PERM = true;
    bf16* O; int ldc;
    __device__ __forceinline__ void operator()(const Acc& acc, const Unit& u, int wr, int wc, int fr, int fq) const {
        const int row0 = u.pm * BM + wr * 64 + fr, col0 = u.pn * BM + wc * 32 + 8 * fq;
#pragma unroll
        for (int ai = 0; ai < 2; ++ai)
#pragma unroll
            for (int m = 0; m < 4; ++m) { bf16* rowp = O + (size_t)(row0 + ai * HALF + m * 16) * ldc + col0;
#pragma unroll
                for (int bj = 0; bj < 2; ++bj) *(u32x4*)(rowp + bj * HALF) = pack8(acc[ai][bj][m][0], acc[ai][bj][m][1]); }
    }
};
constexpr float RSC1 = P1_F8 ? 1.0f / WSC : 1.0f;
struct EpiIn {
    static constexpr bool PERM = true;
    bf16* Z; const u64* ssin; u64* ssq; u64* sskv; bool accum;
    bf16 *KA, *QB, *KB, *VB, *QC, *KC, *VC; const f32x2* tab32; const f32x2* tab64; const float* gq; const float* gk; unsigned char *VTB, *VTC; bool vt;
    __device__ __forceinline__ void operator()(const Acc& acc, const Unit& u, int wr, int wc, int fr, int fq) const {
        const int row0 = u.pm * BM + wr * 64 + fr;
        if (u.pn < 2) {
#pragma unroll
            for (int ai = 0; ai < 2; ++ai)
#pragma unroll
                for (int m = 0; m < 4; ++m) { const int row = row0 + ai * HALF + m * 16; const float rs = (__builtin_amdgcn_rsqf(fx_load(ssin + row) * (1.0f / D) + EPS) * RSC1);
                    const f32x4 a0 = acc[ai][0][m][0] * rs, a1 = acc[ai][0][m][1] * rs, b0 = acc[ai][1][m][0] * rs, b1 = acc[ai][1][m][1] * rs;
                    bf16* rowp = Z + (size_t)row * ZQ + u.pn * BM + wc * 32 + 8 * fq;
                    *(u32x4*)rowp = pack8(a0, a1);
                    if (u.pn == 0) { *(u32x4*)(rowp + HALF) = pack8(b0, b1); const float s = fq_sum(sq4(a0) + sq4(a1) + sq4(b0) + sq4(b1)); if (fq == 0 && accum) atomic_addf(ssq + row, s); }
                    else { const float s = fq_sum(sq4(a0) + sq4(a1)); if (fq == 0 && accum) atomic_addf(sskv + row, s);
                        if (wc == 0) { const f32x2* cs = tab32 + (size_t)(row & (SEQ - 1)) * 16 + 4 * fq; const f32x2 c0 = cs[0], c1 = cs[1], c2 = cs[2], c3 = cs[3];
                            f32x4 r0, r1; r0[0] = b0[0] * c0.x - b0[1] * c0.y; r0[1] = b0[1] * c0.x + b0[0] * c0.y; r0[2] = b0[2] * c1.x - b0[3] * c1.y; r0[3] = b0[3] * c1.x + b0[2] * c1.y;
                            r1[0] = b1[0] * c2.x - b1[1] * c2.y; r1[1] = b1[1] * c2.x + b1[0] * c2.y; r1[2] = b1[2] * c3.x - b1[3] * c3.y; r1[3] = b1[3] * c3.x + b1[2] * c3.y;
                            if (ATT_F8) { const u32x2 w = pk8_fp8(r0, r1); unsigned char* kp = (unsigned char*)KA + (size_t)row * KAP + 64 + 8 * fq;
#pragma unroll
                                for (int h = 0; h < 6; ++h) *(u32x2*)(kp + h * 96) = w; }
                            else { const u32x4 w = pack8(r0, r1); bf16* kp = KA + (size_t)row * KAP + 64 + 8 * fq;
#pragma unroll
                                for (int h = 0; h < 6; ++h) *(u32x4*)(kp + h * 96) = w; } } } }
            return;
        }
        const int hs = 4 * (u.pn - 2) + wc;
        if (hs >= 18) return;
        if (hs < 8) {
            const float* g = (hs < 6) ? gq : gk; float gn[2][2][4];
#pragma unroll
            for (int bj = 0; bj < 2; ++bj)
#pragma unroll
                for (int n = 0; n < 2; ++n)
#pragma unroll
                    for (int i = 0; i < 4; ++i) gn[bj][n][i] = g[32 * bj + (4 * fq + 2 * n + (i >> 1)) + 16 * (i & 1)];
            bf16* dst = (hs < 6) ? QB + hs * 64 : KB + (hs - 6) * 64; const int pitch = (hs < 6) ? QBP : KBP; const float osc = (hs < 6) ? C2B : 1.0f;
            unsigned char* dst8 = (hs < 6) ? (unsigned char*)QB + hs * 64 : (unsigned char*)KB + (hs - 6) * 64;
#pragma unroll
            for (int ai = 0; ai < 2; ++ai)
#pragma unroll
                for (int m = 0; m < 4; ++m) { const int row = row0 + ai * HALF + m * 16, pos = row & (SEQ - 1); const float rs = (__builtin_amdgcn_rsqf(fx_load(ssin + row) * (1.0f / D) + EPS) * RSC1);
                    f32x4 v[2][2]; float s = 0.f;
#pragma unroll
                    for (int bj = 0; bj < 2; ++bj)
#pragma unroll
                        for (int n = 0; n < 2; ++n) { v[bj][n] = acc[ai][bj][m][n] * rs; s += sq4(v[bj][n]); }
                    const float nrm = __builtin_amdgcn_rsqf(fq_sum(s) * (1.0f / 64) + EPS) * osc;
#pragma unroll
                    for (int bj = 0; bj < 2; ++bj) { const f32x2* cs = tab32 + (size_t)(bj ? (pos & 63) : (pos >> 6)) * 16 + 4 * fq; f32x4 r[2];
#pragma unroll
                        for (int n = 0; n < 2; ++n) { const f32x2 ca = cs[2 * n], cb = cs[2 * n + 1];
                            const float x0 = v[bj][n][0] * nrm * gn[bj][n][0], x1 = v[bj][n][1] * nrm * gn[bj][n][1], x2 = v[bj][n][2] * nrm * gn[bj][n][2], x3 = v[bj][n][3] * nrm * gn[bj][n][3];
                            r[n][0] = x0 * ca.x - x1 * ca.y; r[n][1] = x1 * ca.x + x0 * ca.y; r[n][2] = x2 * cb.x - x3 * cb.y; r[n][3] = x3 * cb.x + x2 * cb.y; }
                        if (ATT_F8) *(u32x2*)((unsigned char*)dst8 + (size_t)row * pitch + 32 * bj + 8 * fq) = pk8_fp8(r[0], r[1]);
                        else *(u32x4*)(dst + (size_t)row * pitch + 32 * bj + 8 * fq) = pack8(r[0], r[1]); }
                    if (m & 1) asm volatile("" ::: "memory"); }
        } else if (hs >= 10 && hs < 16) {
            bf16* dst = (hs < 14) ? QC + (hs - 10) * 64 : KC + (hs - 14) * 64; const int pitch = (hs < 14) ? QCP : KCP; const float osc = (hs < 14) ? C2B : 1.0f;
#pragma unroll
            for (int ai = 0; ai < 2; ++ai)
#pragma unroll
                for (int m = 0; m < 4; ++m) { const int row = row0 + ai * HALF + m * 16, pos = row & (SEQ - 1); const float rs = (__builtin_amdgcn_rsqf(fx_load(ssin + row) * (1.0f / D) + EPS) * RSC1) * osc;
                    const f32x2* cs = tab64 + (size_t)pos * 32 + 8 * fq; f32x4 lo[2], hh[2];
#pragma unroll
                    for (int n = 0; n < 2; ++n)
#pragma unroll
                        for (int i = 0; i < 4; ++i) { const f32x2 c = cs[4 * n + i]; const float x1 = acc[ai][0][m][n][i] * rs, x2 = acc[ai][1][m][n][i] * rs; lo[n][i] = x1 * c.x - x2 * c.y; hh[n][i] = x2 * c.x + x1 * c.y; }
                    if (ATT_F8) { unsigned char* rp = ((hs < 14) ? (unsigned char*)QC + (hs - 10) * 64 : (unsigned char*)KC + (hs - 14) * 64) + (size_t)row * pitch + 8 * fq; *(u32x2*)rp = pk8_fp8(lo[0], lo[1]); *(u32x2*)(rp + 32) = pk8_fp8(hh[0], hh[1]); }
                    else { bf16* rp = dst + (size_t)row * pitch + 8 * fq; *(u32x4*)rp = pack8(lo[0], lo[1]); *(u32x4*)(rp + 32) = pack8(hh[0], hh[1]); }
                    if (m & 1) asm volatile("" ::: "memory"); }
        } else {
        if (vt) {
            unsigned char* dst = (hs < 10) ? VTB + (size_t)(hs - 8) * ((size_t)T * 64) : VTC + (size_t)(hs - 16) * ((size_t)T * 64);
#pragma unroll
            for (int ai = 0; ai < 2; ++ai) { float rs[4];
#pragma unroll
                for (int m = 0; m < 4; ++m) rs[m] = __builtin_amdgcn_rsqf(fx_load(ssin + row0 + ai * HALF + m * 16) * (1.0f / D) + EPS) * (VSC * RSC1);
                unsigned char* bp = dst + (size_t)(u.pm * 4 + ai * 2 + wr) * 4096 + 4 * fr + 8 * fq * 64;
#pragma unroll
                for (int bj = 0; bj < 2; ++bj)
#pragma unroll
                    for (int n = 0; n < 2; ++n)
#pragma unroll
                        for (int i = 0; i < 4; ++i)
                            *(unsigned*)(bp + (32 * bj + 4 * n + i) * 64) = pk4_fp8(acc[ai][bj][0][n][i] * rs[0], acc[ai][bj][1][n][i] * rs[1], acc[ai][bj][2][n][i] * rs[2], acc[ai][bj][3][n][i] * rs[3]);
                asm volatile("" ::: "memory"); }
        }
        if (!vt) {
            bf16* dst = (hs < 10) ? VB + (hs - 8) * 64 : VC + (hs - 16) * 64;
#pragma unroll
            for (int ai = 0; ai < 2; ++ai)
#pragma unroll
                for (int m = 0; m < 4; ++m) { const int row = row0 + ai * HALF + m * 16; const float rs = (__builtin_amdgcn_rsqf(fx_load(ssin + row) * (1.0f / D) + EPS) * RSC1);
                    bf16* rp = dst + (size_t)row * 128 + 8 * fq; *(u32x4*)rp = pack8(acc[ai][0][m][0] * rs, acc[ai][0][m][1] * rs); *(u32x4*)(rp + 32) = pack8(acc[ai][1][m][0] * rs, acc[ai][1][m][1] * rs); }
        }
        }
    }
};
struct EpiMla {
    static constexpr bool PERM = true;
    bf16 *QA, *KA, *VA; const u64* ssq; const u64* sskv; const f32x2* tab32; unsigned char* VTA; bool vt;
    __device__ __forceinline__ void operator()(const Acc& acc, const Unit& u, int wr, int wc, int fr, int fq) const {
        const int row0 = u.pm * BM + wr * 64 + fr, colw = u.pn * BM + wc * 32 + 8 * fq; const bool kv = (u.aux != 0);
        if (vt && kv && wc >= 2) {
#pragma unroll
            for (int ai = 0; ai < 2; ++ai) { float rs[4];
#pragma unroll
                for (int m = 0; m < 4; ++m) rs[m] = __builtin_amdgcn_rsqf(fx_load(sskv + row0 + ai * HALF + m * 16) * (1.0f / 128) + EPS) * VSC;
                unsigned char* bp = VTA + (size_t)(u.pm * 4 + ai * 2 + wr) * 4096 + 4 * fr + (32 * (wc - 2) + 8 * fq) * 64;
#pragma unroll
                for (int bj = 0; bj < 2; ++bj) { unsigned char* hp = bp + (size_t)(2 * u.pn + bj) * ((size_t)T * 64);
#pragma unroll
                    for (int n = 0; n < 2; ++n)
#pragma unroll
                        for (int i = 0; i < 4; ++i)
                            *(unsigned*)(hp + (4 * n + i) * 64) = pk4_fp8(acc[ai][bj][0][n][i] * rs[0], acc[ai][bj][1][n][i] * rs[1], acc[ai][bj][2][n][i] * rs[2], acc[ai][bj][3][n][i] * rs[3]); }
                asm volatile("" ::: "memory"); }
            return;
        }
#pragma unroll
        for (int ai = 0; ai < 2; ++ai)
#pragma unroll
            for (int m = 0; m < 4; ++m) { const int row = row0 + ai * HALF + m * 16;
                const float rs = kv ? __builtin_amdgcn_rsqf(fx_load(sskv + row) * (1.0f / 128) + EPS) : __builtin_amdgcn_rsqf(fx_load(ssq + row) * (1.0f / 256) + EPS);
#pragma unroll
                for (int bj = 0; bj < 2; ++bj) { const int n0 = colw + bj * HALF; f32x4 v0 = acc[ai][bj][m][0] * rs, v1 = acc[ai][bj][m][1] * rs;
                    if (kv) { const int h = n0 >> 7, d = n0 & 127;
                        if (ATT_F8 && d < 64) *(u32x2*)((unsigned char*)KA + (size_t)row * KAP + h * 96 + d) = pk8_fp8(v0, v1);
                        else { bf16* dst = (d < 64) ? KA + (size_t)row * KAP + h * 96 + d : VA + (size_t)row * VAP + h * 64 + (d - 64); *(u32x4*)dst = pack8(v0, v1); } }
                    else if (n0 < 576) { const int h = n0 / 96, d = n0 - h * 96;
                        if (d >= 64) { const f32x2* cs = tab32 + (size_t)(row & (SEQ - 1)) * 16 + ((d - 64) >> 1); const f32x2 c0 = cs[0], c1 = cs[1], c2 = cs[2], c3 = cs[3];
                            f32x4 r0, r1; r0[0] = v0[0] * c0.x - v0[1] * c0.y; r0[1] = v0[1] * c0.x + v0[0] * c0.y; r0[2] = v0[2] * c1.x - v0[3] * c1.y; r0[3] = v0[3] * c1.x + v0[2] * c1.y;
                            r1[0] = v1[0] * c2.x - v1[1] * c2.y; r1[1] = v1[1] * c2.x + v1[0] * c2.y; r1[2] = v1[2] * c3.x - v1[3] * c3.y; r1[3] = v1[3] * c3.x + v1[2] * c3.y; v0 = r0; v1 = r1; }
                        if (ATT_F8) *(u32x2*)((unsigned char*)QA + (size_t)row * QAP + n0) = pk8_fp8(v0 * C2A, v1 * C2A);
                        else *(u32x4*)(QA + (size_t)row * QAP + n0) = pack8(v0 * C2A, v1 * C2A); } }
                if (m & 1) asm volatile("" ::: "memory"); }
    }
};
struct EpiRes {
    static constexpr bool PERM = false;
    const float* base; const bf16* baseb; float* XF; bf16* XB; u64* ss; bool accum; unsigned char* XQ; float asc;
    __device__ __forceinline__ void operator()(const Acc& acc, const Unit& u, int wr, int wc, int fr, int fq) const {
        const int row0 = u.pm * BM + wr * 64 + fr, col0 = u.pn * BM + wc * 32 + 4 * fq;
#pragma unroll
        for (int ai = 0; ai < 2; ++ai)
#pragma unroll
            for (int m = 0; m < 4; ++m) { const int row = row0 + ai * HALF + m * 16; const size_t off = (size_t)row * D + col0; float s = 0.f;
#pragma unroll
                for (int bj = 0; bj < 2; ++bj)
#pragma unroll
                    for (int n = 0; n < 2; ++n) { const size_t o = off + bj * HALF + n * 16; f32x4 b;
                        if (baseb) { const u32x2 w = *(const u32x2*)(baseb + o); b = (f32x4){bflo(w.x), bfhi(w.x), bflo(w.y), bfhi(w.y)}; } else b = *(const f32x4*)(base + o);
                        const f32x4 v = P4_F8 ? b + acc[ai][bj][m][n] * asc : b + acc[ai][bj][m][n]; if (!X1_BF16) *(f32x4*)(XF + o) = v;
                        if (!MOE_F8 || X1_BF16) { u32x2 w; w.x = cvt_pk_bf16(v[0], v[1]); w.y = cvt_pk_bf16(v[2], v[3]); *(u32x2*)(XB + o) = w; }
                        s += sq4(v); }
                s = fq_sum(s); if (fq == 0 && accum) atomic_addf(ss + row, s);
                if (m == 3) asm volatile("" ::: "memory"); }
    }
};
struct EpiGate {
    static constexpr bool PERM = false;
    const bf16* X2; bf16* XB; const bf16* EB; const float* rs2; u64* ss; bool accum; unsigned char* XQ;
    __device__ __forceinline__ void operator()(const Acc& acc, const Unit& u, int wr, int wc, int fr, int fq) const {
        const int row0 = u.pm * BM + wr * 64 + fr, col0 = u.pn * BM + wc * 32 + 4 * fq;
#pragma unroll
        for (int ai = 0; ai < 2; ++ai)
#pragma unroll
            for (int m = 0; m < 4; ++m) { const int row = row0 + ai * HALF + m * 16; const size_t off = (size_t)row * D + col0; const float rs = rs2[row]; float s = 0.f;
#pragma unroll
                for (int bj = 0; bj < 2; ++bj)
#pragma unroll
                    for (int n = 0; n < 2; ++n) { const size_t o = off + bj * HALF + n * 16; const u32x2 x2 = *(const u32x2*)(X2 + o); const u32x2 e = *(const u32x2*)(EB + o); const f32x4 a = acc[ai][bj][m][n] * rs;
                        f32x4 v; v[0] = bflo(x2.x) + bflo(e.x) * sigmoidf_fast(a[0]); v[1] = bfhi(x2.x) + bfhi(e.x) * sigmoidf_fast(a[1]); v[2] = bflo(x2.y) + bflo(e.y) * sigmoidf_fast(a[2]); v[3] = bfhi(x2.y) + bfhi(e.y) * sigmoidf_fast(a[3]);
                        u32x2 w; w.x = cvt_pk_bf16(v[0], v[1]); w.y = cvt_pk_bf16(v[2], v[3]); *(u32x2*)(XB + o) = w; s += sq4(v);
                        if (P1_F8) *(unsigned*)(XQ + o) = pk4_fp8(v[0], v[1], v[2], v[3]); }
                s = fq_sum(s); if (fq == 0 && accum) atomic_addf(ss + row, s);
                if (m == 3) asm volatile("" ::: "memory"); }
    }
};
struct MoeTab { LAS int* P; LAS int* C; LAS int* R2E; };
__device__ __forceinline__ int ldsu(LAS int* p) { return __builtin_amdgcn_readfirstlane(*(volatile LAS int*)p); }
struct UpSched {
    MoeTab tb; const int* perm; const char* A; const char* B; int G, c;
    __device__ __forceinline__ bool next(int i, Unit& u) const {
        const int Lx = i * (G >> 3) + (c >> 3), rt = (Lx >> 3) * 8 + (c & 7), pn = Lx & 7; if (rt >= ldsu(tb.P + NE)) return false;
        const int e = ldsu(tb.R2E + rt);
        u.pm = rt; u.pn = pn; u.aux = e | ((rt - ldsu(tb.P + e)) << 8); u.A = A; u.B = B + ((size_t)e * 2048 + (size_t)pn * BM) * D * MOE_ES; return true; }
    __device__ __forceinline__ unsigned rowoff(const Unit& u, int r) const { const int e = u.aux & 255, slot = (u.aux >> 8) * BM + r; int tok = 0; if (slot < ldsu(tb.C + e)) tok = perm[e * ECAP + slot] >> 2; return (unsigned)tok * (unsigned)(D * MOE_ES); }
    __device__ __forceinline__ unsigned rowraw(const Unit& u, int r) const { const int e = u.aux & 255, slot = (u.aux >> 8) * BM + r; int pw = 0; if (slot < ldsu(tb.C + e)) pw = perm[e * ECAP + slot]; return (unsigned)pw; }
    __device__ __forceinline__ unsigned rawoff(unsigned raw) const { return (raw >> 2) * (unsigned)(D * MOE_ES); }
};
struct DownSched {
    MoeTab tb; const char* A; const char* B; int G, c;
    __device__ __forceinline__ bool next(int i, Unit& u) const {
        const int Lx = i * (G >> 3) + (c >> 3), rt = (Lx >> 2) * 8 + (c & 7), pn = Lx & 3; if (rt >= ldsu(tb.P + NE)) return false;
        const int e = ldsu(tb.R2E + rt);
        u.pm = rt; u.pn = pn; u.aux = e | ((rt - ldsu(tb.P + e)) << 8); u.A = A + (size_t)rt * BM * D * MOE_ES; u.B = B + ((size_t)e * D + (size_t)pn * BM) * D * MOE_ES; return true; }
    __device__ __forceinline__ unsigned rowoff(const Unit&, int r) const { return (unsigned)(r * D * MOE_ES); }
    __device__ __forceinline__ unsigned rowraw(const Unit&, int r) const { return (unsigned)(r * D * MOE_ES); }
    __device__ __forceinline__ unsigned rawoff(unsigned raw) const { return raw; }
};
struct EpiUp {
    static constexpr bool PERM = true;
    bf16* ACT; const float* rsl; const float* bup; MoeTab tb;
    __device__ __forceinline__ void operator()(const Acc& acc, const Unit& u, int wr, int wc, int fr, int fq) const {
        const int e = u.aux & 255, mt = u.aux >> 8, cnt = ldsu(tb.C + e); const int colh = wc * 32 + 8 * fq;
        const float* bp = bup + (size_t)e * 2048 + u.pn * BM + colh; const f32x4 bg0 = *(const f32x4*)bp, bg1 = *(const f32x4*)(bp + 4), bl0 = *(const f32x4*)(bp + HALF), bl1 = *(const f32x4*)(bp + HALF + 4);
#pragma unroll
        for (int ai = 0; ai < 2; ++ai)
#pragma unroll
            for (int m = 0; m < 4; ++m) { const int r = ai * HALF + wr * 64 + m * 16 + fr, slot = mt * BM + r; float rs = 1.0f; if (MOE_F8) rs = WSC_INV; else if (slot < cnt) rs = rsl[e * ECAP + slot];
                f32x4 g[2], li[2], o[2]; g[0] = acc[ai][0][m][0] * rs + bg0; g[1] = acc[ai][0][m][1] * rs + bg1; li[0] = acc[ai][1][m][0] * rs + bl0; li[1] = acc[ai][1][m][1] * rs + bl1;
#pragma unroll
                for (int n = 0; n < 2; ++n)
#pragma unroll
                    for (int i = 0; i < 4; ++i) { const float xg = fminf(g[n][i], 7.0f), xl = fminf(fmaxf(li[n][i], -7.0f), 7.0f); o[n][i] = xg * sigmoidf_fast(1.702f * xg) * (xl + 1.0f); }
                if (MOE_F8) { u32x2 w; w.x = pk4_fp8(o[0][0], o[0][1], o[0][2], o[0][3]); w.y = pk4_fp8(o[1][0], o[1][1], o[1][2], o[1][3]); *(u32x2*)((unsigned char*)ACT + (size_t)(u.pm * BM + r) * D + u.pn * HALF + colh) = w; }
                else *(u32x4*)(ACT + (size_t)(u.pm * BM + r) * D + u.pn * HALF + colh) = pack8(o[0], o[1]); }
    }
};
struct EpiDown {
    static constexpr bool PERM = true;
    bf16* Y; const float* bdn; const float* gsl; const int* perm; MoeTab tb;
    __device__ __forceinline__ void operator()(const Acc& acc, const Unit& u, int wr, int wc, int fr, int fq) const {
        const int e = u.aux & 255, mt = u.aux >> 8, cnt = ldsu(tb.C + e); const int col0 = u.pn * BM + wc * 32 + 8 * fq;
        const float* bp = bdn + (size_t)e * D + col0; f32x4 b[2][2];
#pragma unroll
        for (int bj = 0; bj < 2; ++bj) { b[bj][0] = *(const f32x4*)(bp + bj * HALF); b[bj][1] = *(const f32x4*)(bp + bj * HALF + 4); }
#pragma unroll
        for (int ai = 0; ai < 2; ++ai)
#pragma unroll
            for (int m = 0; m < 4; ++m) { const int r = ai * HALF + wr * 64 + m * 16 + fr, slot = mt * BM + r;
                if (slot < cnt) { const int pair = perm[e * ECAP + slot]; const float gt = gsl[e * ECAP + slot]; bf16* rowp = Y + (size_t)pair * D + col0;
#pragma unroll
                    for (int bj = 0; bj < 2; ++bj) { const float ws = MOE_F8 ? WSC_INV : 1.0f; *(u32x4*)(rowp + bj * HALF) = pack8((acc[ai][bj][m][0] * ws + b[bj][0]) * gt, (acc[ai][bj][m][1] * ws + b[bj][1]) * gt); } } }
    }
};
struct MlaSched {
    const char* Z; const char* Wq; const char* Wkv; int G, c;
    __device__ __forceinline__ bool next(int i, Unit& u) const {
        const int L = i * G + c; if (L >= 768) return false;
        const int kind = L / 384, rem = L - kind * 384, pm = rem / 3, pn = rem - pm * 3;
        u.pm = pm; u.pn = pn; u.aux = kind; u.A = Z + (size_t)pm * BM * ZQ * 2 + (kind ? 256 : 0); u.B = (kind ? Wkv : Wq) + (size_t)pn * BM * 256 * 2; return true; }
    __device__ __forceinline__ unsigned rowoff(const Unit&, int r) const { return (unsigned)(r * ZQ * 2); }
    __device__ __forceinline__ unsigned rowraw(const Unit&, int r) const { return (unsigned)(r * ZQ * 2); }
    __device__ __forceinline__ unsigned rawoff(unsigned raw) const { return raw; }
};
}

namespace at {
typedef LAS const char* lds_cptr;
__device__ __forceinline__ int crow(int r, int hi) { return (r & 3) + 8 * (r >> 2) + 4 * hi; }
__device__ __forceinline__ void glds16(const void* gsrc, unsigned lds_dst) { unsigned keep;
    asm volatile("s_mov_b32 %0, m0\n\ts_mov_b32 m0, %2\n\ts_nop 0\n\tglobal_load_lds_dwordx4 %1, off\n\ts_mov_b32 m0, %0" : "=&s"(keep) : "v"(gsrc), "s"(lds_dst) : "memory"); }
#define AT_WAIT_BAR(N) asm volatile("s_waitcnt vmcnt(" #N ") lgkmcnt(0)\n\ts_barrier" ::: "memory")
#define AT_MX3(a, b, c) __builtin_fmaxf(__builtin_fmaxf((a), (b)), (c))
__device__ __forceinline__ float rowmax(const f32x16& p0, const f32x16& p1) {
    float a = AT_MX3(p0[0], p0[1], p1[0]), b = AT_MX3(p0[2], p0[3], p1[1]); a = AT_MX3(a, p1[2], p1[3]);
#pragma unroll
    for (int r = 4; r < 16; r += 4) { a = AT_MX3(a, p0[r], p0[r + 1]); b = AT_MX3(b, p0[r + 2], p0[r + 3]); a = AT_MX3(a, p1[r], p1[r + 1]); b = AT_MX3(b, p1[r + 2], p1[r + 3]); }
    const float m = __builtin_fmaxf(a, b); auto rr = __builtin_amdgcn_permlane32_swap(__float_as_uint(m), __float_as_uint(m), false, false);
    return __builtin_fmaxf(__uint_as_float(rr[0]), __uint_as_float(rr[1]));
}
template <int DKC> __device__ __forceinline__ void qkt(f32x16& p0, f32x16& p1, lds_cptr Kslot, const bf16x8* qr, int r32, int hi) {
    lds_cptr kb = Kslot + hi * 1024 + r32 * 16; const f32x16 z = {};
#pragma unroll
    for (int d0 = 0; d0 < DKC; ++d0) {
        const bf16x8 b0 = *(const LAS bf16x8*)(kb + d0 * 2048), b1 = *(const LAS bf16x8*)(kb + d0 * 2048 + 512);
        if (d0 == 0) { p0 = __builtin_amdgcn_mfma_f32_32x32x16_bf16(b0, qr[0], z, 0, 0, 0); p1 = __builtin_amdgcn_mfma_f32_32x32x16_bf16(b1, qr[0], z, 0, 0, 0); }
        else { p0 = __builtin_amdgcn_mfma_f32_32x32x16_bf16(b0, qr[d0], p0, 0, 0, 0); p1 = __builtin_amdgcn_mfma_f32_32x32x16_bf16(b1, qr[d0], p1, 0, 0, 0); } }
}
__device__ __forceinline__ void pv(f32x16* o, int vb, bf16x8 pa0, bf16x8 pa1, bf16x8 pa2, bf16x8 pa3) {
#pragma unroll
    for (int d0 = 0; d0 < 2; ++d0) { s16x4 lo[4], hi[4];
#pragma unroll
        for (int ks = 0; ks < 4; ++ks) {
            asm volatile("ds_read_b64_tr_b16 %0,%1 offset:%c2" : "=&v"(lo[ks]) : "v"(vb), "i"(d0 * 4096 + ks * 1024) : "memory");
            asm volatile("ds_read_b64_tr_b16 %0,%1 offset:%c2" : "=&v"(hi[ks]) : "v"(vb), "i"(d0 * 4096 + ks * 1024 + 512) : "memory"); }
        asm volatile("s_waitcnt lgkmcnt(0)" ::: "memory"); __builtin_amdgcn_sched_barrier(0);
#define AT_PK(k) (bf16x8){lo[k][0], lo[k][1], lo[k][2], lo[k][3], hi[k][0], hi[k][1], hi[k][2], hi[k][3]}
        o[d0] = __builtin_amdgcn_mfma_f32_32x32x16_bf16(pa0, AT_PK(0), o[d0], 0, 0, 0);
        o[d0] = __builtin_amdgcn_mfma_f32_32x32x16_bf16(pa1, AT_PK(1), o[d0], 0, 0, 0);
        o[d0] = __builtin_amdgcn_mfma_f32_32x32x16_bf16(pa2, AT_PK(2), o[d0], 0, 0, 0);
        o[d0] = __builtin_amdgcn_mfma_f32_32x32x16_bf16(pa3, AT_PK(3), o[d0], 0, 0, 0);
#undef AT_PK
    }
}
template <int DKC> struct Lay { static constexpr int KSLOT = DKC * 2048, LDS_K = 0, LDS_V = 3 * KSLOT, LDS_WS = LDS_V + 3 * 8192, LDS_OST = LDS_WS + NWAVES * 256, BYTES = LDS_OST + NWAVES * 4096; };
template <int DKC, int MODE>
__device__ __forceinline__ void attn_unit(const bf16* Qu, int qp, const bf16* Kh, int kp, const bf16* Vh, int vp, bf16* Ou, int op, int t0, int t1, int qpos0, float sinkl2, char* shm) {
    typedef Lay<DKC> LY;
    const int tid = opaque_tid(), lane = tid & 63, r32 = lane & 31, hi = lane >> 5; const int wid = __builtin_amdgcn_readfirstlane(tid >> 6);
    const unsigned lds0 = (unsigned)(uintptr_t)shm;
    const lds_cptr shm3 = (lds_cptr)shm;
    LAS float* wsf = (LAS float*)(shm3 + LY::LDS_WS) + wid * 64;
    const bf16* Qw = Qu + (size_t)(wid * 32) * qp;
    const bool k2 = (wid + 8 < 2 * DKC);
    const bf16* ksrc = Kh + (size_t)lane * kp + wid * 8;
    const bf16* vsrc = Vh + (size_t)(16 * (wid & 3) + (lane >> 2)) * vp + (wid >> 2) * 32 + (lane & 3) * 8;
    const unsigned kdst = lds0 + LY::LDS_K + wid * 1024, vdst = lds0 + LY::LDS_V + wid * 1024;
#define AT_DMA(t, s) do { glds16(ksrc + (size_t)(t) * 64 * kp, (unsigned)__builtin_amdgcn_readfirstlane(kdst + (s) * LY::KSLOT)); \
        if (k2) glds16(ksrc + (size_t)(t) * 64 * kp + 64, (unsigned)__builtin_amdgcn_readfirstlane(kdst + (s) * LY::KSLOT + 8192)); \
        glds16(vsrc + (size_t)(t) * 64 * vp, (unsigned)__builtin_amdgcn_readfirstlane(vdst + (s) * 8192)); } while (0)
    const int vb0 = (int)(lds0 + LY::LDS_V) + ((lane >> 4) & 1) * 32 + (lane & 3) * 8 + (4 * hi + ((lane & 15) >> 2)) * 64;
    bf16x8 qr[DKC];
#pragma unroll
    for (int d0 = 0; d0 < DKC; ++d0) qr[d0] = *(const bf16x8*)(Qw + (size_t)r32 * qp + d0 * 16 + hi * 8);
    AT_DMA(t0, 0);
    float mrun = -INFINITY, l = 0.f; f32x16 o[2]; o[0] = f32x16{}; o[1] = f32x16{};
    const int qpos = qpos0 + wid * 32 + r32;
    int sl = 0;
    for (int t = t0; t < t1; ++t) {
        const bool more = (t + 1 < t1); const int sn = (sl == 2) ? 0 : sl + 1;
        if (more) { AT_DMA(t + 1, sn); if (k2) AT_WAIT_BAR(3); else AT_WAIT_BAR(2); } else AT_WAIT_BAR(0);
        f32x16 p0, p1;
        qkt<DKC>(p0, p1, shm3 + LY::LDS_K + sl * LY::KSLOT, qr, r32, hi);
        if (MODE == 1) { const int kb = t * 64 + 4 * hi;
#pragma unroll
            for (int r = 0; r < 16; ++r) { const int d0 = kb + (r & 3) + 8 * (r >> 2) - qpos, d1 = d0 + 32; if (d0 > 128 || d0 < -128) p0[r] = -INFINITY; if (d1 > 128 || d1 < -128) p1[r] = -INFINITY; } }
        const float rm = rowmax(p0, p1), mnew = __builtin_fmaxf(mrun, rm), mref = (mnew == -INFINITY) ? 0.f : mnew;
        const float alpha = __builtin_amdgcn_exp2f(mrun - mref); mrun = mnew;
        float s = 0.f;
#pragma unroll
        for (int r = 0; r < 16; ++r) { p0[r] = __builtin_amdgcn_exp2f(p0[r] - mref); p1[r] = __builtin_amdgcn_exp2f(p1[r] - mref); s += p0[r] + p1[r]; }
        l = l * alpha + s;
        if (__any(alpha != 1.0f)) { if (hi == 0) wsf[r32] = alpha; LDS_WAIT();
#pragma unroll
            for (int r = 0; r < 16; ++r) { const float f = wsf[crow(r, hi)]; o[0][r] *= f; o[1][r] *= f; } }
        u32x4 pw0, pw1, pw2, pw3;
        pw0 = (u32x4){cvt_pk_bf16(p0[0], p0[1]), cvt_pk_bf16(p0[2], p0[3]), cvt_pk_bf16(p0[4], p0[5]), cvt_pk_bf16(p0[6], p0[7])};
        pw1 = (u32x4){cvt_pk_bf16(p0[8], p0[9]), cvt_pk_bf16(p0[10], p0[11]), cvt_pk_bf16(p0[12], p0[13]), cvt_pk_bf16(p0[14], p0[15])};
        pw2 = (u32x4){cvt_pk_bf16(p1[0], p1[1]), cvt_pk_bf16(p1[2], p1[3]), cvt_pk_bf16(p1[4], p1[5]), cvt_pk_bf16(p1[6], p1[7])};
        pw3 = (u32x4){cvt_pk_bf16(p1[8], p1[9]), cvt_pk_bf16(p1[10], p1[11]), cvt_pk_bf16(p1[12], p1[13]), cvt_pk_bf16(p1[14], p1[15])};
        __builtin_amdgcn_sched_barrier(0);
        pv(o, vb0 + sl * 8192, __builtin_bit_cast(bf16x8, pw0), __builtin_bit_cast(bf16x8, pw1), __builtin_bit_cast(bf16x8, pw2), __builtin_bit_cast(bf16x8, pw3));
        sl = sn;
    }
    { auto rr = __builtin_amdgcn_permlane32_swap(__float_as_uint(l), __float_as_uint(l), false, false); l = __uint_as_float(rr[0]) + __uint_as_float(rr[1]); }
    if (MODE == 1) l += __builtin_amdgcn_exp2f(sinkl2 - mrun);
    if (hi == 0) wsf[32 + r32] = l; LDS_WAIT();
    float rli[16];
#pragma unroll
    for (int r = 0; r < 16; ++r) rli[r] = __builtin_amdgcn_rcpf(wsf[32 + crow(r, hi)]);
    bf16* Ow = Ou + (size_t)(wid * 32) * op;
    { LAS bf16* stg = (LAS bf16*)(shm3 + LY::LDS_OST) + wid * 2048;
#pragma unroll
        for (int r = 0; r < 16; ++r) { const int orow = crow(r, hi);
#pragma unroll
            for (int d0 = 0; d0 < 2; ++d0) stg[orow * 64 + d0 * 32 + r32] = (bf16)(cvt_pk_bf16(o[d0][r] * rli[r], 0.f) & 0xffffu); }
        LDS_WAIT();
#pragma unroll
        for (int i = 0; i < 4; ++i) { const int row = i * 8 + (lane >> 3), ch = lane & 7; const u32x4 v = *(const LAS u32x4*)(stg + row * 64 + ch * 8); *(u32x4*)(Ow + (size_t)row * op + ch * 8) = v; } }
    asm volatile("s_waitcnt lgkmcnt(0)\n\ts_barrier" ::: "memory");
#undef AT_DMA
}
typedef short v4i16_t __attribute__((ext_vector_type(4)));
__device__ __forceinline__ s16x4 vtr(lds_cptr p) { return __builtin_bit_cast(s16x4, __builtin_amdgcn_ds_read_tr16_b64_v4i16((LAS v4i16_t*)p)); }
template <int DKC> struct LayP { static constexpr int KSLOT = DKC * 2048, NS = 4, LDS_K = 0, LDS_V = NS * KSLOT, LDS_WS = LDS_V + NS * 8192, LDS_OST = LDS_WS + NWAVES * 256, BYTES = LDS_OST + NWAVES * 4096; };
#define AT_BAR_L() asm volatile("s_waitcnt lgkmcnt(0)\n\ts_barrier" ::: "memory")
template <int DKC, int MODE>
__device__ __forceinline__ void attn_unit_pp(const bf16* Qu, int qp, const bf16* Kh, int kp, const bf16* Vh, int vp, bf16* Ou, int op, int t0, int t1, int qpos0, float sinkl2, char* shm) {
    typedef LayP<DKC> LY; constexpr float THR = 8.0f;
    static_assert(LY::BYTES <= RING_BYTES, "attention LDS");
    const int tid = opaque_tid(), lane = tid & 63, r32 = lane & 31, hi = lane >> 5; const int wid = __builtin_amdgcn_readfirstlane(tid >> 6);
    const bool hb = (wid >= 4);
    const unsigned lds0 = (unsigned)(uintptr_t)shm;
    const lds_cptr shm3 = (lds_cptr)shm;
    LAS float* wsf = (LAS float*)(shm3 + LY::LDS_WS) + wid * 64;
    const bf16* Qw = Qu + (size_t)(wid * 32) * qp;
    const bool k2 = (wid + 8 < 2 * DKC);
    const bf16* ksrc = Kh + (size_t)lane * kp + wid * 8;
    const bf16* vsrc = Vh + (size_t)(16 * (wid & 3) + (lane >> 2)) * vp + (wid >> 2) * 32 + (lane & 3) * 8;
    const unsigned kdst = lds0 + LY::LDS_K + wid * 1024, vdst = lds0 + LY::LDS_V + wid * 1024;
#define AT_ISSUE(s) do { const int s_ = (s); if (s_ < t1) { const int sl_ = (s_ - t0) & 3; \
        glds16(ksrc + (size_t)s_ * 64 * kp, (unsigned)__builtin_amdgcn_readfirstlane(kdst + sl_ * LY::KSLOT)); \
        if (k2) glds16(ksrc + (size_t)s_ * 64 * kp + 64, (unsigned)__builtin_amdgcn_readfirstlane(kdst + sl_ * LY::KSLOT + 8192)); \
        glds16(vsrc + (size_t)s_ * 64 * vp, (unsigned)__builtin_amdgcn_readfirstlane(vdst + sl_ * 8192)); } } while (0)
#define AT_WAITBAR(young) do { if ((young) < t1) { if (k2) AT_WAIT_BAR(3); else AT_WAIT_BAR(2); } else AT_WAIT_BAR(0); } while (0)
    const int vb0 = (int)(lds0 + LY::LDS_V) + ((lane >> 4) & 1) * 32 + (lane & 3) * 8 + (4 * hi + ((lane & 15) >> 2)) * 64;
    bf16x8 qr[DKC];
#pragma unroll
    for (int d0 = 0; d0 < DKC; ++d0) qr[d0] = *(const bf16x8*)(Qw + (size_t)r32 * qp + d0 * 16 + hi * 8);
    AT_ISSUE(t0); AT_ISSUE(t0 + 1);
    float mhat = 0.f, l = 0.f; f32x16 o[2]; o[0] = f32x16{}; o[1] = f32x16{}; f32x16 negm = f32x16{};
    const int qpos = qpos0 + wid * 32 + r32;
    const int n = t1 - t0;
    AT_WAITBAR(t0 + 1);
    if (hb) { AT_ISSUE(t0 + 2); AT_BAR_L(); }
    u32x4 pw0 = {}, pw1 = {}, pw2 = {}, pw3 = {}; bf16x8 vf[8];
#pragma unroll
    for (int q = 0; q < 8; ++q) vf[q] = bf16x8{};
    for (int j = 0; j < n; ++j) {
        const int i = t0 + j, sl = j & 3;
        if (!hb) AT_ISSUE(i + 2);
        f32x16 p0, p1;
        { lds_cptr kb = shm3 + LY::LDS_K + sl * LY::KSLOT + hi * 1024 + r32 * 16; bf16x8 kf[2 * DKC];
#pragma unroll
          for (int d0 = 0; d0 < DKC; ++d0) { kf[2 * d0] = *(const LAS bf16x8*)(kb + d0 * 2048); kf[2 * d0 + 1] = *(const LAS bf16x8*)(kb + d0 * 2048 + 512); }
          __builtin_amdgcn_s_setprio(1);
          if (j > 0) {
#pragma unroll
              for (int ks = 0; ks < 4; ++ks) { const bf16x8 pa = __builtin_bit_cast(bf16x8, ks == 0 ? pw0 : ks == 1 ? pw1 : ks == 2 ? pw2 : pw3);
                  o[0] = __builtin_amdgcn_mfma_f32_32x32x16_bf16(pa, vf[ks], o[0], 0, 0, 0); o[1] = __builtin_amdgcn_mfma_f32_32x32x16_bf16(pa, vf[4 + ks], o[1], 0, 0, 0); } }
#pragma unroll
          for (int d0 = 0; d0 < DKC; ++d0) {
              if (d0 == 0) { p0 = __builtin_amdgcn_mfma_f32_32x32x16_bf16(kf[0], qr[0], negm, 0, 0, 0); p1 = __builtin_amdgcn_mfma_f32_32x32x16_bf16(kf[1], qr[0], negm, 0, 0, 0); }
              else { p0 = __builtin_amdgcn_mfma_f32_32x32x16_bf16(kf[2 * d0], qr[d0], p0, 0, 0, 0); p1 = __builtin_amdgcn_mfma_f32_32x32x16_bf16(kf[2 * d0 + 1], qr[d0], p1, 0, 0, 0); } }
          __builtin_amdgcn_s_setprio(0); }
        if (hb) AT_WAITBAR(i + 2); else AT_BAR_L();
        if (hb) AT_ISSUE(i + 3);
        { lds_cptr vp = shm3 + LY::LDS_V + sl * 8192 + ((lane >> 4) & 1) * 32 + (lane & 3) * 8 + (4 * hi + ((lane & 15) >> 2)) * 64;
#pragma unroll
          for (int q = 0; q < 8; ++q) { const s16x4 lo = vtr(vp + (q >> 2) * 4096 + (q & 3) * 1024), hh = vtr(vp + (q >> 2) * 4096 + (q & 3) * 1024 + 512); vf[q] = (bf16x8){lo[0], lo[1], lo[2], lo[3], hh[0], hh[1], hh[2], hh[3]}; } }
        if (MODE == 1) { const int kb = i * 64 + 4 * hi;
#pragma unroll
            for (int r = 0; r < 16; ++r) { const int d0 = kb + (r & 3) + 8 * (r >> 2) - qpos, d1 = d0 + 32; if (d0 > 128 || d0 < -128) p0[r] = -INFINITY; if (d1 > 128 || d1 < -128) p1[r] = -INFINITY; } }
        { const float rm = rowmax(p0, p1);
          if (j == 0 || __any(rm > THR)) {
              float dl = (j == 0) ? rm : __builtin_fmaxf(rm, 0.f); if (dl == -INFINITY) dl = 0.f;
              mhat += dl;
#pragma unroll
              for (int r = 0; r < 16; ++r) { p0[r] -= dl; p1[r] -= dl; }
#pragma unroll
              for (int r = 0; r < 16; ++r) negm[r] = -mhat;
              if (j > 0) { const float f = __builtin_amdgcn_exp2f(-dl); l *= f; if (hi == 0) wsf[r32] = f; LDS_WAIT();
#pragma unroll
                  for (int r = 0; r < 16; ++r) { const float g = wsf[crow(r, hi)]; o[0][r] *= g; o[1][r] *= g; } } } }
        { float sa = 0.f, sb = 0.f;
#pragma unroll
          for (int r = 0; r < 16; ++r) { p0[r] = __builtin_amdgcn_exp2f(p0[r]); p1[r] = __builtin_amdgcn_exp2f(p1[r]); sa += p0[r]; sb += p1[r]; }
          l += sa + sb; }
        pw0 = (u32x4){cvt_pk_bf16(p0[0], p0[1]), cvt_pk_bf16(p0[2], p0[3]), cvt_pk_bf16(p0[4], p0[5]), cvt_pk_bf16(p0[6], p0[7])};
        pw1 = (u32x4){cvt_pk_bf16(p0[8], p0[9]), cvt_pk_bf16(p0[10], p0[11]), cvt_pk_bf16(p0[12], p0[13]), cvt_pk_bf16(p0[14], p0[15])};
        pw2 = (u32x4){cvt_pk_bf16(p1[0], p1[1]), cvt_pk_bf16(p1[2], p1[3]), cvt_pk_bf16(p1[4], p1[5]), cvt_pk_bf16(p1[6], p1[7])};
        pw3 = (u32x4){cvt_pk_bf16(p1[8], p1[9]), cvt_pk_bf16(p1[10], p1[11]), cvt_pk_bf16(p1[12], p1[13]), cvt_pk_bf16(p1[14], p1[15])};
        if (!hb) AT_WAITBAR(i + 2); else AT_BAR_L();
    }
    __builtin_amdgcn_s_setprio(1);
#pragma unroll
    for (int ks = 0; ks < 4; ++ks) { const bf16x8 pa = __builtin_bit_cast(bf16x8, ks == 0 ? pw0 : ks == 1 ? pw1 : ks == 2 ? pw2 : pw3);
        o[0] = __builtin_amdgcn_mfma_f32_32x32x16_bf16(pa, vf[ks], o[0], 0, 0, 0); o[1] = __builtin_amdgcn_mfma_f32_32x32x16_bf16(pa, vf[4 + ks], o[1], 0, 0, 0); }
    __builtin_amdgcn_s_setprio(0);
    if (!hb) AT_BAR_L();
    { auto rr = __builtin_amdgcn_permlane32_swap(__float_as_uint(l), __float_as_uint(l), false, false); l = __uint_as_float(rr[0]) + __uint_as_float(rr[1]); }
    if (MODE == 1) l += __builtin_amdgcn_exp2f(sinkl2 - mhat);
    if (hi == 0) wsf[32 + r32] = l; LDS_WAIT();
    float rli[16];
#pragma unroll
    for (int r = 0; r < 16; ++r) rli[r] = __builtin_amdgcn_rcpf(wsf[32 + crow(r, hi)]);
    bf16* Ow = Ou + (size_t)(wid * 32) * op;
    { LAS bf16* stg = (LAS bf16*)(shm3 + LY::LDS_OST) + wid * 2048;
#pragma unroll
        for (int r = 0; r < 16; ++r) { const int orow = crow(r, hi);
#pragma unroll
            for (int d0 = 0; d0 < 2; ++d0) stg[orow * 64 + d0 * 32 + r32] = (bf16)(cvt_pk_bf16(o[d0][r] * rli[r], 0.f) & 0xffffu); }
        LDS_WAIT();
#pragma unroll
        for (int i = 0; i < 4; ++i) { const int row = i * 8 + (lane >> 3), ch = lane & 7; const u32x4 v = *(const LAS u32x4*)(stg + row * 64 + ch * 8); *(u32x4*)(Ow + (size_t)row * op + ch * 8) = v; } }
    AT_BAR_L();
#undef AT_ISSUE
#undef AT_WAITBAR
}
typedef int i32x8 __attribute__((ext_vector_type(8)));
template <int DKS> struct LayP8 { static constexpr int KSLOT = DKS * 4096, NS = 4, LDS_K = 0, LDS_V = NS * KSLOT, LDS_WS = LDS_V + NS * 8192, LDS_OST = LDS_WS + NWAVES * 256, BYTES = LDS_OST + NWAVES * 4096; };
template <int DKS, int NCH, int MODE>
__device__ __forceinline__ void attn_unit_f8(const unsigned char* Qu, int qp, const unsigned char* Kh, int kp, const bf16* Vh, int vp, bf16* Ou, int op, int t0, int t1, int qpos0, float sinkl2, char* shm) {
    typedef LayP8<DKS> LY; constexpr float THR = 8.0f;
    static_assert(LY::BYTES <= RING_BYTES, "attention LDS");
    const int tid = opaque_tid(), lane = tid & 63, r32 = lane & 31, hi = lane >> 5; const int wid = __builtin_amdgcn_readfirstlane(tid >> 6);
    const bool hb = (wid >= 4);
    const unsigned lds0 = (unsigned)(uintptr_t)shm;
    const lds_cptr shm3 = (lds_cptr)shm;
    LAS float* wsf = (LAS float*)(shm3 + LY::LDS_WS) + wid * 64;
    const unsigned char* Qw = Qu + (size_t)(wid * 32) * qp;
    const bool kw = (wid < NCH);
    const unsigned char* ksrc = Kh + (size_t)lane * kp + wid * 16;
    const bf16* vsrc = Vh + (size_t)(16 * (wid & 3) + (lane >> 2)) * vp + (wid >> 2) * 32 + (lane & 3) * 8;
    const unsigned kdst = lds0 + LY::LDS_K + wid * 1024, vdst = lds0 + LY::LDS_V + wid * 1024;
#define AT_ISSUE(s) do { const int s_ = (s); if (s_ < t1) { const int sl_ = (s_ - t0) & 3; \
        if (kw) glds16(ksrc + (size_t)s_ * 64 * kp, (unsigned)__builtin_amdgcn_readfirstlane(kdst + sl_ * LY::KSLOT)); \
        glds16(vsrc + (size_t)s_ * 64 * vp, (unsigned)__builtin_amdgcn_readfirstlane(vdst + sl_ * 8192)); } } while (0)
#define AT_WAITBAR(young) do { if ((young) < t1) { if (kw) AT_WAIT_BAR(2); else AT_WAIT_BAR(1); } else AT_WAIT_BAR(0); } while (0)
    if (NCH < DKS * 4) {
        for (int b = tid * 16; b < 4 * (DKS * 4 - NCH) * 1024; b += NWAVES * 64 * 16) { const int sl_ = b / ((DKS * 4 - NCH) * 1024), rem = b % ((DKS * 4 - NCH) * 1024);
            *(LAS u32x4*)(shm3 + LY::LDS_K + sl_ * LY::KSLOT + NCH * 1024 + rem) = (u32x4){0u, 0u, 0u, 0u}; } }
    i32x8 qf[DKS];
#pragma unroll
    for (int s = 0; s < DKS; ++s) { const unsigned char* qa = Qw + (size_t)r32 * qp + s * 64 + hi * 32;
        if (s * 64 + hi * 32 < NCH * 16) { const u32x4 lo = *(const u32x4*)qa, hh = *(const u32x4*)(qa + 16); qf[s] = __builtin_bit_cast(i32x8, __builtin_shufflevector(lo, hh, 0, 1, 2, 3, 4, 5, 6, 7)); }
        else qf[s] = i32x8{}; }
    AT_ISSUE(t0); AT_ISSUE(t0 + 1);
    float mhat = 0.f, l = 0.f; f32x16 o[2]; o[0] = f32x16{}; o[1] = f32x16{}; f32x16 negm = f32x16{};
    const unsigned one_sc = 0x7f7f7f7fu;
    const int qpos = qpos0 + wid * 32 + r32;
    const int n = t1 - t0;
    AT_WAITBAR(t0 + 1);
    if (hb) { AT_ISSUE(t0 + 2); AT_BAR_L(); }
    u32x4 pw0 = {}, pw1 = {}, pw2 = {}, pw3 = {}; bf16x8 vf[8];
#pragma unroll
    for (int q = 0; q < 8; ++q) vf[q] = bf16x8{};
    for (int j = 0; j < n; ++j) {
        const int i = t0 + j, sl = j & 3;
        if (!hb) AT_ISSUE(i + 2);
        f32x16 p0 = negm, p1 = negm;
        { lds_cptr kb = shm3 + LY::LDS_K + sl * LY::KSLOT + hi * 2048 + r32 * 16; i32x8 kf[DKS][2];
#pragma unroll
          for (int s = 0; s < DKS; ++s)
#pragma unroll
              for (int h2 = 0; h2 < 2; ++h2) { const u32x4 lo = *(const LAS u32x4*)(kb + s * 4096 + h2 * 512), hh = *(const LAS u32x4*)(kb + s * 4096 + 1024 + h2 * 512);
                  kf[s][h2] = __builtin_bit_cast(i32x8, __builtin_shufflevector(lo, hh, 0, 1, 2, 3, 4, 5, 6, 7)); }
          __builtin_amdgcn_s_setprio(1);
          if (j > 0) {
#pragma unroll
              for (int ks = 0; ks < 4; ++ks) { const bf16x8 pa = __builtin_bit_cast(bf16x8, ks == 0 ? pw0 : ks == 1 ? pw1 : ks == 2 ? pw2 : pw3);
                  o[0] = __builtin_amdgcn_mfma_f32_32x32x16_bf16(pa, vf[ks], o[0], 0, 0, 0); o[1] = __builtin_amdgcn_mfma_f32_32x32x16_bf16(pa, vf[4 + ks], o[1], 0, 0, 0); } }
#pragma unroll
          for (int s = 0; s < DKS; ++s) {
              asm volatile("v_mfma_scale_f32_32x32x64_f8f6f4 %0, %1, %2, %0, %3, %3 op_sel_hi:[0,0,0]" : "+v"(p0) : "v"(kf[s][0]), "v"(qf[s]), "v"(one_sc));
              asm volatile("v_mfma_scale_f32_32x32x64_f8f6f4 %0, %1, %2, %0, %3, %3 op_sel_hi:[0,0,0]" : "+v"(p1) : "v"(kf[s][1]), "v"(qf[s]), "v"(one_sc)); }
          __builtin_amdgcn_s_setprio(0); }
        if (hb) AT_WAITBAR(i + 2); else AT_BAR_L();
        if (hb) AT_ISSUE(i + 3);
        asm volatile("s_nop 15\n\ts_nop 3" : "+v"(p0), "+v"(p1));
        { lds_cptr vp_ = shm3 + LY::LDS_V + sl * 8192 + ((lane >> 4) & 1) * 32 + (lane & 3) * 8 + (4 * hi + ((lane & 15) >> 2)) * 64;
#pragma unroll
          for (int q = 0; q < 8; ++q) { const s16x4 lo = vtr(vp_ + (q >> 2) * 4096 + (q & 3) * 1024), hh = vtr(vp_ + (q >> 2) * 4096 + (q & 3) * 1024 + 512); vf[q] = (bf16x8){lo[0], lo[1], lo[2], lo[3], hh[0], hh[1], hh[2], hh[3]}; } }
        if (MODE == 1) { const int kb2 = i * 64 + 4 * hi;
#pragma unroll
            for (int r = 0; r < 16; ++r) { const int d0 = kb2 + (r & 3) + 8 * (r >> 2) - qpos, d1 = d0 + 32; if (d0 > 128 || d0 < -128) p0[r] = -INFINITY; if (d1 > 128 || d1 < -128) p1[r] = -INFINITY; } }
        { const float rm = rowmax(p0, p1);
          if (j == 0 || __any(rm > THR)) {
              float dl = (j == 0) ? rm : __builtin_fmaxf(rm, 0.f); if (dl == -INFINITY) dl = 0.f;
              mhat += dl;
#pragma unroll
              for (int r = 0; r < 16; ++r) { p0[r] -= dl; p1[r] -= dl; }
#pragma unroll
              for (int r = 0; r < 16; ++r) negm[r] = -mhat;
              if (j > 0) { const float f = __builtin_amdgcn_exp2f(-dl); l *= f; if (hi == 0) wsf[r32] = f; LDS_WAIT();
#pragma unroll
                  for (int r = 0; r < 16; ++r) { const float g = wsf[crow(r, hi)]; o[0][r] *= g; o[1][r] *= g; } } } }
        { float sa = 0.f, sb = 0.f;
#pragma unroll
          for (int r = 0; r < 16; ++r) { p0[r] = __builtin_amdgcn_exp2f(p0[r]); p1[r] = __builtin_amdgcn_exp2f(p1[r]); sa += p0[r]; sb += p1[r]; }
          l += sa + sb; }
        pw0 = (u32x4){cvt_pk_bf16(p0[0], p0[1]), cvt_pk_bf16(p0[2], p0[3]), cvt_pk_bf16(p0[4], p0[5]), cvt_pk_bf16(p0[6], p0[7])};
        pw1 = (u32x4){cvt_pk_bf16(p0[8], p0[9]), cvt_pk_bf16(p0[10], p0[11]), cvt_pk_bf16(p0[12], p0[13]), cvt_pk_bf16(p0[14], p0[15])};
        pw2 = (u32x4){cvt_pk_bf16(p1[0], p1[1]), cvt_pk_bf16(p1[2], p1[3]), cvt_pk_bf16(p1[4], p1[5]), cvt_pk_bf16(p1[6], p1[7])};
        pw3 = (u32x4){cvt_pk_bf16(p1[8], p1[9]), cvt_pk_bf16(p1[10], p1[11]), cvt_pk_bf16(p1[12], p1[13]), cvt_pk_bf16(p1[14], p1[15])};
        if (!hb) AT_WAITBAR(i + 2); else AT_BAR_L();
    }
    __builtin_amdgcn_s_setprio(1);
#pragma unroll
    for (int ks = 0; ks < 4; ++ks) { const bf16x8 pa = __builtin_bit_cast(bf16x8, ks == 0 ? pw0 : ks == 1 ? pw1 : ks == 2 ? pw2 : pw3);
        o[0] = __builtin_amdgcn_mfma_f32_32x32x16_bf16(pa, vf[ks], o[0], 0, 0, 0); o[1] = __builtin_amdgcn_mfma_f32_32x32x16_bf16(pa, vf[4 + ks], o[1], 0, 0, 0); }
    __builtin_amdgcn_s_setprio(0);
    if (!hb) AT_BAR_L();
    { auto rr = __builtin_amdgcn_permlane32_swap(__float_as_uint(l), __float_as_uint(l), false, false); l = __uint_as_float(rr[0]) + __uint_as_float(rr[1]); }
    if (MODE == 1) l += __builtin_amdgcn_exp2f(sinkl2 - mhat);
    if (hi == 0) wsf[32 + r32] = l; LDS_WAIT();
    float rli[16];
#pragma unroll
    for (int r = 0; r < 16; ++r) rli[r] = __builtin_amdgcn_rcpf(wsf[32 + crow(r, hi)]);
    bf16* Ow = Ou + (size_t)(wid * 32) * op;
    { LAS bf16* stg = (LAS bf16*)(shm3 + LY::LDS_OST) + wid * 2048;
#pragma unroll
        for (int r = 0; r < 16; ++r) { const int orow = crow(r, hi);
#pragma unroll
            for (int d0 = 0; d0 < 2; ++d0) stg[orow * 64 + d0 * 32 + r32] = (bf16)(cvt_pk_bf16(o[d0][r] * rli[r], 0.f) & 0xffffu); }
        LDS_WAIT();
#pragma unroll
        for (int i2 = 0; i2 < 4; ++i2) { const int row = i2 * 8 + (lane >> 3), ch = lane & 7; const u32x4 v = *(const LAS u32x4*)(stg + row * 64 + ch * 8); *(u32x4*)(Ow + (size_t)row * op + ch * 8) = v; } }
    AT_BAR_L();
#undef AT_ISSUE
#undef AT_WAITBAR
}
struct AUnit { const unsigned char* Qu; const unsigned char* Kh; const bf16* Vh; bf16* Ou; int t0, t1, qpos0; float sinkl2; };
template <int DKS, int NCH, int MODE, class Dec>
__device__ __forceinline__ void attn_loop_f8(int idx0, int idx_end, int G, const Dec& dec, int qp, int kp, int vp, int op, char* shm) {
    if (idx0 >= idx_end) return;
    typedef LayP8<DKS> LY; constexpr float THR = 8.0f;
    static_assert(LY::BYTES <= RING_BYTES, "attention LDS");
    const int tid = opaque_tid(), lane = tid & 63, r32 = lane & 31, hi = lane >> 5; const int wid = __builtin_amdgcn_readfirstlane(tid >> 6);
    const bool hb = (wid >= 4);
    const unsigned lds0 = (unsigned)(uintptr_t)shm;
    const lds_cptr shm3 = (lds_cptr)shm;
    LAS float* wsf = (LAS float*)(shm3 + LY::LDS_WS) + wid * 64;
    const bool kw = (wid < NCH);
    AUnit u = dec(idx0); int t0 = u.t0, t1 = u.t1;
    const size_t koff = (size_t)lane * kp + wid * 16, voff = (size_t)(16 * (wid & 3) + (lane >> 2)) * vp + (wid >> 2) * 32 + (lane & 3) * 8;
    const unsigned char* ksrc = u.Kh + koff; const bf16* vsrc = u.Vh + voff;
    const unsigned kdst = lds0 + LY::LDS_K + wid * 1024, vdst = lds0 + LY::LDS_V + wid * 1024;
#define AT_ISSUE(s) do { const int s_ = (s); if (s_ < t1) { const int sl_ = (s_ - t0) & 3; \
        if (kw) glds16(ksrc + (size_t)s_ * 64 * kp, (unsigned)__builtin_amdgcn_readfirstlane(kdst + sl_ * LY::KSLOT)); \
        glds16(vsrc + (size_t)s_ * 64 * vp, (unsigned)__builtin_amdgcn_readfirstlane(vdst + sl_ * 8192)); } } while (0)
#define AT_WAITBAR(young) do { if ((young) < t1) { if (kw) AT_WAIT_BAR(2); else AT_WAIT_BAR(1); } else AT_WAIT_BAR(0); } while (0)
    if (NCH < DKS * 4) {
        for (int b = tid * 16; b < 4 * (DKS * 4 - NCH) * 1024; b += NWAVES * 64 * 16) { const int sl_ = b / ((DKS * 4 - NCH) * 1024), rem = b % ((DKS * 4 - NCH) * 1024);
            *(LAS u32x4*)(shm3 + LY::LDS_K + sl_ * LY::KSLOT + NCH * 1024 + rem) = (u32x4){0u, 0u, 0u, 0u}; } }
    i32x8 qf[DKS], qfn[DKS];
#define AT_QLOAD(dst, Qu_) do { const unsigned char* Qw_ = (Qu_) + (size_t)(wid * 32) * qp; _Pragma("unroll") for (int s = 0; s < DKS; ++s) { const unsigned char* qa = Qw_ + (size_t)r32 * qp + s * 64 + hi * 32; \
        if (s * 64 + hi * 32 < NCH * 16) { const u32x4 lo = *(const u32x4*)qa, hh = *(const u32x4*)(qa + 16); (dst)[s] = __builtin_bit_cast(i32x8, __builtin_shufflevector(lo, hh, 0, 1, 2, 3, 4, 5, 6, 7)); } \
        else (dst)[s] = i32x8{}; } } while (0)
    AT_QLOAD(qf, u.Qu);
    AT_ISSUE(t0); AT_ISSUE(t0 + 1);
    const unsigned one_sc = 0x7f7f7f7fu;
    for (int idx = idx0;;) {
    const int idxn = idx + G; const bool has_next = idxn < idx_end; AUnit un = u;
    float mhat = 0.f, l = 0.f; f32x16 o[2]; o[0] = f32x16{}; o[1] = f32x16{}; f32x16 negm = f32x16{};
    const int qpos = u.qpos0 + wid * 32 + r32;
    const int n = t1 - t0;
    AT_WAITBAR(t0 + 1);
    if (hb) { AT_ISSUE(t0 + 2); AT_BAR_L(); }
    u32x4 pw0 = {}, pw1 = {}, pw2 = {}, pw3 = {}; bf16x8 vf[8];
#pragma unroll
    for (int q = 0; q < 8; ++q) vf[q] = bf16x8{};
    for (int j = 0; j < n; ++j) {
        const int i = t0 + j, sl = j & 3;
        if (!hb) AT_ISSUE(i + 2);
        f32x16 p0 = negm, p1 = negm;
        { lds_cptr kb = shm3 + LY::LDS_K + sl * LY::KSLOT + hi * 2048 + r32 * 16; i32x8 kf[DKS][2];
#pragma unroll
          for (int s = 0; s < DKS; ++s)
#pragma unroll
              for (int h2 = 0; h2 < 2; ++h2) { const u32x4 lo = *(const LAS u32x4*)(kb + s * 4096 + h2 * 512), hh = *(const LAS u32x4*)(kb + s * 4096 + 1024 + h2 * 512);
                  kf[s][h2] = __builtin_bit_cast(i32x8, __builtin_shufflevector(lo, hh, 0, 1, 2, 3, 4, 5, 6, 7)); }
          __builtin_amdgcn_s_setprio(1);
          if (j > 0) {
#pragma unroll
              for (int ks = 0; ks < 4; ++ks) { const bf16x8 pa = __builtin_bit_cast(bf16x8, ks == 0 ? pw0 : ks == 1 ? pw1 : ks == 2 ? pw2 : pw3);
                  o[0] = __builtin_amdgcn_mfma_f32_32x32x16_bf16(pa, vf[ks], o[0], 0, 0, 0); o[1] = __builtin_amdgcn_mfma_f32_32x32x16_bf16(pa, vf[4 + ks], o[1], 0, 0, 0); } }
#pragma unroll
          for (int s = 0; s < DKS; ++s) {
              asm volatile("v_mfma_scale_f32_32x32x64_f8f6f4 %0, %1, %2, %0, %3, %3 op_sel_hi:[0,0,0]" : "+v"(p0) : "v"(kf[s][0]), "v"(qf[s]), "v"(one_sc));
              asm volatile("v_mfma_scale_f32_32x32x64_f8f6f4 %0, %1, %2, %0, %3, %3 op_sel_hi:[0,0,0]" : "+v"(p1) : "v"(kf[s][1]), "v"(qf[s]), "v"(one_sc)); }
          __builtin_amdgcn_s_setprio(0); }
        if (hb) AT_WAITBAR(i + 2); else AT_BAR_L();
        if (hb) AT_ISSUE(i + 3);
        asm volatile("s_nop 15\n\ts_nop 3" : "+v"(p0), "+v"(p1));
        { lds_cptr vp_ = shm3 + LY::LDS_V + sl * 8192 + ((lane >> 4) & 1) * 32 + (lane & 3) * 8 + (4 * hi + ((lane & 15) >> 2)) * 64;
#pragma unroll
          for (int q = 0; q < 8; ++q) { const s16x4 lo = vtr(vp_ + (q >> 2) * 4096 + (q & 3) * 1024), hh = vtr(vp_ + (q >> 2) * 4096 + (q & 3) * 1024 + 512); vf[q] = (bf16x8){lo[0], lo[1], lo[2], lo[3], hh[0], hh[1], hh[2], hh[3]}; } }
        if (MODE == 1) { const int kb2 = i * 64 + 4 * hi;
#pragma unroll
            for (int r = 0; r < 16; ++r) { const int d0 = kb2 + (r & 3) + 8 * (r >> 2) - qpos, d1 = d0 + 32; if (d0 > 128 || d0 < -128) p0[r] = -INFINITY; if (d1 > 128 || d1 < -128) p1[r] = -INFINITY; } }
        { const float rm = rowmax(p0, p1);
          if (j == 0 || __any(rm > THR)) {
              float dl = (j == 0) ? rm : __builtin_fmaxf(rm, 0.f); if (dl == -INFINITY) dl = 0.f;
              mhat += dl;
#pragma unroll
              for (int r = 0; r < 16; ++r) { p0[r] -= dl; p1[r] -= dl; }
#pragma unroll
              for (int r = 0; r < 16; ++r) negm[r] = -mhat;
              if (j > 0) { const float f = __builtin_amdgcn_exp2f(-dl); l *= f; if (hi == 0) wsf[r32] = f; LDS_WAIT();
#pragma unroll
                  for (int r = 0; r < 16; ++r) { const float g = wsf[crow(r, hi)]; o[0][r] *= g; o[1][r] *= g; } } } }
        { float sa = 0.f, sb = 0.f;
#pragma unroll
          for (int r = 0; r < 16; ++r) { p0[r] = __builtin_amdgcn_exp2f(p0[r]); p1[r] = __builtin_amdgcn_exp2f(p1[r]); sa += p0[r]; sb += p1[r]; }
          l += sa + sb; }
        pw0 = (u32x4){cvt_pk_bf16(p0[0], p0[1]), cvt_pk_bf16(p0[2], p0[3]), cvt_pk_bf16(p0[4], p0[5]), cvt_pk_bf16(p0[6], p0[7])};
        pw1 = (u32x4){cvt_pk_bf16(p0[8], p0[9]), cvt_pk_bf16(p0[10], p0[11]), cvt_pk_bf16(p0[12], p0[13]), cvt_pk_bf16(p0[14], p0[15])};
        pw2 = (u32x4){cvt_pk_bf16(p1[0], p1[1]), cvt_pk_bf16(p1[2], p1[3]), cvt_pk_bf16(p1[4], p1[5]), cvt_pk_bf16(p1[6], p1[7])};
        pw3 = (u32x4){cvt_pk_bf16(p1[8], p1[9]), cvt_pk_bf16(p1[10], p1[11]), cvt_pk_bf16(p1[12], p1[13]), cvt_pk_bf16(p1[14], p1[15])};
        if (!hb) AT_WAITBAR(i + 2); else AT_BAR_L();
    }
#define AT_SEAM() do { if (has_next) { un = dec(idxn); ksrc = un.Kh + koff; vsrc = un.Vh + voff; t0 = un.t0; t1 = un.t1; AT_ISSUE(t0); AT_ISSUE(t0 + 1); AT_QLOAD(qfn, un.Qu); } } while (0)
    if (hb) AT_SEAM();
    __builtin_amdgcn_s_setprio(1);
#pragma unroll
    for (int ks = 0; ks < 4; ++ks) { const bf16x8 pa = __builtin_bit_cast(bf16x8, ks == 0 ? pw0 : ks == 1 ? pw1 : ks == 2 ? pw2 : pw3);
        o[0] = __builtin_amdgcn_mfma_f32_32x32x16_bf16(pa, vf[ks], o[0], 0, 0, 0); o[1] = __builtin_amdgcn_mfma_f32_32x32x16_bf16(pa, vf[4 + ks], o[1], 0, 0, 0); }
    __builtin_amdgcn_s_setprio(0);
    if (!hb) { AT_BAR_L(); AT_SEAM(); }
    { auto rr = __builtin_amdgcn_permlane32_swap(__float_as_uint(l), __float_as_uint(l), false, false); l = __uint_as_float(rr[0]) + __uint_as_float(rr[1]); }
    if (MODE == 1) l += __builtin_amdgcn_exp2f(u.sinkl2 - mhat);
    if (hi == 0) wsf[32 + r32] = l; LDS_WAIT();
    float rli[16];
#pragma unroll
    for (int r = 0; r < 16; ++r) rli[r] = __builtin_amdgcn_rcpf(wsf[32 + crow(r, hi)]);
    bf16* Ow = u.Ou + (size_t)(wid * 32) * op;
    { LAS bf16* stg = (LAS bf16*)(shm3 + LY::LDS_OST) + wid * 2048;
#pragma unroll
        for (int r = 0; r < 16; ++r) { const int orow = crow(r, hi);
#pragma unroll
            for (int d0 = 0; d0 < 2; ++d0) stg[orow * 64 + d0 * 32 + r32] = (bf16)(cvt_pk_bf16(o[d0][r] * rli[r], 0.f) & 0xffffu); }
        LDS_WAIT();
#pragma unroll
        for (int i2 = 0; i2 < 4; ++i2) { const int row = i2 * 8 + (lane >> 3), ch = lane & 7; const u32x4 v = *(const LAS u32x4*)(stg + row * 64 + ch * 8); *(u32x4*)(Ow + (size_t)row * op + ch * 8) = v; } }
    AT_BAR_L();
    if (!has_next) break;
    u = un; idx = idxn;
#pragma unroll
    for (int s = 0; s < DKS; ++s) qf[s] = qfn[s];
    }
#undef AT_SEAM
#undef AT_QLOAD
#undef AT_ISSUE
#undef AT_WAITBAR
}
template <int DKS, int NCH, int MODE, class Dec>
__device__ __forceinline__ void attn_loop_f8v(int idx0, int idx_end, int G, const Dec& dec, int qp, int kp, int op, char* shm) {
    if (idx0 >= idx_end) return;
    typedef LayP8<DKS> LY; constexpr float SH = 3.0f, SMAX = 448.0f;
    static_assert(LY::BYTES <= RING_BYTES, "attention LDS");
    const int tid = opaque_tid(), lane = tid & 63, r32 = lane & 31, hi = lane >> 5; const int wid = __builtin_amdgcn_readfirstlane(tid >> 6);
    const bool hb = (wid >= 4);
    const unsigned lds0 = (unsigned)(uintptr_t)shm;
    const lds_cptr shm3 = (lds_cptr)shm;
    LAS float* wsf = (LAS float*)(shm3 + LY::LDS_WS) + wid * 64;
    const bool kw = (wid < NCH), vw = (wid >= 4);
    AUnit u = dec(idx0); int t0 = u.t0, t1 = u.t1;
    const int krow = 16 * (lane & 3) + 8 * ((lane >> 2) & 1) + ((lane & 31) >> 3) + 4 * (lane >> 5);
    const int vrow = ((wid & 3) * 64 + lane) >> 2;
    const size_t koff = (size_t)krow * kp + wid * 16, voff = (size_t)vrow * 64 + (((lane & 3) ^ ((vrow >> 2) & 3)) << 4);
    const unsigned char* ksrc = u.Kh + koff; const unsigned char* vsrc = (const unsigned char*)u.Vh + voff;
    const unsigned kdst = lds0 + LY::LDS_K + wid * 1024, vdst = lds0 + LY::LDS_V + (wid & 3) * 1024;
#define AT_ISSUE(s) do { const int s_ = (s); if (s_ < t1) { const int sl_ = (s_ - t0) & 3; \
        if (kw) glds16(ksrc + (size_t)s_ * 64 * kp, (unsigned)__builtin_amdgcn_readfirstlane(kdst + sl_ * LY::KSLOT)); \
        if (vw) glds16(vsrc + (size_t)s_ * 4096, (unsigned)__builtin_amdgcn_readfirstlane(vdst + sl_ * 8192)); } } while (0)
#define AT_WAITBAR(young) do { if ((young) < t1) { if (kw && vw) AT_WAIT_BAR(2); else if (kw || vw) AT_WAIT_BAR(1); else AT_WAIT_BAR(0); } else AT_WAIT_BAR(0); } while (0)
    if (NCH < DKS * 4) {
        for (int b = tid * 16; b < 4 * (DKS * 4 - NCH) * 1024; b += NWAVES * 64 * 16) { const int sl_ = b / ((DKS * 4 - NCH) * 1024), rem = b % ((DKS * 4 - NCH) * 1024);
            *(LAS u32x4*)(shm3 + LY::LDS_K + sl_ * LY::KSLOT + NCH * 1024 + rem) = (u32x4){0u, 0u, 0u, 0u}; } }
    i32x8 qf[DKS], qfn[DKS];
#define AT_QLOAD(dst, Qu_) do { const unsigned char* Qw_ = (Qu_) + (size_t)(wid * 32) * qp; _Pragma("unroll") for (int s = 0; s < DKS; ++s) { const unsigned char* qa = Qw_ + (size_t)r32 * qp + s * 64 + hi * 32; \
        if (s * 64 + hi * 32 < NCH * 16) { const u32x4 lo = *(const u32x4*)qa, hh = *(const u32x4*)(qa + 16); (dst)[s] = __builtin_bit_cast(i32x8, __builtin_shufflevector(lo, hh, 0, 1, 2, 3, 4, 5, 6, 7)); } \
        else (dst)[s] = i32x8{}; } } while (0)
    AT_QLOAD(qf, u.Qu);
    AT_ISSUE(t0); AT_ISSUE(t0 + 1);
    const unsigned one_sc = 0x7f7f7f7fu;
    for (int idx = idx0;;) {
    const int idxn = idx + G; const bool has_next = idxn < idx_end; AUnit un = u;
    float mhat = 0.f, l = 0.f; f32x16 o[2]; o[0] = f32x16{}; o[1] = f32x16{}; f32x16 negm;
#pragma unroll
    for (int r = 0; r < 16; ++r) negm[r] = SH;
    const int qpos = u.qpos0 + wid * 32 + r32;
    const int n = t1 - t0;
    AT_WAITBAR(t0 + 1);
    if (hb) { AT_ISSUE(t0 + 2); AT_BAR_L(); }
    i32x8 pw = i32x8{}, vf[2]; vf[0] = i32x8{}; vf[1] = i32x8{};
    for (int j = 0; j < n; ++j) {
        const int i = t0 + j, sl = j & 3;
        if (!hb) AT_ISSUE(i + 2);
        f32x16 p0 = negm, p1 = negm;
        { lds_cptr kb = shm3 + LY::LDS_K + sl * LY::KSLOT + hi * 2048 + r32 * 16; i32x8 kf[DKS][2];
#pragma unroll
          for (int s = 0; s < DKS; ++s)
#pragma unroll
              for (int h2 = 0; h2 < 2; ++h2) { const u32x4 lo = *(const LAS u32x4*)(kb + s * 4096 + h2 * 512), hh = *(const LAS u32x4*)(kb + s * 4096 + 1024 + h2 * 512);
                  kf[s][h2] = __builtin_bit_cast(i32x8, __builtin_shufflevector(lo, hh, 0, 1, 2, 3, 4, 5, 6, 7)); }
          __builtin_amdgcn_s_setprio(1);
          if (j > 0) {
              asm volatile("v_mfma_scale_f32_32x32x64_f8f6f4 %0, %1, %2, %0, %3, %3 op_sel_hi:[0,0,0]" : "+v"(o[0]) : "v"(pw), "v"(vf[0]), "v"(one_sc));
              asm volatile("v_mfma_scale_f32_32x32x64_f8f6f4 %0, %1, %2, %0, %3, %3 op_sel_hi:[0,0,0]" : "+v"(o[1]) : "v"(pw), "v"(vf[1]), "v"(one_sc)); }
#pragma unroll
          for (int s = 0; s < DKS; ++s) {
              asm volatile("v_mfma_scale_f32_32x32x64_f8f6f4 %0, %1, %2, %0, %3, %3 op_sel_hi:[0,0,0]" : "+v"(p0) : "v"(kf[s][0]), "v"(qf[s]), "v"(one_sc));
              asm volatile("v_mfma_scale_f32_32x32x64_f8f6f4 %0, %1, %2, %0, %3, %3 op_sel_hi:[0,0,0]" : "+v"(p1) : "v"(kf[s][1]), "v"(qf[s]), "v"(one_sc)); }
          __builtin_amdgcn_s_setprio(0); }
        if (hb) AT_WAITBAR(i + 2); else AT_BAR_L();
        if (hb) AT_ISSUE(i + 3);
        asm volatile("s_nop 15\n\ts_nop 3" : "+v"(p0), "+v"(p1));
        { lds_cptr vp_ = shm3 + LY::LDS_V + sl * 8192 + r32 * 64; const int sw = (r32 >> 2) & 3, c0 = ((2 * hi) ^ sw) << 4, c1 = ((2 * hi + 1) ^ sw) << 4;
#pragma unroll
          for (int d0 = 0; d0 < 2; ++d0) { const u32x4 lo = *(const LAS u32x4*)(vp_ + d0 * 2048 + c0), hh = *(const LAS u32x4*)(vp_ + d0 * 2048 + c1);
              vf[d0] = __builtin_bit_cast(i32x8, __builtin_shufflevector(lo, hh, 0, 1, 2, 3, 4, 5, 6, 7)); } }
        if (MODE == 1) { const int kb2 = i * 64 + 8 * hi - qpos;
#pragma unroll
            for (int r = 0; r < 16; ++r) { const int d0 = kb2 + 16 * (r & 3) + (r >> 2), d1 = d0 + 4; if (d0 > 128 || d0 < -128) p0[r] = -INFINITY; if (d1 > 128 || d1 < -128) p1[r] = -INFINITY; } }
        f32x16 e0, e1; float S;
#define AT_EXPSUM() do { _Pragma("unroll") for (int r = 0; r < 16; ++r) { e0[r] = __builtin_amdgcn_exp2f(p0[r]); e1[r] = __builtin_amdgcn_exp2f(p1[r]); } \
          f32x2 s2 = (f32x2){e0[0], e0[1]} + (f32x2){e1[0], e1[1]}; _Pragma("unroll") for (int k = 1; k < 8; ++k) { s2 += (f32x2){e0[2 * k], e0[2 * k + 1]}; s2 += (f32x2){e1[2 * k], e1[2 * k + 1]}; } S = s2.x + s2.y; } while (0)
        AT_EXPSUM();
        if (j == 0 || __any(!(S <= SMAX))) {
            const float rm = rowmax(p0, p1);
            float dl = (j == 0) ? rm - SH : __builtin_fmaxf(rm - SH, 0.f); if (dl == -INFINITY) dl = 0.f;
            mhat += dl;
#pragma unroll
            for (int r = 0; r < 16; ++r) { p0[r] -= dl; p1[r] -= dl; }
#pragma unroll
            for (int r = 0; r < 16; ++r) negm[r] = SH - mhat;
            if (j > 0) { const float f = __builtin_amdgcn_exp2f(-dl); l *= f; if (hi == 0) wsf[r32] = f; LDS_WAIT();
#pragma unroll
                for (int r = 0; r < 16; ++r) { const float g = wsf[crow(r, hi)]; o[0][r] *= g; o[1][r] *= g; } }
            AT_EXPSUM();
        }
#undef AT_EXPSUM
        l += S;
#pragma unroll
        for (int k = 0; k < 4; ++k) { pw[k] = (int)pk4_fp8(e0[4 * k], e0[4 * k + 1], e0[4 * k + 2], e0[4 * k + 3]); pw[4 + k] = (int)pk4_fp8(e1[4 * k], e1[4 * k + 1], e1[4 * k + 2], e1[4 * k + 3]); }
        if (!hb) AT_WAITBAR(i + 2); else AT_BAR_L();
    }
#define AT_SEAM() do { if (has_next) { un = dec(idxn); ksrc = un.Kh + koff; vsrc = (const unsigned char*)un.Vh + voff; t0 = un.t0; t1 = un.t1; AT_ISSUE(t0); AT_ISSUE(t0 + 1); AT_QLOAD(qfn, un.Qu); } } while (0)
    if (hb) AT_SEAM();
    __builtin_amdgcn_s_setprio(1);
    asm volatile("v_mfma_scale_f32_32x32x64_f8f6f4 %0, %1, %2, %0, %3, %3 op_sel_hi:[0,0,0]" : "+v"(o[0]) : "v"(pw), "v"(vf[0]), "v"(one_sc));
    asm volatile("v_mfma_scale_f32_32x32x64_f8f6f4 %0, %1, %2, %0, %3, %3 op_sel_hi:[0,0,0]" : "+v"(o[1]) : "v"(pw), "v"(vf[1]), "v"(one_sc));
    __builtin_amdgcn_s_setprio(0);
    asm volatile("s_nop 15\n\ts_nop 3" : "+v"(o[0]), "+v"(o[1]));
    if (!hb) { AT_BAR_L(); AT_SEAM(); }
    { auto rr = __builtin_amdgcn_permlane32_swap(__float_as_uint(l), __float_as_uint(l), false, false); l = __uint_as_float(rr[0]) + __uint_as_float(rr[1]); }
    if (MODE == 1) l += __builtin_amdgcn_exp2f(u.sinkl2 - mhat + SH);
    if (hi == 0) wsf[32 + r32] = l; LDS_WAIT();
    float rli[16];
#pragma unroll
    for (int r = 0; r < 16; ++r) rli[r] = __builtin_amdgcn_rcpf(wsf[32 + crow(r, hi)]) * ((P4_F8 ? MSC : 1.0f) / VSC);
    if (P4_F8) {
        unsigned char* Ow = (unsigned char*)u.Ou + (size_t)(wid * 32) * op; LAS unsigned char* stg = (LAS unsigned char*)(shm3 + LY::LDS_OST) + wid * 4096;
#pragma unroll
        for (int r = 0; r < 16; ++r) { const int orow = crow(r, hi); const int w = __builtin_amdgcn_cvt_pk_fp8_f32(o[0][r] * rli[r], o[1][r] * rli[r], 0, false);
            stg[orow * 64 + r32] = (unsigned char)(w & 0xff); stg[orow * 64 + 32 + r32] = (unsigned char)((w >> 8) & 0xff); }
        LDS_WAIT();
#pragma unroll
        for (int i2 = 0; i2 < 2; ++i2) { const int row = i2 * 16 + (lane >> 2), ch = lane & 3; const u32x4 v = *(const LAS u32x4*)(stg + row * 64 + ch * 16); *(u32x4*)(Ow + (size_t)row * op + ch * 16) = v; }
    } else {
    bf16* Ow = u.Ou + (size_t)(wid * 32) * op;
    { LAS bf16* stg = (LAS bf16*)(shm3 + LY::LDS_OST) + wid * 2048;
#pragma unroll
        for (int r = 0; r < 16; ++r) { const int orow = crow(r, hi);
#pragma unroll
            for (int d0 = 0; d0 < 2; ++d0) stg[orow * 64 + d0 * 32 + r32] = (bf16)(cvt_pk_bf16(o[d0][r] * rli[r], 0.f) & 0xffffu); }
        LDS_WAIT();
#pragma unroll
        for (int i2 = 0; i2 < 4; ++i2) { const int row = i2 * 8 + (lane >> 3), ch = lane & 7; const u32x4 v = *(const LAS u32x4*)(stg + row * 64 + ch * 8); *(u32x4*)(Ow + (size_t)row * op + ch * 8) = v; } }
    }
    AT_BAR_L();
    if (!has_next) break;
    u = un; idx = idxn;
#pragma unroll
    for (int s = 0; s < DKS; ++s) qf[s] = qfn[s];
    }
#undef AT_SEAM
#undef AT_QLOAD
#undef AT_ISSUE
#undef AT_WAITBAR
}
struct DecA { const unsigned char* Q; const unsigned char* K; const bf16* V; bf16* MIX; bool vt;
    __device__ __forceinline__ AUnit operator()(int idx) const { const int b = idx / 96, h = (idx >> 4) % 6, qb = idx & 15; const size_t rb = (size_t)b * SEQ, rq = rb + qb * 256;
        AUnit u; u.Qu = Q + rq * QAP + h * 96; u.Kh = K + rb * KAP + h * 96; u.Vh = vt ? (const bf16*)((const unsigned char*)V + ((size_t)h * (T / 64) + b * 64) * 4096) : V + rb * VAP + h * 64; u.Ou = (P4_F8 && vt) ? (bf16*)((unsigned char*)MIX + rq * D + h * 64) : MIX + rq * D + h * 64; u.t0 = 0; u.t1 = SEQ / 64; u.qpos0 = qb * 256; u.sinkl2 = 0.f; return u; } };
struct DecB { const unsigned char* Q; const unsigned char* K; const bf16* V; bf16* MIX; bool vt;
    __device__ __forceinline__ AUnit operator()(int idx) const { const int b = idx / 96, h = (idx >> 4) % 6, qb = idx & 15, hk = h / 3; const size_t rb = (size_t)b * SEQ, rq = rb + qb * 256;
        AUnit u; u.Qu = Q + rq * QBP + h * 64; u.Kh = K + rb * KBP + hk * 64; u.Vh = vt ? (const bf16*)((const unsigned char*)V + ((size_t)hk * (T / 64) + b * 64) * 4096) : V + rb * VBP + hk * 64; u.Ou = (P4_F8 && vt) ? (bf16*)((unsigned char*)MIX + rq * D + 384 + h * 64) : MIX + rq * D + 384 + h * 64; u.t0 = 0; u.t1 = SEQ / 64; u.qpos0 = qb * 256; u.sinkl2 = 0.f; return u; } };
struct DecC { const unsigned char* Q; const unsigned char* K; const bf16* V; bf16* MIX; const float* sink; bool vt;
    __device__ __forceinline__ AUnit operator()(int idx) const { const int b = idx / 64, h = (idx >> 4) & 3, qb = idx & 15, hk = h >> 1; const size_t rb = (size_t)b * SEQ, rq = rb + qb * 256;
        AUnit u; u.Qu = Q + rq * QCP + h * 64; u.Kh = K + rb * KCP + hk * 64; u.Vh = vt ? (const bf16*)((const unsigned char*)V + ((size_t)hk * (T / 64) + b * 64) * 4096) : V + rb * VCP + hk * 64; u.Ou = (P4_F8 && vt) ? (bf16*)((unsigned char*)MIX + rq * D + 768 + h * 64) : MIX + rq * D + 768 + h * 64;
        u.t0 = (qb * 4 - 2 < 0) ? 0 : qb * 4 - 2; u.t1 = (qb * 4 + 6 > SEQ / 64) ? SEQ / 64 : qb * 4 + 6; u.qpos0 = qb * 256; u.sinkl2 = sink[h] * LOG2E; return u; } };
}

struct Args {
    const float *x, *p, *attn_norm, *w_in, *mla_q_norm, *mla_wq_up, *mla_kv_norm, *mla_wkv_up, *gqa_q_norm, *gqa_k_norm, *swa_sink, *w_out, *moe_norm, *router_w, *router_b,
        *w_up, *b_up, *w_down, *b_down, *ple_norm, *w_ple, *w_ple_gate, *final_norm;
    float* out; unsigned char* ws;
};
struct Ctx { LAS unsigned char* lds; int tid, lane, wave, vcu, G, gw, NGW; };

template <bool F8OUT = false, class RMap>
__device__ __forceinline__ void tr_item(const float* W, int N, bf16* WT, int ldo, int kofs, const float* gain, RMap rmap, LAS float* scr, int kb, int nb, int lane, float wsc = 1.0f) {
    const int k0 = 64 * kb, n0 = 32 * nb;
    float wv[32]; const float* src = W + (size_t)(k0 + (lane >> 5)) * N + n0 + (lane & 31);
#pragma unroll
    for (int i = 0; i < 32; ++i) wv[i] = src[(size_t)(2 * i) * N];
#pragma unroll
    for (int i = 0; i < 32; ++i) scr[(2 * i + (lane >> 5)) * 33 + (lane & 31)] = wv[i];
    LDS_WAIT(); asm volatile("" ::: "memory");
    const int c = lane & 7; float gs[8];
#pragma unroll
    for (int q = 0; q < 8; ++q) gs[q] = (gain ? gain[k0 + 8 * c + q] : 1.0f) * wsc;
#pragma unroll
    for (int j = 0; j < 4; ++j) { const int n = (lane >> 3) + 8 * j; const LAS float* s = scr + (8 * c) * 33 + n;
        if (F8OUT) { u32x2 o; o.x = pk4_fp8(s[0 * 33] * gs[0], s[1 * 33] * gs[1], s[2 * 33] * gs[2], s[3 * 33] * gs[3]); o.y = pk4_fp8(s[4 * 33] * gs[4], s[5 * 33] * gs[5], s[6 * 33] * gs[6], s[7 * 33] * gs[7]);
            *(u32x2*)((unsigned char*)WT + (size_t)rmap(n0 + n) * ldo + kofs + k0 + 8 * c) = o; }
        else { u32x4 o; o.x = cvt_pk_bf16(s[0 * 33] * gs[0], s[1 * 33] * gs[1]); o.y = cvt_pk_bf16(s[2 * 33] * gs[2], s[3 * 33] * gs[3]); o.z = cvt_pk_bf16(s[4 * 33] * gs[4], s[5 * 33] * gs[5]); o.w = cvt_pk_bf16(s[6 * 33] * gs[6], s[7 * 33] * gs[7]);
            *(u32x4*)(WT + (size_t)rmap(n0 + n) * ldo + kofs + k0 + 8 * c) = o; } }
    LDS_WAIT(); asm volatile("" ::: "memory");
}
struct MapId { __device__ __forceinline__ int operator()(int n) const { return n; } };
struct MapIn { __device__ __forceinline__ int operator()(int n) const {
    if (n < 384) return n;
    if (n < 416) { const int j = n - 384; return 384 + ((j < 16) ? 2 * j : 2 * (j - 16) + 1); }
    int hs, d; bool pairs; if (n < ZC) { const int q = n - ZB; hs = q >> 6; d = q & 63; pairs = (hs < 8); } else { const int q = n - ZC; hs = 10 + (q >> 6); d = q & 63; pairs = false; }
    const int bj = d >> 5, dd = d & 31, p = pairs ? ((dd & 15) * 2 + (dd >> 4)) : dd;
    return 256 * (2 + (hs >> 2)) + 128 * bj + 32 * (hs & 3) + p; } };
struct MapQ { __device__ __forceinline__ int operator()(int n) const { const int h = n / 96, d = n - h * 96; if (d < 64) return n; const int j = d - 64; return h * 96 + 64 + ((j < 16) ? 2 * j : 2 * (j - 16) + 1); } };
struct MapUp { __device__ __forceinline__ int operator()(int n) const { if (n < 1024) return (n >> 7) * 256 + (n & 127); const int m = n - 1024; return (m >> 7) * 256 + 128 + (m & 127); } };

__device__ __forceinline__ void zero16(bf16* base, size_t n16, const Ctx& C) {
    const u32x4 z = {0u, 0u, 0u, 0u};
    for (size_t i = (size_t)C.gw * 64 + C.lane; i < n16; i += (size_t)C.NGW * 64) ((u32x4*)base)[i] = z;
}

__device__ __forceinline__ void prologue(const Args& a, const Ctx& C) {
    unsigned char* ws = launder(a.ws);
    LAS float* scr = (LAS float*)(C.lds + C.wave * 16384);
    constexpr int I_UP = 16 * 64, I_DN = 16 * 32, I_IN = 16 * 49, I_OUT = 16 * 32, I_G = 16 * 32, I_Q = 4 * 18, I_KV = 2 * 24, I_PLE = 4 * 32;
    constexpr int N_UP = NL * NE * I_UP, N_DN = NL * NE * I_DN, N_IN = NL * I_IN, N_OUT = NL * I_OUT, N_G = NL * I_G, N_Q = NL * I_Q, N_KV = NL * I_KV, N_PLE = NL * I_PLE;
    constexpr int NITEMS = N_UP + N_DN + N_IN + N_OUT + N_G + N_Q + N_KV + N_PLE;
    for (int it = C.gw; it < NITEMS; it += C.NGW) {
        int r = it;
        if (r < N_UP) { const int le = r / I_UP, q = r - le * I_UP, l = le / NE; tr_item<MOE_F8 != 0>(a.w_up + (size_t)le * D * 2048, 2048, (bf16*)(ws + WS_WUP + (size_t)le * 2048 * D * MOE_ES), D, 0, a.moe_norm + l * D, MapUp(), scr, q / 64, q % 64, C.lane, WSC); continue; } r -= N_UP;
        if (r < N_DN) { const int le = r / I_DN, q = r - le * I_DN; tr_item<MOE_F8 != 0>(a.w_down + (size_t)le * D * D, D, (bf16*)(ws + WS_WDN + (size_t)le * D * D * MOE_ES), D, 0, nullptr, MapId(), scr, q / 32, q % 32, C.lane, WSC); continue; } r -= N_DN;
        if (r < N_IN) { const int l = r / I_IN, q = r - l * I_IN; tr_item<P1_F8 != 0>(a.w_in + (size_t)l * D * 1568, 1568, (bf16*)(ws + WS_WIN + (size_t)l * ZP * D * (P1_F8 ? 1 : 2)), D, 0, a.attn_norm + l * D, MapIn(), scr, q / 49, q % 49, C.lane, P1_F8 ? WSC : 1.0f); continue; } r -= N_IN;
        if (r < N_OUT) { const int l = r / I_OUT, q = r - l * I_OUT; tr_item<P4_F8 != 0>(a.w_out + (size_t)l * D * D, D, (bf16*)(ws + WS_WOUT + (size_t)l * D * D * (P4_F8 ? 1 : 2)), D, 0, nullptr, MapId(), scr, q / 32, q % 32, C.lane, P4_F8 ? WSC : 1.0f); continue; } r -= N_OUT;
        if (r < N_G) { const int l = r / I_G, q = r - l * I_G; tr_item(a.w_ple_gate + (size_t)l * D * D, D, (bf16*)(ws + WS_WG) + (size_t)l * D * D, D, 0, a.ple_norm + l * D, MapId(), scr, q / 32, q % 32, C.lane); continue; } r -= N_G;
        if (r < N_Q) { const int l = r / I_Q, q = r - l * I_Q; tr_item(a.mla_wq_up + (size_t)l * 256 * 576, 576, (bf16*)(ws + WS_WQ) + (size_t)l * 768 * 256, 256, 0, a.mla_q_norm + l * 256, MapQ(), scr, q / 18, q % 18, C.lane); continue; } r -= N_Q;
        if (r < N_KV) { const int l = r / I_KV, q = r - l * I_KV; tr_item(a.mla_wkv_up + (size_t)l * 128 * 768, 768, (bf16*)(ws + WS_WKV) + (size_t)l * 768 * 256, 256, 128, a.mla_kv_norm + l * 128, MapId(), scr, q / 24, q % 24, C.lane); continue; } r -= N_KV;
        { const int l = r / I_PLE, q = r - l * I_PLE; tr_item(a.w_ple + (size_t)l * 256 * D, D, (bf16*)(ws + WS_WPLE) + (size_t)l * D * 256, 256, 0, nullptr, MapId(), scr, q / 32, q % 32, C.lane); }
    }
    for (int l = 0; l < NL; ++l) {
        constexpr int E1 = P1_F8 ? 1 : 2;
        zero16((bf16*)(ws + WS_WIN + ((size_t)l * ZP + 416) * D * E1), (size_t)96 * D * E1 / 16, C);
        zero16((bf16*)(ws + WS_WIN + ((size_t)l * ZP + 1600) * D * E1), (size_t)64 * D * E1 / 16, C);
        zero16((bf16*)(ws + WS_WIN + ((size_t)l * ZP + 1728) * D * E1), (size_t)64 * D * E1 / 16, C);
        zero16((bf16*)(ws + WS_WQ) + ((size_t)l * 768 + 576) * 256, (size_t)192 * 256 / 8, C);
    }
    for (int i = C.gw * 64 + C.lane; i < NL * 768 * 16; i += C.NGW * 64) { const int row = i >> 4, pc = i & 15; *(u32x4*)((bf16*)(ws + WS_WKV) + (size_t)row * 256 + pc * 8) = (u32x4){0u, 0u, 0u, 0u}; }
    for (int m = 4 * C.gw; m < T; m += 4 * C.NGW) {
        f32x4 v[4][4]; float s[4];
#pragma unroll
        for (int q = 0; q < 4; ++q) { const f32x4* xr = (const f32x4*)(a.x + (size_t)(m + q) * D) + C.lane;
#pragma unroll
            for (int j = 0; j < 4; ++j) v[q][j] = xr[64 * j]; }
#pragma unroll
        for (int q = 0; q < 4; ++q) { s[q] = 0.f;
#pragma unroll
            for (int j = 0; j < 4; ++j) s[q] += (v[q][j][0] * v[q][j][0] + v[q][j][1] * v[q][j][1]) + (v[q][j][2] * v[q][j][2] + v[q][j][3] * v[q][j][3]);
            s[q] = wave_sum(s[q]);
            u32x2* o8 = (u32x2*)((bf16*)(ws + WS_XB) + (size_t)(m + q) * D) + C.lane;
#pragma unroll
            for (int j = 0; j < 4; ++j) { u32x2 w; w.x = cvt_pk_bf16(v[q][j][0], v[q][j][1]); w.y = cvt_pk_bf16(v[q][j][2], v[q][j][3]); o8[64 * j] = w; }
            if (P1_F8) { unsigned* q8 = (unsigned*)(ws + WS_XQ + (size_t)(m + q) * D) + C.lane;
#pragma unroll
                for (int j = 0; j < 4; ++j) q8[64 * j] = pk4_fp8(v[q][j][0], v[q][j][1], v[q][j][2], v[q][j][3]); }
            if (C.lane == 0) __hip_atomic_store((u64*)(ws + WS_SS0) + m + q, fx_enc(s[q]), RLX_AGENT); }
    }
    for (size_t i0 = (size_t)C.gw * 256; i0 < (size_t)NL * T * 256 / 8; i0 += (size_t)C.NGW * 256) {
        f32x4 v[4][2];
#pragma unroll
        for (int q = 0; q < 4; ++q) { const size_t i = i0 + q * 64 + C.lane; v[q][0] = ((const f32x4*)a.p)[2 * i]; v[q][1] = ((const f32x4*)a.p)[2 * i + 1]; }
#pragma unroll
        for (int q = 0; q < 4; ++q) { const size_t i = i0 + q * 64 + C.lane;
            u32x4 w; w.x = cvt_pk_bf16(v[q][0][0], v[q][0][1]); w.y = cvt_pk_bf16(v[q][0][2], v[q][0][3]); w.z = cvt_pk_bf16(v[q][1][0], v[q][1][1]); w.w = cvt_pk_bf16(v[q][1][2], v[q][1][3]); ((u32x4*)(ws + WS_PB))[i] = w; }
    }
    for (int i = C.gw * 64 + C.lane; i < SEQ * 48; i += C.NGW * 64) {
        int pos, j; double ex; f32x2* dst;
        if (i < SEQ * 16) { pos = i >> 4; j = i & 15; ex = (double)j / 16.0; dst = (f32x2*)(ws + WS_TAB32) + i; }
        else { const int q = i - SEQ * 16; pos = q >> 5; j = q & 31; ex = (double)j / 32.0; dst = (f32x2*)(ws + WS_TAB64) + q; }
        const float inv = (float)exp2(-13.287712379549449 * ex);
        const float angf = (float)pos * inv;
        const double rev = (double)angf * 0.15915494309189535; const float fr = (float)(rev - floor(rev));
        *dst = (f32x2){__builtin_amdgcn_cosf(fr), __builtin_amdgcn_sinf(fr)};
    }
    for (int i = C.gw * 64 + C.lane; i < NL * D * NE; i += C.NGW * 64) { const int l = i / (D * NE), k = (i / NE) % D; ((float*)(ws + WS_WR))[i] = a.router_w[i] * a.moe_norm[l * D + k]; }
    for (int i = C.gw * 64 + C.lane; i < NL * NE * D; i += C.NGW * 64) { const int l = i / (NE * D), e = (i / D) % NE, k = i % D; const float w = a.router_w[((size_t)l * D + k) * NE + e] * a.moe_norm[l * D + k];
        const unsigned h = cvt_pk_bf16(w, 0.f) & 0xffffu; const float lo = w - __uint_as_float(h << 16);
        ((bf16*)(ws + WS_WR + 512 * 1024))[i] = (bf16)h; ((bf16*)(ws + WS_WR + 768 * 1024))[i] = (bf16)(cvt_pk_bf16(lo, 0.f) & 0xffffu); }
    for (int i = C.gw * 64 + C.lane; i < NL * NE * 2048; i += C.NGW * 64) { const int le = i / 2048, n = i % 2048; ((float*)(ws + WS_BUP))[(size_t)le * 2048 + MapUp()(n)] = a.b_up[i]; }
}
namespace gp { }
__device__ __forceinline__ float sq4g(f32x4 v) { return (v[0] * v[0] + v[1] * v[1]) + (v[2] * v[2] + v[3] * v[3]); }

__device__ __forceinline__ void rope_phase(const Args& a, const Ctx& C, int l) {
    unsigned char* ws = launder(a.ws);
    const bf16* Z = (const bf16*)(ws + WS_Z); const f32x2* tab32 = (const f32x2*)(ws + WS_TAB32); const f32x2* tab64 = (const f32x2*)(ws + WS_TAB64);
    bf16 *KA = (bf16*)(ws + WS_KA), *QB = (bf16*)(ws + WS_QB), *KB = (bf16*)(ws + WS_KB), *VB = (bf16*)(ws + WS_VB), *QC = (bf16*)(ws + WS_QC), *KC = (bf16*)(ws + WS_KC), *VC = (bf16*)(ws + WS_VC);
    const int lane = C.lane;
    const float gq = a.gqa_q_norm[l * 64 + lane], gk = a.gqa_k_norm[l * 64 + lane];
    for (int t = C.gw; t < T; t += C.NGW) {
        const int pos = t & (SEQ - 1), prow = pos >> 6, pcol = pos & 63; const bf16* zr = Z + (size_t)t * ZP;
        {
            const float v = bf2f(zr[384 + (lane & 31)]); const float pr = __shfl_xor(v, 16); const int j = lane & 15; const f32x2 cs = tab32[pos * 16 + j];
            const float o = (lane & 16) ? (v * cs.x + pr * cs.y) : (v * cs.x - pr * cs.y); const bf16 ob = (bf16)(cvt_pk_bf16(o, 0.f) & 0xffffu);
            if (lane < 32) { const int dest = 64 + 2 * j + ((lane >> 4) & 1);
#pragma unroll
                for (int h = 0; h < 6; ++h) KA[(size_t)t * KAP + h * 96 + dest] = ob; }
        }
#pragma unroll
        for (int hb = 0; hb < 10; ++hb) {
            float v = bf2f(zr[ZB + hb * 64 + lane]);
            if (hb < 8) { const float ss = wave_sum(v * v); const float n = v * __builtin_amdgcn_rsqf(ss * (1.0f / 64) + EPS) * (hb < 6 ? gq : gk);
                const float pr = __shfl_xor(n, 16); const int j = lane & 15; const f32x2 cs = tab32[((lane & 32) ? pcol : prow) * 16 + j];
                v = (lane & 16) ? (n * cs.x + pr * cs.y) : (n * cs.x - pr * cs.y); if (hb < 6) v *= C2B; }
            const bf16 ob = (bf16)(cvt_pk_bf16(v, 0.f) & 0xffffu);
            if (hb < 6) QB[(size_t)t * QBP + hb * 64 + lane] = ob; else if (hb < 8) KB[(size_t)t * KBP + (hb - 6) * 64 + lane] = ob; else VB[(size_t)t * VBP + (hb - 8) * 64 + lane] = ob;
        }
#pragma unroll
        for (int hc = 0; hc < 8; ++hc) {
            float v = bf2f(zr[ZC + hc * 64 + lane]);
            if (hc < 6) { const float pr = __shfl_xor(v, 32); const f32x2 cs = tab64[pos * 32 + (lane & 31)]; v = (lane & 32) ? (v * cs.x + pr * cs.y) : (v * cs.x - pr * cs.y); if (hc < 4) v *= C2B; }
            const bf16 ob = (bf16)(cvt_pk_bf16(v, 0.f) & 0xffffu);
            if (hc < 4) QC[(size_t)t * QCP + hc * 64 + lane] = ob; else if (hc < 6) KC[(size_t)t * KCP + (hc - 4) * 64 + lane] = ob; else VC[(size_t)t * VCP + (hc - 6) * 64 + lane] = ob;
        }
    }
}

__device__ __forceinline__ void router_phase(const Args& a, const Ctx& C, int l, bool commit) {
    unsigned char* ws = launder(a.ws);
    const float* XF = (const float*)(ws + WS_XF); const float* WR = (const float*)(ws + WS_WR) + (size_t)l * D * NE; const u64* ss1 = (const u64*)(ws + WS_CTL + (size_t)CW_SS * 4) + (size_t)(l * 4 + 2) * T;
    int* cnt = (int*)(ws + WS_CTL) + CW_CNT + l * NE; int* perm = (int*)(ws + WS_PERM); float* rsl = (float*)(ws + WS_RSL); float* gsl = (float*)(ws + WS_GSL);
    LAS float* part = (LAS float*)C.lds;
    LAS int* hist = (LAS int*)(C.lds + MISC_OFF + 1024); LAS int* base = hist + NE;
    const int lane = C.lane, r32 = lane & 31, hi = lane >> 5, tg = C.wave & 3, kh = C.wave >> 2;
    for (int blk = C.vcu; blk < T / 128; blk += C.G) {
        const int t0 = blk * 128;
        if (C.tid < NE) hist[C.tid] = 0;
        f32x16 acc = {};
        const float* xr = XF + (size_t)(t0 + tg * 32 + r32) * D + kh * 512 + hi * 4; const bf16* xrb = (const bf16*)(ws + WS_X1B) + (size_t)(t0 + tg * 32 + r32) * D + kh * 512 + hi * 4; const float* wr = WR + (size_t)(kh * 512 + hi * 4) * NE + r32;
        const float rs_l = __builtin_amdgcn_rsqf(fx_load(ss1 + t0 + tg * 32 + r32) * (1.0f / D) + EPS);
        unsigned char* xq = ws + WS_X1Q + (size_t)(t0 + tg * 32 + r32) * D + kh * 512 + hi * 4;
        if (X1_BF16) {
            const bf16* xb_ = (const bf16*)(ws + WS_X1B) + (size_t)(t0 + tg * 32 + r32) * D + kh * 512 + hi * 8;
            const bf16* wh_ = (const bf16*)(ws + WS_WR + 512 * 1024) + ((size_t)l * NE + r32) * D + kh * 512 + hi * 8; const bf16* wl_ = wh_ + (256 * 1024) / 2;
            unsigned char* xq8 = ws + WS_X1Q + (size_t)(t0 + tg * 32 + r32) * D + kh * 512 + hi * 8;
#pragma unroll 1
            for (int kb = 0; kb < 32; kb += 8) { u32x4 xb[8], ah[8], al[8];
#pragma unroll
                for (int q = 0; q < 8; ++q) { xb[q] = *(const u32x4*)(xb_ + (kb + q) * 16); ah[q] = *(const u32x4*)(wh_ + (kb + q) * 16); al[q] = *(const u32x4*)(wl_ + (kb + q) * 16); }
                __builtin_amdgcn_sched_barrier(0);
                if (MOE_F8) {
#pragma unroll
                    for (int q = 0; q < 8; ++q) { const u32x4 w = xb[q]; u32x2 o; o.x = pk4_fp8(bflo(w.x) * rs_l, bfhi(w.x) * rs_l, bflo(w.y) * rs_l, bfhi(w.y) * rs_l); o.y = pk4_fp8(bflo(w.z) * rs_l, bfhi(w.z) * rs_l, bflo(w.w) * rs_l, bfhi(w.w) * rs_l);
                        *(u32x2*)(xq8 + (kb + q) * 16) = o; } }
#pragma unroll
                for (int q = 0; q < 8; ++q) { acc = __builtin_amdgcn_mfma_f32_32x32x16_bf16(__builtin_bit_cast(bf16x8, ah[q]), __builtin_bit_cast(bf16x8, xb[q]), acc, 0, 0, 0);
                    acc = __builtin_amdgcn_mfma_f32_32x32x16_bf16(__builtin_bit_cast(bf16x8, al[q]), __builtin_bit_cast(bf16x8, xb[q]), acc, 0, 0, 0); } }
        } else {
#pragma unroll 1
        for (int kb = 0; kb < 64; kb += 8) { f32x4 xv[8]; float wv[8][4];
#pragma unroll
            for (int q = 0; q < 8; ++q) { if (X1_BF16) { const u32x2 w = *(const u32x2*)(xrb + (kb + q) * 8); xv[q] = (f32x4){bflo(w.x), bfhi(w.x), bflo(w.y), bfhi(w.y)}; } else xv[q] = *(const f32x4*)(xr + (kb + q) * 8);
#pragma unroll
                for (int i = 0; i < 4; ++i) wv[q][i] = wr[((kb + q) * 8 + i) * NE]; }
            __builtin_amdgcn_sched_barrier(0);
            if (MOE_F8) {
#pragma unroll
                for (int q = 0; q < 8; ++q) *(unsigned*)(xq + (kb + q) * 8) = pk4_fp8(xv[q][0] * rs_l, xv[q][1] * rs_l, xv[q][2] * rs_l, xv[q][3] * rs_l); }
#pragma unroll
            for (int q = 0; q < 8; ++q)
#pragma unroll
                for (int i = 0; i < 4; ++i) acc = __builtin_amdgcn_mfma_f32_32x32x2f32(wv[q][i], xv[q][i], acc, 0, 0, 0); }
        }
#pragma unroll
        for (int r = 0; r < 16; ++r) part[(kh * 128 + tg * 32 + r32) * 33 + at::crow(r, hi)] = acc[r];
        __syncthreads();
        int ek[4]; float wk[4]; int rk[4]; float rs_t = 1.0f; const int t = t0 + C.tid;
        if (C.tid < 128) {
            const float rs = __builtin_amdgcn_rsqf(fx_load(ss1 + t) * (1.0f / D) + EPS); float v[NE]; rs_t = rs;
#pragma unroll
            for (int e = 0; e < NE; ++e) v[e] = (part[C.tid * 33 + e] + part[(128 + C.tid) * 33 + e]) * rs + a.router_b[l * NE + e];
            unsigned used = 0u; float tv[4];
#pragma unroll
            for (int k = 0; k < 4; ++k) { float best = -INFINITY; int bi = 0;
#pragma unroll
                for (int e = 0; e < NE; ++e) { const bool ok = !((used >> e) & 1u) && (v[e] > best); best = ok ? v[e] : best; bi = ok ? e : bi; }
                used |= 1u << bi; ek[k] = bi; tv[k] = best; }
            float den = 0.f;
#pragma unroll
            for (int k = 0; k < 4; ++k) { wk[k] = __expf(tv[k] - tv[0]); den += wk[k]; }
            const float rd = 1.0f / den;
#pragma unroll
            for (int k = 0; k < 4; ++k) { wk[k] *= rd; rk[k] = commit ? atomicAdd((int*)(hist + ek[k]), 1) : 0; }
        }
        __syncthreads();
        if (C.tid < NE && commit) base[C.tid] = atomicAdd(cnt + C.tid, hist[C.tid]);
        __syncthreads();
        if (C.tid < 128 && commit) {
#pragma unroll
            for (int k = 0; k < 4; ++k) { const int sidx = ek[k] * ECAP + base[ek[k]] + rk[k]; __hip_atomic_store(perm + sidx, t * 4 + k, RLX_AGENT); __hip_atomic_store(rsl + sidx, rs_t, RLX_AGENT); __hip_atomic_store(gsl + sidx, wk[k], RLX_AGENT); }
        }
        __syncthreads();
    }
}

__device__ __forceinline__ void combine_phase(const Args& a, const Ctx& C) {
    unsigned char* ws = launder(a.ws); const float* XF = (const float*)(ws + WS_XF); const bf16* Y = (const bf16*)(ws + WS_Y); bf16* X2B = (bf16*)(ws + WS_X2B); float* rs2 = (float*)(ws + WS_RS2);
    for (int t0 = 2 * C.gw; t0 < T; t0 += 2 * C.NGW) {
        f32x4 v[2][4]; u32x2 y[2][4][4];
#pragma unroll
        for (int q = 0; q < 2; ++q) { const f32x4* xr = (const f32x4*)(XF + (size_t)(t0 + q) * D) + C.lane; const u32x2* xrb = (const u32x2*)((const bf16*)(ws + WS_X1B) + (size_t)(t0 + q) * D) + C.lane;
#pragma unroll
            for (int j = 0; j < 4; ++j) { if (X1_BF16) { const u32x2 w = xrb[64 * j]; v[q][j] = (f32x4){bflo(w.x), bfhi(w.x), bflo(w.y), bfhi(w.y)}; } else v[q][j] = xr[64 * j]; }
#pragma unroll
            for (int k = 0; k < 4; ++k) { const u32x2* yr = (const u32x2*)(Y + (size_t)((t0 + q) * 4 + k) * D) + C.lane;
#pragma unroll
                for (int j = 0; j < 4; ++j) y[q][k][j] = yr[64 * j]; } }
#pragma unroll
        for (int q = 0; q < 2; ++q) { float s = 0.f;
#pragma unroll
            for (int k = 0; k < 4; ++k)
#pragma unroll
                for (int j = 0; j < 4; ++j) { const u32x2 w = y[q][k][j]; v[q][j][0] += bflo(w.x); v[q][j][1] += bfhi(w.x); v[q][j][2] += bflo(w.y); v[q][j][3] += bfhi(w.y); }
            u32x2* o8 = (u32x2*)(X2B + (size_t)(t0 + q) * D) + C.lane;
#pragma unroll
            for (int j = 0; j < 4; ++j) { u32x2 w; w.x = cvt_pk_bf16(v[q][j][0], v[q][j][1]); w.y = cvt_pk_bf16(v[q][j][2], v[q][j][3]); o8[64 * j] = w; s += sq4g(v[q][j]); }
            s = wave_sum(s);
            if (C.lane == 0) __hip_atomic_store(rs2 + t0 + q, __builtin_amdgcn_rsqf(s * (1.0f / D) + EPS), RLX_AGENT); }
    }
}
__device__ __forceinline__ void final_phase(const Args& a, const Ctx& C) {
    const bf16* XB = (const bf16*)(launder(a.ws) + WS_XB);
    const f32x4* g = (const f32x4*)a.final_norm + C.lane; f32x4 gv[4];
#pragma unroll
    for (int j = 0; j < 4; ++j) gv[j] = g[64 * j];
    for (int t0 = 4 * C.gw; t0 < T; t0 += 4 * C.NGW) {
        u32x2 w[4][4];
#pragma unroll
        for (int q = 0; q < 4; ++q) { const u32x2* xr = (const u32x2*)(XB + (size_t)(t0 + q) * D) + C.lane;
#pragma unroll
            for (int j = 0; j < 4; ++j) w[q][j] = xr[64 * j]; }
#pragma unroll
        for (int q = 0; q < 4; ++q) { f32x4 v[4]; float s = 0.f;
#pragma unroll
            for (int j = 0; j < 4; ++j) { v[j] = (f32x4){bflo(w[q][j].x), bfhi(w[q][j].x), bflo(w[q][j].y), bfhi(w[q][j].y)}; s += sq4g(v[j]); }
            s = wave_sum(s); const float rs = 1.0f / sqrtf(s * (1.0f / D) + EPS);
            f32x4* o = (f32x4*)(a.out + (size_t)(t0 + q) * D) + C.lane;
#pragma unroll
            for (int j = 0; j < 4; ++j) o[64 * j] = v[j] * rs * gv[j]; }
    }
}
__device__ __forceinline__ Ctx make_ctx(LAS unsigned char* lds) {
    Ctx C; C.lds = lds; C.tid = opaque_tid(); C.lane = C.tid & 63; C.wave = __builtin_amdgcn_readfirstlane(C.tid >> 6);
    C.G = gridDim.x; const int bx = blockIdx.x; C.vcu = (C.G % 8 == 0) ? (bx % 8) * (C.G / 8) + bx / 8 : bx; C.gw = C.vcu * NWAVES + C.wave; C.NGW = C.G * NWAVES; return C;
}
#ifdef PROBE_A
#define STAMP(i) do { if (blockIdx.x == 0 && threadIdx.x == 0) ((LAS u64*)(lds + MISC_OFF + 3072))[(i)] = __builtin_amdgcn_s_memrealtime(); } while (0)
#else
#define STAMP(i) do { } while (0)
#endif
#define GRID_BAR() do { XcdBarrier b_; b_.bar = (unsigned*)(launder(a.ws) + WS_CTL) + CW_BAR; b_.x = xb_xcc_id(); b_.st = (volatile LAS unsigned*)(lds + MISC_OFF); xcd_barrier(b_); } while (0)
__global__ void __launch_bounds__(NWAVES * 64, 2) fwd(Args a) {
    extern __shared__ __attribute__((aligned(16))) unsigned char lds_raw[];
    LAS unsigned char* lds = (LAS unsigned char*)lds_raw;
    for (int u = threadIdx.x; u < (LDS_BYTES - MISC_OFF) / 4; u += NWAVES * 64) ((LAS unsigned*)(lds + MISC_OFF))[u] = 0u;
    __syncthreads();
    (void)xcd_barrier_post((unsigned*)(launder(a.ws) + WS_CTL) + CW_BAR, (volatile LAS unsigned*)(lds + MISC_OFF));
    const int bx = blockIdx.x;
    STAMP(0);
    PH(0) { const Ctx C = make_ctx(lds); prologue(a, C); }
    GRID_BAR(); STAMP(1);

#pragma unroll 1
    for (int l = 0; l < NL; ++l) {
        PH(1) { unsigned char* ws = launder(a.ws); u64* ssb = (u64*)(ws + WS_CTL + (size_t)CW_SS * 4) + (size_t)l * 4 * T;
          const u64* ssin = (l == 0) ? (const u64*)(ws + WS_SS0) : (const u64*)(ws + WS_CTL + (size_t)CW_SS * 4) + (size_t)((l - 1) * 4 + 3) * T;
          gp::DenseSched S; if (P1_F8) S.init(ws + WS_XQ, D / 2, ws + WS_WIN + (size_t)l * ZP * D, D / 2, T, ZP, gridDim.x, bx); else S.init(ws + WS_XB, D, (bf16*)(ws + WS_WIN) + (size_t)l * ZP * D, D, T, ZP, gridDim.x, bx);
          gp::EpiIn E{(bf16*)(ws + WS_Z), ssin, ssb, ssb + T, rep_ == 0, (bf16*)(ws + WS_KA), (bf16*)(ws + WS_QB), (bf16*)(ws + WS_KB), (bf16*)(ws + WS_VB), (bf16*)(ws + WS_QC), (bf16*)(ws + WS_KC), (bf16*)(ws + WS_VC),
                       (const f32x2*)(ws + WS_TAB32), (const f32x2*)(ws + WS_TAB64), a.gqa_q_norm + l * 64, a.gqa_k_norm + l * 64, ws + WS_VTB, ws + WS_VTC, PV_F8 != 0};
          gp::gemm_phase<gp::EpiIn, gp::DenseSched, true, P1_F8 != 0>(lds, D, S, E); }
        GRID_BAR(); STAMP(2 + l * 9 + 0);
        PH(3) { unsigned char* ws = launder(a.ws); u64* ssb = (u64*)(ws + WS_CTL + (size_t)CW_SS * 4) + (size_t)l * 4 * T;
          gp::MlaSched S{(const char*)(ws + WS_Z), (const char*)((bf16*)(ws + WS_WQ) + (size_t)l * 768 * 256), (const char*)((bf16*)(ws + WS_WKV) + (size_t)l * 768 * 256), (int)gridDim.x, bx};
          gp::EpiMla E{(bf16*)(ws + WS_QA), (bf16*)(ws + WS_KA), (bf16*)(ws + WS_VA), ssb, ssb + T, (const f32x2*)(ws + WS_TAB32), ws + WS_VTA, PV_F8 != 0};
          gp::gemm_phase<gp::EpiMla, gp::MlaSched, true>(lds, 256, S, E); }
        GRID_BAR(); STAMP(2 + l * 9 + 1);
#if PV_CHECK
        { unsigned char* ws = launder(a.ws); u64* ssb = (u64*)(ws + WS_CTL + (size_t)CW_SS * 4) + (size_t)l * 4 * T;
          const u64* ssin = (l == 0) ? (const u64*)(ws + WS_SS0) : (const u64*)(ws + WS_CTL + (size_t)CW_SS * 4) + (size_t)((l - 1) * 4 + 3) * T;
          gp::DenseSched S; if (P1_F8) S.init(ws + WS_XQ, D / 2, ws + WS_WIN + (size_t)l * ZP * D, D / 2, T, ZP, gridDim.x, bx); else S.init(ws + WS_XB, D, (bf16*)(ws + WS_WIN) + (size_t)l * ZP * D, D, T, ZP, gridDim.x, bx);
          gp::EpiIn E{(bf16*)(ws + WS_Z), ssin, ssb, ssb + T, false, (bf16*)(ws + WS_KA), (bf16*)(ws + WS_QB), (bf16*)(ws + WS_KB), (bf16*)(ws + WS_VB), (bf16*)(ws + WS_QC), (bf16*)(ws + WS_KC), (bf16*)(ws + WS_VC),
                       (const f32x2*)(ws + WS_TAB32), (const f32x2*)(ws + WS_TAB64), a.gqa_q_norm + l * 64, a.gqa_k_norm + l * 64, ws + WS_VTB, ws + WS_VTC, false};
          gp::gemm_phase<gp::EpiIn, gp::DenseSched, true, P1_F8 != 0>(lds, D, S, E); }
        GRID_BAR();
        { unsigned char* ws = launder(a.ws); u64* ssb = (u64*)(ws + WS_CTL + (size_t)CW_SS * 4) + (size_t)l * 4 * T;
          gp::MlaSched S{(const char*)(ws + WS_Z), (const char*)((bf16*)(ws + WS_WQ) + (size_t)l * 768 * 256), (const char*)((bf16*)(ws + WS_WKV) + (size_t)l * 768 * 256), (int)gridDim.x, bx};
          gp::EpiMla E{(bf16*)(ws + WS_QA), (bf16*)(ws + WS_KA), (bf16*)(ws + WS_VA), ssb, ssb + T, (const f32x2*)(ws + WS_TAB32), ws + WS_VTA, false};
          gp::gemm_phase<gp::EpiMla, gp::MlaSched, true>(lds, 256, S, E); }
        GRID_BAR();
#endif
        {
            char* shm = (char*)lds_raw; const int G = gridDim.x, vcu = (G % 8 == 0) ? (bx % 8) * (G / 8) + bx / 8 : bx;
#if PV_CHECK
            { unsigned char* ws = launder(a.ws); at::DecA dec{ws + WS_QA, ws + WS_KA, (const bf16*)(ws + WS_VA), (bf16*)(ws + WS_MIX), false};
              at::attn_loop_f8<2, 6, 0>(vcu, NB * 6 * 16, G, dec, QAP, KAP, VAP, D, shm); }
            { unsigned char* ws = launder(a.ws); at::DecB dec{ws + WS_QB, ws + WS_KB, (const bf16*)(ws + WS_VB), (bf16*)(ws + WS_MIX), false};
              at::attn_loop_f8<1, 4, 0>(vcu, NB * 6 * 16, G, dec, QBP, KBP, VBP, D, shm); }
            { unsigned char* ws = launder(a.ws); at::DecC dec{ws + WS_QC, ws + WS_KC, (const bf16*)(ws + WS_VC), (bf16*)(ws + WS_MIX), a.swa_sink + l * 4, false};
              at::attn_loop_f8<1, 4, 1>(vcu, NB * 4 * 16, G, dec, QCP, KCP, VCP, D, shm); }
            { unsigned char* ws = launder(a.ws); at::DecA dec{ws + WS_QA, ws + WS_KA, (const bf16*)(ws + WS_VTA), (bf16*)(ws + WS_MIX2), true};
              at::attn_loop_f8v<2, 6, 0>(vcu, NB * 6 * 16, G, dec, QAP, KAP, D, shm); }
            { unsigned char* ws = launder(a.ws); at::DecB dec{ws + WS_QB, ws + WS_KB, (const bf16*)(ws + WS_VTB), (bf16*)(ws + WS_MIX2), true};
              at::attn_loop_f8v<1, 4, 0>(vcu, NB * 6 * 16, G, dec, QBP, KBP, D, shm); }
            { unsigned char* ws = launder(a.ws); at::DecC dec{ws + WS_QC, ws + WS_KC, (const bf16*)(ws + WS_VTC), (bf16*)(ws + WS_MIX2), a.swa_sink + l * 4, true};
              at::attn_loop_f8v<1, 4, 1>(vcu, NB * 4 * 16, G, dec, QCP, KCP, D, shm); }
            GRID_BAR();
            { unsigned char* ws = launder(a.ws); const bf16* M1 = (const bf16*)(ws + WS_MIX); const bf16* M2 = (const bf16*)(ws + WS_MIX2); float d2 = 0.f, r2 = 0.f;
              const int tid_ = opaque_tid(), col = ((bx & 1) * 512 + tid_), mx = col < 384 ? 0 : col < 768 ? 1 : 2;
#pragma unroll 1
              for (int row = bx >> 1; row < T; row += (int)(gridDim.x >> 1)) { const size_t e = (size_t)row * D + col; const float v1 = (float)M1[e], v2 = (float)M2[e], df = v1 - v2; d2 += df * df; r2 += v1 * v1; }
              float* chk = (float*)(ws + WS_CTL) + CW_CHK;
              atomicAdd(chk + l * 8 + mx, d2); atomicAdd(chk + l * 8 + 4 + mx, r2); }
#else
            PH(4) { unsigned char* ws = launder(a.ws); at::DecA dec{ws + WS_QA, ws + WS_KA, (const bf16*)(ws + WS_VTA), (bf16*)(ws + WS_MIX), PV_F8 != 0};
              if (PV_F8) at::attn_loop_f8v<2, 6, 0>(vcu, NB * 6 * 16, G, dec, QAP, KAP, D, shm); else at::attn_loop_f8<2, 6, 0>(vcu, NB * 6 * 16, G, dec, QAP, KAP, VAP, D, shm); }
            PH(5) { unsigned char* ws = launder(a.ws); at::DecB dec{ws + WS_QB, ws + WS_KB, (const bf16*)(ws + WS_VTB), (bf16*)(ws + WS_MIX), PV_F8 != 0};
              if (PV_F8) at::attn_loop_f8v<1, 4, 0>(vcu, NB * 6 * 16, G, dec, QBP, KBP, D, shm); else at::attn_loop_f8<1, 4, 0>(vcu, NB * 6 * 16, G, dec, QBP, KBP, VBP, D, shm); }
            PH(6) { unsigned char* ws = launder(a.ws); at::DecC dec{ws + WS_QC, ws + WS_KC, (const bf16*)(ws + WS_VTC), (bf16*)(ws + WS_MIX), a.swa_sink + l * 4, PV_F8 != 0};
              if (PV_F8) at::attn_loop_f8v<1, 4, 1>(vcu, NB * 4 * 16, G, dec, QCP, KCP, D, shm); else at::attn_loop_f8<1, 4, 1>(vcu, NB * 4 * 16, G, dec, QCP, KCP, VCP, D, shm); }
#endif
        }
        GRID_BAR(); STAMP(2 + l * 9 + 2);
        for (int rep_ = 0; rep_ < 1 + (((REPMASK >> 7) & 1) && l == 0); ++rep_) { unsigned char* ws = launder(a.ws); u64* ssb = (u64*)(ws + WS_CTL + (size_t)CW_SS * 4) + (size_t)l * 4 * T; float* XF = (float*)(ws + WS_XF);
          gp::DenseSched S; if (P4_F8) S.init(ws + WS_MIX, D / 2, ws + WS_WOUT + (size_t)l * D * D, D / 2, T, D, gridDim.x, bx); else S.init(ws + WS_MIX, D, (bf16*)(ws + WS_WOUT) + (size_t)l * D * D, D, T, D, gridDim.x, bx);
          gp::EpiRes E{a.x, (l == 0) ? (const bf16*)nullptr : (const bf16*)(ws + WS_XB), XF, (bf16*)(ws + WS_X1B), ssb + 2 * T, rep_ == 0, ws + WS_X1Q, 1.0f / (MSC * WSC)};
          gp::gemm_phase<gp::EpiRes, gp::DenseSched, true, P4_F8 != 0>(lds, D, S, E); }
        GRID_BAR(); STAMP(2 + l * 9 + 3);
        PH(8) { const Ctx C = make_ctx(lds); router_phase(a, C, l, rep_ == 0); }
        PH(9) { unsigned char* ws = launder(a.ws);
          gp::DenseSched S; S.init((bf16*)(ws + WS_PB) + (size_t)l * T * 256, 256, (bf16*)(ws + WS_WPLE) + (size_t)l * D * 256, 256, T, D, gridDim.x, bx);
          gp::EpiPlain E{(bf16*)(ws + WS_EB), D};
          gp::gemm_phase<gp::EpiPlain, gp::DenseSched, true>(lds, 256, S, E); }
        GRID_BAR(); STAMP(2 + l * 9 + 4);
        gp::MoeTab tb; tb.P = (LAS int*)(lds + MISC_OFF + 2048); tb.C = tb.P + 64; tb.R2E = (LAS int*)(lds + MISC_OFF + 4096);
        if (threadIdx.x == 0) { const int* cnt = (const int*)(launder(a.ws) + WS_CTL) + CW_CNT + l * NE; int accp = 0;
            for (int e = 0; e < NE; ++e) { const int c = cnt[e]; tb.C[e] = c; tb.P[e] = accp; accp += (c + 255) >> 8; } tb.P[NE] = accp; }
        __syncthreads();
        { const int nrt = tb.P[NE];
#pragma unroll 1
          for (int rt = opaque_tid(); rt < nrt; rt += NWAVES * 64) { int e = 0;
#pragma unroll 1
              for (int j = 1; j < NE; ++j) e = (tb.P[j] <= rt) ? j : e;
              tb.R2E[rt] = e; } }
        __syncthreads();
        PH(10) { unsigned char* ws = launder(a.ws); u64* ssb = (u64*)(ws + WS_CTL + (size_t)CW_SS * 4) + (size_t)l * 4 * T; const int* perm = (const int*)(ws + WS_PERM);
          gp::UpSched S{tb, perm, (const char*)(ws + (MOE_F8 ? WS_X1Q : WS_X1B)), (const char*)(ws + WS_WUP + (size_t)l * NE * 2048 * D * MOE_ES), (int)gridDim.x, bx};
          gp::EpiUp E{(bf16*)(ws + WS_ACT), (const float*)(ws + WS_RSL), (const float*)(ws + WS_BUP) + (size_t)l * NE * 2048, tb};
          gp::gemm_phase<gp::EpiUp, gp::UpSched, true, MOE_F8 != 0>(lds, D, S, E); }
        GRID_BAR(); STAMP(2 + l * 9 + 5);
        PH(11) { unsigned char* ws = launder(a.ws); const int* perm = (const int*)(ws + WS_PERM);
          gp::DownSched S{tb, (const char*)(ws + WS_ACT), (const char*)(ws + WS_WDN + (size_t)l * NE * D * D * MOE_ES), (int)gridDim.x, bx};
          gp::EpiDown E{(bf16*)(ws + WS_Y), a.b_down + (size_t)l * NE * D, (const float*)(ws + WS_GSL), perm, tb};
          gp::gemm_phase<gp::EpiDown, gp::DownSched, true, MOE_F8 != 0>(lds, D, S, E); }
        GRID_BAR(); STAMP(2 + l * 9 + 6);
        PH(12) { const Ctx C = make_ctx(lds); combine_phase(a, C); }
        GRID_BAR(); STAMP(2 + l * 9 + 7);
        PH(13) { unsigned char* ws = launder(a.ws); u64* ssb = (u64*)(ws + WS_CTL + (size_t)CW_SS * 4) + (size_t)l * 4 * T;
          gp::DenseSched S; S.init(ws + WS_X2B, D, (bf16*)(ws + WS_WG) + (size_t)l * D * D, D, T, D, gridDim.x, bx);
          gp::EpiGate E{(const bf16*)(ws + WS_X2B), (bf16*)(ws + WS_XB), (const bf16*)(ws + WS_EB), (const float*)(ws + WS_RS2), ssb + 3 * T, rep_ == 0, ws + WS_XQ};
          gp::gemm_phase<gp::EpiGate, gp::DenseSched, true>(lds, D, S, E); }
        GRID_BAR(); STAMP(2 + l * 9 + 8);
    }
#ifdef PROBE_A
    if (blockIdx.x == 0 && threadIdx.x == 0) { LAS u64* st = (LAS u64*)(lds + MISC_OFF + 3072); const float ms = (float)(long long)(st[PROBE_B] - st[PROBE_A]) * 1e-5f;
        __hip_atomic_store((float*)(launder(a.ws) + WS_RS2) + T, 1.0f + ms, RLX_AGENT); }
    GRID_BAR();
#endif
    PH(14) { const Ctx C = make_ctx(lds); final_phase(a, C); }
#if PV_CHECK
    GRID_BAR();
    if (bx == 0 && threadIdx.x == 0) { const float* chk = (const float*)(launder(a.ws) + WS_CTL) + CW_CHK; bool bad = false;
        for (int l = 0; l < NL; ++l) for (int q = 0; q < 3; ++q) { const float d = __builtin_nontemporal_load(chk + l * 8 + q), r = __builtin_nontemporal_load(chk + l * 8 + 4 + q); if (!(r > 0.f) || !(d <= PV_TOL * r) || !(d >= PV_LOW * r)) bad = true; }
        if (bad) a.out[0] = __builtin_nanf(""); }
#endif
}

extern "C" void kernel_launch(void* const* d_in, const int* in_sizes, int n_in, void* d_out, int out_size, void* d_ws, size_t ws_size, hipStream_t stream) {
    static int grid = 0;
    if (grid == 0) {
        if (n_in != 23 || out_size != T * D || ws_size < WS_END) { fprintf(stderr, "kernel_launch: unexpected shapes (n_in %d out %d ws %zu)\n", n_in, out_size, ws_size); grid = -1; return; }
        int dev = 0, cus = 0, per_cu = 0;
        if (hipGetDevice(&dev) != hipSuccess || hipDeviceGetAttribute(&cus, hipDeviceAttributeMultiprocessorCount, dev) != hipSuccess) { grid = -1; return; }
        if (hipFuncSetAttribute((const void*)fwd, hipFuncAttributeMaxDynamicSharedMemorySize, LDS_BYTES) != hipSuccess) { fprintf(stderr, "kernel_launch: hipFuncSetAttribute failed\n"); grid = -1; return; }
        if (hipOccupancyMaxActiveBlocksPerMultiprocessor(&per_cu, (const void*)fwd, NWAVES * 64, LDS_BYTES) != hipSuccess || per_cu < 1) fprintf(stderr, "kernel_launch: occupancy query reports %d\n", per_cu);
        (void)hipGetLastError();
        grid = cus;
    }
    if (grid < 0) return;
    if (hipMemsetAsync((char*)d_ws + WS_CTL, 0, CTL_ZERO_BYTES, stream) != hipSuccess) return;
    Args a{};
    const float** ap = (const float**)&a;
    for (int i = 0; i < 23; ++i) ap[i] = (const float*)d_in[i];
    a.out = (float*)d_out; a.ws = (unsigned char*)d_ws;
    hipLaunchKernelGGL(fwd, dim3(grid), dim3(NWAVES * 64), LDS_BYTES, stream, a);
}
```

```cpp
#include <hip/hip_runtime.h>
#include <cstdio>
#include <cstdint>
#include <type_traits>

#define GAS __attribute__((address_space(1)))
#define LAS __attribute__((address_space(3)))
typedef unsigned short bf16;
typedef short bf16x8 __attribute__((ext_vector_type(8)));
typedef short s16x4 __attribute__((ext_vector_type(4)));
typedef float f32x2 __attribute__((ext_vector_type(2)));
typedef float f32x4 __attribute__((ext_vector_type(4)));
typedef float f32x16 __attribute__((ext_vector_type(16)));
typedef unsigned u32x2 __attribute__((ext_vector_type(2)));
typedef unsigned u32x4 __attribute__((ext_vector_type(4)));

constexpr int NB = 8, SEQ = 4096, T = NB * SEQ, D = 1024, NL = 2;
constexpr int ZP = 1792;
constexpr int ZQ = 384;
constexpr int A_COLS = 416, B_COLS = 640;
constexpr int ZB = A_COLS, ZC = A_COLS + B_COLS;
constexpr int QAP = 576, KAP = 576, VAP = 384, QBP = 384, KBP = 128, VBP = 128, QCP = 256, KCP = 128, VCP = 128;
constexpr int NE = 32, TOPK = 4, ECAP = T;
constexpr int ACT_ROWS = T * TOPK + NE * 256;
constexpr float EPS = 1e-6f, LOG2E = 1.4426950408889634f;
constexpr float C2A = 0.10206207261596577f * LOG2E;
constexpr float C2B = 0.125f * LOG2E;

#ifndef P1_F8
#define P1_F8 1
#endif
#ifndef P4_F8
#define P4_F8 1
#endif
constexpr float MSC = 64.0f;
#ifndef PP_A
#define PP_A 0
#endif
#ifndef PP_B
#define PP_B 0
#endif
#ifndef PP_C
#define PP_C 1
#endif
#ifndef PV_CHECK
#define PV_CHECK 0
#endif
#ifndef PV_LOW
#define PV_LOW 0.0f
#endif
#ifndef PV_TOL
#define PV_TOL 0.02f
#endif
#ifndef PV_F8
#define PV_F8 1
#endif
constexpr float VSC = 8.0f;
#ifndef ATT_F8
#define ATT_F8 1
#endif
#ifndef X1_BF16
#define X1_BF16 1
#endif
#ifndef MOE_F8
#define MOE_F8 1
#endif
constexpr int MOE_ES = MOE_F8 ? 1 : 2;
constexpr float WSC = 64.0f, WSC_INV = 1.0f / 64.0f;

constexpr size_t MiB = 1u << 20;
constexpr size_t WS_CTL = 0, CTL_ZERO_BYTES = 4 * MiB;
constexpr int CW_BAR = 4096;
constexpr int CW_CNT = 16384;
constexpr int CW_SS = 65536;
static_assert(CW_SS * 4 + NL * 4 * T * 8 <= (int)CTL_ZERO_BYTES, "ctl");
constexpr size_t WS_TAB32 = 4 * MiB;
constexpr size_t WS_TAB64 = 5 * MiB;
constexpr size_t WS_WR = 6 * MiB;
constexpr size_t WS_BUP = 7 * MiB;
constexpr size_t WS_SS0 = 8 * MiB;
constexpr size_t WS_RS2 = 8 * MiB + 512 * 1024;
constexpr size_t WS_GATES = 9 * MiB;
constexpr size_t WS_PERM = 10 * MiB;
constexpr size_t WS_WIN = 16 * MiB;
constexpr size_t WS_WQ = 24 * MiB;
constexpr size_t WS_WKV = 25 * MiB;
constexpr size_t WS_WOUT = 26 * MiB;
constexpr size_t WS_WG = 30 * MiB;
constexpr size_t WS_WPLE = 34 * MiB;
constexpr size_t WS_WUP = 36 * MiB;
constexpr size_t WS_WDN = 292 * MiB;
constexpr size_t WS_XB = 420 * MiB;
constexpr size_t WS_X1B = 484 * MiB;
constexpr size_t WS_X2B = 548 * MiB;
constexpr size_t WS_XF = 612 * MiB;
constexpr size_t WS_PB = 740 * MiB;
constexpr size_t WS_Z = 772 * MiB;
constexpr size_t WS_QA = 884 * MiB;
constexpr size_t WS_KA = 920 * MiB;
constexpr size_t WS_VA = 956 * MiB;
constexpr size_t WS_QB = 980 * MiB;
constexpr size_t WS_KB = 1004 * MiB;
constexpr size_t WS_VB = 1012 * MiB;
constexpr size_t WS_QC = 1020 * MiB;
constexpr size_t WS_KC = 1036 * MiB;
constexpr size_t WS_VC = 1044 * MiB;
constexpr size_t WS_MIX = 1052 * MiB;
constexpr size_t WS_EB = 1116 * MiB;
constexpr size_t WS_ACT = 1180 * MiB;
constexpr size_t WS_Y = 1452 * MiB;
constexpr size_t WS_RSL = 1708 * MiB;
constexpr size_t WS_GSL = 1712 * MiB;
constexpr size_t WS_X1Q = 1716 * MiB;
constexpr size_t WS_END = 1748 * MiB;
constexpr size_t WS_XQ = WS_XF;
static_assert(X1_BF16 || !P1_F8, "XQ aliases XF");
constexpr size_t WS_VTA = PV_CHECK ? WS_Y : WS_VA, WS_VTB = PV_CHECK ? WS_Y + 16 * MiB : WS_VB, WS_VTC = PV_CHECK ? WS_Y + 24 * MiB : WS_VC, WS_MIX2 = WS_Y + 32 * MiB;
constexpr int CW_CHK = CW_CNT + 1024;

constexpr int RING_BYTES = 131072;
constexpr int MISC_OFF = RING_BYTES;
constexpr int LDS_BYTES = 147456;
constexpr int NWAVES = 8;

#define RLX_AGENT __ATOMIC_RELAXED, __HIP_MEMORY_SCOPE_AGENT
#define LDS_WAIT() asm volatile("s_waitcnt lgkmcnt(0)" ::: "memory")
#define VM_WAIT() asm volatile("s_waitcnt vmcnt(0)" ::: "memory")
__device__ __forceinline__ unsigned cvt_pk_bf16(float lo, float hi) { unsigned r; asm volatile("v_cvt_pk_bf16_f32 %0, %1, %2" : "=v"(r) : "v"(lo), "v"(hi)); return r; }
__device__ __forceinline__ unsigned pk4_fp8(float a, float b, float c, float d) { int w = 0; w = __builtin_amdgcn_cvt_pk_fp8_f32(a, b, w, false); w = __builtin_amdgcn_cvt_pk_fp8_f32(c, d, w, true); return (unsigned)w; }
__device__ __forceinline__ u32x2 pk8_fp8(f32x4 a, f32x4 b) { u32x2 w; w.x = pk4_fp8(a[0], a[1], a[2], a[3]); w.y = pk4_fp8(b[0], b[1], b[2], b[3]); return w; }
__device__ __forceinline__ float bf2f(unsigned short b) { return __uint_as_float((unsigned)b << 16); }
__device__ __forceinline__ float bflo(unsigned w) { return __uint_as_float(w << 16); }
__device__ __forceinline__ float bfhi(unsigned w) { return __uint_as_float(w & 0xffff0000u); }
typedef unsigned long long u64;
__device__ __forceinline__ u64 fx_enc(float v) { return (u64)__float2ll_rn(v * 1048576.0f); }
__device__ __forceinline__ void atomic_addf(u64* p, float v) { (void)__hip_atomic_fetch_add(p, fx_enc(v), __ATOMIC_RELAXED, __HIP_MEMORY_SCOPE_AGENT); }
__device__ __forceinline__ float fx_load(const u64* p) { return (float)(long long)(*p) * (1.0f / 1048576.0f); }
__device__ __forceinline__ float wave_sum(float v) {
#pragma unroll
    for (int o = 1; o < 64; o <<= 1) v += __shfl_xor(v, o);
    return v;
}
__device__ __forceinline__ float sigmoidf_fast(float x) { return __builtin_amdgcn_rcpf(1.0f + __builtin_amdgcn_exp2f(-x * LOG2E)); }

__device__ __forceinline__ unsigned char* launder(unsigned char* p) { GAS unsigned char* g = (GAS unsigned char*)p; asm volatile("" : "+s"(g)); return (unsigned char*)g; }
__device__ __forceinline__ int opaque_tid() { int t = threadIdx.x; asm volatile("" : "+v"(t)); return t; }
#ifndef REPMASK
#define REPMASK 0
#endif
#define PH(k) for (int rep_ = 0; rep_ < 1 + ((REPMASK >> (k)) & 1); ++rep_)

#define XB_TMO      128
#define XB_XCNT(j)  (256  + 64 * (j))
#define XB_XSUB(j)  (1280 + 64 * (j))
#define XB_XGEN(j)  (2304 + 64 * (j))
#define XB_TOP      3328
#define XB_TOPGEN   3392
#define XCD_BAR_WORDS 3456
#define XB_SPIN_CAP (1u << 18)
__device__ __forceinline__ unsigned xb_ld(unsigned* p)              { return __hip_atomic_load(p, __ATOMIC_RELAXED, __HIP_MEMORY_SCOPE_AGENT); }
__device__ __forceinline__ unsigned xb_add(unsigned* p, unsigned v) { return __hip_atomic_fetch_add(p, v, __ATOMIC_RELAXED, __HIP_MEMORY_SCOPE_AGENT); }
__device__ __forceinline__ unsigned xb_xcc_id() { return (unsigned)__builtin_amdgcn_s_getreg((3 << 11) | 20) & 0xFu; }
#define XB_SPIN(cond, bar) do { unsigned _sp = 0; while (cond) { __builtin_amdgcn_s_sleep(1); \
    if ((++_sp & 255u) == 0u) { if (xb_ld(&(bar)[XB_TMO])) break; if (_sp > XB_SPIN_CAP) { atomicAdd(&(bar)[XB_TMO], 1u); break; } } } } while (0)
struct XcdBarrier { unsigned* bar; unsigned x; volatile LAS unsigned* st; };
__device__ __forceinline__ XcdBarrier xcd_barrier_post(unsigned* bar, volatile LAS unsigned* st) {
    XcdBarrier b; b.bar = bar; b.x = xb_xcc_id(); b.st = st;
    if (threadIdx.x == 0) (void)xb_add(&bar[XB_XCNT(b.x)], 1u);
    return b;
}
__device__ __forceinline__ void xcd_barrier_complete(unsigned* bar, unsigned x, unsigned& nloc, unsigned& nx) {
    const unsigned G = gridDim.x * gridDim.y * gridDim.z;
    unsigned sum, cnt, mine, sp = 0u;
    for (;;) {
        sum = 0u; cnt = 0u; mine = 0u;
#pragma unroll
        for (unsigned j = 0; j < 16; ++j) { const unsigned c = xb_ld(&bar[XB_XCNT(j)]); sum += c; cnt += (c > 0u) ? 1u : 0u; mine = (j == x) ? c : mine; }
        if (sum == G) break;
        __builtin_amdgcn_s_sleep(1);
        if ((++sp & 255u) == 0u) { if (xb_ld(&bar[XB_TMO])) break; if (sp > XB_SPIN_CAP) { atomicAdd(&bar[XB_TMO], 1u); break; } }
    }
    nloc = mine > 0u ? mine : 1u; nx = cnt > 0u ? cnt : 1u;
}
__device__ __forceinline__ void xcd_barrier(const XcdBarrier& b) {
    asm volatile("s_waitcnt vmcnt(0)" ::: "memory");
    __syncthreads();
    if (threadIdx.x == 0) {
        unsigned* bar = b.bar;
        __builtin_amdgcn_s_waitcnt(0);
        unsigned nloc = b.st[0], nx = b.st[1];
        if (nloc == 0u) { xcd_barrier_complete(bar, b.x, nloc, nx); b.st[0] = nloc; b.st[1] = nx; }
        const unsigned old = xb_add(&bar[XB_XSUB(b.x)], 1u);
        const unsigned gen = old / nloc;
        if (old + 1u == (gen + 1u) * nloc) {
            __builtin_amdgcn_fence(__ATOMIC_RELEASE, "agent");
            asm volatile("s_waitcnt vmcnt(0)" ::: "memory");
            const unsigned og = xb_add(&bar[XB_TOP], 1u);
            const unsigned tg = og / nx;
            if (og + 1u == (tg + 1u) * nx) xb_add(&bar[XB_TOPGEN], 1u);
            else XB_SPIN(xb_ld(&bar[XB_TOPGEN]) == tg, bar);
            __builtin_amdgcn_fence(__ATOMIC_ACQUIRE, "agent");
            xb_add(&bar[XB_XGEN(b.x)], 1u);
            asm volatile("s_waitcnt vmcnt(0)" ::: "memory");
        } else {
            XB_SPIN(xb_ld(&bar[XB_XGEN(b.x)]) == gen, bar);
            __builtin_amdgcn_fence(__ATOMIC_ACQUIRE, "agent");
            asm volatile("s_waitcnt vmcnt(0)" ::: "memory");
        }
    }
    __syncthreads();
}

namespace gp {
constexpr int BM = 256, BK = 64, HALF = 128, HTB = HALF * BK * 2, STAGE_BYTES = 8 * HTB, NXCD = 8, WGM = 16;
__host__ __device__ __forceinline__ int lds_byte(int r, int c) { const int st = (r >> 4) * 2 + (c >> 5), rr = r & 15, cc = c & 31, ob = rr * 64 + cc * 2; return st * 1024 + (ob ^ (((ob >> 9) & 1) << 5)); }
__host__ __device__ __forceinline__ void stage_rc(int b, int& R, int& C) { const int st = b / 1024, sb = b % 1024, swz = sb ^ (((sb >> 9) & 1) << 5); R = (st >> 1) * 16 + swz / 64; C = (st & 1) * 32 + (swz % 64) / 2; }
__host__ __device__ __forceinline__ int perm32(int rho) { const int n = rho >> 4, i = rho & 15; return 8 * (i >> 2) + 4 * n + (i & 3); }

struct Unit { int pm, pn, aux; const char* A; const char* B; };

struct TileOrder {
    int nM, nN, nwg, G, c;
    __device__ __forceinline__ void init(int nM_, int nN_, int G_, int c_) { nM = nM_; nN = nN_; nwg = nM * nN; G = G_; c = c_; }
    __device__ __forceinline__ bool tile(int i, int& pm, int& pn) const {
        const long L = (long)i * G + c; if (L >= nwg) return false;
        int wgid = (int)L; { const int q = nwg / NXCD, r = nwg % NXCD, xcd = wgid % NXCD, off = wgid / NXCD; wgid = (xcd < r ? xcd * (q + 1) : r * (q + 1) + (xcd - r) * q) + off; }
        const int nig = WGM * nN, gid = wgid / nig, fm = gid * WGM, gsz = (nM - fm) < WGM ? (nM - fm) : WGM;
        pm = fm + ((wgid % nig) % gsz); pn = (wgid % nig) / gsz; return true;
    }
};
struct DenseSched {
    TileOrder o; const char* A; const char* B; int lda, K;
    __device__ __forceinline__ void init(const void* A_, int lda_, const void* B_, int K_, int M, int N, int G, int c) { A = (const char*)A_; B = (const char*)B_; lda = lda_; K = K_; o.init(M / BM, N / BM, G, c); }
    __device__ __forceinline__ bool next(int i, Unit& u) const { int pm, pn; if (!o.tile(i, pm, pn)) return false; u.pm = pm; u.pn = pn; u.aux = 0;
        u.A = A + (size_t)pm * BM * lda * 2; u.B = B + (size_t)pn * BM * K * 2; return true; }
    __device__ __forceinline__ unsigned rowoff(const Unit&, int r) const { return (unsigned)(r * lda * 2); }
    __device__ __forceinline__ unsigned rowraw(const Unit&, int r) const { return (unsigned)(r * lda * 2); }
    __device__ __forceinline__ unsigned rawoff(unsigned raw) const { return raw; }
};

typedef int i32x8 __attribute__((ext_vector_type(8)));
template <class Epi, class Sched, bool ALIGN_EPI, bool F8 = false>
__device__ __forceinline__ void gemm_phase(LAS unsigned char* lds, const int Kel, const Sched& S, const Epi& E) {
    const int K = F8 ? (Kel >> 1) : Kel;
    const int tid = opaque_tid(), wid = __builtin_amdgcn_readfirstlane(tid >> 6), lane = tid & 63, wr = wid >> 2, wc = wid & 3, fr = lane & 15, fq = lane >> 4;
    const int nt = K / BK;
    int Rr[2], Cc[2]; unsigned voffB[2];
#pragma unroll
    for (int i = 0; i < 2; ++i) { int R, C; stage_rc(tid * 16 + i * 8192, R, C); const int Rb = Epi::PERM ? ((R & ~31) + perm32(R & 31)) : R;
        Rr[i] = R; Cc[i] = C * 2; voffB[i] = (unsigned)(Rb * K + C) * 2u; }
    const size_t kstep = (size_t)(BK * 2);
    const size_t hstepB = (size_t)HALF * K * 2;
    const unsigned ldsw = (unsigned)wid * 1024u;
    const int aoff = lds_byte(wr * 64 + fr, fq * (F8 ? 16 : 8)), boff = lds_byte(wc * 32 + fr, fq * (F8 ? 16 : 8));
#define GP_SA(b, h) (((b) * 2 + (h)) * HTB)
#define GP_SB(b, h) ((4 + (b) * 2 + (h)) * HTB)
#define GP_STAGE(bufoff, gbase, voff) do { _Pragma("unroll") for (int _i = 0; _i < 2; ++_i) \
        __builtin_amdgcn_global_load_lds((const unsigned*)((const char*)(gbase) + (voff)[_i]), (LAS unsigned*)(lds + (bufoff) + ldsw + _i * 8192), 16, 0, 0); } while (0)
#define GP_LD1(dst, base) do { if constexpr (F8) { const u32x4 lo_ = *(const LAS u32x4*)(base), hi_ = *(const LAS u32x4*)((base) + 16); (dst)[0] = __builtin_bit_cast(i32x8, __builtin_shufflevector(lo_, hi_, 0, 1, 2, 3, 4, 5, 6, 7)); } \
        else { _Pragma("unroll") for (int k = 0; k < NK; ++k) (dst)[k] = __builtin_bit_cast(frag_t, *(const LAS typename std::conditional<F8, i32x8, bf16x8>::type*)((base) + k * 1024)); } } while (0)
#define GP_LDA(dst, b, h) do { _Pragma("unroll") for (int m = 0; m < 4; ++m) GP_LD1(dst[m], lds + GP_SA(b, h) + aoff + m * 2048); } while (0)
#define GP_LDB(dst, b, h) do { _Pragma("unroll") for (int n = 0; n < 2; ++n) GP_LD1(dst[n], lds + GP_SB(b, h) + boff + n * 2048); } while (0)
#define GP_MMA(ai, bj, At, Bt) do { __builtin_amdgcn_s_setprio(1); \
        if constexpr (F8) { _Pragma("unroll") for (int m = 0; m < 4; ++m) _Pragma("unroll") for (int n = 0; n < 2; ++n) \
            asm volatile("v_mfma_scale_f32_16x16x128_f8f6f4 %0, %1, %2, %0, %3, %3 op_sel_hi:[0,0,0]" : "+v"(acc[ai][bj][m][n]) : "v"(Bt[n][0]), "v"(At[m][0]), "v"(one_sc)); } \
        else { _Pragma("unroll") for (int m = 0; m < 4; ++m) _Pragma("unroll") for (int n = 0; n < 2; ++n) _Pragma("unroll") for (int k = 0; k < NK; ++k) \
            acc[ai][bj][m][n] = __builtin_amdgcn_mfma_f32_16x16x32_bf16(__builtin_bit_cast(bf16x8, Bt[n][k]), __builtin_bit_cast(bf16x8, At[m][k]), acc[ai][bj][m][n], 0, 0, 0); } \
        __builtin_amdgcn_s_setprio(0); } while (0)
#define GP_WAIT_V(n) asm volatile("s_waitcnt vmcnt(" #n ")" ::: "memory")
#define GP_WAIT_L(n) asm volatile("s_waitcnt lgkmcnt(" #n ")" ::: "memory")
#define GP_BAR __builtin_amdgcn_s_barrier()
#define GP_SCHED __builtin_amdgcn_sched_barrier(0)
    Unit cur, nxt; int ui = 0;
    if (!S.next(0, cur)) return;
    unsigned vAc[2][2], vAn[2][2];
#pragma unroll
    for (int h = 0; h < 2; ++h)
#pragma unroll
        for (int i = 0; i < 2; ++i) vAc[h][i] = S.rowoff(cur, h * HALF + Rr[i]) + (unsigned)Cc[i];
    f32x4 acc[2][2][4][2];
#pragma unroll
    for (int a = 0; a < 2; ++a)
#pragma unroll
        for (int b = 0; b < 2; ++b)
#pragma unroll
            for (int m = 0; m < 4; ++m)
#pragma unroll
                for (int n = 0; n < 2; ++n) acc[a][b][m][n] = (f32x4){0.f, 0.f, 0.f, 0.f};
    typedef typename std::conditional<F8, i32x8, bf16x8>::type frag_t; constexpr int NK = F8 ? 1 : 2;
    frag_t At[4][NK], B0[2][NK], B1[2][NK]; const unsigned one_sc = 0x7f7f7f7fu;
    const char* cA = cur.A; const char* cB = cur.B;
    GP_STAGE(GP_SB(0, 0), cB, voffB); GP_STAGE(GP_SB(0, 1), cB + hstepB, voffB); GP_STAGE(GP_SA(0, 0), cA, vAc[0]); GP_STAGE(GP_SA(0, 1), cA, vAc[1]);
    if (wr == 1) GP_BAR;
    GP_WAIT_V(2); GP_BAR;
    GP_STAGE(GP_SB(1, 0), cB + kstep, voffB); GP_STAGE(GP_SA(1, 0), cA + kstep, vAc[0]); GP_STAGE(GP_SB(1, 1), cB + hstepB + kstep, voffB);
    GP_WAIT_V(6); GP_BAR;
    for (;;) {
        const bool has_next = S.next(ui + 1, nxt);
        const char* nA = has_next ? nxt.A : cA; const char* nB = has_next ? nxt.B : cB;
#pragma unroll
        for (int h = 0; h < 2; ++h)
#pragma unroll
            for (int i = 0; i < 2; ++i) vAn[h][i] = has_next ? S.rowraw(nxt, h * HALF + Rr[i]) : 0u;
#pragma unroll 1
        for (int t = 0; t < nt; t += 2) {
            const bool last = (t == nt - 2);
            const char* a1 = cA + (size_t)(t + 1) * kstep;
            const char* a2 = last ? nA : cA + (size_t)(t + 2) * kstep; const char* b2 = last ? nB : cB + (size_t)(t + 2) * kstep;
            const char* a3 = a2 + kstep; const char* b3 = b2 + kstep;
            GP_LDB(B0, 0, 0); GP_LDB(B1, 0, 1); GP_SCHED; GP_LDA(At, 0, 0); GP_STAGE(GP_SA(1, 1), a1, vAc[1]);
            if (last && has_next) {
#pragma unroll
                for (int h = 0; h < 2; ++h)
#pragma unroll
                    for (int i = 0; i < 2; ++i) { unsigned r_ = vAn[h][i]; asm volatile("" : "+v"(r_)); vAc[h][i] = S.rawoff(r_) + (unsigned)Cc[i]; } }
            GP_WAIT_V(8); GP_WAIT_L(0); GP_BAR; GP_MMA(0, 0, At, B0); GP_MMA(0, 1, At, B1); GP_BAR; GP_SCHED;
            GP_LDA(At, 0, 1); GP_STAGE(GP_SB(0, 0), b2, voffB); GP_STAGE(GP_SB(0, 1), b2 + hstepB, voffB); GP_STAGE(GP_SA(0, 0), a2, vAc[0]);
            GP_WAIT_V(8); GP_WAIT_L(0); GP_BAR; GP_MMA(1, 0, At, B0); GP_MMA(1, 1, At, B1); GP_BAR; GP_SCHED;
            GP_LDB(B0, 1, 0); GP_LDB(B1, 1, 1); GP_SCHED; GP_LDA(At, 1, 0); GP_STAGE(GP_SA(0, 1), a2, vAc[1]);
            GP_WAIT_V(8); GP_WAIT_L(0); GP_BAR; GP_MMA(0, 0, At, B0); GP_MMA(0, 1, At, B1); GP_BAR; GP_SCHED;
            GP_LDA(At, 1, 1); GP_STAGE(GP_SB(1, 0), b3, voffB); GP_STAGE(GP_SB(1, 1), b3 + hstepB, voffB); GP_STAGE(GP_SA(1, 0), a3, vAc[0]);
            GP_WAIT_V(8); GP_WAIT_L(0); GP_BAR; GP_MMA(1, 0, At, B0); GP_MMA(1, 1, At, B1); GP_BAR; GP_SCHED;
        }
        if constexpr (ALIGN_EPI) { if (wr == 0) GP_BAR; }
        if constexpr (F8) asm volatile("s_nop 15\n\ts_nop 15" ::: "memory");
        E(acc, cur, wr, wc, fr, fq);
        if (!has_next) break;
#pragma unroll
        for (int a = 0; a < 2; ++a)
#pragma unroll
            for (int b = 0; b < 2; ++b)
#pragma unroll
                for (int m = 0; m < 4; ++m)
#pragma unroll
                    for (int n = 0; n < 2; ++n) acc[a][b][m][n] = (f32x4){0.f, 0.f, 0.f, 0.f};
        cur = nxt; cA = nA; cB = nB; ++ui;
        if constexpr (ALIGN_EPI) { if (wr == 1) GP_BAR; }
    }
    GP_WAIT_V(0);
    if constexpr (!ALIGN_EPI) { if (wr == 0) GP_BAR; }
    GP_BAR;
#undef GP_SA
#undef GP_SB
#undef GP_STAGE
#undef GP_LDA
#undef GP_LDB
#undef GP_MMA
#undef GP_LD1
#undef GP_WAIT_V
#undef GP_WAIT_L
#undef GP_BAR
#undef GP_SCHED
}

typedef f32x4 Acc[2][2][4][2];
__device__ __forceinline__ u32x4 pack8(f32x4 v0, f32x4 v1) { u32x4 w; w.x = cvt_pk_bf16(v0[0], v0[1]); w.y = cvt_pk_bf16(v0[2], v0[3]); w.z = cvt_pk_bf16(v1[0], v1[1]); w.w = cvt_pk_bf16(v1[2], v1[3]); return w; }
__device__ __forceinline__ float sq4(f32x4 v) { return (v[0] * v[0] + v[1] * v[1]) + (v[2] * v[2] + v[3] * v[3]); }
__device__ __forceinline__ float fq_sum(float s) { s += __shfl_xor(s, 16); s += __shfl_xor(s, 32); return s; }

struct EpiPlain {
    static constexpr bool PERM = true;
    bf16* O; int ldc;
    __device__ __forceinline__ void operator()(const Acc& acc, const Unit& u, int wr, int wc, int fr, int fq) const {
        const int row0 = u.pm * BM + wr * 64 + fr, col0 = u.pn * BM + wc * 32 + 8 * fq;
#pragma unroll
        for (int ai = 0; ai < 2; ++ai)
#pragma unroll
            for (int m = 0; m < 4; ++m) { bf16* rowp = O + (size_t)(row0 + ai * HALF + m * 16) * ldc + col0;
#pragma unroll
                for (int bj = 0; bj < 2; ++bj) *(u32x4*)(rowp + bj * HALF) = pack8(acc[ai][bj][m][0], acc[ai][bj][m][1]); }
    }
};
constexpr float RSC1 = P1_F8 ? 1.0f / WSC : 1.0f;
struct EpiIn {
    static constexpr bool PERM = true;
    bf16* Z; const u64* ssin; u64* ssq; u64* sskv; bool accum;
    bf16 *KA, *QB, *KB, *VB, *QC, *KC, *VC; const f32x2* tab32; const f32x2* tab64; const float* gq; const float* gk; unsigned char *VTB, *VTC; bool vt;
    __device__ __forceinline__ void operator()(const Acc& acc, const Unit& u, int wr, int wc, int fr, int fq) const {
        const int row0 = u.pm * BM + wr * 64 + fr;
        if (u.pn < 2) {
#pragma unroll
            for (int ai = 0; ai < 2; ++ai)
#pragma unroll
                for (int m = 0; m < 4; ++m) { const int row = row0 + ai * HALF + m * 16; const float rs = (__builtin_amdgcn_rsqf(fx_load(ssin + row) * (1.0f / D) + EPS) * RSC1);
                    const f32x4 a0 = acc[ai][0][m][0] * rs, a1 = acc[ai][0][m][1] * rs, b0 = acc[ai][1][m][0] * rs, b1 = acc[ai][1][m][1] * rs;
                    bf16* rowp = Z + (size_t)row * ZQ + u.pn * BM + wc * 32 + 8 * fq;
                    *(u32x4*)rowp = pack8(a0, a1);
                    if (u.pn == 0) { *(u32x4*)(rowp + HALF) = pack8(b0, b1); const float s = fq_sum(sq4(a0) + sq4(a1) + sq4(b0) + sq4(b1)); if (fq == 0 && accum) atomic_addf(ssq + row, s); }
                    else { const float s = fq_sum(sq4(a0) + sq4(a1)); if (fq == 0 && accum) atomic_addf(sskv + row, s);
                        if (wc == 0) { const f32x2* cs = tab32 + (size_t)(row & (SEQ - 1)) * 16 + 4 * fq; const f32x2 c0 = cs[0], c1 = cs[1], c2 = cs[2], c3 = cs[3];
                            f32x4 r0, r1; r0[0] = b0[0] * c0.x - b0[1] * c0.y; r0[1] = b0[1] * c0.x + b0[0] * c0.y; r0[2] = b0[2] * c1.x - b0[3] * c1.y; r0[3] = b0[3] * c1.x + b0[2] * c1.y;
                            r1[0] = b1[0] * c2.x - b1[1] * c2.y; r1[1] = b1[1] * c2.x + b1[0] * c2.y; r1[2] = b1[2] * c3.x - b1[3] * c3.y; r1[3] = b1[3] * c3.x + b1[2] * c3.y;
                            if (ATT_F8) { const u32x2 w = pk8_fp8(r0, r1); unsigned char* kp = (unsigned char*)KA + (size_t)row * KAP + 64 + 8 * fq;
#pragma unroll
                                for (int h = 0; h < 6; ++h) *(u32x2*)(kp + h * 96) = w; }
                            else { const u32x4 w = pack8(r0, r1); bf16* kp = KA + (size_t)row * KAP + 64 + 8 * fq;
#pragma unroll
                                for (int h = 0; h < 6; ++h) *(u32x4*)(kp + h * 96) = w; } } } }
            return;
        }
        const int hs = 4 * (u.pn - 2) + wc;
        if (hs >= 18) return;
        if (hs < 8) {
            const float* g = (hs < 6) ? gq : gk; float gn[2][2][4];
#pragma unroll
            for (int bj = 0; bj < 2; ++bj)
#pragma unroll
                for (int n = 0; n < 2; ++n)
#pragma unroll
                    for (int i = 0; i < 4; ++i) gn[bj][n][i] = g[32 * bj + (4 * fq + 2 * n + (i >> 1)) + 16 * (i & 1)];
            bf16* dst = (hs < 6) ? QB + hs * 64 : KB + (hs - 6) * 64; const int pitch = (hs < 6) ? QBP : KBP; const float osc = (hs < 6) ? C2B : 1.0f;
            unsigned char* dst8 = (hs < 6) ? (unsigned char*)QB + hs * 64 : (unsigned char*)KB + (hs - 6) * 64;
#pragma unroll
            for (int ai = 0; ai < 2; ++ai)
#pragma unroll
                for (int m = 0; m < 4; ++m) { const int row = row0 + ai * HALF + m * 16, pos = row & (SEQ - 1); const float rs = (__builtin_amdgcn_rsqf(fx_load(ssin + row) * (1.0f / D) + EPS) * RSC1);
                    f32x4 v[2][2]; float s = 0.f;
#pragma unroll
                    for (int bj = 0; bj < 2; ++bj)
#pragma unroll
                        for (int n = 0; n < 2; ++n) { v[bj][n] = acc[ai][bj][m][n] * rs; s += sq4(v[bj][n]); }
                    const float nrm = __builtin_amdgcn_rsqf(fq_sum(s) * (1.0f / 64) + EPS) * osc;
#pragma unroll
                    for (int bj = 0; bj < 2; ++bj) { const f32x2* cs = tab32 + (size_t)(bj ? (pos & 63) : (pos >> 6)) * 16 + 4 * fq; f32x4 r[2];
#pragma unroll
                        for (int n = 0; n < 2; ++n) { const f32x2 ca = cs[2 * n], cb = cs[2 * n + 1];
                            const float x0 = v[bj][n][0] * nrm * gn[bj][n][0], x1 = v[bj][n][1] * nrm * gn[bj][n][1], x2 = v[bj][n][2] * nrm * gn[bj][n][2], x3 = v[bj][n][3] * nrm * gn[bj][n][3];
                            r[n][0] = x0 * ca.x - x1 * ca.y; r[n][1] = x1 * ca.x + x0 * ca.y; r[n][2] = x2 * cb.x - x3 * cb.y; r[n][3] = x3 * cb.x + x2 * cb.y; }
                        if (ATT_F8) *(u32x2*)((unsigned char*)dst8 + (size_t)row * pitch + 32 * bj + 8 * fq) = pk8_fp8(r[0], r[1]);
                        else *(u32x4*)(dst + (size_t)row * pitch + 32 * bj + 8 * fq) = pack8(r[0], r[1]); }
                    if (m & 1) asm volatile("" ::: "memory"); }
        } else if (hs >= 10 && hs < 16) {
            bf16* dst = (hs < 14) ? QC + (hs - 10) * 64 : KC + (hs - 14) * 64; const int pitch = (hs < 14) ? QCP : KCP; const float osc = (hs < 14) ? C2B : 1.0f;
#pragma unroll
            for (int ai = 0; ai < 2; ++ai)
#pragma unroll
                for (int m = 0; m < 4; ++m) { const int row = row0 + ai * HALF + m * 16, pos = row & (SEQ - 1); const float rs = (__builtin_amdgcn_rsqf(fx_load(ssin + row) * (1.0f / D) + EPS) * RSC1) * osc;
                    const f32x2* cs = tab64 + (size_t)pos * 32 + 8 * fq; f32x4 lo[2], hh[2];
#pragma unroll
                    for (int n = 0; n < 2; ++n)
#pragma unroll
                        for (int i = 0; i < 4; ++i) { const f32x2 c = cs[4 * n + i]; const float x1 = acc[ai][0][m][n][i] * rs, x2 = acc[ai][1][m][n][i] * rs; lo[n][i] = x1 * c.x - x2 * c.y; hh[n][i] = x2 * c.x + x1 * c.y; }
                    if (ATT_F8) { unsigned char* rp = ((hs < 14) ? (unsigned char*)QC + (hs - 10) * 64 : (unsigned char*)KC + (hs - 14) * 64) + (size_t)row * pitch + 8 * fq; *(u32x2*)rp = pk8_fp8(lo[0], lo[1]); *(u32x2*)(rp + 32) = pk8_fp8(hh[0], hh[1]); }
                    else { bf16* rp = dst + (size_t)row * pitch + 8 * fq; *(u32x4*)rp = pack8(lo[0], lo[1]); *(u32x4*)(rp + 32) = pack8(hh[0], hh[1]); }
                    if (m & 1) asm volatile("" ::: "memory"); }
        } else {
        if (vt) {
            unsigned char* dst = (hs < 10) ? VTB + (size_t)(hs - 8) * ((size_t)T * 64) : VTC + (size_t)(hs - 16) * ((size_t)T * 64);
#pragma unroll
            for (int ai = 0; ai < 2; ++ai) { float rs[4];
#pragma unroll
                for (int m = 0; m < 4; ++m) rs[m] = __builtin_amdgcn_rsqf(fx_load(ssin + row0 + ai * HALF + m * 16) * (1.0f / D) + EPS) * (VSC * RSC1);
                unsigned char* bp = dst + (size_t)(u.pm * 4 + ai * 2 + wr) * 4096 + 4 * fr + 8 * fq * 64;
#pragma unroll
                for (int bj = 0; bj < 2; ++bj)
#pragma unroll
                    for (int n = 0; n < 2; ++n)
#pragma unroll
                        for (int i = 0; i < 4; ++i)
                            *(unsigned*)(bp + (32 * bj + 4 * n + i) * 64) = pk4_fp8(acc[ai][bj][0][n][i] * rs[0], acc[ai][bj][1][n][i] * rs[1], acc[ai][bj][2][n][i] * rs[2], acc[ai][bj][3][n][i] * rs[3]);
                asm volatile("" ::: "memory"); }
        }
        if (!vt) {
            bf16* dst = (hs < 10) ? VB + (hs - 8) * 64 : VC + (hs - 16) * 64;
#pragma unroll
            for (int ai = 0; ai < 2; ++ai)
#pragma unroll
                for (int m = 0; m < 4; ++m) { const int row = row0 + ai * HALF + m * 16; const float rs = (__builtin_amdgcn_rsqf(fx_load(ssin + row) * (1.0f / D) + EPS) * RSC1);
                    bf16* rp = dst + (size_t)row * 128 + 8 * fq; *(u32x4*)rp = pack8(acc[ai][0][m][0] * rs, acc[ai][0][m][1] * rs); *(u32x4*)(rp + 32) = pack8(acc[ai][1][m][0] * rs, acc[ai][1][m][1] * rs); }
        }
        }
    }
};
struct EpiMla {
    static constexpr bool PERM = true;
    bf16 *QA, *KA, *VA; const u64* ssq; const u64* sskv; const f32x2* tab32; unsigned char* VTA; bool vt;
    __device__ __forceinline__ void operator()(const Acc& acc, const Unit& u, int wr, int wc, int fr, int fq) const {
        const int row0 = u.pm * BM + wr * 64 + fr, colw = u.pn * BM + wc * 32 + 8 * fq; const bool kv = (u.aux != 0);
        if (vt && kv && wc >= 2) {
#pragma unroll
            for (int ai = 0; ai < 2; ++ai) { float rs[4];
#pragma unroll
                for (int m = 0; m < 4; ++m) rs[m] = __builtin_amdgcn_rsqf(fx_load(sskv + row0 + ai * HALF + m * 16) * (1.0f / 128) + EPS) * VSC;
                unsigned char* bp = VTA + (size_t)(u.pm * 4 + ai * 2 + wr) * 4096 + 4 * fr + (32 * (wc - 2) + 8 * fq) * 64;
#pragma unroll
                for (int bj = 0; bj < 2; ++bj) { unsigned char* hp = bp + (size_t)(2 * u.pn + bj) * ((size_t)T * 64);
#pragma unroll
                    for (int n = 0; n < 2; ++n)
#pragma unroll
                        for (int i = 0; i < 4; ++i)
                            *(unsigned*)(hp + (4 * n + i) * 64) = pk4_fp8(acc[ai][bj][0][n][i] * rs[0], acc[ai][bj][1][n][i] * rs[1], acc[ai][bj][2][n][i] * rs[2], acc[ai][bj][3][n][i] * rs[3]); }
                asm volatile("" ::: "memory"); }
            return;
        }
#pragma unroll
        for (int ai = 0; ai < 2; ++ai)
#pragma unroll
            for (int m = 0; m < 4; ++m) { const int row = row0 + ai * HALF + m * 16;
                const float rs = kv ? __builtin_amdgcn_rsqf(fx_load(sskv + row) * (1.0f / 128) + EPS) : __builtin_amdgcn_rsqf(fx_load(ssq + row) * (1.0f / 256) + EPS);
#pragma unroll
                for (int bj = 0; bj < 2; ++bj) { const int n0 = colw + bj * HALF; f32x4 v0 = acc[ai][bj][m][0] * rs, v1 = acc[ai][bj][m][1] * rs;
                    if (kv) { const int h = n0 >> 7, d = n0 & 127;
                        if (ATT_F8 && d < 64) *(u32x2*)((unsigned char*)KA + (size_t)row * KAP + h * 96 + d) = pk8_fp8(v0, v1);
                        else { bf16* dst = (d < 64) ? KA + (size_t)row * KAP + h * 96 + d : VA + (size_t)row * VAP + h * 64 + (d - 64); *(u32x4*)dst = pack8(v0, v1); } }
                    else if (n0 < 576) { const int h = n0 / 96, d = n0 - h * 96;
                        if (d >= 64) { const f32x2* cs = tab32 + (size_t)(row & (SEQ - 1)) * 16 + ((d - 64) >> 1); const f32x2 c0 = cs[0], c1 = cs[1], c2 = cs[2], c3 = cs[3];
                            f32x4 r0, r1; r0[0] = v0[0] * c0.x - v0[1] * c0.y; r0[1] = v0[1] * c0.x + v0[0] * c0.y; r0[2] = v0[2] * c1.x - v0[3] * c1.y; r0[3] = v0[3] * c1.x + v0[2] * c1.y;
                            r1[0] = v1[0] * c2.x - v1[1] * c2.y; r1[1] = v1[1] * c2.x + v1[0] * c2.y; r1[2] = v1[2] * c3.x - v1[3] * c3.y; r1[3] = v1[3] * c3.x + v1[2] * c3.y; v0 = r0; v1 = r1; }
                        if (ATT_F8) *(u32x2*)((unsigned char*)QA + (size_t)row * QAP + n0) = pk8_fp8(v0 * C2A, v1 * C2A);
                        else *(u32x4*)(QA + (size_t)row * QAP + n0) = pack8(v0 * C2A, v1 * C2A); } }
                if (m & 1) asm volatile("" ::: "memory"); }
    }
};
struct EpiRes {
    static constexpr bool PERM = false;
    const float* base; const bf16* baseb; float* XF; bf16* XB; u64* ss; bool accum; unsigned char* XQ; float asc;
    __device__ __forceinline__ void operator()(const Acc& acc, const Unit& u, int wr, int wc, int fr, int fq) const {
        const int row0 = u.pm * BM + wr * 64 + fr, col0 = u.pn * BM + wc * 32 + 4 * fq;
#pragma unroll
        for (int ai = 0; ai < 2; ++ai)
#pragma unroll
            for (int m = 0; m < 4; ++m) { const int row = row0 + ai * HALF + m * 16; const size_t off = (size_t)row * D + col0; float s = 0.f;
#pragma unroll
                for (int bj = 0; bj < 2; ++bj)
#pragma unroll
                    for (int n = 0; n < 2; ++n) { const size_t o = off + bj * HALF + n * 16; f32x4 b;
                        if (baseb) { const u32x2 w = *(const u32x2*)(baseb + o); b = (f32x4){bflo(w.x), bfhi(w.x), bflo(w.y), bfhi(w.y)}; } else b = *(const f32x4*)(base + o);
                        const f32x4 v = P4_F8 ? b + acc[ai][bj][m][n] * asc : b + acc[ai][bj][m][n]; if (!X1_BF16) *(f32x4*)(XF + o) = v;
                        if (!MOE_F8 || X1_BF16) { u32x2 w; w.x = cvt_pk_bf16(v[0], v[1]); w.y = cvt_pk_bf16(v[2], v[3]); *(u32x2*)(XB + o) = w; }
                        s += sq4(v); }
                s = fq_sum(s); if (fq == 0 && accum) atomic_addf(ss + row, s);
                if (m == 3) asm volatile("" ::: "memory"); }
    }
};
struct EpiGate {
    static constexpr bool PERM = false;
    const bf16* X2; bf16* XB; const bf16* EB; const float* rs2; u64* ss; bool accum; unsigned char* XQ;
    __device__ __forceinline__ void operator()(const Acc& acc, const Unit& u, int wr, int wc, int fr, int fq) const {
        const int row0 = u.pm * BM + wr * 64 + fr, col0 = u.pn * BM + wc * 32 + 4 * fq;
#pragma unroll
        for (int ai = 0; ai < 2; ++ai)
#pragma unroll
            for (int m = 0; m < 4; ++m) { const int row = row0 + ai * HALF + m * 16; const size_t off = (size_t)row * D + col0; const float rs = rs2[row]; float s = 0.f;
#pragma unroll
                for (int bj = 0; bj < 2; ++bj)
#pragma unroll
                    for (int n = 0; n < 2; ++n) { const size_t o = off + bj * HALF + n * 16; const u32x2 x2 = *(const u32x2*)(X2 + o); const u32x2 e = *(const u32x2*)(EB + o); const f32x4 a = acc[ai][bj][m][n] * rs;
                        f32x4 v; v[0] = bflo(x2.x) + bflo(e.x) * sigmoidf_fast(a[0]); v[1] = bfhi(x2.x) + bfhi(e.x) * sigmoidf_fast(a[1]); v[2] = bflo(x2.y) + bflo(e.y) * sigmoidf_fast(a[2]); v[3] = bfhi(x2.y) + bfhi(e.y) * sigmoidf_fast(a[3]);
                        u32x2 w; w.x = cvt_pk_bf16(v[0], v[1]); w.y = cvt_pk_bf16(v[2], v[3]); *(u32x2*)(XB + o) = w; s += sq4(v);
                        if (P1_F8) *(unsigned*)(XQ + o) = pk4_fp8(v[0], v[1], v[2], v[3]); }
                s = fq_sum(s); if (fq == 0 && accum) atomic_addf(ss + row, s);
                if (m == 3) asm volatile("" ::: "memory"); }
    }
};
struct MoeTab { LAS int* P; LAS int* C; LAS int* R2E; };
__device__ __forceinline__ int ldsu(LAS int* p) { return __builtin_amdgcn_readfirstlane(*(volatile LAS int*)p); }
struct UpSched {
    MoeTab tb; const int* perm; const char* A; const char* B; int G, c;
    __device__ __forceinline__ bool next(int i, Unit& u) const {
        const int Lx = i * (G >> 3) + (c >> 3), rt = (Lx >> 3) * 8 + (c & 7), pn = Lx & 7; if (rt >= ldsu(tb.P + NE)) return false;
        const int e = ldsu(tb.R2E + rt);
        u.pm = rt; u.pn = pn; u.aux = e | ((rt - ldsu(tb.P + e)) << 8); u.A = A; u.B = B + ((size_t)e * 2048 + (size_t)pn * BM) * D * MOE_ES; return true; }
    __device__ __forceinline__ unsigned rowoff(const Unit& u, int r) const { const int e = u.aux & 255, slot = (u.aux >> 8) * BM + r; int tok = 0; if (slot < ldsu(tb.C + e)) tok = perm[e * ECAP + slot] >> 2; return (unsigned)tok * (unsigned)(D * MOE_ES); }
    __device__ __forceinline__ unsigned rowraw(const Unit& u, int r) const { const int e = u.aux & 255, slot = (u.aux >> 8) * BM + r; int pw = 0; if (slot < ldsu(tb.C + e)) pw = perm[e * ECAP + slot]; return (unsigned)pw; }
    __device__ __forceinline__ unsigned rawoff(unsigned raw) const { return (raw >> 2) * (unsigned)(D * MOE_ES); }
};
struct DownSched {
    MoeTab tb; const char* A; const char* B; int G, c;
    __device__ __forceinline__ bool next(int i, Unit& u) const {
        const int Lx = i * (G >> 3) + (c >> 3), rt = (Lx >> 2) * 8 + (c & 7), pn = Lx & 3; if (rt >= ldsu(tb.P + NE)) return false;
        const int e = ldsu(tb.R2E + rt);
        u.pm = rt; u.pn = pn; u.aux = e | ((rt - ldsu(tb.P + e)) << 8); u.A = A + (size_t)rt * BM * D * MOE_ES; u.B = B + ((size_t)e * D + (size_t)pn * BM) * D * MOE_ES; return true; }
    __device__ __forceinline__ unsigned rowoff(const Unit&, int r) const { return (unsigned)(r * D * MOE_ES); }
    __device__ __forceinline__ unsigned rowraw(const Unit&, int r) const { return (unsigned)(r * D * MOE_ES); }
    __device__ __forceinline__ unsigned rawoff(unsigned raw) const { return raw; }
};
struct EpiUp {
    static constexpr bool PERM = true;
    bf16* ACT; const float* rsl; const float* bup; MoeTab tb;
    __device__ __forceinline__ void operator()(const Acc& acc, const Unit& u, int wr, int wc, int fr, int fq) const {
        const int e = u.aux & 255, mt = u.aux >> 8, cnt = ldsu(tb.C + e); const int colh = wc * 32 + 8 * fq;
        const float* bp = bup + (size_t)e * 2048 + u.pn * BM + colh; const f32x4 bg0 = *(const f32x4*)bp, bg1 = *(const f32x4*)(bp + 4), bl0 = *(const f32x4*)(bp + HALF), bl1 = *(const f32x4*)(bp + HALF + 4);
#pragma unroll
        for (int ai = 0; ai < 2; ++ai)
#pragma unroll
            for (int m = 0; m < 4; ++m) { const int r = ai * HALF + wr * 64 + m * 16 + fr, slot = mt * BM + r; float rs = 1.0f; if (MOE_F8) rs = WSC_INV; else if (slot < cnt) rs = rsl[e * ECAP + slot];
                f32x4 g[2], li[2], o[2]; g[0] = acc[ai][0][m][0] * rs + bg0; g[1] = acc[ai][0][m][1] * rs + bg1; li[0] = acc[ai][1][m][0] * rs + bl0; li[1] = acc[ai][1][m][1] * rs + bl1;
#pragma unroll
                for (int n = 0; n < 2; ++n)
#pragma unroll
                    for (int i = 0; i < 4; ++i) { const float xg = fminf(g[n][i], 7.0f), xl = fminf(fmaxf(li[n][i], -7.0f), 7.0f); o[n][i] = xg * sigmoidf_fast(1.702f * xg) * (xl + 1.0f); }
                if (MOE_F8) { u32x2 w; w.x = pk4_fp8(o[0][0], o[0][1], o[0][2], o[0][3]); w.y = pk4_fp8(o[1][0], o[1][1], o[1][2], o[1][3]); *(u32x2*)((unsigned char*)ACT + (size_t)(u.pm * BM + r) * D + u.pn * HALF + colh) = w; }
                else *(u32x4*)(ACT + (size_t)(u.pm * BM + r) * D + u.pn * HALF + colh) = pack8(o[0], o[1]); }
    }
};
struct EpiDown {
    static constexpr bool PERM = true;
    bf16* Y; const float* bdn; const float* gsl; const int* perm; MoeTab tb;
    __device__ __forceinline__ void operator()(const Acc& acc, const Unit& u, int wr, int wc, int fr, int fq) const {
        const int e = u.aux & 255, mt = u.aux >> 8, cnt = ldsu(tb.C + e); const int col0 = u.pn * BM + wc * 32 + 8 * fq;
        const float* bp = bdn + (size_t)e * D + col0; f32x4 b[2][2];
#pragma unroll
        for (int bj = 0; bj < 2; ++bj) { b[bj][0] = *(const f32x4*)(bp + bj * HALF); b[bj][1] = *(const f32x4*)(bp + bj * HALF + 4); }
#pragma unroll
        for (int ai = 0; ai < 2; ++ai)
#pragma unroll
            for (int m = 0; m < 4; ++m) { const int r = ai * HALF + wr * 64 + m * 16 + fr, slot = mt * BM + r;
                if (slot < cnt) { const int pair = perm[e * ECAP + slot]; const float gt = gsl[e * ECAP + slot]; bf16* rowp = Y + (size_t)pair * D + col0;
#pragma unroll
                    for (int bj = 0; bj < 2; ++bj) { const float ws = MOE_F8 ? WSC_INV : 1.0f; *(u32x4*)(rowp + bj * HALF) = pack8((acc[ai][bj][m][0] * ws + b[bj][0]) * gt, (acc[ai][bj][m][1] * ws + b[bj][1]) * gt); } } }
    }
};
struct MlaSched {
    const char* Z; const char* Wq; const char* Wkv; int G, c;
    __device__ __forceinline__ bool next(int i, Unit& u) const {
        const int L = i * G + c; if (L >= 768) return false;
        const int kind = L / 384, rem = L - kind * 384, pm = rem / 3, pn = rem - pm * 3;
        u.pm = pm; u.pn = pn; u.aux = kind; u.A = Z + (size_t)pm * BM * ZQ * 2 + (kind ? 256 : 0); u.B = (kind ? Wkv : Wq) + (size_t)pn * BM * 256 * 2; return true; }
    __device__ __forceinline__ unsigned rowoff(const Unit&, int r) const { return (unsigned)(r * ZQ * 2); }
    __device__ __forceinline__ unsigned rowraw(const Unit&, int r) const { return (unsigned)(r * ZQ * 2); }
    __device__ __forceinline__ unsigned rawoff(unsigned raw) const { return raw; }
};
}

namespace at {
typedef LAS const char* lds_cptr;
__device__ __forceinline__ int crow(int r, int hi) { return (r & 3) + 8 * (r >> 2) + 4 * hi; }
__device__ __forceinline__ void glds16(const void* gsrc, unsigned lds_dst) { unsigned keep;
    asm volatile("s_mov_b32 %0, m0\n\ts_mov_b32 m0, %2\n\ts_nop 0\n\tglobal_load_lds_dwordx4 %1, off\n\ts_mov_b32 m0, %0" : "=&s"(keep) : "v"(gsrc), "s"(lds_dst) : "memory"); }
#define AT_WAIT_BAR(N) asm volatile("s_waitcnt vmcnt(" #N ") lgkmcnt(0)\n\ts_barrier" ::: "memory")
#define AT_MX3(a, b, c) __builtin_fmaxf(__builtin_fmaxf((a), (b)), (c))
__device__ __forceinline__ float rowmax(const f32x16& p0, const f32x16& p1) {
    float a = AT_MX3(p0[0], p0[1], p1[0]), b = AT_MX3(p0[2], p0[3], p1[1]); a = AT_MX3(a, p1[2], p1[3]);
#pragma unroll
    for (int r = 4; r < 16; r += 4) { a = AT_MX3(a, p0[r], p0[r + 1]); b = AT_MX3(b, p0[r + 2], p0[r + 3]); a = AT_MX3(a, p1[r], p1[r + 1]); b = AT_MX3(b, p1[r + 2], p1[r + 3]); }
    const float m = __builtin_fmaxf(a, b); auto rr = __builtin_amdgcn_permlane32_swap(__float_as_uint(m), __float_as_uint(m), false, false);
    return __builtin_fmaxf(__uint_as_float(rr[0]), __uint_as_float(rr[1]));
}
template <int DKC> __device__ __forceinline__ void qkt(f32x16& p0, f32x16& p1, lds_cptr Kslot, const bf16x8* qr, int r32, int hi) {
    lds_cptr kb = Kslot + hi * 1024 + r32 * 16; const f32x16 z = {};
#pragma unroll
    for (int d0 = 0; d0 < DKC; ++d0) {
        const bf16x8 b0 = *(const LAS bf16x8*)(kb + d0 * 2048), b1 = *(const LAS bf16x8*)(kb + d0 * 2048 + 512);
        if (d0 == 0) { p0 = __builtin_amdgcn_mfma_f32_32x32x16_bf16(b0, qr[0], z, 0, 0, 0); p1 = __builtin_amdgcn_mfma_f32_32x32x16_bf16(b1, qr[0], z, 0, 0, 0); }
        else { p0 = __builtin_amdgcn_mfma_f32_32x32x16_bf16(b0, qr[d0], p0, 0, 0, 0); p1 = __builtin_amdgcn_mfma_f32_32x32x16_bf16(b1, qr[d0], p1, 0, 0, 0); } }
}
__device__ __forceinline__ void pv(f32x16* o, int vb, bf16x8 pa0, bf16x8 pa1, bf16x8 pa2, bf16x8 pa3) {
#pragma unroll
    for (int d0 = 0; d0 < 2; ++d0) { s16x4 lo[4], hi[4];
#pragma unroll
        for (int ks = 0; ks < 4; ++ks) {
            asm volatile("ds_read_b64_tr_b16 %0,%1 offset:%c2" : "=&v"(lo[ks]) : "v"(vb), "i"(d0 * 4096 + ks * 1024) : "memory");
            asm volatile("ds_read_b64_tr_b16 %0,%1 offset:%c2" : "=&v"(hi[ks]) : "v"(vb), "i"(d0 * 4096 + ks * 1024 + 512) : "memory"); }
        asm volatile("s_waitcnt lgkmcnt(0)" ::: "memory"); __builtin_amdgcn_sched_barrier(0);
#define AT_PK(k) (bf16x8){lo[k][0], lo[k][1], lo[k][2], lo[k][3], hi[k][0], hi[k][1], hi[k][2], hi[k][3]}
        o[d0] = __builtin_amdgcn_mfma_f32_32x32x16_bf16(pa0, AT_PK(0), o[d0], 0, 0, 0);
        o[d0] = __builtin_amdgcn_mfma_f32_32x32x16_bf16(pa1, AT_PK(1), o[d0], 0, 0, 0);
        o[d0] = __builtin_amdgcn_mfma_f32_32x32x16_bf16(pa2, AT_PK(2), o[d0], 0, 0, 0);
        o[d0] = __builtin_amdgcn_mfma_f32_32x32x16_bf16(pa3, AT_PK(3), o[d0], 0, 0, 0);
#undef AT_PK
    }
}
template <int DKC> struct Lay { static constexpr int KSLOT = DKC * 2048, LDS_K = 0, LDS_V = 3 * KSLOT, LDS_WS = LDS_V + 3 * 8192, LDS_OST = LDS_WS + NWAVES * 256, BYTES = LDS_OST + NWAVES * 4096; };
template <int DKC, int MODE>
__device__ __forceinline__ void attn_unit(const bf16* Qu, int qp, const bf16* Kh, int kp, const bf16* Vh, int vp, bf16* Ou, int op, int t0, int t1, int qpos0, float sinkl2, char* shm) {
    typedef Lay<DKC> LY;
    const int tid = opaque_tid(), lane = tid & 63, r32 = lane & 31, hi = lane >> 5; const int wid = __builtin_amdgcn_readfirstlane(tid >> 6);
    const unsigned lds0 = (unsigned)(uintptr_t)shm;
    const lds_cptr shm3 = (lds_cptr)shm;
    LAS float* wsf = (LAS float*)(shm3 + LY::LDS_WS) + wid * 64;
    const bf16* Qw = Qu + (size_t)(wid * 32) * qp;
    const bool k2 = (wid + 8 < 2 * DKC);
    const bf16* ksrc = Kh + (size_t)lane * kp + wid * 8;
    const bf16* vsrc = Vh + (size_t)(16 * (wid & 3) + (lane >> 2)) * vp + (wid >> 2) * 32 + (lane & 3) * 8;
    const unsigned kdst = lds0 + LY::LDS_K + wid * 1024, vdst = lds0 + LY::LDS_V + wid * 1024;
#define AT_DMA(t, s) do { glds16(ksrc + (size_t)(t) * 64 * kp, (unsigned)__builtin_amdgcn_readfirstlane(kdst + (s) * LY::KSLOT)); \
        if (k2) glds16(ksrc + (size_t)(t) * 64 * kp + 64, (unsigned)__builtin_amdgcn_readfirstlane(kdst + (s) * LY::KSLOT + 8192)); \
        glds16(vsrc + (size_t)(t) * 64 * vp, (unsigned)__builtin_amdgcn_readfirstlane(vdst + (s) * 8192)); } while (0)
    const int vb0 = (int)(lds0 + LY::LDS_V) + ((lane >> 4) & 1) * 32 + (lane & 3) * 8 + (4 * hi + ((lane & 15) >> 2)) * 64;
    bf16x8 qr[DKC];
#pragma unroll
    for (int d0 = 0; d0 < DKC; ++d0) qr[d0] = *(const bf16x8*)(Qw + (size_t)r32 * qp + d0 * 16 + hi * 8);
    AT_DMA(t0, 0);
    float mrun = -INFINITY, l = 0.f; f32x16 o[2]; o[0] = f32x16{}; o[1] = f32x16{};
    const int qpos = qpos0 + wid * 32 + r32;
    int sl = 0;
    for (int t = t0; t < t1; ++t) {
        const bool more = (t + 1 < t1); const int sn = (sl == 2) ? 0 : sl + 1;
        if (more) { AT_DMA(t + 1, sn); if (k2) AT_WAIT_BAR(3); else AT_WAIT_BAR(2); } else AT_WAIT_BAR(0);
        f32x16 p0, p1;
        qkt<DKC>(p0, p1, shm3 + LY::LDS_K + sl * LY::KSLOT, qr, r32, hi);
        if (MODE == 1) { const int kb = t * 64 + 4 * hi;
#pragma unroll
            for (int r = 0; r < 16; ++r) { const int d0 = kb + (r & 3) + 8 * (r >> 2) - qpos, d1 = d0 + 32; if (d0 > 128 || d0 < -128) p0[r] = -INFINITY; if (d1 > 128 || d1 < -128) p1[r] = -INFINITY; } }
        const float rm = rowmax(p0, p1), mnew = __builtin_fmaxf(mrun, rm), mref = (mnew == -INFINITY) ? 0.f : mnew;
        const float alpha = __builtin_amdgcn_exp2f(mrun - mref); mrun = mnew;
        float s = 0.f;
#pragma unroll
        for (int r = 0; r < 16; ++r) { p0[r] = __builtin_amdgcn_exp2f(p0[r] - mref); p1[r] = __builtin_amdgcn_exp2f(p1[r] - mref); s += p0[r] + p1[r]; }
        l = l * alpha + s;
        if (__any(alpha != 1.0f)) { if (hi == 0) wsf[r32] = alpha; LDS_WAIT();
#pragma unroll
            for (int r = 0; r < 16; ++r) { const float f = wsf[crow(r, hi)]; o[0][r] *= f; o[1][r] *= f; } }
        u32x4 pw0, pw1, pw2, pw3;
        pw0 = (u32x4){cvt_pk_bf16(p0[0], p0[1]), cvt_pk_bf16(p0[2], p0[3]), cvt_pk_bf16(p0[4], p0[5]), cvt_pk_bf16(p0[6], p0[7])};
        pw1 = (u32x4){cvt_pk_bf16(p0[8], p0[9]), cvt_pk_bf16(p0[10], p0[11]), cvt_pk_bf16(p0[12], p0[13]), cvt_pk_bf16(p0[14], p0[15])};
        pw2 = (u32x4){cvt_pk_bf16(p1[0], p1[1]), cvt_pk_bf16(p1[2], p1[3]), cvt_pk_bf16(p1[4], p1[5]), cvt_pk_bf16(p1[6], p1[7])};
        pw3 = (u32x4){cvt_pk_bf16(p1[8], p1[9]), cvt_pk_bf16(p1[10], p1[11]), cvt_pk_bf16(p1[12], p1[13]), cvt_pk_bf16(p1[14], p1[15])};
        __builtin_amdgcn_sched_barrier(0);
        pv(o, vb0 + sl * 8192, __builtin_bit_cast(bf16x8, pw0), __builtin_bit_cast(bf16x8, pw1), __builtin_bit_cast(bf16x8, pw2), __builtin_bit_cast(bf16x8, pw3));
        sl = sn;
    }
    { auto rr = __builtin_amdgcn_permlane32_swap(__float_as_uint(l), __float_as_uint(l), false, false); l = __uint_as_float(rr[0]) + __uint_as_float(rr[1]); }
    if (MODE == 1) l += __builtin_amdgcn_exp2f(sinkl2 - mrun);
    if (hi == 0) wsf[32 + r32] = l; LDS_WAIT();
    float rli[16];
#pragma unroll
    for (int r = 0; r < 16; ++r) rli[r] = __builtin_amdgcn_rcpf(wsf[32 + crow(r, hi)]);
    bf16* Ow = Ou + (size_t)(wid * 32) * op;
    { LAS bf16* stg = (LAS bf16*)(shm3 + LY::LDS_OST) + wid * 2048;
#pragma unroll
        for (int r = 0; r < 16; ++r) { const int orow = crow(r, hi);
#pragma unroll
            for (int d0 = 0; d0 < 2; ++d0) stg[orow * 64 + d0 * 32 + r32] = (bf16)(cvt_pk_bf16(o[d0][r] * rli[r], 0.f) & 0xffffu); }
        LDS_WAIT();
#pragma unroll
        for (int i = 0; i < 4; ++i) { const int row = i * 8 + (lane >> 3), ch = lane & 7; const u32x4 v = *(const LAS u32x4*)(stg + row * 64 + ch * 8); *(u32x4*)(Ow + (size_t)row * op + ch * 8) = v; } }
    asm volatile("s_waitcnt lgkmcnt(0)\n\ts_barrier" ::: "memory");
#undef AT_DMA
}
typedef short v4i16_t __attribute__((ext_vector_type(4)));
__device__ __forceinline__ s16x4 vtr(lds_cptr p) { return __builtin_bit_cast(s16x4, __builtin_amdgcn_ds_read_tr16_b64_v4i16((LAS v4i16_t*)p)); }
template <int DKC> struct LayP { static constexpr int KSLOT = DKC * 2048, NS = 4, LDS_K = 0, LDS_V = NS * KSLOT, LDS_WS = LDS_V + NS * 8192, LDS_OST = LDS_WS + NWAVES * 256, BYTES = LDS_OST + NWAVES * 4096; };
#define AT_BAR_L() asm volatile("s_waitcnt lgkmcnt(0)\n\ts_barrier" ::: "memory")
template <int DKC, int MODE>
__device__ __forceinline__ void attn_unit_pp(const bf16* Qu, int qp, const bf16* Kh, int kp, const bf16* Vh, int vp, bf16* Ou, int op, int t0, int t1, int qpos0, float sinkl2, char* shm) {
    typedef LayP<DKC> LY; constexpr float THR = 8.0f;
    static_assert(LY::BYTES <= RING_BYTES, "attention LDS");
    const int tid = opaque_tid(), lane = tid & 63, r32 = lane & 31, hi = lane >> 5; const int wid = __builtin_amdgcn_readfirstlane(tid >> 6);
    const bool hb = (wid >= 4);
    const unsigned lds0 = (unsigned)(uintptr_t)shm;
    const lds_cptr shm3 = (lds_cptr)shm;
    LAS float* wsf = (LAS float*)(shm3 + LY::LDS_WS) + wid * 64;
    const bf16* Qw = Qu + (size_t)(wid * 32) * qp;
    const bool k2 = (wid + 8 < 2 * DKC);
    const bf16* ksrc = Kh + (size_t)lane * kp + wid * 8;
    const bf16* vsrc = Vh + (size_t)(16 * (wid & 3) + (lane >> 2)) * vp + (wid >> 2) * 32 + (lane & 3) * 8;
    const unsigned kdst = lds0 + LY::LDS_K + wid * 1024, vdst = lds0 + LY::LDS_V + wid * 1024;
#define AT_ISSUE(s) do { const int s_ = (s); if (s_ < t1) { const int sl_ = (s_ - t0) & 3; \
        glds16(ksrc + (size_t)s_ * 64 * kp, (unsigned)__builtin_amdgcn_readfirstlane(kdst + sl_ * LY::KSLOT)); \
        if (k2) glds16(ksrc + (size_t)s_ * 64 * kp + 64, (unsigned)__builtin_amdgcn_readfirstlane(kdst + sl_ * LY::KSLOT + 8192)); \
        glds16(vsrc + (size_t)s_ * 64 * vp, (unsigned)__builtin_amdgcn_readfirstlane(vdst + sl_ * 8192)); } } while (0)
#define AT_WAITBAR(young) do { if ((young) < t1) { if (k2) AT_WAIT_BAR(3); else AT_WAIT_BAR(2); } else AT_WAIT_BAR(0); } while (0)
    const int vb0 = (int)(lds0 + LY::LDS_V) + ((lane >> 4) & 1) * 32 + (lane & 3) * 8 + (4 * hi + ((lane & 15) >> 2)) * 64;
    bf16x8 qr[DKC];
#pragma unroll
    for (int d0 = 0; d0 < DKC; ++d0) qr[d0] = *(const bf16x8*)(Qw + (size_t)r32 * qp + d0 * 16 + hi * 8);
    AT_ISSUE(t0); AT_ISSUE(t0 + 1);
    float mhat = 0.f, l = 0.f; f32x16 o[2]; o[0] = f32x16{}; o[1] = f32x16{}; f32x16 negm = f32x16{};
    const int qpos = qpos0 + wid * 32 + r32;
    const int n = t1 - t0;
    AT_WAITBAR(t0 + 1);
    if (hb) { AT_ISSUE(t0 + 2); AT_BAR_L(); }
    u32x4 pw0 = {}, pw1 = {}, pw2 = {}, pw3 = {}; bf16x8 vf[8];
#pragma unroll
    for (int q = 0; q < 8; ++q) vf[q] = bf16x8{};
    for (int j = 0; j < n; ++j) {
        const int i = t0 + j, sl = j & 3;
        if (!hb) AT_ISSUE(i + 2);
        f32x16 p0, p1;
        { lds_cptr kb = shm3 + LY::LDS_K + sl * LY::KSLOT + hi * 1024 + r32 * 16; bf16x8 kf[2 * DKC];
#pragma unroll
          for (int d0 = 0; d0 < DKC; ++d0) { kf[2 * d0] = *(const LAS bf16x8*)(kb + d0 * 2048); kf[2 * d0 + 1] = *(const LAS bf16x8*)(kb + d0 * 2048 + 512); }
          __builtin_amdgcn_s_setprio(1);
          if (j > 0) {
#pragma unroll
              for (int ks = 0; ks < 4; ++ks) { const bf16x8 pa = __builtin_bit_cast(bf16x8, ks == 0 ? pw0 : ks == 1 ? pw1 : ks == 2 ? pw2 : pw3);
                  o[0] = __builtin_amdgcn_mfma_f32_32x32x16_bf16(pa, vf[ks], o[0], 0, 0, 0); o[1] = __builtin_amdgcn_mfma_f32_32x32x16_bf16(pa, vf[4 + ks], o[1], 0, 0, 0); } }
#pragma unroll
          for (int d0 = 0; d0 < DKC; ++d0) {
              if (d0 == 0) { p0 = __builtin_amdgcn_mfma_f32_32x32x16_bf16(kf[0], qr[0], negm, 0, 0, 0); p1 = __builtin_amdgcn_mfma_f32_32x32x16_bf16(kf[1], qr[0], negm, 0, 0, 0); }
              else { p0 = __builtin_amdgcn_mfma_f32_32x32x16_bf16(kf[2 * d0], qr[d0], p0, 0, 0, 0); p1 = __builtin_amdgcn_mfma_f32_32x32x16_bf16(kf[2 * d0 + 1], qr[d0], p1, 0, 0, 0); } }
          __builtin_amdgcn_s_setprio(0); }
        if (hb) AT_WAITBAR(i + 2); else AT_BAR_L();
        if (hb) AT_ISSUE(i + 3);
        { lds_cptr vp = shm3 + LY::LDS_V + sl * 8192 + ((lane >> 4) & 1) * 32 + (lane & 3) * 8 + (4 * hi + ((lane & 15) >> 2)) * 64;
#pragma unroll
          for (int q = 0; q < 8; ++q) { const s16x4 lo = vtr(vp + (q >> 2) * 4096 + (q & 3) * 1024), hh = vtr(vp + (q >> 2) * 4096 + (q & 3) * 1024 + 512); vf[q] = (bf16x8){lo[0], lo[1], lo[2], lo[3], hh[0], hh[1], hh[2], hh[3]}; } }
        if (MODE == 1) { const int kb = i * 64 + 4 * hi;
#pragma unroll
            for (int r = 0; r < 16; ++r) { const int d0 = kb + (r & 3) + 8 * (r >> 2) - qpos, d1 = d0 + 32; if (d0 > 128 || d0 < -128) p0[r] = -INFINITY; if (d1 > 128 || d1 < -128) p1[r] = -INFINITY; } }
        { const float rm = rowmax(p0, p1);
          if (j == 0 || __any(rm > THR)) {
              float dl = (j == 0) ? rm : __builtin_fmaxf(rm, 0.f); if (dl == -INFINITY) dl = 0.f;
              mhat += dl;
#pragma unroll
              for (int r = 0; r < 16; ++r) { p0[r] -= dl; p1[r] -= dl; }
#pragma unroll
              for (int r = 0; r < 16; ++r) negm[r] = -mhat;
              if (j > 0) { const float f = __builtin_amdgcn_exp2f(-dl); l *= f; if (hi == 0) wsf[r32] = f; LDS_WAIT();
#pragma unroll
                  for (int r = 0; r < 16; ++r) { const float g = wsf[crow(r, hi)]; o[0][r] *= g; o[1][r] *= g; } } } }
        { float sa = 0.f, sb = 0.f;
#pragma unroll
          for (int r = 0; r < 16; ++r) { p0[r] = __builtin_amdgcn_exp2f(p0[r]); p1[r] = __builtin_amdgcn_exp2f(p1[r]); sa += p0[r]; sb += p1[r]; }
          l += sa + sb; }
        pw0 = (u32x4){cvt_pk_bf16(p0[0], p0[1]), cvt_pk_bf16(p0[2], p0[3]), cvt_pk_bf16(p0[4], p0[5]), cvt_pk_bf16(p0[6], p0[7])};
        pw1 = (u32x4){cvt_pk_bf16(p0[8], p0[9]), cvt_pk_bf16(p0[10], p0[11]), cvt_pk_bf16(p0[12], p0[13]), cvt_pk_bf16(p0[14], p0[15])};
        pw2 = (u32x4){cvt_pk_bf16(p1[0], p1[1]), cvt_pk_bf16(p1[2], p1[3]), cvt_pk_bf16(p1[4], p1[5]), cvt_pk_bf16(p1[6], p1[7])};
        pw3 = (u32x4){cvt_pk_bf16(p1[8], p1[9]), cvt_pk_bf16(p1[10], p1[11]), cvt_pk_bf16(p1[12], p1[13]), cvt_pk_bf16(p1[14], p1[15])};
        if (!hb) AT_WAITBAR(i + 2); else AT_BAR_L();
    }
    __builtin_amdgcn_s_setprio(1);
#pragma unroll
    for (int ks = 0; ks < 4; ++ks) { const bf16x8 pa = __builtin_bit_cast(bf16x8, ks == 0 ? pw0 : ks == 1 ? pw1 : ks == 2 ? pw2 : pw3);
        o[0] = __builtin_amdgcn_mfma_f32_32x32x16_bf16(pa, vf[ks], o[0], 0, 0, 0); o[1] = __builtin_amdgcn_mfma_f32_32x32x16_bf16(pa, vf[4 + ks], o[1], 0, 0, 0); }
    __builtin_amdgcn_s_setprio(0);
    if (!hb) AT_BAR_L();
    { auto rr = __builtin_amdgcn_permlane32_swap(__float_as_uint(l), __float_as_uint(l), false, false); l = __uint_as_float(rr[0]) + __uint_as_float(rr[1]); }
    if (MODE == 1) l += __builtin_amdgcn_exp2f(sinkl2 - mhat);
    if (hi == 0) wsf[32 + r32] = l; LDS_WAIT();
    float rli[16];
#pragma unroll
    for (int r = 0; r < 16; ++r) rli[r] = __builtin_amdgcn_rcpf(wsf[32 + crow(r, hi)]);
    bf16* Ow = Ou + (size_t)(wid * 32) * op;
    { LAS bf16* stg = (LAS bf16*)(shm3 + LY::LDS_OST) + wid * 2048;
#pragma unroll
        for (int r = 0; r < 16; ++r) { const int orow = crow(r, hi);
#pragma unroll
            for (int d0 = 0; d0 < 2; ++d0) stg[orow * 64 + d0 * 32 + r32] = (bf16)(cvt_pk_bf16(o[d0][r] * rli[r], 0.f) & 0xffffu); }
        LDS_WAIT();
#pragma unroll
        for (int i = 0; i < 4; ++i) { const int row = i * 8 + (lane >> 3), ch = lane & 7; const u32x4 v = *(const LAS u32x4*)(stg + row * 64 + ch * 8); *(u32x4*)(Ow + (size_t)row * op + ch * 8) = v; } }
    AT_BAR_L();
#undef AT_ISSUE
#undef AT_WAITBAR
}
typedef int i32x8 __attribute__((ext_vector_type(8)));
template <int DKS> struct LayP8 { static constexpr int KSLOT = DKS * 4096, NS = 4, LDS_K = 0, LDS_V = NS * KSLOT, LDS_WS = LDS_V + NS * 8192, LDS_OST = LDS_WS + NWAVES * 256, BYTES = LDS_OST + NWAVES * 4096; };
template <int DKS, int NCH, int MODE>
__device__ __forceinline__ void attn_unit_f8(const unsigned char* Qu, int qp, const unsigned char* Kh, int kp, const bf16* Vh, int vp, bf16* Ou, int op, int t0, int t1, int qpos0, float sinkl2, char* shm) {
    typedef LayP8<DKS> LY; constexpr float THR = 8.0f;
    static_assert(LY::BYTES <= RING_BYTES, "attention LDS");
    const int tid = opaque_tid(), lane = tid & 63, r32 = lane & 31, hi = lane >> 5; const int wid = __builtin_amdgcn_readfirstlane(tid >> 6);
    const bool hb = (wid >= 4);
    const unsigned lds0 = (unsigned)(uintptr_t)shm;
    const lds_cptr shm3 = (lds_cptr)shm;
    LAS float* wsf = (LAS float*)(shm3 + LY::LDS_WS) + wid * 64;
    const unsigned char* Qw = Qu + (size_t)(wid * 32) * qp;
    const bool kw = (wid < NCH);
    const unsigned char* ksrc = Kh + (size_t)lane * kp + wid * 16;
    const bf16* vsrc = Vh + (size_t)(16 * (wid & 3) + (lane >> 2)) * vp + (wid >> 2) * 32 + (lane & 3) * 8;
    const unsigned kdst = lds0 + LY::LDS_K + wid * 1024, vdst = lds0 + LY::LDS_V + wid * 1024;
#define AT_ISSUE(s) do { const int s_ = (s); if (s_ < t1) { const int sl_ = (s_ - t0) & 3; \
        if (kw) glds16(ksrc + (size_t)s_ * 64 * kp, (unsigned)__builtin_amdgcn_readfirstlane(kdst + sl_ * LY::KSLOT)); \
        glds16(vsrc + (size_t)s_ * 64 * vp, (unsigned)__builtin_amdgcn_readfirstlane(vdst + sl_ * 8192)); } } while (0)
#define AT_WAITBAR(young) do { if ((young) < t1) { if (kw) AT_WAIT_BAR(2); else AT_WAIT_BAR(1); } else AT_WAIT_BAR(0); } while (0)
    if (NCH < DKS * 4) {
        for (int b = tid * 16; b < 4 * (DKS * 4 - NCH) * 1024; b += NWAVES * 64 * 16) { const int sl_ = b / ((DKS * 4 - NCH) * 1024), rem = b % ((DKS * 4 - NCH) * 1024);
            *(LAS u32x4*)(shm3 + LY::LDS_K + sl_ * LY::KSLOT + NCH * 1024 + rem) = (u32x4){0u, 0u, 0u, 0u}; } }
    i32x8 qf[DKS];
#pragma unroll
    for (int s = 0; s < DKS; ++s) { const unsigned char* qa = Qw + (size_t)r32 * qp + s * 64 + hi * 32;
        if (s * 64 + hi * 32 < NCH * 16) { const u32x4 lo = *(const u32x4*)qa, hh = *(const u32x4*)(qa + 16); qf[s] = __builtin_bit_cast(i32x8, __builtin_shufflevector(lo, hh, 0, 1, 2, 3, 4, 5, 6, 7)); }
        else qf[s] = i32x8{}; }
    AT_ISSUE(t0); AT_ISSUE(t0 + 1);
    float mhat = 0.f, l = 0.f; f32x16 o[2]; o[0] = f32x16{}; o[1] = f32x16{}; f32x16 negm = f32x16{};
    const unsigned one_sc = 0x7f7f7f7fu;
    const int qpos = qpos0 + wid * 32 + r32;
    const int n = t1 - t0;
    AT_WAITBAR(t0 + 1);
    if (hb) { AT_ISSUE(t0 + 2); AT_BAR_L(); }
    u32x4 pw0 = {}, pw1 = {}, pw2 = {}, pw3 = {}; bf16x8 vf[8];
#pragma unroll
    for (int q = 0; q < 8; ++q) vf[q] = bf16x8{};
    for (int j = 0; j < n; ++j) {
        const int i = t0 + j, sl = j & 3;
        if (!hb) AT_ISSUE(i + 2);
        f32x16 p0 = negm, p1 = negm;
        { lds_cptr kb = shm3 + LY::LDS_K + sl * LY::KSLOT + hi * 2048 + r32 * 16; i32x8 kf[DKS][2];
#pragma unroll
          for (int s = 0; s < DKS; ++s)
#pragma unroll
              for (int h2 = 0; h2 < 2; ++h2) { const u32x4 lo = *(const LAS u32x4*)(kb + s * 4096 + h2 * 512), hh = *(const LAS u32x4*)(kb + s * 4096 + 1024 + h2 * 512);
                  kf[s][h2] = __builtin_bit_cast(i32x8, __builtin_shufflevector(lo, hh, 0, 1, 2, 3, 4, 5, 6, 7)); }
          __builtin_amdgcn_s_setprio(1);
          if (j > 0) {
#pragma unroll
              for (int ks = 0; ks < 4; ++ks) { const bf16x8 pa = __builtin_bit_cast(bf16x8, ks == 0 ? pw0 : ks == 1 ? pw1 : ks == 2 ? pw2 : pw3);
                  o[0] = __builtin_amdgcn_mfma_f32_32x32x16_bf16(pa, vf[ks], o[0], 0, 0, 0); o[1] = __builtin_amdgcn_mfma_f32_32x32x16_bf16(pa, vf[4 + ks], o[1], 0, 0, 0); } }
#pragma unroll
          for (int s = 0; s < DKS; ++s) {
              asm volatile("v_mfma_scale_f32_32x32x64_f8f6f4 %0, %1, %2, %0, %3, %3 op_sel_hi:[0,0,0]" : "+v"(p0) : "v"(kf[s][0]), "v"(qf[s]), "v"(one_sc));
              asm volatile("v_mfma_scale_f32_32x32x64_f8f6f4 %0, %1, %2, %0, %3, %3 op_sel_hi:[0,0,0]" : "+v"(p1) : "v"(kf[s][1]), "v"(qf[s]), "v"(one_sc)); }
          __builtin_amdgcn_s_setprio(0); }
        if (hb) AT_WAITBAR(i + 2); else AT_BAR_L();
        if (hb) AT_ISSUE(i + 3);
        asm volatile("s_nop 15\n\ts_nop 3" : "+v"(p0), "+v"(p1));
        { lds_cptr vp_ = shm3 + LY::LDS_V + sl * 8192 + ((lane >> 4) & 1) * 32 + (lane & 3) * 8 + (4 * hi + ((lane & 15) >> 2)) * 64;
#pragma unroll
          for (int q = 0; q < 8; ++q) { const s16x4 lo = vtr(vp_ + (q >> 2) * 4096 + (q & 3) * 1024), hh = vtr(vp_ + (q >> 2) * 4096 + (q & 3) * 1024 + 512); vf[q] = (bf16x8){lo[0], lo[1], lo[2], lo[3], hh[0], hh[1], hh[2], hh[3]}; } }
        if (MODE == 1) { const int kb2 = i * 64 + 4 * hi;
#pragma unroll
            for (int r = 0; r < 16; ++r) { const int d0 = kb2 + (r & 3) + 8 * (r >> 2) - qpos, d1 = d0 + 32; if (d0 > 128 || d0 < -128) p0[r] = -INFINITY; if (d1 > 128 || d1 < -128) p1[r] = -INFINITY; } }
        { const float rm = rowmax(p0, p1);
          if (j == 0 || __any(rm > THR)) {
              float dl = (j == 0) ? rm : __builtin_fmaxf(rm, 0.f); if (dl == -INFINITY) dl = 0.f;
              mhat += dl;
#pragma unroll
              for (int r = 0; r < 16; ++r) { p0[r] -= dl; p1[r] -= dl; }
#pragma unroll
              for (int r = 0; r < 16; ++r) negm[r] = -mhat;
              if (j > 0) { const float f = __builtin_amdgcn_exp2f(-dl); l *= f; if (hi == 0) wsf[r32] = f; LDS_WAIT();
#pragma unroll
                  for (int r = 0; r < 16; ++r) { const float g = wsf[crow(r, hi)]; o[0][r] *= g; o[1][r] *= g; } } } }
        { float sa = 0.f, sb = 0.f;
#pragma unroll
          for (int r = 0; r < 16; ++r) { p0[r] = __builtin_amdgcn_exp2f(p0[r]); p1[r] = __builtin_amdgcn_exp2f(p1[r]); sa += p0[r]; sb += p1[r]; }
          l += sa + sb; }
        pw0 = (u32x4){cvt_pk_bf16(p0[0], p0[1]), cvt_pk_bf16(p0[2], p0[3]), cvt_pk_bf16(p0[4], p0[5]), cvt_pk_bf16(p0[6], p0[7])};
        pw1 = (u32x4){cvt_pk_bf16(p0[8], p0[9]), cvt_pk_bf16(p0[10], p0[11]), cvt_pk_bf16(p0[12], p0[13]), cvt_pk_bf16(p0[14], p0[15])};
        pw2 = (u32x4){cvt_pk_bf16(p1[0], p1[1]), cvt_pk_bf16(p1[2], p1[3]), cvt_pk_bf16(p1[4], p1[5]), cvt_pk_bf16(p1[6], p1[7])};
        pw3 = (u32x4){cvt_pk_bf16(p1[8], p1[9]), cvt_pk_bf16(p1[10], p1[11]), cvt_pk_bf16(p1[12], p1[13]), cvt_pk_bf16(p1[14], p1[15])};
        if (!hb) AT_WAITBAR(i + 2); else AT_BAR_L();
    }
    __builtin_amdgcn_s_setprio(1);
#pragma unroll
    for (int ks = 0; ks < 4; ++ks) { const bf16x8 pa = __builtin_bit_cast(bf16x8, ks == 0 ? pw0 : ks == 1 ? pw1 : ks == 2 ? pw2 : pw3);
        o[0] = __builtin_amdgcn_mfma_f32_32x32x16_bf16(pa, vf[ks], o[0], 0, 0, 0); o[1] = __builtin_amdgcn_mfma_f32_32x32x16_bf16(pa, vf[4 + ks], o[1], 0, 0, 0); }
    __builtin_amdgcn_s_setprio(0);
    if (!hb) AT_BAR_L();
    { auto rr = __builtin_amdgcn_permlane32_swap(__float_as_uint(l), __float_as_uint(l), false, false); l = __uint_as_float(rr[0]) + __uint_as_float(rr[1]); }
    if (MODE == 1) l += __builtin_amdgcn_exp2f(sinkl2 - mhat);
    if (hi == 0) wsf[32 + r32] = l; LDS_WAIT();
    float rli[16];
#pragma unroll
    for (int r = 0; r < 16; ++r) rli[r] = __builtin_amdgcn_rcpf(wsf[32 + crow(r, hi)]);
    bf16* Ow = Ou + (size_t)(wid * 32) * op;
    { LAS bf16* stg = (LAS bf16*)(shm3 + LY::LDS_OST) + wid * 2048;
#pragma unroll
        for (int r = 0; r < 16; ++r) { const int orow = crow(r, hi);
#pragma unroll
            for (int d0 = 0; d0 < 2; ++d0) stg[orow * 64 + d0 * 32 + r32] = (bf16)(cvt_pk_bf16(o[d0][r] * rli[r], 0.f) & 0xffffu); }
        LDS_WAIT();
#pragma unroll
        for (int i2 = 0; i2 < 4; ++i2) { const int row = i2 * 8 + (lane >> 3), ch = lane & 7; const u32x4 v = *(const LAS u32x4*)(stg + row * 64 + ch * 8); *(u32x4*)(Ow + (size_t)row * op + ch * 8) = v; } }
    AT_BAR_L();
#undef AT_ISSUE
#undef AT_WAITBAR
}
struct AUnit { const unsigned char* Qu; const unsigned char* Kh; const bf16* Vh; bf16* Ou; int t0, t1, qpos0; float sinkl2; };
template <int DKS, int NCH, int MODE, class Dec>
__device__ __forceinline__ void attn_loop_f8(int idx0, int idx_end, int G, const Dec& dec, int qp, int kp, int vp, int op, char* shm) {
    if (idx0 >= idx_end) return;
    typedef LayP8<DKS> LY; constexpr float THR = 8.0f;
    static_assert(LY::BYTES <= RING_BYTES, "attention LDS");
    const int tid = opaque_tid(), lane = tid & 63, r32 = lane & 31, hi = lane >> 5; const int wid = __builtin_amdgcn_readfirstlane(tid >> 6);
    const bool hb = (wid >= 4);
    const unsigned lds0 = (unsigned)(uintptr_t)shm;
    const lds_cptr shm3 = (lds_cptr)shm;
    LAS float* wsf = (LAS float*)(shm3 + LY::LDS_WS) + wid * 64;
    const bool kw = (wid < NCH);
    AUnit u = dec(idx0); int t0 = u.t0, t1 = u.t1;
    const size_t koff = (size_t)lane * kp + wid * 16, voff = (size_t)(16 * (wid & 3) + (lane >> 2)) * vp + (wid >> 2) * 32 + (lane & 3) * 8;
    const unsigned char* ksrc = u.Kh + koff; const bf16* vsrc = u.Vh + voff;
    const unsigned kdst = lds0 + LY::LDS_K + wid * 1024, vdst = lds0 + LY::LDS_V + wid * 1024;
#define AT_ISSUE(s) do { const int s_ = (s); if (s_ < t1) { const int sl_ = (s_ - t0) & 3; \
        if (kw) glds16(ksrc + (size_t)s_ * 64 * kp, (unsigned)__builtin_amdgcn_readfirstlane(kdst + sl_ * LY::KSLOT)); \
        glds16(vsrc + (size_t)s_ * 64 * vp, (unsigned)__builtin_amdgcn_readfirstlane(vdst + sl_ * 8192)); } } while (0)
#define AT_WAITBAR(young) do { if ((young) < t1) { if (kw) AT_WAIT_BAR(2); else AT_WAIT_BAR(1); } else AT_WAIT_BAR(0); } while (0)
    if (NCH < DKS * 4) {
        for (int b = tid * 16; b < 4 * (DKS * 4 - NCH) * 1024; b += NWAVES * 64 * 16) { const int sl_ = b / ((DKS * 4 - NCH) * 1024), rem = b % ((DKS * 4 - NCH) * 1024);
            *(LAS u32x4*)(shm3 + LY::LDS_K + sl_ * LY::KSLOT + NCH * 1024 + rem) = (u32x4){0u, 0u, 0u, 0u}; } }
    i32x8 qf[DKS], qfn[DKS];
#define AT_QLOAD(dst, Qu_) do { const unsigned char* Qw_ = (Qu_) + (size_t)(wid * 32) * qp; _Pragma("unroll") for (int s = 0; s < DKS; ++s) { const unsigned char* qa = Qw_ + (size_t)r32 * qp + s * 64 + hi * 32; \
        if (s * 64 + hi * 32 < NCH * 16) { const u32x4 lo = *(const u32x4*)qa, hh = *(const u32x4*)(qa + 16); (dst)[s] = __builtin_bit_cast(i32x8, __builtin_shufflevector(lo, hh, 0, 1, 2, 3, 4, 5, 6, 7)); } \
        else (dst)[s] = i32x8{}; } } while (0)
    AT_QLOAD(qf, u.Qu);
    AT_ISSUE(t0); AT_ISSUE(t0 + 1);
    const unsigned one_sc = 0x7f7f7f7fu;
    for (int idx = idx0;;) {
    const int idxn = idx + G; const bool has_next = idxn < idx_end; AUnit un = u;
    float mhat = 0.f, l = 0.f; f32x16 o[2]; o[0] = f32x16{}; o[1] = f32x16{}; f32x16 negm = f32x16{};
    const int qpos = u.qpos0 + wid * 32 + r32;
    const int n = t1 - t0;
    AT_WAITBAR(t0 + 1);
    if (hb) { AT_ISSUE(t0 + 2); AT_BAR_L(); }
    u32x4 pw0 = {}, pw1 = {}, pw2 = {}, pw3 = {}; bf16x8 vf[8];
#pragma unroll
    for (int q = 0; q < 8; ++q) vf[q] = bf16x8{};
    for (int j = 0; j < n; ++j) {
        const int i = t0 + j, sl = j & 3;
        if (!hb) AT_ISSUE(i + 2);
        f32x16 p0 = negm, p1 = negm;
        { lds_cptr kb = shm3 + LY::LDS_K + sl * LY::KSLOT + hi * 2048 + r32 * 16; i32x8 kf[DKS][2];
#pragma unroll
          for (int s = 0; s < DKS; ++s)
#pragma unroll
              for (int h2 = 0; h2 < 2; ++h2) { const u32x4 lo = *(const LAS u32x4*)(kb + s * 4096 + h2 * 512), hh = *(const LAS u32x4*)(kb + s * 4096 + 1024 + h2 * 512);
                  kf[s][h2] = __builtin_bit_cast(i32x8, __builtin_shufflevector(lo, hh, 0, 1, 2, 3, 4, 5, 6, 7)); }
          __builtin_amdgcn_s_setprio(1);
          if (j > 0) {
#pragma unroll
              for (int ks = 0; ks < 4; ++ks) { const bf16x8 pa = __builtin_bit_cast(bf16x8, ks == 0 ? pw0 : ks == 1 ? pw1 : ks == 2 ? pw2 : pw3);
                  o[0] = __builtin_amdgcn_mfma_f32_32x32x16_bf16(pa, vf[ks], o[0], 0, 0, 0); o[1] = __builtin_amdgcn_mfma_f32_32x32x16_bf16(pa, vf[4 + ks], o[1], 0, 0, 0); } }
#pragma unroll
          for (int s = 0; s < DKS; ++s) {
              asm volatile("v_mfma_scale_f32_32x32x64_f8f6f4 %0, %1, %2, %0, %3, %3 op_sel_hi:[0,0,0]" : "+v"(p0) : "v"(kf[s][0]), "v"(qf[s]), "v"(one_sc));
              asm volatile("v_mfma_scale_f32_32x32x64_f8f6f4 %0, %1, %2, %0, %3, %3 op_sel_hi:[0,0,0]" : "+v"(p1) : "v"(kf[s][1]), "v"(qf[s]), "v"(one_sc)); }
          __builtin_amdgcn_s_setprio(0); }
        if (hb) AT_WAITBAR(i + 2); else AT_BAR_L();
        if (hb) AT_ISSUE(i + 3);
        asm volatile("s_nop 15\n\ts_nop 3" : "+v"(p0), "+v"(p1));
        { lds_cptr vp_ = shm3 + LY::LDS_V + sl * 8192 + ((lane >> 4) & 1) * 32 + (lane & 3) * 8 + (4 * hi + ((lane & 15) >> 2)) * 64;
#pragma unroll
          for (int q = 0; q < 8; ++q) { const s16x4 lo = vtr(vp_ + (q >> 2) * 4096 + (q & 3) * 1024), hh = vtr(vp_ + (q >> 2) * 4096 + (q & 3) * 1024 + 512); vf[q] = (bf16x8){lo[0], lo[1], lo[2], lo[3], hh[0], hh[1], hh[2], hh[3]}; } }
        if (MODE == 1) { const int kb2 = i * 64 + 4 * hi;
#pragma unroll
            for (int r = 0; r < 16; ++r) { const int d0 = kb2 + (r & 3) + 8 * (r >> 2) - qpos, d1 = d0 + 32; if (d0 > 128 || d0 < -128) p0[r] = -INFINITY; if (d1 > 128 || d1 < -128) p1[r] = -INFINITY; } }
        { const float rm = rowmax(p0, p1);
          if (j == 0 || __any(rm > THR)) {
              float dl = (j == 0) ? rm : __builtin_fmaxf(rm, 0.f); if (dl == -INFINITY) dl = 0.f;
              mhat += dl;
#pragma unroll
              for (int r = 0; r < 16; ++r) { p0[r] -= dl; p1[r] -= dl; }
#pragma unroll
              for (int r = 0; r < 16; ++r) negm[r] = -mhat;
              if (j > 0) { const float f = __builtin_amdgcn_exp2f(-dl); l *= f; if (hi == 0) wsf[r32] = f; LDS_WAIT();
#pragma unroll
                  for (int r = 0; r < 16; ++r) { const float g = wsf[crow(r, hi)]; o[0][r] *= g; o[1][r] *= g; } } } }
        { float sa = 0.f, sb = 0.f;
#pragma unroll
          for (int r = 0; r < 16; ++r) { p0[r] = __builtin_amdgcn_exp2f(p0[r]); p1[r] = __builtin_amdgcn_exp2f(p1[r]); sa += p0[r]; sb += p1[r]; }
          l += sa + sb; }
        pw0 = (u32x4){cvt_pk_bf16(p0[0], p0[1]), cvt_pk_bf16(p0[2], p0[3]), cvt_pk_bf16(p0[4], p0[5]), cvt_pk_bf16(p0[6], p0[7])};
        pw1 = (u32x4){cvt_pk_bf16(p0[8], p0[9]), cvt_pk_bf16(p0[10], p0[11]), cvt_pk_bf16(p0[12], p0[13]), cvt_pk_bf16(p0[14], p0[15])};
        pw2 = (u32x4){cvt_pk_bf16(p1[0], p1[1]), cvt_pk_bf16(p1[2], p1[3]), cvt_pk_bf16(p1[4], p1[5]), cvt_pk_bf16(p1[6], p1[7])};
        pw3 = (u32x4){cvt_pk_bf16(p1[8], p1[9]), cvt_pk_bf16(p1[10], p1[11]), cvt_pk_bf16(p1[12], p1[13]), cvt_pk_bf16(p1[14], p1[15])};
        if (!hb) AT_WAITBAR(i + 2); else AT_BAR_L();
    }
#define AT_SEAM() do { if (has_next) { un = dec(idxn); ksrc = un.Kh + koff; vsrc = un.Vh + voff; t0 = un.t0; t1 = un.t1; AT_ISSUE(t0); AT_ISSUE(t0 + 1); AT_QLOAD(qfn, un.Qu); } } while (0)
    if (hb) AT_SEAM();
    __builtin_amdgcn_s_setprio(1);
#pragma unroll
    for (int ks = 0; ks < 4; ++ks) { const bf16x8 pa = __builtin_bit_cast(bf16x8, ks == 0 ? pw0 : ks == 1 ? pw1 : ks == 2 ? pw2 : pw3);
        o[0] = __builtin_amdgcn_mfma_f32_32x32x16_bf16(pa, vf[ks], o[0], 0, 0, 0); o[1] = __builtin_amdgcn_mfma_f32_32x32x16_bf16(pa, vf[4 + ks], o[1], 0, 0, 0); }
    __builtin_amdgcn_s_setprio(0);
    if (!hb) { AT_BAR_L(); AT_SEAM(); }
    { auto rr = __builtin_amdgcn_permlane32_swap(__float_as_uint(l), __float_as_uint(l), false, false); l = __uint_as_float(rr[0]) + __uint_as_float(rr[1]); }
    if (MODE == 1) l += __builtin_amdgcn_exp2f(u.sinkl2 - mhat);
    if (hi == 0) wsf[32 + r32] = l; LDS_WAIT();
    float rli[16];
#pragma unroll
    for (int r = 0; r < 16; ++r) rli[r] = __builtin_amdgcn_rcpf(wsf[32 + crow(r, hi)]);
    bf16* Ow = u.Ou + (size_t)(wid * 32) * op;
    { LAS bf16* stg = (LAS bf16*)(shm3 + LY::LDS_OST) + wid * 2048;
#pragma unroll
        for (int r = 0; r < 16; ++r) { const int orow = crow(r, hi);
#pragma unroll
            for (int d0 = 0; d0 < 2; ++d0) stg[orow * 64 + d0 * 32 + r32] = (bf16)(cvt_pk_bf16(o[d0][r] * rli[r], 0.f) & 0xffffu); }
        LDS_WAIT();
#pragma unroll
        for (int i2 = 0; i2 < 4; ++i2) { const int row = i2 * 8 + (lane >> 3), ch = lane & 7; const u32x4 v = *(const LAS u32x4*)(stg + row * 64 + ch * 8); *(u32x4*)(Ow + (size_t)row * op + ch * 8) = v; } }
    AT_BAR_L();
    if (!has_next) break;
    u = un; idx = idxn;
#pragma unroll
    for (int s = 0; s < DKS; ++s) qf[s] = qfn[s];
    }
#undef AT_SEAM
#undef AT_QLOAD
#undef AT_ISSUE
#undef AT_WAITBAR
}
template <int DKS, int NCH, int MODE, class Dec, bool PRIO = true, bool PP = true>
__device__ __forceinline__ void attn_loop_f8v(int idx0, int idx_end, int G, const Dec& dec, int qp, int kp, int op, char* shm) {
    if (idx0 >= idx_end) return;
    typedef LayP8<DKS> LY; constexpr float SH = 3.0f, SMAX = 448.0f;
    static_assert(LY::BYTES <= RING_BYTES, "attention LDS");
    const int tid = opaque_tid(), lane = tid & 63, r32 = lane & 31, hi = lane >> 5; const int wid = __builtin_amdgcn_readfirstlane(tid >> 6);
    const bool hb = PP && (wid >= 4);
    const unsigned lds0 = (unsigned)(uintptr_t)shm;
    const lds_cptr shm3 = (lds_cptr)shm;
    LAS float* wsf = (LAS float*)(shm3 + LY::LDS_WS) + wid * 64;
    const bool kw = (wid < NCH), vw = (wid >= 4);
    AUnit u = dec(idx0); int t0 = u.t0, t1 = u.t1;
    const int krow = 16 * (lane & 3) + 8 * ((lane >> 2) & 1) + ((lane & 31) >> 3) + 4 * (lane >> 5);
    const int vrow = ((wid & 3) * 64 + lane) >> 2;
    const size_t koff = (size_t)krow * kp + wid * 16, voff = (size_t)vrow * 64 + (((lane & 3) ^ ((vrow >> 2) & 3)) << 4);
    const unsigned char* ksrc = u.Kh + koff; const unsigned char* vsrc = (const unsigned char*)u.Vh + voff;
    const unsigned kdst = lds0 + LY::LDS_K + wid * 1024, vdst = lds0 + LY::LDS_V + (wid & 3) * 1024;
#define AT_ISSUE(s) do { const int s_ = (s); if (s_ < t1) { const int sl_ = (s_ - t0) & 3; \
        if (kw) glds16(ksrc + (size_t)s_ * 64 * kp, (unsigned)__builtin_amdgcn_readfirstlane(kdst + sl_ * LY::KSLOT)); \
        if (vw) glds16(vsrc + (size_t)s_ * 4096, (unsigned)__builtin_amdgcn_readfirstlane(vdst + sl_ * 8192)); } } while (0)
#define AT_WAITBAR(young) do { if ((young) < t1) { if (kw && vw) AT_WAIT_BAR(2); else if (kw || vw) AT_WAIT_BAR(1); else AT_WAIT_BAR(0); } else AT_WAIT_BAR(0); } while (0)
    if (NCH < DKS * 4) {
        for (int b = tid * 16; b < 4 * (DKS * 4 - NCH) * 1024; b += NWAVES * 64 * 16) { const int sl_ = b / ((DKS * 4 - NCH) * 1024), rem = b % ((DKS * 4 - NCH) * 1024);
            *(LAS u32x4*)(shm3 + LY::LDS_K + sl_ * LY::KSLOT + NCH * 1024 + rem) = (u32x4){0u, 0u, 0u, 0u}; } }
    i32x8 qf[DKS], qfn[DKS];
#define AT_QLOAD(dst, Qu_) do { const unsigned char* Qw_ = (Qu_) + (size_t)(wid * 32) * qp; _Pragma("unroll") for (int s = 0; s < DKS; ++s) { const unsigned char* qa = Qw_ + (size_t)r32 * qp + s * 64 + hi * 32; \
        if (s * 64 + hi * 32 < NCH * 16) { const u32x4 lo = *(const u32x4*)qa, hh = *(const u32x4*)(qa + 16); (dst)[s] = __builtin_bit_cast(i32x8, __builtin_shufflevector(lo, hh, 0, 1, 2, 3, 4, 5, 6, 7)); } \
        else (dst)[s] = i32x8{}; } } while (0)
    AT_QLOAD(qf, u.Qu);
    AT_ISSUE(t0); AT_ISSUE(t0 + 1);
    const unsigned one_sc = 0x7f7f7f7fu;
    for (int idx = idx0;;) {
    const int idxn = idx + G; const bool has_next = idxn < idx_end; AUnit un = u;
    float mhat = 0.f, l = 0.f; f32x16 o[2]; o[0] = f32x16{}; o[1] = f32x16{}; f32x16 negm;
#pragma unroll
    for (int r = 0; r < 16; ++r) negm[r] = SH;
    const int qpos = u.qpos0 + wid * 32 + r32;
    const int n = t1 - t0;
    AT_WAITBAR(t0 + 1);
    if (hb) { AT_ISSUE(t0 + 2); AT_BAR_L(); }
    i32x8 pw = i32x8{}, vf[2]; vf[0] = i32x8{}; vf[1] = i32x8{};
    for (int j = 0; j < n; ++j) {
        const int i = t0 + j, sl = j & 3;
        if (!hb) AT_ISSUE(i + 2);
        f32x16 p0 = negm, p1 = negm;
        { lds_cptr kb = shm3 + LY::LDS_K + sl * LY::KSLOT + hi * 2048 + r32 * 16; i32x8 kf[DKS][2];
#pragma unroll
          for (int s = 0; s < DKS; ++s)
#pragma unroll
              for (int h2 = 0; h2 < 2; ++h2) { const u32x4 lo = *(const LAS u32x4*)(kb + s * 4096 + h2 * 512), hh = *(const LAS u32x4*)(kb + s * 4096 + 1024 + h2 * 512);
                  kf[s][h2] = __builtin_bit_cast(i32x8, __builtin_shufflevector(lo, hh, 0, 1, 2, 3, 4, 5, 6, 7)); }
          if (PRIO) __builtin_amdgcn_s_setprio(1);
          if (PP && j > 0) {
              asm volatile("v_mfma_scale_f32_32x32x64_f8f6f4 %0, %1, %2, %0, %3, %3 op_sel_hi:[0,0,0]" : "+v"(o[0]) : "v"(pw), "v"(vf[0]), "v"(one_sc));
              asm volatile("v_mfma_scale_f32_32x32x64_f8f6f4 %0, %1, %2, %0, %3, %3 op_sel_hi:[0,0,0]" : "+v"(o[1]) : "v"(pw), "v"(vf[1]), "v"(one_sc)); }
#pragma unroll
          for (int s = 0; s < DKS; ++s) {
              asm volatile("v_mfma_scale_f32_32x32x64_f8f6f4 %0, %1, %2, %0, %3, %3 op_sel_hi:[0,0,0]" : "+v"(p0) : "v"(kf[s][0]), "v"(qf[s]), "v"(one_sc));
              asm volatile("v_mfma_scale_f32_32x32x64_f8f6f4 %0, %1, %2, %0, %3, %3 op_sel_hi:[0,0,0]" : "+v"(p1) : "v"(kf[s][1]), "v"(qf[s]), "v"(one_sc)); }
          if (!PP && j > 0) {
              asm volatile("v_mfma_scale_f32_32x32x64_f8f6f4 %0, %1, %2, %0, %3, %3 op_sel_hi:[0,0,0]" : "+v"(o[0]) : "v"(pw), "v"(vf[0]), "v"(one_sc));
              asm volatile("v_mfma_scale_f32_32x32x64_f8f6f4 %0, %1, %2, %0, %3, %3 op_sel_hi:[0,0,0]" : "+v"(o[1]) : "v"(pw), "v"(vf[1]), "v"(one_sc)); }
          if (PRIO) __builtin_amdgcn_s_setprio(0); }
        if (hb) AT_WAITBAR(i + 2); else if (PP) AT_BAR_L();
        if (hb) AT_ISSUE(i + 3);
        asm volatile("s_nop 15\n\ts_nop 3" : "+v"(p0), "+v"(p1));
        { lds_cptr vp_ = shm3 + LY::LDS_V + sl * 8192 + r32 * 64; const int sw = (r32 >> 2) & 3, c0 = ((2 * hi) ^ sw) << 4, c1 = ((2 * hi + 1) ^ sw) << 4;
#pragma unroll
          for (int d0 = 0; d0 < 2; ++d0) { const u32x4 lo = *(const LAS u32x4*)(vp_ + d0 * 2048 + c0), hh = *(const LAS u32x4*)(vp_ + d0 * 2048 + c1);
              vf[d0] = __builtin_bit_cast(i32x8, __builtin_shufflevector(lo, hh, 0, 1, 2, 3, 4, 5, 6, 7)); } }
        if (MODE == 1) { const int kb2 = i * 64 + 8 * hi - qpos;
#pragma unroll
            for (int r = 0; r < 16; ++r) { const int d0 = kb2 + 16 * (r & 3) + (r >> 2), d1 = d0 + 4; if (d0 > 128 || d0 < -128) p0[r] = -INFINITY; if (d1 > 128 || d1 < -128) p1[r] = -INFINITY; } }
        f32x16 e0, e1; float S;
#define AT_EXPSUM() do { _Pragma("unroll") for (int r = 0; r < 16; ++r) { e0[r] = __builtin_amdgcn_exp2f(p0[r]); e1[r] = __builtin_amdgcn_exp2f(p1[r]); } \
          f32x2 s2 = (f32x2){e0[0], e0[1]} + (f32x2){e1[0], e1[1]}; _Pragma("unroll") for (int k = 1; k < 8; ++k) { s2 += (f32x2){e0[2 * k], e0[2 * k + 1]}; s2 += (f32x2){e1[2 * k], e1[2 * k + 1]}; } S = s2.x + s2.y; } while (0)
        AT_EXPSUM();
        if (j == 0 || __any(!(S <= SMAX))) {
            const float rm = rowmax(p0, p1);
            float dl = (j == 0) ? rm - SH : __builtin_fmaxf(rm - SH, 0.f); if (dl == -INFINITY) dl = 0.f;
            mhat += dl;
#pragma unroll
            for (int r = 0; r < 16; ++r) { p0[r] -= dl; p1[r] -= dl; }
#pragma unroll
            for (int r = 0; r < 16; ++r) negm[r] = SH - mhat;
            if (j > 0) { const float f = __builtin_amdgcn_exp2f(-dl); l *= f; if (hi == 0) wsf[r32] = f; LDS_WAIT();
                if (!PP) asm volatile("s_nop 15\n\ts_nop 15\n\ts_nop 15\n\ts_nop 15\n\ts_nop 15\n\ts_nop 15\n\ts_nop 15\n\ts_nop 15\n\ts_nop 15\n\ts_nop 15" : "+v"(o[0]), "+v"(o[1]));
#pragma unroll
                for (int r = 0; r < 16; ++r) { const float g = wsf[crow(r, hi)]; o[0][r] *= g; o[1][r] *= g; } }
            AT_EXPSUM();
        }
#undef AT_EXPSUM
        l += S;
#pragma unroll
        for (int k = 0; k < 4; ++k) { pw[k] = (int)pk4_fp8(e0[4 * k], e0[4 * k + 1], e0[4 * k + 2], e0[4 * k + 3]); pw[4 + k] = (int)pk4_fp8(e1[4 * k], e1[4 * k + 1], e1[4 * k + 2], e1[4 * k + 3]); }
        if (!hb) AT_WAITBAR(i + 2); else AT_BAR_L();
    }
#define AT_SEAM() do { if (has_next) { un = dec(idxn); ksrc = un.Kh + koff; vsrc = (const unsigned char*)un.Vh + voff; t0 = un.t0; t1 = un.t1; AT_ISSUE(t0); AT_ISSUE(t0 + 1); AT_QLOAD(qfn, un.Qu); } } while (0)
    if (hb) AT_SEAM();
    if (PRIO) __builtin_amdgcn_s_setprio(1);
    asm volatile("v_mfma_scale_f32_32x32x64_f8f6f4 %0, %1, %2, %0, %3, %3 op_sel_hi:[0,0,0]" : "+v"(o[0]) : "v"(pw), "v"(vf[0]), "v"(one_sc));
    asm volatile("v_mfma_scale_f32_32x32x64_f8f6f4 %0, %1, %2, %0, %3, %3 op_sel_hi:[0,0,0]" : "+v"(o[1]) : "v"(pw), "v"(vf[1]), "v"(one_sc));
    if (PRIO) __builtin_amdgcn_s_setprio(0);
    asm volatile("s_nop 15\n\ts_nop 3" : "+v"(o[0]), "+v"(o[1]));
    if (!hb) { AT_BAR_L(); AT_SEAM(); }
    { auto rr = __builtin_amdgcn_permlane32_swap(__float_as_uint(l), __float_as_uint(l), false, false); l = __uint_as_float(rr[0]) + __uint_as_float(rr[1]); }
    if (MODE == 1) l += __builtin_amdgcn_exp2f(u.sinkl2 - mhat + SH);
    if (hi == 0) wsf[32 + r32] = l; LDS_WAIT();
    float rli[16];
#pragma unroll
    for (int r = 0; r < 16; ++r) rli[r] = __builtin_amdgcn_rcpf(wsf[32 + crow(r, hi)]) * ((P4_F8 ? MSC : 1.0f) / VSC);
    if (P4_F8) {
        unsigned char* Ow = (unsigned char*)u.Ou + (size_t)(wid * 32) * op; LAS unsigned char* stg = (LAS unsigned char*)(shm3 + LY::LDS_OST) + wid * 4096;
#pragma unroll
        for (int r = 0; r < 16; ++r) { const int orow = crow(r, hi); const int w = __builtin_amdgcn_cvt_pk_fp8_f32(o[0][r] * rli[r], o[1][r] * rli[r], 0, false);
            stg[orow * 64 + r32] = (unsigned char)(w & 0xff); stg[orow * 64 + 32 + r32] = (unsigned char)((w >> 8) & 0xff); }
        LDS_WAIT();
#pragma unroll
        for (int i2 = 0; i2 < 2; ++i2) { const int row = i2 * 16 + (lane >> 2), ch = lane & 3; const u32x4 v = *(const LAS u32x4*)(stg + row * 64 + ch * 16); *(u32x4*)(Ow + (size_t)row * op + ch * 16) = v; }
    } else {
    bf16* Ow = u.Ou + (size_t)(wid * 32) * op;
    { LAS bf16* stg = (LAS bf16*)(shm3 + LY::LDS_OST) + wid * 2048;
#pragma unroll
        for (int r = 0; r < 16; ++r) { const int orow = crow(r, hi);
#pragma unroll
            for (int d0 = 0; d0 < 2; ++d0) stg[orow * 64 + d0 * 32 + r32] = (bf16)(cvt_pk_bf16(o[d0][r] * rli[r], 0.f) & 0xffffu); }
        LDS_WAIT();
#pragma unroll
        for (int i2 = 0; i2 < 4; ++i2) { const int row = i2 * 8 + (lane >> 3), ch = lane & 7; const u32x4 v = *(const LAS u32x4*)(stg + row * 64 + ch * 8); *(u32x4*)(Ow + (size_t)row * op + ch * 8) = v; } }
    }
    AT_BAR_L();
    if (!has_next) break;
    u = un; idx = idxn;
#pragma unroll
    for (int s = 0; s < DKS; ++s) qf[s] = qfn[s];
    }
#undef AT_SEAM
#undef AT_QLOAD
#undef AT_ISSUE
#undef AT_WAITBAR
}
struct DecA { const unsigned char* Q; const unsigned char* K; const bf16* V; bf16* MIX; bool vt;
    __device__ __forceinline__ AUnit operator()(int idx) const { const int b = idx / 96, h = (idx >> 4) % 6, qb = idx & 15; const size_t rb = (size_t)b * SEQ, rq = rb + qb * 256;
        AUnit u; u.Qu = Q + rq * QAP + h * 96; u.Kh = K + rb * KAP + h * 96; u.Vh = vt ? (const bf16*)((const unsigned char*)V + ((size_t)h * (T / 64) + b * 64) * 4096) : V + rb * VAP + h * 64; u.Ou = (P4_F8 && vt) ? (bf16*)((unsigned char*)MIX + rq * D + h * 64) : MIX + rq * D + h * 64; u.t0 = 0; u.t1 = SEQ / 64; u.qpos0 = qb * 256; u.sinkl2 = 0.f; return u; } };
struct DecB { const unsigned char* Q; const unsigned char* K; const bf16* V; bf16* MIX; bool vt;
    __device__ __forceinline__ AUnit operator()(int idx) const { const int b = idx / 96, h = (idx >> 4) % 6, qb = idx & 15, hk = h / 3; const size_t rb = (size_t)b * SEQ, rq = rb + qb * 256;
        AUnit u; u.Qu = Q + rq * QBP + h * 64; u.Kh = K + rb * KBP + hk * 64; u.Vh = vt ? (const bf16*)((const unsigned char*)V + ((size_t)hk * (T / 64) + b * 64) * 4096) : V + rb * VBP + hk * 64; u.Ou = (P4_F8 && vt) ? (bf16*)((unsigned char*)MIX + rq * D + 384 + h * 64) : MIX + rq * D + 384 + h * 64; u.t0 = 0; u.t1 = SEQ / 64; u.qpos0 = qb * 256; u.sinkl2 = 0.f; return u; } };
struct DecC { const unsigned char* Q; const unsigned char* K; const bf16* V; bf16* MIX; const float* sink; bool vt;
    __device__ __forceinline__ AUnit operator()(int idx) const { const int b = idx / 64, h = (idx >> 4) & 3, qb = idx & 15, hk = h >> 1; const size_t rb = (size_t)b * SEQ, rq = rb + qb * 256;
        AUnit u; u.Qu = Q + rq * QCP + h * 64; u.Kh = K + rb * KCP + hk * 64; u.Vh = vt ? (const bf16*)((const unsigned char*)V + ((size_t)hk * (T / 64) + b * 64) * 4096) : V + rb * VCP + hk * 64; u.Ou = (P4_F8 && vt) ? (bf16*)((unsigned char*)MIX + rq * D + 768 + h * 64) : MIX + rq * D + 768 + h * 64;
        u.t0 = (qb * 4 - 2 < 0) ? 0 : qb * 4 - 2; u.t1 = (qb * 4 + 6 > SEQ / 64) ? SEQ / 64 : qb * 4 + 6; u.qpos0 = qb * 256; u.sinkl2 = sink[h] * LOG2E; return u; } };
}

struct Args {
    const float *x, *p, *attn_norm, *w_in, *mla_q_norm, *mla_wq_up, *mla_kv_norm, *mla_wkv_up, *gqa_q_norm, *gqa_k_norm, *swa_sink, *w_out, *moe_norm, *router_w, *router_b,
        *w_up, *b_up, *w_down, *b_down, *ple_norm, *w_ple, *w_ple_gate, *final_norm;
    float* out; unsigned char* ws;
};
struct Ctx { LAS unsigned char* lds; int tid, lane, wave, vcu, G, gw, NGW; };

template <bool F8OUT = false, class RMap>
__device__ __forceinline__ void tr_item(const float* W, int N, bf16* WT, int ldo, int kofs, const float* gain, RMap rmap, LAS float* scr, int kb, int nb, int lane, float wsc = 1.0f) {
    const int k0 = 64 * kb, n0 = 32 * nb;
    float wv[32]; const float* src = W + (size_t)(k0 + (lane >> 5)) * N + n0 + (lane & 31);
#pragma unroll
    for (int i = 0; i < 32; ++i) wv[i] = src[(size_t)(2 * i) * N];
#pragma unroll
    for (int i = 0; i < 32; ++i) scr[(2 * i + (lane >> 5)) * 33 + (lane & 31)] = wv[i];
    LDS_WAIT(); asm volatile("" ::: "memory");
    const int c = lane & 7; float gs[8];
#pragma unroll
    for (int q = 0; q < 8; ++q) gs[q] = (gain ? gain[k0 + 8 * c + q] : 1.0f) * wsc;
#pragma unroll
    for (int j = 0; j < 4; ++j) { const int n = (lane >> 3) + 8 * j; const LAS float* s = scr + (8 * c) * 33 + n;
        if (F8OUT) { u32x2 o; o.x = pk4_fp8(s[0 * 33] * gs[0], s[1 * 33] * gs[1], s[2 * 33] * gs[2], s[3 * 33] * gs[3]); o.y = pk4_fp8(s[4 * 33] * gs[4], s[5 * 33] * gs[5], s[6 * 33] * gs[6], s[7 * 33] * gs[7]);
            *(u32x2*)((unsigned char*)WT + (size_t)rmap(n0 + n) * ldo + kofs + k0 + 8 * c) = o; }
        else { u32x4 o; o.x = cvt_pk_bf16(s[0 * 33] * gs[0], s[1 * 33] * gs[1]); o.y = cvt_pk_bf16(s[2 * 33] * gs[2], s[3 * 33] * gs[3]); o.z = cvt_pk_bf16(s[4 * 33] * gs[4], s[5 * 33] * gs[5]); o.w = cvt_pk_bf16(s[6 * 33] * gs[6], s[7 * 33] * gs[7]);
            *(u32x4*)(WT + (size_t)rmap(n0 + n) * ldo + kofs + k0 + 8 * c) = o; } }
    LDS_WAIT(); asm volatile("" ::: "memory");
}
struct MapId { __device__ __forceinline__ int operator()(int n) const { return n; } };
struct MapIn { __device__ __forceinline__ int operator()(int n) const {
    if (n < 384) return n;
    if (n < 416) { const int j = n - 384; return 384 + ((j < 16) ? 2 * j : 2 * (j - 16) + 1); }
    int hs, d; bool pairs; if (n < ZC) { const int q = n - ZB; hs = q >> 6; d = q & 63; pairs = (hs < 8); } else { const int q = n - ZC; hs = 10 + (q >> 6); d = q & 63; pairs = false; }
    const int bj = d >> 5, dd = d & 31, p = pairs ? ((dd & 15) * 2 + (dd >> 4)) : dd;
    return 256 * (2 + (hs >> 2)) + 128 * bj + 32 * (hs & 3) + p; } };
struct MapQ { __device__ __forceinline__ int operator()(int n) const { const int h = n / 96, d = n - h * 96; if (d < 64) return n; const int j = d - 64; return h * 96 + 64 + ((j < 16) ? 2 * j : 2 * (j - 16) + 1); } };
struct MapUp { __device__ __forceinline__ int operator()(int n) const { if (n < 1024) return (n >> 7) * 256 + (n & 127); const int m = n - 1024; return (m >> 7) * 256 + 128 + (m & 127); } };

__device__ __forceinline__ void zero16(bf16* base, size_t n16, const Ctx& C) {
    const u32x4 z = {0u, 0u, 0u, 0u};
    for (size_t i = (size_t)C.gw * 64 + C.lane; i < n16; i += (size_t)C.NGW * 64) ((u32x4*)base)[i] = z;
}

__device__ __forceinline__ void prologue(const Args& a, const Ctx& C) {
    unsigned char* ws = launder(a.ws);
    LAS float* scr = (LAS float*)(C.lds + C.wave * 16384);
    constexpr int I_UP = 16 * 64, I_DN = 16 * 32, I_IN = 16 * 49, I_OUT = 16 * 32, I_G = 16 * 32, I_Q = 4 * 18, I_KV = 2 * 24, I_PLE = 4 * 32;
    constexpr int N_UP = NL * NE * I_UP, N_DN = NL * NE * I_DN, N_IN = NL * I_IN, N_OUT = NL * I_OUT, N_G = NL * I_G, N_Q = NL * I_Q, N_KV = NL * I_KV, N_PLE = NL * I_PLE;
    constexpr int NITEMS = N_UP + N_DN + N_IN + N_OUT + N_G + N_Q + N_KV + N_PLE;
    for (int it = C.gw; it < NITEMS; it += C.NGW) {
        int r = it;
        if (r < N_UP) { const int le = r / I_UP, q = r - le * I_UP, l = le / NE; tr_item<MOE_F8 != 0>(a.w_up + (size_t)le * D * 2048, 2048, (bf16*)(ws + WS_WUP + (size_t)le * 2048 * D * MOE_ES), D, 0, a.moe_norm + l * D, MapUp(), scr, q / 64, q % 64, C.lane, WSC); continue; } r -= N_UP;
        if (r < N_DN) { const int le = r / I_DN, q = r - le * I_DN; tr_item<MOE_F8 != 0>(a.w_down + (size_t)le * D * D, D, (bf16*)(ws + WS_WDN + (size_t)le * D * D * MOE_ES), D, 0, nullptr, MapId(), scr, q / 32, q % 32, C.lane, WSC); continue; } r -= N_DN;
        if (r < N_IN) { const int l = r / I_IN, q = r - l * I_IN; tr_item<P1_F8 != 0>(a.w_in + (size_t)l * D * 1568, 1568, (bf16*)(ws + WS_WIN + (size_t)l * ZP * D * (P1_F8 ? 1 : 2)), D, 0, a.attn_norm + l * D, MapIn(), scr, q / 49, q % 49, C.lane, P1_F8 ? WSC : 1.0f); continue; } r -= N_IN;
        if (r < N_OUT) { const int l = r / I_OUT, q = r - l * I_OUT; tr_item<P4_F8 != 0>(a.w_out + (size_t)l * D * D, D, (bf16*)(ws + WS_WOUT + (size_t)l * D * D * (P4_F8 ? 1 : 2)), D, 0, nullptr, MapId(), scr, q / 32, q % 32, C.lane, P4_F8 ? WSC : 1.0f); continue; } r -= N_OUT;
        if (r < N_G) { const int l = r / I_G, q = r - l * I_G; tr_item(a.w_ple_gate + (size_t)l * D * D, D, (bf16*)(ws + WS_WG) + (size_t)l * D * D, D, 0, a.ple_norm + l * D, MapId(), scr, q / 32, q % 32, C.lane); continue; } r -= N_G;
        if (r < N_Q) { const int l = r / I_Q, q = r - l * I_Q; tr_item(a.mla_wq_up + (size_t)l * 256 * 576, 576, (bf16*)(ws + WS_WQ) + (size_t)l * 768 * 256, 256, 0, a.mla_q_norm + l * 256, MapQ(), scr, q / 18, q % 18, C.lane); continue; } r -= N_Q;
        if (r < N_KV) { const int l = r / I_KV, q = r - l * I_KV; tr_item(a.mla_wkv_up + (size_t)l * 128 * 768, 768, (bf16*)(ws + WS_WKV) + (size_t)l * 768 * 256, 256, 128, a.mla_kv_norm + l * 128, MapId(), scr, q / 24, q % 24, C.lane); continue; } r -= N_KV;
        { const int l = r / I_PLE, q = r - l * I_PLE; tr_item(a.w_ple + (size_t)l * 256 * D, D, (bf16*)(ws + WS_WPLE) + (size_t)l * D * 256, 256, 0, nullptr, MapId(), scr, q / 32, q % 32, C.lane); }
    }
    for (int l = 0; l < NL; ++l) {
        constexpr int E1 = P1_F8 ? 1 : 2;
        zero16((bf16*)(ws + WS_WIN + ((size_t)l * ZP + 416) * D * E1), (size_t)96 * D * E1 / 16, C);
        zero16((bf16*)(ws + WS_WIN + ((size_t)l * ZP + 1600) * D * E1), (size_t)64 * D * E1 / 16, C);
        zero16((bf16*)(ws + WS_WIN + ((size_t)l * ZP + 1728) * D * E1), (size_t)64 * D * E1 / 16, C);
        zero16((bf16*)(ws + WS_WQ) + ((size_t)l * 768 + 576) * 256, (size_t)192 * 256 / 8, C);
    }
    for (int i = C.gw * 64 + C.lane; i < NL * 768 * 16; i += C.NGW * 64) { const int row = i >> 4, pc = i & 15; *(u32x4*)((bf16*)(ws + WS_WKV) + (size_t)row * 256 + pc * 8) = (u32x4){0u, 0u, 0u, 0u}; }
    for (int m = 4 * C.gw; m < T; m += 4 * C.NGW) {
        f32x4 v[4][4]; float s[4];
#pragma unroll
        for (int q = 0; q < 4; ++q) { const f32x4* xr = (const f32x4*)(a.x + (size_t)(m + q) * D) + C.lane;
#pragma unroll
            for (int j = 0; j < 4; ++j) v[q][j] = xr[64 * j]; }
#pragma unroll
        for (int q = 0; q < 4; ++q) { s[q] = 0.f;
#pragma unroll
            for (int j = 0; j < 4; ++j) s[q] += (v[q][j][0] * v[q][j][0] + v[q][j][1] * v[q][j][1]) + (v[q][j][2] * v[q][j][2] + v[q][j][3] * v[q][j][3]);
            s[q] = wave_sum(s[q]);
            u32x2* o8 = (u32x2*)((bf16*)(ws + WS_XB) + (size_t)(m + q) * D) + C.lane;
#pragma unroll
            for (int j = 0; j < 4; ++j) { u32x2 w; w.x = cvt_pk_bf16(v[q][j][0], v[q][j][1]); w.y = cvt_pk_bf16(v[q][j][2], v[q][j][3]); o8[64 * j] = w; }
            if (P1_F8) { unsigned* q8 = (unsigned*)(ws + WS_XQ + (size_t)(m + q) * D) + C.lane;
#pragma unroll
                for (int j = 0; j < 4; ++j) q8[64 * j] = pk4_fp8(v[q][j][0], v[q][j][1], v[q][j][2], v[q][j][3]); }
            if (C.lane == 0) __hip_atomic_store((u64*)(ws + WS_SS0) + m + q, fx_enc(s[q]), RLX_AGENT); }
    }
    for (size_t i0 = (size_t)C.gw * 256; i0 < (size_t)NL * T * 256 / 8; i0 += (size_t)C.NGW * 256) {
        f32x4 v[4][2];
#pragma unroll
        for (int q = 0; q < 4; ++q) { const size_t i = i0 + q * 64 + C.lane; v[q][0] = ((const f32x4*)a.p)[2 * i]; v[q][1] = ((const f32x4*)a.p)[2 * i + 1]; }
#pragma unroll
        for (int q = 0; q < 4; ++q) { const size_t i = i0 + q * 64 + C.lane;
            u32x4 w; w.x = cvt_pk_bf16(v[q][0][0], v[q][0][1]); w.y = cvt_pk_bf16(v[q][0][2], v[q][0][3]); w.z = cvt_pk_bf16(v[q][1][0], v[q][1][1]); w.w = cvt_pk_bf16(v[q][1][2], v[q][1][3]); ((u32x4*)(ws + WS_PB))[i] = w; }
    }
    for (int i = C.gw * 64 + C.lane; i < SEQ * 48; i += C.NGW * 64) {
        int pos, j; double ex; f32x2* dst;
        if (i < SEQ * 16) { pos = i >> 4; j = i & 15; ex = (double)j / 16.0; dst = (f32x2*)(ws + WS_TAB32) + i; }
        else { const int q = i - SEQ * 16; pos = q >> 5; j = q & 31; ex = (double)j / 32.0; dst = (f32x2*)(ws + WS_TAB64) + q; }
        const float inv = (float)exp2(-13.287712379549449 * ex);
        const float angf = (float)pos * inv;
        const double rev = (double)angf * 0.15915494309189535; const float fr = (float)(rev - floor(rev));
        *dst = (f32x2){__builtin_amdgcn_cosf(fr), __builtin_amdgcn_sinf(fr)};
    }
    for (int i = C.gw * 64 + C.lane; i < NL * D * NE; i += C.NGW * 64) { const int l = i / (D * NE), k = (i / NE) % D; ((float*)(ws + WS_WR))[i] = a.router_w[i] * a.moe_norm[l * D + k]; }
    for (int i = C.gw * 64 + C.lane; i < NL * NE * D; i += C.NGW * 64) { const int l = i / (NE * D), e = (i / D) % NE, k = i % D; const float w = a.router_w[((size_t)l * D + k) * NE + e] * a.moe_norm[l * D + k];
        const unsigned h = cvt_pk_bf16(w, 0.f) & 0xffffu; const float lo = w - __uint_as_float(h << 16);
        ((bf16*)(ws + WS_WR + 512 * 1024))[i] = (bf16)h; ((bf16*)(ws + WS_WR + 768 * 1024))[i] = (bf16)(cvt_pk_bf16(lo, 0.f) & 0xffffu); }
    for (int i = C.gw * 64 + C.lane; i < NL * NE * 2048; i += C.NGW * 64) { const int le = i / 2048, n = i % 2048; ((float*)(ws + WS_BUP))[(size_t)le * 2048 + MapUp()(n)] = a.b_up[i]; }
}
namespace gp { }
__device__ __forceinline__ float sq4g(f32x4 v) { return (v[0] * v[0] + v[1] * v[1]) + (v[2] * v[2] + v[3] * v[3]); }

__device__ __forceinline__ void rope_phase(const Args& a, const Ctx& C, int l) {
    unsigned char* ws = launder(a.ws);
    const bf16* Z = (const bf16*)(ws + WS_Z); const f32x2* tab32 = (const f32x2*)(ws + WS_TAB32); const f32x2* tab64 = (const f32x2*)(ws + WS_TAB64);
    bf16 *KA = (bf16*)(ws + WS_KA), *QB = (bf16*)(ws + WS_QB), *KB = (bf16*)(ws + WS_KB), *VB = (bf16*)(ws + WS_VB), *QC = (bf16*)(ws + WS_QC), *KC = (bf16*)(ws + WS_KC), *VC = (bf16*)(ws + WS_VC);
    const int lane = C.lane;
    const float gq = a.gqa_q_norm[l * 64 + lane], gk = a.gqa_k_norm[l * 64 + lane];
    for (int t = C.gw; t < T; t += C.NGW) {
        const int pos = t & (SEQ - 1), prow = pos >> 6, pcol = pos & 63; const bf16* zr = Z + (size_t)t * ZP;
        {
            const float v = bf2f(zr[384 + (lane & 31)]); const float pr = __shfl_xor(v, 16); const int j = lane & 15; const f32x2 cs = tab32[pos * 16 + j];
            const float o = (lane & 16) ? (v * cs.x + pr * cs.y) : (v * cs.x - pr * cs.y); const bf16 ob = (bf16)(cvt_pk_bf16(o, 0.f) & 0xffffu);
            if (lane < 32) { const int dest = 64 + 2 * j + ((lane >> 4) & 1);
#pragma unroll
                for (int h = 0; h < 6; ++h) KA[(size_t)t * KAP + h * 96 + dest] = ob; }
        }
#pragma unroll
        for (int hb = 0; hb < 10; ++hb) {
            float v = bf2f(zr[ZB + hb * 64 + lane]);
            if (hb < 8) { const float ss = wave_sum(v * v); const float n = v * __builtin_amdgcn_rsqf(ss * (1.0f / 64) + EPS) * (hb < 6 ? gq : gk);
                const float pr = __shfl_xor(n, 16); const int j = lane & 15; const f32x2 cs = tab32[((lane & 32) ? pcol : prow) * 16 + j];
                v = (lane & 16) ? (n * cs.x + pr * cs.y) : (n * cs.x - pr * cs.y); if (hb < 6) v *= C2B; }
            const bf16 ob = (bf16)(cvt_pk_bf16(v, 0.f) & 0xffffu);
            if (hb < 6) QB[(size_t)t * QBP + hb * 64 + lane] = ob; else if (hb < 8) KB[(size_t)t * KBP + (hb - 6) * 64 + lane] = ob; else VB[(size_t)t * VBP + (hb - 8) * 64 + lane] = ob;
        }
#pragma unroll
        for (int hc = 0; hc < 8; ++hc) {
            float v = bf2f(zr[ZC + hc * 64 + lane]);
            if (hc < 6) { const float pr = __shfl_xor(v, 32); const f32x2 cs = tab64[pos * 32 + (lane & 31)]; v = (lane & 32) ? (v * cs.x + pr * cs.y) : (v * cs.x - pr * cs.y); if (hc < 4) v *= C2B; }
            const bf16 ob = (bf16)(cvt_pk_bf16(v, 0.f) & 0xffffu);
            if (hc < 4) QC[(size_t)t * QCP + hc * 64 + lane] = ob; else if (hc < 6) KC[(size_t)t * KCP + (hc - 4) * 64 + lane] = ob; else VC[(size_t)t * VCP + (hc - 6) * 64 + lane] = ob;
        }
    }
}

__device__ __forceinline__ void router_phase(const Args& a, const Ctx& C, int l, bool commit) {
    unsigned char* ws = launder(a.ws);
    const float* XF = (const float*)(ws + WS_XF); const float* WR = (const float*)(ws + WS_WR) + (size_t)l * D * NE; const u64* ss1 = (const u64*)(ws + WS_CTL + (size_t)CW_SS * 4) + (size_t)(l * 4 + 2) * T;
    int* cnt = (int*)(ws + WS_CTL) + CW_CNT + l * NE; int* perm = (int*)(ws + WS_PERM); float* rsl = (float*)(ws + WS_RSL); float* gsl = (float*)(ws + WS_GSL);
    LAS float* part = (LAS float*)C.lds;
    LAS int* hist = (LAS int*)(C.lds + MISC_OFF + 1024); LAS int* base = hist + NE;
    const int lane = C.lane, r32 = lane & 31, hi = lane >> 5, tg = C.wave & 3, kh = C.wave >> 2;
    for (int blk = C.vcu; blk < T / 128; blk += C.G) {
        const int t0 = blk * 128;
        if (C.tid < NE) hist[C.tid] = 0;
        f32x16 acc = {};
        const float* xr = XF + (size_t)(t0 + tg * 32 + r32) * D + kh * 512 + hi * 4; const bf16* xrb = (const bf16*)(ws + WS_X1B) + (size_t)(t0 + tg * 32 + r32) * D + kh * 512 + hi * 4; const float* wr = WR + (size_t)(kh * 512 + hi * 4) * NE + r32;
        const float rs_l = __builtin_amdgcn_rsqf(fx_load(ss1 + t0 + tg * 32 + r32) * (1.0f / D) + EPS);
        unsigned char* xq = ws + WS_X1Q + (size_t)(t0 + tg * 32 + r32) * D + kh * 512 + hi * 4;
        if (X1_BF16) {
            const bf16* xb_ = (const bf16*)(ws + WS_X1B) + (size_t)(t0 + tg * 32 + r32) * D + kh * 512 + hi * 8;
            const bf16* wh_ = (const bf16*)(ws + WS_WR + 512 * 1024) + ((size_t)l * NE + r32) * D + kh * 512 + hi * 8; const bf16* wl_ = wh_ + (256 * 1024) / 2;
            unsigned char* xq8 = ws + WS_X1Q + (size_t)(t0 + tg * 32 + r32) * D + kh * 512 + hi * 8;
#pragma unroll 1
            for (int kb = 0; kb < 32; kb += 8) { u32x4 xb[8], ah[8], al[8];
#pragma unroll
                for (int q = 0; q < 8; ++q) { xb[q] = *(const u32x4*)(xb_ + (kb + q) * 16); ah[q] = *(const u32x4*)(wh_ + (kb + q) * 16); al[q] = *(const u32x4*)(wl_ + (kb + q) * 16); }
                __builtin_amdgcn_sched_barrier(0);
                if (MOE_F8) {
#pragma unroll
                    for (int q = 0; q < 8; ++q) { const u32x4 w = xb[q]; u32x2 o; o.x = pk4_fp8(bflo(w.x) * rs_l, bfhi(w.x) * rs_l, bflo(w.y) * rs_l, bfhi(w.y) * rs_l); o.y = pk4_fp8(bflo(w.z) * rs_l, bfhi(w.z) * rs_l, bflo(w.w) * rs_l, bfhi(w.w) * rs_l);
                        *(u32x2*)(xq8 + (kb + q) * 16) = o; } }
#pragma unroll
                for (int q = 0; q < 8; ++q) { acc = __builtin_amdgcn_mfma_f32_32x32x16_bf16(__builtin_bit_cast(bf16x8, ah[q]), __builtin_bit_cast(bf16x8, xb[q]), acc, 0, 0, 0);
                    acc = __builtin_amdgcn_mfma_f32_32x32x16_bf16(__builtin_bit_cast(bf16x8, al[q]), __builtin_bit_cast(bf16x8, xb[q]), acc, 0, 0, 0); } }
        } else {
#pragma unroll 1
        for (int kb = 0; kb < 64; kb += 8) { f32x4 xv[8]; float wv[8][4];
#pragma unroll
            for (int q = 0; q < 8; ++q) { if (X1_BF16) { const u32x2 w = *(const u32x2*)(xrb + (kb + q) * 8); xv[q] = (f32x4){bflo(w.x), bfhi(w.x), bflo(w.y), bfhi(w.y)}; } else xv[q] = *(const f32x4*)(xr + (kb + q) * 8);
#pragma unroll
                for (int i = 0; i < 4; ++i) wv[q][i] = wr[((kb + q) * 8 + i) * NE]; }
            __builtin_amdgcn_sched_barrier(0);
            if (MOE_F8) {
#pragma unroll
                for (int q = 0; q < 8; ++q) *(unsigned*)(xq + (kb + q) * 8) = pk4_fp8(xv[q][0] * rs_l, xv[q][1] * rs_l, xv[q][2] * rs_l, xv[q][3] * rs_l); }
#pragma unroll
            for (int q = 0; q < 8; ++q)
#pragma unroll
                for (int i = 0; i < 4; ++i) acc = __builtin_amdgcn_mfma_f32_32x32x2f32(wv[q][i], xv[q][i], acc, 0, 0, 0); }
        }
#pragma unroll
        for (int r = 0; r < 16; ++r) part[(kh * 128 + tg * 32 + r32) * 33 + at::crow(r, hi)] = acc[r];
        __syncthreads();
        int ek[4]; float wk[4]; int rk[4]; float rs_t = 1.0f; const int t = t0 + C.tid;
        if (C.tid < 128) {
            const float rs = __builtin_amdgcn_rsqf(fx_load(ss1 + t) * (1.0f / D) + EPS); float v[NE]; rs_t = rs;
#pragma unroll
            for (int e = 0; e < NE; ++e) v[e] = (part[C.tid * 33 + e] + part[(128 + C.tid) * 33 + e]) * rs + a.router_b[l * NE + e];
            unsigned used = 0u; float tv[4];
#pragma unroll
            for (int k = 0; k < 4; ++k) { float best = -INFINITY; int bi = 0;
#pragma unroll
                for (int e = 0; e < NE; ++e) { const bool ok = !((used >> e) & 1u) && (v[e] > best); best = ok ? v[e] : best; bi = ok ? e : bi; }
                used |= 1u << bi; ek[k] = bi; tv[k] = best; }
            float den = 0.f;
#pragma unroll
            for (int k = 0; k < 4; ++k) { wk[k] = __expf(tv[k] - tv[0]); den += wk[k]; }
            const float rd = 1.0f / den;
#pragma unroll
            for (int k = 0; k < 4; ++k) { wk[k] *= rd; rk[k] = commit ? atomicAdd((int*)(hist + ek[k]), 1) : 0; }
        }
        __syncthreads();
        if (C.tid < NE && commit) base[C.tid] = atomicAdd(cnt + C.tid, hist[C.tid]);
        __syncthreads();
        if (C.tid < 128 && commit) {
#pragma unroll
            for (int k = 0; k < 4; ++k) { const int sidx = ek[k] * ECAP + base[ek[k]] + rk[k]; __hip_atomic_store(perm + sidx, t * 4 + k, RLX_AGENT); __hip_atomic_store(rsl + sidx, rs_t, RLX_AGENT); __hip_atomic_store(gsl + sidx, wk[k], RLX_AGENT); }
        }
        __syncthreads();
    }
}

__device__ __forceinline__ void combine_phase(const Args& a, const Ctx& C) {
    unsigned char* ws = launder(a.ws); const float* XF = (const float*)(ws + WS_XF); const bf16* Y = (const bf16*)(ws + WS_Y); bf16* X2B = (bf16*)(ws + WS_X2B); float* rs2 = (float*)(ws + WS_RS2);
    for (int t0 = 2 * C.gw; t0 < T; t0 += 2 * C.NGW) {
        f32x4 v[2][4]; u32x2 y[2][4][4];
#pragma unroll
        for (int q = 0; q < 2; ++q) { const f32x4* xr = (const f32x4*)(XF + (size_t)(t0 + q) * D) + C.lane; const u32x2* xrb = (const u32x2*)((const bf16*)(ws + WS_X1B) + (size_t)(t0 + q) * D) + C.lane;
#pragma unroll
            for (int j = 0; j < 4; ++j) { if (X1_BF16) { const u32x2 w = xrb[64 * j]; v[q][j] = (f32x4){bflo(w.x), bfhi(w.x), bflo(w.y), bfhi(w.y)}; } else v[q][j] = xr[64 * j]; }
#pragma unroll
            for (int k = 0; k < 4; ++k) { const u32x2* yr = (const u32x2*)(Y + (size_t)((t0 + q) * 4 + k) * D) + C.lane;
#pragma unroll
                for (int j = 0; j < 4; ++j) y[q][k][j] = yr[64 * j]; } }
#pragma unroll
        for (int q = 0; q < 2; ++q) { float s = 0.f;
#pragma unroll
            for (int k = 0; k < 4; ++k)
#pragma unroll
                for (int j = 0; j < 4; ++j) { const u32x2 w = y[q][k][j]; v[q][j][0] += bflo(w.x); v[q][j][1] += bfhi(w.x); v[q][j][2] += bflo(w.y); v[q][j][3] += bfhi(w.y); }
            u32x2* o8 = (u32x2*)(X2B + (size_t)(t0 + q) * D) + C.lane;
#pragma unroll
            for (int j = 0; j < 4; ++j) { u32x2 w; w.x = cvt_pk_bf16(v[q][j][0], v[q][j][1]); w.y = cvt_pk_bf16(v[q][j][2], v[q][j][3]); o8[64 * j] = w; s += sq4g(v[q][j]); }
            s = wave_sum(s);
            if (C.lane == 0) __hip_atomic_store(rs2 + t0 + q, __builtin_amdgcn_rsqf(s * (1.0f / D) + EPS), RLX_AGENT); }
    }
}
__device__ __forceinline__ void final_phase(const Args& a, const Ctx& C) {
    const bf16* XB = (const bf16*)(launder(a.ws) + WS_XB);
    const f32x4* g = (const f32x4*)a.final_norm + C.lane; f32x4 gv[4];
#pragma unroll
    for (int j = 0; j < 4; ++j) gv[j] = g[64 * j];
    for (int t0 = 4 * C.gw; t0 < T; t0 += 4 * C.NGW) {
        u32x2 w[4][4];
#pragma unroll
        for (int q = 0; q < 4; ++q) { const u32x2* xr = (const u32x2*)(XB + (size_t)(t0 + q) * D) + C.lane;
#pragma unroll
            for (int j = 0; j < 4; ++j) w[q][j] = xr[64 * j]; }
#pragma unroll
        for (int q = 0; q < 4; ++q) { f32x4 v[4]; float s = 0.f;
#pragma unroll
            for (int j = 0; j < 4; ++j) { v[j] = (f32x4){bflo(w[q][j].x), bfhi(w[q][j].x), bflo(w[q][j].y), bfhi(w[q][j].y)}; s += sq4g(v[j]); }
            s = wave_sum(s); const float rs = 1.0f / sqrtf(s * (1.0f / D) + EPS);
            f32x4* o = (f32x4*)(a.out + (size_t)(t0 + q) * D) + C.lane;
#pragma unroll
            for (int j = 0; j < 4; ++j) o[64 * j] = v[j] * rs * gv[j]; }
    }
}
__device__ __forceinline__ Ctx make_ctx(LAS unsigned char* lds) {
    Ctx C; C.lds = lds; C.tid = opaque_tid(); C.lane = C.tid & 63; C.wave = __builtin_amdgcn_readfirstlane(C.tid >> 6);
    C.G = gridDim.x; const int bx = blockIdx.x; C.vcu = (C.G % 8 == 0) ? (bx % 8) * (C.G / 8) + bx / 8 : bx; C.gw = C.vcu * NWAVES + C.wave; C.NGW = C.G * NWAVES; return C;
}
#ifdef PROBE_A
#define STAMP(i) do { if (blockIdx.x == 0 && threadIdx.x == 0) ((LAS u64*)(lds + MISC_OFF + 3072))[(i)] = __builtin_amdgcn_s_memrealtime(); } while (0)
#else
#define STAMP(i) do { } while (0)
#endif
#define GRID_BAR() do { XcdBarrier b_; b_.bar = (unsigned*)(launder(a.ws) + WS_CTL) + CW_BAR; b_.x = xb_xcc_id(); b_.st = (volatile LAS unsigned*)(lds + MISC_OFF); xcd_barrier(b_); } while (0)
__global__ void __launch_bounds__(NWAVES * 64, 2) fwd(Args a) {
    extern __shared__ __attribute__((aligned(16))) unsigned char lds_raw[];
    LAS unsigned char* lds = (LAS unsigned char*)lds_raw;
    for (int u = threadIdx.x; u < (LDS_BYTES - MISC_OFF) / 4; u += NWAVES * 64) ((LAS unsigned*)(lds + MISC_OFF))[u] = 0u;
    __syncthreads();
    (void)xcd_barrier_post((unsigned*)(launder(a.ws) + WS_CTL) + CW_BAR, (volatile LAS unsigned*)(lds + MISC_OFF));
    const int bx = blockIdx.x;
    STAMP(0);
    PH(0) { const Ctx C = make_ctx(lds); prologue(a, C); }
    GRID_BAR(); STAMP(1);

#pragma unroll 1
    for (int l = 0; l < NL; ++l) {
        PH(1) { unsigned char* ws = launder(a.ws); u64* ssb = (u64*)(ws + WS_CTL + (size_t)CW_SS * 4) + (size_t)l * 4 * T;
          const u64* ssin = (l == 0) ? (const u64*)(ws + WS_SS0) : (const u64*)(ws + WS_CTL + (size_t)CW_SS * 4) + (size_t)((l - 1) * 4 + 3) * T;
          gp::DenseSched S; if (P1_F8) S.init(ws + WS_XQ, D / 2, ws + WS_WIN + (size_t)l * ZP * D, D / 2, T, ZP, gridDim.x, bx); else S.init(ws + WS_XB, D, (bf16*)(ws + WS_WIN) + (size_t)l * ZP * D, D, T, ZP, gridDim.x, bx);
          gp::EpiIn E{(bf16*)(ws + WS_Z), ssin, ssb, ssb + T, rep_ == 0, (bf16*)(ws + WS_KA), (bf16*)(ws + WS_QB), (bf16*)(ws + WS_KB), (bf16*)(ws + WS_VB), (bf16*)(ws + WS_QC), (bf16*)(ws + WS_KC), (bf16*)(ws + WS_VC),
                       (const f32x2*)(ws + WS_TAB32), (const f32x2*)(ws + WS_TAB64), a.gqa_q_norm + l * 64, a.gqa_k_norm + l * 64, ws + WS_VTB, ws + WS_VTC, PV_F8 != 0};
          gp::gemm_phase<gp::EpiIn, gp::DenseSched, true, P1_F8 != 0>(lds, D, S, E); }
        GRID_BAR(); STAMP(2 + l * 9 + 0);
        PH(3) { unsigned char* ws = launder(a.ws); u64* ssb = (u64*)(ws + WS_CTL + (size_t)CW_SS * 4) + (size_t)l * 4 * T;
          gp::MlaSched S{(const char*)(ws + WS_Z), (const char*)((bf16*)(ws + WS_WQ) + (size_t)l * 768 * 256), (const char*)((bf16*)(ws + WS_WKV) + (size_t)l * 768 * 256), (int)gridDim.x, bx};
          gp::EpiMla E{(bf16*)(ws + WS_QA), (bf16*)(ws + WS_KA), (bf16*)(ws + WS_VA), ssb, ssb + T, (const f32x2*)(ws + WS_TAB32), ws + WS_VTA, PV_F8 != 0};
          gp::gemm_phase<gp::EpiMla, gp::MlaSched, true>(lds, 256, S, E); }
        GRID_BAR(); STAMP(2 + l * 9 + 1);
#if PV_CHECK
        { unsigned char* ws = launder(a.ws); u64* ssb = (u64*)(ws + WS_CTL + (size_t)CW_SS * 4) + (size_t)l * 4 * T;
          const u64* ssin = (l == 0) ? (const u64*)(ws + WS_SS0) : (const u64*)(ws + WS_CTL + (size_t)CW_SS * 4) + (size_t)((l - 1) * 4 + 3) * T;
          gp::DenseSched S; if (P1_F8) S.init(ws + WS_XQ, D / 2, ws + WS_WIN + (size_t)l * ZP * D, D / 2, T, ZP, gridDim.x, bx); else S.init(ws + WS_XB, D, (bf16*)(ws + WS_WIN) + (size_t)l * ZP * D, D, T, ZP, gridDim.x, bx);
          gp::EpiIn E{(bf16*)(ws + WS_Z), ssin, ssb, ssb + T, false, (bf16*)(ws + WS_KA), (bf16*)(ws + WS_QB), (bf16*)(ws + WS_KB), (bf16*)(ws + WS_VB), (bf16*)(ws + WS_QC), (bf16*)(ws + WS_KC), (bf16*)(ws + WS_VC),
                       (const f32x2*)(ws + WS_TAB32), (const f32x2*)(ws + WS_TAB64), a.gqa_q_norm + l * 64, a.gqa_k_norm + l * 64, ws + WS_VTB, ws + WS_VTC, false};
          gp::gemm_phase<gp::EpiIn, gp::DenseSched, true, P1_F8 != 0>(lds, D, S, E); }
        GRID_BAR();
        { unsigned char* ws = launder(a.ws); u64* ssb = (u64*)(ws + WS_CTL + (size_t)CW_SS * 4) + (size_t)l * 4 * T;
          gp::MlaSched S{(const char*)(ws + WS_Z), (const char*)((bf16*)(ws + WS_WQ) + (size_t)l * 768 * 256), (const char*)((bf16*)(ws + WS_WKV) + (size_t)l * 768 * 256), (int)gridDim.x, bx};
          gp::EpiMla E{(bf16*)(ws + WS_QA), (bf16*)(ws + WS_KA), (bf16*)(ws + WS_VA), ssb, ssb + T, (const f32x2*)(ws + WS_TAB32), ws + WS_VTA, false};
          gp::gemm_phase<gp::EpiMla, gp::MlaSched, true>(lds, 256, S, E); }
        GRID_BAR();
#endif
        {
            char* shm = (char*)lds_raw; const int G = gridDim.x, vcu = (G % 8 == 0) ? (bx % 8) * (G / 8) + bx / 8 : bx;
#if PV_CHECK
            { unsigned char* ws = launder(a.ws); at::DecA dec{ws + WS_QA, ws + WS_KA, (const bf16*)(ws + WS_VA), (bf16*)(ws + WS_MIX), false};
              at::attn_loop_f8<2, 6, 0>(vcu, NB * 6 * 16, G, dec, QAP, KAP, VAP, D, shm); }
            { unsigned char* ws = launder(a.ws); at::DecB dec{ws + WS_QB, ws + WS_KB, (const bf16*)(ws + WS_VB), (bf16*)(ws + WS_MIX), false};
              at::attn_loop_f8<1, 4, 0>(vcu, NB * 6 * 16, G, dec, QBP, KBP, VBP, D, shm); }
            { unsigned char* ws = launder(a.ws); at::DecC dec{ws + WS_QC, ws + WS_KC, (const bf16*)(ws + WS_VC), (bf16*)(ws + WS_MIX), a.swa_sink + l * 4, false};
              at::attn_loop_f8<1, 4, 1>(vcu, NB * 4 * 16, G, dec, QCP, KCP, VCP, D, shm); }
            { unsigned char* ws = launder(a.ws); at::DecA dec{ws + WS_QA, ws + WS_KA, (const bf16*)(ws + WS_VTA), (bf16*)(ws + WS_MIX2), true};
              at::attn_loop_f8v<2, 6, 0, at::DecA, PP_A != 0, PP_A != 0>(vcu, NB * 6 * 16, G, dec, QAP, KAP, D, shm); }
            { unsigned char* ws = launder(a.ws); at::DecB dec{ws + WS_QB, ws + WS_KB, (const bf16*)(ws + WS_VTB), (bf16*)(ws + WS_MIX2), true};
              at::attn_loop_f8v<1, 4, 0, at::DecB, false, PP_B != 0>(vcu, NB * 6 * 16, G, dec, QBP, KBP, D, shm); }
            { unsigned char* ws = launder(a.ws); at::DecC dec{ws + WS_QC, ws + WS_KC, (const bf16*)(ws + WS_VTC), (bf16*)(ws + WS_MIX2), a.swa_sink + l * 4, true};
              at::attn_loop_f8v<1, 4, 1, at::DecC, false, PP_C != 0>(vcu, NB * 4 * 16, G, dec, QCP, KCP, D, shm); }
            GRID_BAR();
            { unsigned char* ws = launder(a.ws); const bf16* M1 = (const bf16*)(ws + WS_MIX); const bf16* M2 = (const bf16*)(ws + WS_MIX2); float d2 = 0.f, r2 = 0.f;
              const int tid_ = opaque_tid(), col = ((bx & 1) * 512 + tid_), mx = col < 384 ? 0 : col < 768 ? 1 : 2;
#pragma unroll 1
              for (int row = bx >> 1; row < T; row += (int)(gridDim.x >> 1)) { const size_t e = (size_t)row * D + col; const float v1 = (float)M1[e], v2 = (float)M2[e], df = v1 - v2; d2 += df * df; r2 += v1 * v1; }
              float* chk = (float*)(ws + WS_CTL) + CW_CHK;
              atomicAdd(chk + l * 8 + mx, d2); atomicAdd(chk + l * 8 + 4 + mx, r2); }
#else
            PH(4) { unsigned char* ws = launder(a.ws); at::DecA dec{ws + WS_QA, ws + WS_KA, (const bf16*)(ws + WS_VTA), (bf16*)(ws + WS_MIX), PV_F8 != 0};
              if (PV_F8) at::attn_loop_f8v<2, 6, 0, at::DecA, PP_A != 0, PP_A != 0>(vcu, NB * 6 * 16, G, dec, QAP, KAP, D, shm); else at::attn_loop_f8<2, 6, 0>(vcu, NB * 6 * 16, G, dec, QAP, KAP, VAP, D, shm); }
            PH(5) { unsigned char* ws = launder(a.ws); at::DecB dec{ws + WS_QB, ws + WS_KB, (const bf16*)(ws + WS_VTB), (bf16*)(ws + WS_MIX), PV_F8 != 0};
              if (PV_F8) at::attn_loop_f8v<1, 4, 0, at::DecB, false, PP_B != 0>(vcu, NB * 6 * 16, G, dec, QBP, KBP, D, shm); else at::attn_loop_f8<1, 4, 0>(vcu, NB * 6 * 16, G, dec, QBP, KBP, VBP, D, shm); }
            PH(6) { unsigned char* ws = launder(a.ws); at::DecC dec{ws + WS_QC, ws + WS_KC, (const bf16*)(ws + WS_VTC), (bf16*)(ws + WS_MIX), a.swa_sink + l * 4, PV_F8 != 0};
              if (PV_F8) at::attn_loop_f8v<1, 4, 1, at::DecC, false, PP_C != 0>(vcu, NB * 4 * 16, G, dec, QCP, KCP, D, shm); else at::attn_loop_f8<1, 4, 1>(vcu, NB * 4 * 16, G, dec, QCP, KCP, VCP, D, shm); }
#endif
        }
        GRID_BAR(); STAMP(2 + l * 9 + 2);
        for (int rep_ = 0; rep_ < 1 + (((REPMASK >> 7) & 1) && l == 0); ++rep_) { unsigned char* ws = launder(a.ws); u64* ssb = (u64*)(ws + WS_CTL + (size_t)CW_SS * 4) + (size_t)l * 4 * T; float* XF = (float*)(ws + WS_XF);
          gp::DenseSched S; if (P4_F8) S.init(ws + WS_MIX, D / 2, ws + WS_WOUT + (size_t)l * D * D, D / 2, T, D, gridDim.x, bx); else S.init(ws + WS_MIX, D, (bf16*)(ws + WS_WOUT) + (size_t)l * D * D, D, T, D, gridDim.x, bx);
          gp::EpiRes E{a.x, (l == 0) ? (const bf16*)nullptr : (const bf16*)(ws + WS_XB), XF, (bf16*)(ws + WS_X1B), ssb + 2 * T, rep_ == 0, ws + WS_X1Q, 1.0f / (MSC * WSC)};
          gp::gemm_phase<gp::EpiRes, gp::DenseSched, true, P4_F8 != 0>(lds, D, S, E); }
        GRID_BAR(); STAMP(2 + l * 9 + 3);
        PH(8) { const Ctx C = make_ctx(lds); router_phase(a, C, l, rep_ == 0); }
        PH(9) { unsigned char* ws = launder(a.ws);
          gp::DenseSched S; S.init((bf16*)(ws + WS_PB) + (size_t)l * T * 256, 256, (bf16*)(ws + WS_WPLE) + (size_t)l * D * 256, 256, T, D, gridDim.x, bx);
          gp::EpiPlain E{(bf16*)(ws + WS_EB), D};
          gp::gemm_phase<gp::EpiPlain, gp::DenseSched, true>(lds, 256, S, E); }
        GRID_BAR(); STAMP(2 + l * 9 + 4);
        gp::MoeTab tb; tb.P = (LAS int*)(lds + MISC_OFF + 2048); tb.C = tb.P + 64; tb.R2E = (LAS int*)(lds + MISC_OFF + 4096);
        if (threadIdx.x == 0) { const int* cnt = (const int*)(launder(a.ws) + WS_CTL) + CW_CNT + l * NE; int accp = 0;
            for (int e = 0; e < NE; ++e) { const int c = cnt[e]; tb.C[e] = c; tb.P[e] = accp; accp += (c + 255) >> 8; } tb.P[NE] = accp; }
        __syncthreads();
        { const int nrt = tb.P[NE];
#pragma unroll 1
          for (int rt = opaque_tid(); rt < nrt; rt += NWAVES * 64) { int e = 0;
#pragma unroll 1
              for (int j = 1; j < NE; ++j) e = (tb.P[j] <= rt) ? j : e;
              tb.R2E[rt] = e; } }
        __syncthreads();
        PH(10) { unsigned char* ws = launder(a.ws); u64* ssb = (u64*)(ws + WS_CTL + (size_t)CW_SS * 4) + (size_t)l * 4 * T; const int* perm = (const int*)(ws + WS_PERM);
          gp::UpSched S{tb, perm, (const char*)(ws + (MOE_F8 ? WS_X1Q : WS_X1B)), (const char*)(ws + WS_WUP + (size_t)l * NE * 2048 * D * MOE_ES), (int)gridDim.x, bx};
          gp::EpiUp E{(bf16*)(ws + WS_ACT), (const float*)(ws + WS_RSL), (const float*)(ws + WS_BUP) + (size_t)l * NE * 2048, tb};
          gp::gemm_phase<gp::EpiUp, gp::UpSched, true, MOE_F8 != 0>(lds, D, S, E); }
        GRID_BAR(); STAMP(2 + l * 9 + 5);
        PH(11) { unsigned char* ws = launder(a.ws); const int* perm = (const int*)(ws + WS_PERM);
          gp::DownSched S{tb, (const char*)(ws + WS_ACT), (const char*)(ws + WS_WDN + (size_t)l * NE * D * D * MOE_ES), (int)gridDim.x, bx};
          gp::EpiDown E{(bf16*)(ws + WS_Y), a.b_down + (size_t)l * NE * D, (const float*)(ws + WS_GSL), perm, tb};
          gp::gemm_phase<gp::EpiDown, gp::DownSched, true, MOE_F8 != 0>(lds, D, S, E); }
        GRID_BAR(); STAMP(2 + l * 9 + 6);
        PH(12) { const Ctx C = make_ctx(lds); combine_phase(a, C); }
        GRID_BAR(); STAMP(2 + l * 9 + 7);
        PH(13) { unsigned char* ws = launder(a.ws); u64* ssb = (u64*)(ws + WS_CTL + (size_t)CW_SS * 4) + (size_t)l * 4 * T;
          gp::DenseSched S; S.init(ws + WS_X2B, D, (bf16*)(ws + WS_WG) + (size_t)l * D * D, D, T, D, gridDim.x, bx);
          gp::EpiGate E{(const bf16*)(ws + WS_X2B), (bf16*)(ws + WS_XB), (const bf16*)(ws + WS_EB), (const float*)(ws + WS_RS2), ssb + 3 * T, rep_ == 0, ws + WS_XQ};
          gp::gemm_phase<gp::EpiGate, gp::DenseSched, true>(lds, D, S, E); }
        GRID_BAR(); STAMP(2 + l * 9 + 8);
    }
#ifdef PROBE_A
    if (blockIdx.x == 0 && threadIdx.x == 0) { LAS u64* st = (LAS u64*)(lds + MISC_OFF + 3072); const float ms = (float)(long long)(st[PROBE_B] - st[PROBE_A]) * 1e-5f;
        __hip_atomic_store((float*)(launder(a.ws) + WS_RS2) + T, 1.0f + ms, RLX_AGENT); }
    GRID_BAR();
#endif
    PH(14) { const Ctx C = make_ctx(lds); final_phase(a, C); }
#if PV_CHECK
    GRID_BAR();
    if (bx == 0 && threadIdx.x == 0) { const float* chk = (const float*)(launder(a.ws) + WS_CTL) + CW_CHK; bool bad = false;
        for (int l = 0; l < NL; ++l) for (int q = 0; q < 3; ++q) { const float d = __builtin_nontemporal_load(chk + l * 8 + q), r = __builtin_nontemporal_load(chk + l * 8 + 4 + q); if (!(r > 0.f) || !(d <= PV_TOL * r) || !(d >= PV_LOW * r)) bad = true; }
        if (bad) a.out[0] = __builtin_nanf(""); }
#endif
}

extern "C" void kernel_launch(void* const* d_in, const int* in_sizes, int n_in, void* d_out, int out_size, void* d_ws, size_t ws_size, hipStream_t stream) {
    static int grid = 0;
    if (grid == 0) {
        if (n_in != 23 || out_size != T * D || ws_size < WS_END) { fprintf(stderr, "kernel_launch: unexpected shapes (n_in %d out %d ws %zu)\n", n_in, out_size, ws_size); grid = -1; return; }
        int dev = 0, cus = 0, per_cu = 0;
        if (hipGetDevice(&dev) != hipSuccess || hipDeviceGetAttribute(&cus, hipDeviceAttributeMultiprocessorCount, dev) != hipSuccess) { grid = -1; return; }
        if (hipFuncSetAttribute((const void*)fwd, hipFuncAttributeMaxDynamicSharedMemorySize, LDS_BYTES) != hipSuccess) { fprintf(stderr, "kernel_launch: hipFuncSetAttribute failed\n"); grid = -1; return; }
        if (hipOccupancyMaxActiveBlocksPerMultiprocessor(&per_cu, (const void*)fwd, NWAVES * 64, LDS_BYTES) != hipSuccess || per_cu < 1) fprintf(stderr, "kernel_launch: occupancy query reports %d\n", per_cu);
        (void)hipGetLastError();
        grid = cus;
    }
    if (grid < 0) return;
    if (hipMemsetAsync((char*)d_ws + WS_CTL, 0, CTL_ZERO_BYTES, stream) != hipSuccess) return;
    Args a{};
    const float** ap = (const float**)&a;
    for (int i = 0; i < 23; ++i) ap[i] = (const float*)d_in[i];
    a.out = (float*)d_out; a.ws = (unsigned char*)d_ws;
    hipLaunchKernelGGL(fwd, dim3(grid), dim3(NWAVES * 64), LDS_BYTES, stream, a);
}
```

```cpp
#include <hip/hip_runtime.h>
#include <cstdio>
#include <cstdint>
#include <type_traits>

#define GAS __attribute__((address_space(1)))
#define LAS __attribute__((address_space(3)))
typedef unsigned short bf16;
typedef short bf16x8 __attribute__((ext_vector_type(8)));
typedef short s16x4 __attribute__((ext_vector_type(4)));
typedef float f32x2 __attribute__((ext_vector_type(2)));
typedef float f32x4 __attribute__((ext_vector_type(4)));
typedef float f32x16 __attribute__((ext_vector_type(16)));
typedef unsigned u32x2 __attribute__((ext_vector_type(2)));
typedef unsigned u32x4 __attribute__((ext_vector_type(4)));

constexpr int NB = 8, SEQ = 4096, T = NB * SEQ, D = 1024, NL = 2;
constexpr int ZP = 1792;
constexpr int ZQ = 384;
constexpr int A_COLS = 416, B_COLS = 640;
constexpr int ZB = A_COLS, ZC = A_COLS + B_COLS;
constexpr int QAP = 576, KAP = 576, VAP = 384, QBP = 384, KBP = 128, VBP = 128, QCP = 256, KCP = 128, VCP = 128;
constexpr int NE = 32, TOPK = 4, ECAP = T;
constexpr int ACT_ROWS = T * TOPK + NE * 256;
constexpr float EPS = 1e-6f, LOG2E = 1.4426950408889634f;
constexpr float C2A = 0.10206207261596577f * LOG2E;
constexpr float C2B = 0.125f * LOG2E;

#ifndef P1_F8
#define P1_F8 1
#endif
#ifndef P4_F8
#define P4_F8 1
#endif
constexpr float MSC = 64.0f;
#ifndef PP_A
#define PP_A 0
#endif
#ifndef PP_B
#define PP_B 0
#endif
#ifndef PP_C
#define PP_C 0
#endif
#ifndef Y_F8
#define Y_F8 1
#endif
constexpr float YSC = 16.0f;
#ifndef P9_F8
#define P9_F8 1
#endif
#ifndef K_ROT
#define K_ROT 1
#endif
#ifndef EPI_PRE
#define EPI_PRE 1
#endif
#ifndef PV_CHECK
#define PV_CHECK 0
#endif
#ifndef PV_LOW
#define PV_LOW 0.0f
#endif
#ifndef PV_TOL
#define PV_TOL 0.02f
#endif
#ifndef PV_F8
#define PV_F8 1
#endif
constexpr float VSC = 8.0f;
#ifndef ATT_F8
#define ATT_F8 1
#endif
#ifndef X1_BF16
#define X1_BF16 1
#endif
#ifndef MOE_F8
#define MOE_F8 1
#endif
constexpr int MOE_ES = MOE_F8 ? 1 : 2;
constexpr float WSC = 64.0f, WSC_INV = 1.0f / 64.0f;

constexpr size_t MiB = 1u << 20;
constexpr size_t WS_CTL = 0, CTL_ZERO_BYTES = 4 * MiB;
constexpr int CW_BAR = 4096;
constexpr int CW_CNT = 16384;
constexpr int CW_SS = 65536;
static_assert(CW_SS * 4 + NL * 4 * T * 8 <= (int)CTL_ZERO_BYTES, "ctl");
constexpr size_t WS_TAB32 = 4 * MiB;
constexpr size_t WS_TAB64 = 5 * MiB;
constexpr size_t WS_WR = 6 * MiB;
constexpr size_t WS_BUP = 7 * MiB;
constexpr size_t WS_SS0 = 8 * MiB;
constexpr size_t WS_RS2 = 8 * MiB + 512 * 1024;
constexpr size_t WS_GATES = 9 * MiB;
constexpr size_t WS_PERM = 10 * MiB;
constexpr size_t WS_WIN = 16 * MiB;
constexpr size_t WS_WQ = 24 * MiB;
constexpr size_t WS_WKV = 25 * MiB;
constexpr size_t WS_WOUT = 26 * MiB;
constexpr size_t WS_WG = 30 * MiB;
constexpr size_t WS_WPLE = 34 * MiB;
constexpr size_t WS_WUP = 36 * MiB;
constexpr size_t WS_WDN = 292 * MiB;
constexpr size_t WS_XB = 420 * MiB;
constexpr size_t WS_X1B = 484 * MiB;
constexpr size_t WS_X2B = 548 * MiB;
constexpr size_t WS_XF = 612 * MiB;
constexpr size_t WS_PB = 740 * MiB;
constexpr size_t WS_Z = 772 * MiB;
constexpr size_t WS_QA = 884 * MiB;
constexpr size_t WS_KA = 920 * MiB;
constexpr size_t WS_VA = 956 * MiB;
constexpr size_t WS_QB = 980 * MiB;
constexpr size_t WS_KB = 1004 * MiB;
constexpr size_t WS_VB = 1012 * MiB;
constexpr size_t WS_QC = 1020 * MiB;
constexpr size_t WS_KC = 1036 * MiB;
constexpr size_t WS_VC = 1044 * MiB;
constexpr size_t WS_MIX = 1052 * MiB;
constexpr size_t WS_EB = 1116 * MiB;
constexpr size_t WS_ACT = 1180 * MiB;
constexpr size_t WS_Y = 1452 * MiB;
constexpr size_t WS_RSL = 1708 * MiB;
constexpr size_t WS_GSL = 1712 * MiB;
constexpr size_t WS_X1Q = 1716 * MiB;
constexpr size_t WS_END = 1748 * MiB;
constexpr size_t WS_X2Q = WS_XF + 32 * MiB;
constexpr size_t WS_XQ = WS_XF;
static_assert(X1_BF16 || !P1_F8, "XQ aliases XF");
constexpr size_t WS_VTA = PV_CHECK ? WS_Y : WS_VA, WS_VTB = PV_CHECK ? WS_Y + 16 * MiB : WS_VB, WS_VTC = PV_CHECK ? WS_Y + 24 * MiB : WS_VC, WS_MIX2 = WS_Y + 32 * MiB;
constexpr int CW_CHK = CW_CNT + 1024;

constexpr int RING_BYTES = 131072;
constexpr int MISC_OFF = RING_BYTES;
constexpr int LDS_BYTES = 147456;
constexpr int NWAVES = 8;

#define RLX_AGENT __ATOMIC_RELAXED, __HIP_MEMORY_SCOPE_AGENT
#define LDS_WAIT() asm volatile("s_waitcnt lgkmcnt(0)" ::: "memory")
#define VM_WAIT() asm volatile("s_waitcnt vmcnt(0)" ::: "memory")
__device__ __forceinline__ unsigned cvt_pk_bf16(float lo, float hi) { unsigned r; asm volatile("v_cvt_pk_bf16_f32 %0, %1, %2" : "=v"(r) : "v"(lo), "v"(hi)); return r; }
__device__ __forceinline__ unsigned pk4_fp8(float a, float b, float c, float d) { int w = 0; w = __builtin_amdgcn_cvt_pk_fp8_f32(a, b, w, false); w = __builtin_amdgcn_cvt_pk_fp8_f32(c, d, w, true); return (unsigned)w; }
__device__ __forceinline__ u32x4 zero4() { unsigned z = 0; asm volatile("" : "+v"(z)); return (u32x4){z, z, z, z}; }
__device__ __forceinline__ u32x2 pk8_fp8(f32x4 a, f32x4 b) { u32x2 w; w.x = pk4_fp8(a[0], a[1], a[2], a[3]); w.y = pk4_fp8(b[0], b[1], b[2], b[3]); return w; }
__device__ __forceinline__ float bf2f(unsigned short b) { return __uint_as_float((unsigned)b << 16); }
__device__ __forceinline__ float bflo(unsigned w) { return __uint_as_float(w << 16); }
__device__ __forceinline__ float bfhi(unsigned w) { return __uint_as_float(w & 0xffff0000u); }
typedef unsigned long long u64;
__device__ __forceinline__ u64 fx_enc(float v) { return (u64)__float2ll_rn(v * 1048576.0f); }
__device__ __forceinline__ void atomic_addf(u64* p, float v) { (void)__hip_atomic_fetch_add(p, fx_enc(v), __ATOMIC_RELAXED, __HIP_MEMORY_SCOPE_AGENT); }
__device__ __forceinline__ float fx_load(const u64* p) { return (float)(long long)(*p) * (1.0f / 1048576.0f); }
__device__ __forceinline__ float wave_sum(float v) {
#pragma unroll
    for (int o = 1; o < 64; o <<= 1) v += __shfl_xor(v, o);
    return v;
}
__device__ __forceinline__ float sigmoidf_fast(float x) { return __builtin_amdgcn_rcpf(1.0f + __builtin_amdgcn_exp2f(-x * LOG2E)); }

__device__ __forceinline__ unsigned char* launder(unsigned char* p) { GAS unsigned char* g = (GAS unsigned char*)p; asm volatile("" : "+s"(g)); return (unsigned char*)g; }
__device__ __forceinline__ int opaque_tid() { int t = threadIdx.x; asm volatile("" : "+v"(t)); return t; }
#ifndef REPMASK
#define REPMASK 0
#endif
#define PH(k) for (int rep_ = 0; rep_ < 1 + ((REPMASK >> (k)) & 1); ++rep_)

#define XB_TMO      128
#define XB_XCNT(j)  (256  + 64 * (j))
#define XB_XSUB(j)  (1280 + 64 * (j))
#define XB_XGEN(j)  (2304 + 64 * (j))
#define XB_TOP      3328
#define XB_TOPGEN   3392
#define XCD_BAR_WORDS 3456
#define XB_SPIN_CAP (1u << 18)
__device__ __forceinline__ unsigned xb_ld(unsigned* p)              { return __hip_atomic_load(p, __ATOMIC_RELAXED, __HIP_MEMORY_SCOPE_AGENT); }
__device__ __forceinline__ unsigned xb_add(unsigned* p, unsigned v) { return __hip_atomic_fetch_add(p, v, __ATOMIC_RELAXED, __HIP_MEMORY_SCOPE_AGENT); }
__device__ __forceinline__ unsigned xb_xcc_id() { return (unsigned)__builtin_amdgcn_s_getreg((3 << 11) | 20) & 0xFu; }
#define XB_SPIN(cond, bar) do { unsigned _sp = 0; while (cond) { __builtin_amdgcn_s_sleep(1); \
    if ((++_sp & 255u) == 0u) { if (xb_ld(&(bar)[XB_TMO])) break; if (_sp > XB_SPIN_CAP) { atomicAdd(&(bar)[XB_TMO], 1u); break; } } } } while (0)
struct XcdBarrier { unsigned* bar; unsigned x; volatile LAS unsigned* st; };
__device__ __forceinline__ XcdBarrier xcd_barrier_post(unsigned* bar, volatile LAS unsigned* st) {
    XcdBarrier b; b.bar = bar; b.x = xb_xcc_id(); b.st = st;
    if (threadIdx.x == 0) (void)xb_add(&bar[XB_XCNT(b.x)], 1u);
    return b;
}
__device__ __forceinline__ void xcd_barrier_complete(unsigned* bar, unsigned x, unsigned& nloc, unsigned& nx) {
    const unsigned G = gridDim.x * gridDim.y * gridDim.z;
    unsigned sum, cnt, mine, sp = 0u;
    for (;;) {
        sum = 0u; cnt = 0u; mine = 0u;
#pragma unroll
        for (unsigned j = 0; j < 16; ++j) { const unsigned c = xb_ld(&bar[XB_XCNT(j)]); sum += c; cnt += (c > 0u) ? 1u : 0u; mine = (j == x) ? c : mine; }
        if (sum == G) break;
        __builtin_amdgcn_s_sleep(1);
        if ((++sp & 255u) == 0u) { if (xb_ld(&bar[XB_TMO])) break; if (sp > XB_SPIN_CAP) { atomicAdd(&bar[XB_TMO], 1u); break; } }
    }
    nloc = mine > 0u ? mine : 1u; nx = cnt > 0u ? cnt : 1u;
}
__device__ __forceinline__ void xcd_barrier(const XcdBarrier& b) {
    asm volatile("s_waitcnt vmcnt(0)" ::: "memory");
    __syncthreads();
    if (threadIdx.x == 0) {
        unsigned* bar = b.bar;
        __builtin_amdgcn_s_waitcnt(0);
        unsigned nloc = b.st[0], nx = b.st[1];
        if (nloc == 0u) { xcd_barrier_complete(bar, b.x, nloc, nx); b.st[0] = nloc; b.st[1] = nx; }
        const unsigned old = xb_add(&bar[XB_XSUB(b.x)], 1u);
        const unsigned gen = old / nloc;
        if (old + 1u == (gen + 1u) * nloc) {
            __builtin_amdgcn_fence(__ATOMIC_RELEASE, "agent");
            asm volatile("s_waitcnt vmcnt(0)" ::: "memory");
            const unsigned og = xb_add(&bar[XB_TOP], 1u);
            const unsigned tg = og / nx;
            if (og + 1u == (tg + 1u) * nx) xb_add(&bar[XB_TOPGEN], 1u);
            else XB_SPIN(xb_ld(&bar[XB_TOPGEN]) == tg, bar);
            __builtin_amdgcn_fence(__ATOMIC_ACQUIRE, "agent");
            xb_add(&bar[XB_XGEN(b.x)], 1u);
            asm volatile("s_waitcnt vmcnt(0)" ::: "memory");
        } else {
            XB_SPIN(xb_ld(&bar[XB_XGEN(b.x)]) == gen, bar);
            __builtin_amdgcn_fence(__ATOMIC_ACQUIRE, "agent");
            asm volatile("s_waitcnt vmcnt(0)" ::: "memory");
        }
    }
    __syncthreads();
}

namespace gp {
constexpr int BM = 256, BK = 64, HALF = 128, HTB = HALF * BK * 2, STAGE_BYTES = 8 * HTB, NXCD = 8, WGM = 16;
__host__ __device__ __forceinline__ int lds_byte(int r, int c) { const int st = (r >> 4) * 2 + (c >> 5), rr = r & 15, cc = c & 31, ob = rr * 64 + cc * 2; return st * 1024 + (ob ^ (((ob >> 9) & 1) << 5)); }
__host__ __device__ __forceinline__ void stage_rc(int b, int& R, int& C) { const int st = b / 1024, sb = b % 1024, swz = sb ^ (((sb >> 9) & 1) << 5); R = (st >> 1) * 16 + swz / 64; C = (st & 1) * 32 + (swz % 64) / 2; }
__host__ __device__ __forceinline__ int perm32(int rho) { const int n = rho >> 4, i = rho & 15; return 8 * (i >> 2) + 4 * n + (i & 3); }

struct Unit { int pm, pn, aux; const char* A; const char* B; };

struct TileOrder {
    int nM, nN, nwg, G, c;
    __device__ __forceinline__ void init(int nM_, int nN_, int G_, int c_) { nM = nM_; nN = nN_; nwg = nM * nN; G = G_; c = c_; }
    __device__ __forceinline__ bool tile(int i, int& pm, int& pn) const {
        const long L = (long)i * G + c; if (L >= nwg) return false;
        int wgid = (int)L; { const int q = nwg / NXCD, r = nwg % NXCD, xcd = wgid % NXCD, off = wgid / NXCD; wgid = (xcd < r ? xcd * (q + 1) : r * (q + 1) + (xcd - r) * q) + off; }
        const int nig = WGM * nN, gid = wgid / nig, fm = gid * WGM, gsz = (nM - fm) < WGM ? (nM - fm) : WGM;
        pm = fm + ((wgid % nig) % gsz); pn = (wgid % nig) / gsz; return true;
    }
};
struct DenseSched {
    TileOrder o; const char* A; const char* B; int lda, K;
    __device__ __forceinline__ void init(const void* A_, int lda_, const void* B_, int K_, int M, int N, int G, int c) { A = (const char*)A_; B = (const char*)B_; lda = lda_; K = K_; o.init(M / BM, N / BM, G, c); }
    __device__ __forceinline__ bool next(int i, Unit& u) const { int pm, pn; if (!o.tile(i, pm, pn)) return false; u.pm = pm; u.pn = pn; u.aux = 0;
        u.A = A + (size_t)pm * BM * lda * 2; u.B = B + (size_t)pn * BM * K * 2; return true; }
    __device__ __forceinline__ unsigned rowoff(const Unit&, int r) const { return (unsigned)(r * lda * 2); }
    __device__ __forceinline__ unsigned rowraw(const Unit&, int r) const { return (unsigned)(r * lda * 2); }
    __device__ __forceinline__ unsigned rawoff(unsigned raw) const { return raw; }
};

template <class E, class = void> struct haspre_of { static constexpr bool v = false; };
template <class E> struct haspre_of<E, decltype((void)E::HAS_PRE)> { static constexpr bool v = E::HAS_PRE; };
template <class E, class = void> struct perm16_of { static constexpr bool v = false; };
template <class E> struct perm16_of<E, decltype((void)E::PERM16)> { static constexpr bool v = E::PERM16; };
typedef int i32x8 __attribute__((ext_vector_type(8)));
template <class Epi, class Sched, bool ALIGN_EPI, bool F8 = false>
__device__ __forceinline__ void gemm_phase(LAS unsigned char* lds, const int Kel, const Sched& S, const Epi& E) {
    const int K = F8 ? (Kel >> 1) : Kel;
    const int tid = opaque_tid(), wid = __builtin_amdgcn_readfirstlane(tid >> 6), lane = tid & 63, wr = wid >> 2, wc = wid & 3, fr = lane & 15, fq = lane >> 4;
    const int nt = K / BK;
    int Rr[2], Cc[2]; unsigned voffB[2];
    constexpr bool P16 = perm16_of<Epi>::v;
#pragma unroll
    for (int i = 0; i < 2; ++i) { int R, C; stage_rc(tid * 16 + i * 8192, R, C); const int Rb = P16 ? (64 * (R >> 5) + 16 * ((R >> 2) & 3) + 4 * ((R >> 4) & 1) + (R & 3)) : Epi::PERM ? ((R & ~31) + perm32(R & 31)) : R;
        Rr[i] = R; Cc[i] = C * 2; voffB[i] = (unsigned)(Rb * K + C) * 2u; }
    const size_t kstep = (size_t)(BK * 2);
    const size_t hstepB = (size_t)(P16 ? 8 : HALF) * K * 2;
    const unsigned ldsw = (unsigned)wid * 1024u;
    const int aoff = lds_byte(wr * 64 + fr, fq * (F8 ? 16 : 8)), boff = lds_byte(wc * 32 + fr, fq * (F8 ? 16 : 8));
#define GP_SA(b, h) (((b) * 2 + (h)) * HTB)
#define GP_SB(b, h) ((4 + (b) * 2 + (h)) * HTB)
#define GP_STAGE(bufoff, gbase, voff) do { _Pragma("unroll") for (int _i = 0; _i < 2; ++_i) \
        __builtin_amdgcn_global_load_lds((const unsigned*)((const char*)(gbase) + (voff)[_i]), (LAS unsigned*)(lds + (bufoff) + ldsw + _i * 8192), 16, 0, 0); } while (0)
#define GP_LD1(dst, base) do { if constexpr (F8) { const u32x4 lo_ = *(const LAS u32x4*)(base), hi_ = *(const LAS u32x4*)((base) + 16); (dst)[0] = __builtin_bit_cast(i32x8, __builtin_shufflevector(lo_, hi_, 0, 1, 2, 3, 4, 5, 6, 7)); } \
        else { _Pragma("unroll") for (int k = 0; k < NK; ++k) (dst)[k] = __builtin_bit_cast(frag_t, *(const LAS typename std::conditional<F8, i32x8, bf16x8>::type*)((base) + k * 1024)); } } while (0)
#define GP_LDA(dst, b, h) do { _Pragma("unroll") for (int m = 0; m < 4; ++m) GP_LD1(dst[m], lds + GP_SA(b, h) + aoff + m * 2048); } while (0)
#define GP_LDB(dst, b, h) do { _Pragma("unroll") for (int n = 0; n < 2; ++n) GP_LD1(dst[n], lds + GP_SB(b, h) + boff + n * 2048); } while (0)
#define GP_MMA(ai, bj, At, Bt) do { __builtin_amdgcn_s_setprio(1); \
        if constexpr (F8) { _Pragma("unroll") for (int m = 0; m < 4; ++m) _Pragma("unroll") for (int n = 0; n < 2; ++n) \
            asm volatile("v_mfma_scale_f32_16x16x128_f8f6f4 %0, %1, %2, %0, %3, %3 op_sel_hi:[0,0,0]" : "+v"(acc[ai][bj][m][n]) : "v"(Bt[n][0]), "v"(At[m][0]), "v"(one_sc)); } \
        else { _Pragma("unroll") for (int m = 0; m < 4; ++m) _Pragma("unroll") for (int n = 0; n < 2; ++n) _Pragma("unroll") for (int k = 0; k < NK; ++k) \
            acc[ai][bj][m][n] = __builtin_amdgcn_mfma_f32_16x16x32_bf16(__builtin_bit_cast(bf16x8, Bt[n][k]), __builtin_bit_cast(bf16x8, At[m][k]), acc[ai][bj][m][n], 0, 0, 0); } \
        __builtin_amdgcn_s_setprio(0); } while (0)
#define GP_WAIT_V(n) asm volatile("s_waitcnt vmcnt(" #n ")" ::: "memory")
#define GP_WAIT_L(n) asm volatile("s_waitcnt lgkmcnt(" #n ")" ::: "memory")
#define GP_BAR __builtin_amdgcn_s_barrier()
#define GP_SCHED __builtin_amdgcn_sched_barrier(0)
    Unit cur, nxt; int ui = 0;
    if (!S.next(0, cur)) return;
    unsigned vAc[2][2], vAn[2][2];
#pragma unroll
    for (int h = 0; h < 2; ++h)
#pragma unroll
        for (int i = 0; i < 2; ++i) vAc[h][i] = S.rowoff(cur, h * HALF + Rr[i]) + (unsigned)Cc[i];
    f32x4 acc[2][2][4][2];
#pragma unroll
    for (int a = 0; a < 2; ++a)
#pragma unroll
        for (int b = 0; b < 2; ++b)
#pragma unroll
            for (int m = 0; m < 4; ++m)
#pragma unroll
                for (int n = 0; n < 2; ++n) acc[a][b][m][n] = (f32x4){0.f, 0.f, 0.f, 0.f};
    typedef typename std::conditional<F8, i32x8, bf16x8>::type frag_t; constexpr int NK = F8 ? 1 : 2;
    frag_t At[4][NK], B0[2][NK], B1[2][NK]; const unsigned one_sc = 0x7f7f7f7fu;
    const char* cA = cur.A; const char* cB = cur.B;
    const int km = nt - 1; int rc = K_ROT ? ((cur.pm + cur.pn) & km) : 0, rn = 0;
#define GP_KO(t_, r_) ((size_t)(((t_) + (r_)) & km) * kstep)
    GP_STAGE(GP_SB(0, 0), cB + GP_KO(0, rc), voffB); GP_STAGE(GP_SB(0, 1), cB + hstepB + GP_KO(0, rc), voffB); GP_STAGE(GP_SA(0, 0), cA + GP_KO(0, rc), vAc[0]); GP_STAGE(GP_SA(0, 1), cA + GP_KO(0, rc), vAc[1]);
    if (wr == 1) GP_BAR;
    GP_WAIT_V(2); GP_BAR;
    GP_STAGE(GP_SB(1, 0), cB + GP_KO(1, rc), voffB); GP_STAGE(GP_SA(1, 0), cA + GP_KO(1, rc), vAc[0]); GP_STAGE(GP_SB(1, 1), cB + hstepB + GP_KO(1, rc), voffB);
    GP_WAIT_V(6); GP_BAR;
    for (;;) {
        const bool has_next = S.next(ui + 1, nxt);
        const char* nA = has_next ? nxt.A : cA; const char* nB = has_next ? nxt.B : cB; rn = (K_ROT && has_next) ? ((nxt.pm + nxt.pn) & km) : rc;
#pragma unroll
        for (int h = 0; h < 2; ++h)
#pragma unroll
            for (int i = 0; i < 2; ++i) vAn[h][i] = has_next ? S.rowraw(nxt, h * HALF + Rr[i]) : 0u;
#pragma unroll 1
        for (int t = 0; t < nt; t += 2) {
            const bool last = (t == nt - 2);
            if constexpr (haspre_of<Epi>::v) { if (last) E.pre(cur, lds, wid, lane); }
            const char* a1 = cA + GP_KO(t + 1, rc);
            const char* a2 = last ? nA + GP_KO(0, rn) : cA + GP_KO(t + 2, rc); const char* b2 = last ? nB + GP_KO(0, rn) : cB + GP_KO(t + 2, rc);
            const char* a3 = last ? nA + GP_KO(1, rn) : cA + GP_KO(t + 3, rc); const char* b3 = last ? nB + GP_KO(1, rn) : cB + GP_KO(t + 3, rc);
            GP_LDB(B0, 0, 0); GP_LDB(B1, 0, 1); GP_SCHED; GP_LDA(At, 0, 0); GP_STAGE(GP_SA(1, 1), a1, vAc[1]);
            if (last && has_next) {
#pragma unroll
                for (int h = 0; h < 2; ++h)
#pragma unroll
                    for (int i = 0; i < 2; ++i) { unsigned r_ = vAn[h][i]; asm volatile("" : "+v"(r_)); vAc[h][i] = S.rawoff(r_) + (unsigned)Cc[i]; } }
            GP_WAIT_V(8); GP_WAIT_L(0); GP_BAR; GP_MMA(0, 0, At, B0); GP_MMA(0, 1, At, B1); GP_BAR; GP_SCHED;
            GP_LDA(At, 0, 1); GP_STAGE(GP_SB(0, 0), b2, voffB); GP_STAGE(GP_SB(0, 1), b2 + hstepB, voffB); GP_STAGE(GP_SA(0, 0), a2, vAc[0]);
            GP_WAIT_V(8); GP_WAIT_L(0); GP_BAR; GP_MMA(1, 0, At, B0); GP_MMA(1, 1, At, B1); GP_BAR; GP_SCHED;
            GP_LDB(B0, 1, 0); GP_LDB(B1, 1, 1); GP_SCHED; GP_LDA(At, 1, 0); GP_STAGE(GP_SA(0, 1), a2, vAc[1]);
            GP_WAIT_V(8); GP_WAIT_L(0); GP_BAR; GP_MMA(0, 0, At, B0); GP_MMA(0, 1, At, B1); GP_BAR; GP_SCHED;
            GP_LDA(At, 1, 1); GP_STAGE(GP_SB(1, 0), b3, voffB); GP_STAGE(GP_SB(1, 1), b3 + hstepB, voffB); GP_STAGE(GP_SA(1, 0), a3, vAc[0]);
            GP_WAIT_V(8); GP_WAIT_L(0); GP_BAR; GP_MMA(1, 0, At, B0); GP_MMA(1, 1, At, B1); GP_BAR; GP_SCHED;
        }
        if constexpr (ALIGN_EPI) { if (wr == 0) GP_BAR; }
        if constexpr (F8) asm volatile("s_nop 15\n\ts_nop 15" ::: "memory");
        E(acc, cur, wr, wc, fr, fq);
        if (!has_next) break;
#pragma unroll
        for (int a = 0; a < 2; ++a)
#pragma unroll
            for (int b = 0; b < 2; ++b)
#pragma unroll
                for (int m = 0; m < 4; ++m)
#pragma unroll
                    for (int n = 0; n < 2; ++n) acc[a][b][m][n] = (f32x4){0.f, 0.f, 0.f, 0.f};
        cur = nxt; cA = nA; cB = nB; rc = rn; ++ui;
        if constexpr (ALIGN_EPI) { if (wr == 1) GP_BAR; }
    }
    GP_WAIT_V(0);
    if constexpr (!ALIGN_EPI) { if (wr == 0) GP_BAR; }
    GP_BAR;
#undef GP_SA
#undef GP_SB
#undef GP_STAGE
#undef GP_LDA
#undef GP_LDB
#undef GP_MMA
#undef GP_LD1
#undef GP_WAIT_V
#undef GP_WAIT_L
#undef GP_BAR
#undef GP_SCHED
#undef GP_KO
}

typedef f32x4 Acc[2][2][4][2];
__device__ __forceinline__ u32x4 pack8(f32x4 v0, f32x4 v1) { u32x4 w; w.x = cvt_pk_bf16(v0[0], v0[1]); w.y = cvt_pk_bf16(v0[2], v0[3]); w.z = cvt_pk_bf16(v1[0], v1[1]); w.w = cvt_pk_bf16(v1[2], v1[3]); return w; }
__device__ __forceinline__ float sq4(f32x4 v) { return (v[0] * v[0] + v[1] * v[1]) + (v[2] * v[2] + v[3] * v[3]); }
__device__ __forceinline__ float fq_sum(float s) { s += __shfl_xor(s, 16); s += __shfl_xor(s, 32); return s; }

struct EpiPlain {
    static constexpr bool PERM = true;
    bf16* O; int ldc;
    __device__ __forceinline__ void operator()(const Acc& acc, const Unit& u, int wr, int wc, int fr, int fq) const {
        const int row0 = u.pm * BM + wr * 64 + fr, col0 = u.pn * BM + wc * 32 + 8 * fq;
#pragma unroll
        for (int ai = 0; ai < 2; ++ai)
#pragma unroll
            for (int m = 0; m < 4; ++m) { bf16* rowp = O + (size_t)(row0 + ai * HALF + m * 16) * ldc + col0;
#pragma unroll
                for (int bj = 0; bj < 2; ++bj) *(u32x4*)(rowp + bj * HALF) = pack8(acc[ai][bj][m][0], acc[ai][bj][m][1]); }
    }
};
constexpr float RSC1 = P1_F8 ? 1.0f / WSC : 1.0f;
struct EpiIn {
    static constexpr bool PERM = true;
    bf16* Z; const u64* ssin; u64* ssq; u64* sskv; bool accum;
    bf16 *KA, *QB, *KB, *VB, *QC, *KC, *VC; const f32x2* tab32; const f32x2* tab64; const float* gq; const float* gk; unsigned char *VTB, *VTC; bool vt; LAS unsigned char* ldsb;
    static constexpr bool HAS_PRE = EPI_PRE != 0;
    __device__ __forceinline__ void pre(const Unit& u, LAS unsigned char* lds, int wid, int lane) const {
        __builtin_amdgcn_global_load_lds((const unsigned*)(ssin + (size_t)u.pm * BM) + wid * 64 + lane, (LAS unsigned*)(lds + MISC_OFF + 8192 + wid * 256), 4, 0, 0); }
    __device__ __forceinline__ float ssl(const Unit& u, int row) const { return HAS_PRE ? (float)(long long)(*(LAS const u64*)(ldsb + MISC_OFF + 8192 + (row - u.pm * BM) * 8)) * (1.0f / 1048576.0f) : ssl(u, row); }
    __device__ __forceinline__ void operator()(const Acc& acc, const Unit& u, int wr, int wc, int fr, int fq) const {
        const int row0 = u.pm * BM + wr * 64 + fr;
        if (u.pn < 2) {
#pragma unroll
            for (int ai = 0; ai < 2; ++ai)
#pragma unroll
                for (int m = 0; m < 4; ++m) { const int row = row0 + ai * HALF + m * 16; const float rs = (__builtin_amdgcn_rsqf(ssl(u, row) * (1.0f / D) + EPS) * RSC1);
                    const f32x4 a0 = acc[ai][0][m][0] * rs, a1 = acc[ai][0][m][1] * rs, b0 = acc[ai][1][m][0] * rs, b1 = acc[ai][1][m][1] * rs;
                    bf16* rowp = Z + (size_t)row * ZQ + u.pn * BM + wc * 32 + 8 * fq;
                    *(u32x4*)rowp = pack8(a0, a1);
                    if (u.pn == 0) { *(u32x4*)(rowp + HALF) = pack8(b0, b1); const float s = fq_sum(sq4(a0) + sq4(a1) + sq4(b0) + sq4(b1)); if (fq == 0 && accum) atomic_addf(ssq + row, s); }
                    else { const float s = fq_sum(sq4(a0) + sq4(a1)); if (fq == 0 && accum) atomic_addf(sskv + row, s);
                        if (wc == 0) { const f32x2* cs = tab32 + (size_t)(row & (SEQ - 1)) * 16 + 4 * fq; const f32x2 c0 = cs[0], c1 = cs[1], c2 = cs[2], c3 = cs[3];
                            f32x4 r0, r1; r0[0] = b0[0] * c0.x - b0[1] * c0.y; r0[1] = b0[1] * c0.x + b0[0] * c0.y; r0[2] = b0[2] * c1.x - b0[3] * c1.y; r0[3] = b0[3] * c1.x + b0[2] * c1.y;
                            r1[0] = b1[0] * c2.x - b1[1] * c2.y; r1[1] = b1[1] * c2.x + b1[0] * c2.y; r1[2] = b1[2] * c3.x - b1[3] * c3.y; r1[3] = b1[3] * c3.x + b1[2] * c3.y;
                            if (ATT_F8) { const u32x2 w = pk8_fp8(r0, r1); unsigned char* kp = (unsigned char*)KA + (size_t)row * KAP + 64 + 8 * fq;
#pragma unroll
                                for (int h = 0; h < 6; ++h) *(u32x2*)(kp + h * 96) = w; }
                            else { const u32x4 w = pack8(r0, r1); bf16* kp = KA + (size_t)row * KAP + 64 + 8 * fq;
#pragma unroll
                                for (int h = 0; h < 6; ++h) *(u32x4*)(kp + h * 96) = w; } } } }
            return;
        }
        const int hs = 4 * (u.pn - 2) + wc;
        if (hs >= 18) return;
        if (hs < 8) {
            const float* g = (hs < 6) ? gq : gk; float gn[2][2][4];
#pragma unroll
            for (int bj = 0; bj < 2; ++bj)
#pragma unroll
                for (int n = 0; n < 2; ++n)
#pragma unroll
                    for (int i = 0; i < 4; ++i) gn[bj][n][i] = g[32 * bj + (4 * fq + 2 * n + (i >> 1)) + 16 * (i & 1)];
            bf16* dst = (hs < 6) ? QB + hs * 64 : KB + (hs - 6) * 64; const int pitch = (hs < 6) ? QBP : KBP; const float osc = (hs < 6) ? C2B : 1.0f;
            unsigned char* dst8 = (hs < 6) ? (unsigned char*)QB + hs * 64 : (unsigned char*)KB + (hs - 6) * 64;
#pragma unroll
            for (int ai = 0; ai < 2; ++ai)
#pragma unroll
                for (int m = 0; m < 4; ++m) { const int row = row0 + ai * HALF + m * 16, pos = row & (SEQ - 1); const float rs = (__builtin_amdgcn_rsqf(ssl(u, row) * (1.0f / D) + EPS) * RSC1);
                    f32x4 v[2][2]; float s = 0.f;
#pragma unroll
                    for (int bj = 0; bj < 2; ++bj)
#pragma unroll
                        for (int n = 0; n < 2; ++n) { v[bj][n] = acc[ai][bj][m][n] * rs; s += sq4(v[bj][n]); }
                    const float nrm = __builtin_amdgcn_rsqf(fq_sum(s) * (1.0f / 64) + EPS) * osc;
#pragma unroll
                    for (int bj = 0; bj < 2; ++bj) { const f32x2* cs = tab32 + (size_t)(bj ? (pos & 63) : (pos >> 6)) * 16 + 4 * fq; f32x4 r[2];
#pragma unroll
                        for (int n = 0; n < 2; ++n) { const f32x2 ca = cs[2 * n], cb = cs[2 * n + 1];
                            const float x0 = v[bj][n][0] * nrm * gn[bj][n][0], x1 = v[bj][n][1] * nrm * gn[bj][n][1], x2 = v[bj][n][2] * nrm * gn[bj][n][2], x3 = v[bj][n][3] * nrm * gn[bj][n][3];
                            r[n][0] = x0 * ca.x - x1 * ca.y; r[n][1] = x1 * ca.x + x0 * ca.y; r[n][2] = x2 * cb.x - x3 * cb.y; r[n][3] = x3 * cb.x + x2 * cb.y; }
                        if (ATT_F8) *(u32x2*)((unsigned char*)dst8 + (size_t)row * pitch + 32 * bj + 8 * fq) = pk8_fp8(r[0], r[1]);
                        else *(u32x4*)(dst + (size_t)row * pitch + 32 * bj + 8 * fq) = pack8(r[0], r[1]); }
                    if (m & 1) asm volatile("" ::: "memory"); }
        } else if (hs >= 10 && hs < 16) {
            bf16* dst = (hs < 14) ? QC + (hs - 10) * 64 : KC + (hs - 14) * 64; const int pitch = (hs < 14) ? QCP : KCP; const float osc = (hs < 14) ? C2B : 1.0f;
#pragma unroll
            for (int ai = 0; ai < 2; ++ai)
#pragma unroll
                for (int m = 0; m < 4; ++m) { const int row = row0 + ai * HALF + m * 16, pos = row & (SEQ - 1); const float rs = (__builtin_amdgcn_rsqf(ssl(u, row) * (1.0f / D) + EPS) * RSC1) * osc;
                    const f32x2* cs = tab64 + (size_t)pos * 32 + 8 * fq; f32x4 lo[2], hh[2];
#pragma unroll
                    for (int n = 0; n < 2; ++n)
#pragma unroll
                        for (int i = 0; i < 4; ++i) { const f32x2 c = cs[4 * n + i]; const float x1 = acc[ai][0][m][n][i] * rs, x2 = acc[ai][1][m][n][i] * rs; lo[n][i] = x1 * c.x - x2 * c.y; hh[n][i] = x2 * c.x + x1 * c.y; }
                    if (ATT_F8) { unsigned char* rp = ((hs < 14) ? (unsigned char*)QC + (hs - 10) * 64 : (unsigned char*)KC + (hs - 14) * 64) + (size_t)row * pitch + 8 * fq; *(u32x2*)rp = pk8_fp8(lo[0], lo[1]); *(u32x2*)(rp + 32) = pk8_fp8(hh[0], hh[1]); }
                    else { bf16* rp = dst + (size_t)row * pitch + 8 * fq; *(u32x4*)rp = pack8(lo[0], lo[1]); *(u32x4*)(rp + 32) = pack8(hh[0], hh[1]); }
                    if (m & 1) asm volatile("" ::: "memory"); }
        } else {
        if (vt) {
            unsigned char* dst = (hs < 10) ? VTB + (size_t)(hs - 8) * ((size_t)T * 64) : VTC + (size_t)(hs - 16) * ((size_t)T * 64);
#pragma unroll
            for (int ai = 0; ai < 2; ++ai) { float rs[4];
#pragma unroll
                for (int m = 0; m < 4; ++m) rs[m] = __builtin_amdgcn_rsqf(ssl(u, row0 + ai * HALF + m * 16) * (1.0f / D) + EPS) * (VSC * RSC1);
                int vo = 4 * fr + 512 * fq; asm volatile("" : "+v"(vo));
                unsigned char* bp = dst + (size_t)(u.pm * 4 + ai * 2 + wr) * 4096 + vo;
#pragma unroll
                for (int bj = 0; bj < 2; ++bj)
#pragma unroll
                    for (int n = 0; n < 2; ++n)
#pragma unroll
                        for (int i = 0; i < 4; ++i)
                            *(unsigned*)(bp + (32 * bj + 4 * n + i) * 64) = pk4_fp8(acc[ai][bj][0][n][i] * rs[0], acc[ai][bj][1][n][i] * rs[1], acc[ai][bj][2][n][i] * rs[2], acc[ai][bj][3][n][i] * rs[3]);
                asm volatile("" ::: "memory"); }
        }
        if (!vt) {
            bf16* dst = (hs < 10) ? VB + (hs - 8) * 64 : VC + (hs - 16) * 64;
#pragma unroll
            for (int ai = 0; ai < 2; ++ai)
#pragma unroll
                for (int m = 0; m < 4; ++m) { const int row = row0 + ai * HALF + m * 16; const float rs = (__builtin_amdgcn_rsqf(ssl(u, row) * (1.0f / D) + EPS) * RSC1);
                    bf16* rp = dst + (size_t)row * 128 + 8 * fq; *(u32x4*)rp = pack8(acc[ai][0][m][0] * rs, acc[ai][0][m][1] * rs); *(u32x4*)(rp + 32) = pack8(acc[ai][1][m][0] * rs, acc[ai][1][m][1] * rs); }
        }
        }
    }
};
struct EpiMla {
    static constexpr bool PERM = true;
    bf16 *QA, *KA, *VA; const u64* ssq; const u64* sskv; const f32x2* tab32; unsigned char* VTA; bool vt; LAS unsigned char* ldsb;
    static constexpr bool HAS_PRE = EPI_PRE != 0;
    __device__ __forceinline__ void pre(const Unit& u, LAS unsigned char* lds, int wid, int lane) const {
        __builtin_amdgcn_global_load_lds((const unsigned*)((u.aux != 0 ? sskv : ssq) + (size_t)u.pm * BM) + wid * 64 + lane, (LAS unsigned*)(lds + MISC_OFF + 8192 + wid * 256), 4, 0, 0); }
    __device__ __forceinline__ float ssl(const Unit& u, const u64* g, int row) const { return HAS_PRE ? (float)(long long)(*(LAS const u64*)(ldsb + MISC_OFF + 8192 + (row - u.pm * BM) * 8)) * (1.0f / 1048576.0f) : fx_load(g + row); }
    __device__ __forceinline__ void operator()(const Acc& acc, const Unit& u, int wr, int wc, int fr, int fq) const {
        const int row0 = u.pm * BM + wr * 64 + fr, colw = u.pn * BM + wc * 32 + 8 * fq; const bool kv = (u.aux != 0);
        if (vt && kv && wc >= 2) {
#pragma unroll
            for (int ai = 0; ai < 2; ++ai) { float rs[4];
#pragma unroll
                for (int m = 0; m < 4; ++m) rs[m] = __builtin_amdgcn_rsqf(ssl(u, sskv, row0 + ai * HALF + m * 16) * (1.0f / 128) + EPS) * VSC;
                int vo = 4 * fr + 512 * fq; asm volatile("" : "+v"(vo));
                unsigned char* bp = VTA + (size_t)(u.pm * 4 + ai * 2 + wr) * 4096 + vo + 32 * (wc - 2) * 64;
#pragma unroll
                for (int bj = 0; bj < 2; ++bj) { unsigned char* hp = bp + (size_t)(2 * u.pn + bj) * ((size_t)T * 64);
#pragma unroll
                    for (int n = 0; n < 2; ++n)
#pragma unroll
                        for (int i = 0; i < 4; ++i)
                            *(unsigned*)(hp + (4 * n + i) * 64) = pk4_fp8(acc[ai][bj][0][n][i] * rs[0], acc[ai][bj][1][n][i] * rs[1], acc[ai][bj][2][n][i] * rs[2], acc[ai][bj][3][n][i] * rs[3]); }
                asm volatile("" ::: "memory"); }
            return;
        }
#pragma unroll
        for (int ai = 0; ai < 2; ++ai)
#pragma unroll
            for (int m = 0; m < 4; ++m) { const int row = row0 + ai * HALF + m * 16;
                const float rs = kv ? __builtin_amdgcn_rsqf(ssl(u, sskv, row) * (1.0f / 128) + EPS) : __builtin_amdgcn_rsqf(ssl(u, ssq, row) * (1.0f / 256) + EPS);
#pragma unroll
                for (int bj = 0; bj < 2; ++bj) { const int n0 = colw + bj * HALF; f32x4 v0 = acc[ai][bj][m][0] * rs, v1 = acc[ai][bj][m][1] * rs;
                    if (kv) { const int h = n0 >> 7, d = n0 & 127;
                        if (ATT_F8 && d < 64) *(u32x2*)((unsigned char*)KA + (size_t)row * KAP + h * 96 + d) = pk8_fp8(v0, v1);
                        else { bf16* dst = (d < 64) ? KA + (size_t)row * KAP + h * 96 + d : VA + (size_t)row * VAP + h * 64 + (d - 64); *(u32x4*)dst = pack8(v0, v1); } }
                    else if (n0 < 576) { const int h = n0 / 96, d = n0 - h * 96;
                        if (d >= 64) { const f32x2* cs = tab32 + (size_t)(row & (SEQ - 1)) * 16 + ((d - 64) >> 1); const f32x2 c0 = cs[0], c1 = cs[1], c2 = cs[2], c3 = cs[3];
                            f32x4 r0, r1; r0[0] = v0[0] * c0.x - v0[1] * c0.y; r0[1] = v0[1] * c0.x + v0[0] * c0.y; r0[2] = v0[2] * c1.x - v0[3] * c1.y; r0[3] = v0[3] * c1.x + v0[2] * c1.y;
                            r1[0] = v1[0] * c2.x - v1[1] * c2.y; r1[1] = v1[1] * c2.x + v1[0] * c2.y; r1[2] = v1[2] * c3.x - v1[3] * c3.y; r1[3] = v1[3] * c3.x + v1[2] * c3.y; v0 = r0; v1 = r1; }
                        if (ATT_F8) *(u32x2*)((unsigned char*)QA + (size_t)row * QAP + n0) = pk8_fp8(v0 * C2A, v1 * C2A);
                        else *(u32x4*)(QA + (size_t)row * QAP + n0) = pack8(v0 * C2A, v1 * C2A); } }
                if (m & 1) asm volatile("" ::: "memory"); }
    }
};
struct EpiRes {
    static constexpr bool PERM = true;
    const float* base; const bf16* baseb; float* XF; bf16* XB; u64* ss; bool accum; unsigned char* XQ; float asc;
    __device__ __forceinline__ void operator()(const Acc& acc, const Unit& u, int wr, int wc, int fr, int fq) const {
        const int row0 = u.pm * BM + wr * 64 + fr, col0 = u.pn * BM + wc * 32 + 8 * fq;
#pragma unroll
        for (int ai = 0; ai < 2; ++ai)
#pragma unroll
            for (int m = 0; m < 4; ++m) { const int row = row0 + ai * HALF + m * 16; const size_t off = (size_t)row * D + col0; float s = 0.f;
#pragma unroll
                for (int bj = 0; bj < 2; ++bj) { const size_t o = off + bj * HALF; f32x4 b0, b1;
                    if (baseb) { const u32x4 w = *(const u32x4*)(baseb + o); b0 = (f32x4){bflo(w.x), bfhi(w.x), bflo(w.y), bfhi(w.y)}; b1 = (f32x4){bflo(w.z), bfhi(w.z), bflo(w.w), bfhi(w.w)}; }
                    else { b0 = *(const f32x4*)(base + o); b1 = *(const f32x4*)(base + o + 4); }
                    const f32x4 v0 = P4_F8 ? b0 + acc[ai][bj][m][0] * asc : b0 + acc[ai][bj][m][0], v1 = P4_F8 ? b1 + acc[ai][bj][m][1] * asc : b1 + acc[ai][bj][m][1];
                    if (!X1_BF16) { *(f32x4*)(XF + o) = v0; *(f32x4*)(XF + o + 4) = v1; }
                    if (!MOE_F8 || X1_BF16) *(u32x4*)(XB + o) = pack8(v0, v1);
                    s += sq4(v0) + sq4(v1); }
                s = fq_sum(s); if (fq == 0 && accum) atomic_addf(ss + row, s);
                if (m == 3) asm volatile("" ::: "memory"); }
    }
};
struct EpiGate {
    static constexpr bool PERM = true;
    const bf16* X2; bf16* XB; const bf16* EB; const float* rs2; u64* ss; bool accum; unsigned char* XQ; LAS unsigned char* ldsb;
    static constexpr bool HAS_PRE = EPI_PRE != 0;
    __device__ __forceinline__ void pre(const Unit& u, LAS unsigned char* lds, int wid, int lane) const {
        if (wid < 4) __builtin_amdgcn_global_load_lds((const unsigned*)(rs2 + (size_t)u.pm * BM) + wid * 64 + lane, (LAS unsigned*)(lds + MISC_OFF + 8192 + wid * 256), 4, 0, 0); }
    __device__ __forceinline__ void operator()(const Acc& acc, const Unit& u, int wr, int wc, int fr, int fq) const {
        const int row0 = u.pm * BM + wr * 64 + fr, col0 = u.pn * BM + wc * 32 + 8 * fq;
#pragma unroll
        for (int ai = 0; ai < 2; ++ai)
#pragma unroll
            for (int m = 0; m < 4; ++m) { const int row = row0 + ai * HALF + m * 16; const size_t off = (size_t)row * D + col0; const float rs = (HAS_PRE ? ((LAS const float*)(ldsb + MISC_OFF + 8192))[row - u.pm * BM] : rs2[row]) * (P9_F8 ? 1.0f / WSC : 1.0f); float s = 0.f;
#pragma unroll
                for (int bj = 0; bj < 2; ++bj) { const size_t o = off + bj * HALF; const u32x4 x2 = *(const u32x4*)(X2 + o); const u32x4 e = *(const u32x4*)(EB + o); const f32x4 a0 = acc[ai][bj][m][0] * rs, a1 = acc[ai][bj][m][1] * rs;
                    f32x4 v0, v1; v0[0] = bflo(x2.x) + bflo(e.x) * sigmoidf_fast(a0[0]); v0[1] = bfhi(x2.x) + bfhi(e.x) * sigmoidf_fast(a0[1]); v0[2] = bflo(x2.y) + bflo(e.y) * sigmoidf_fast(a0[2]); v0[3] = bfhi(x2.y) + bfhi(e.y) * sigmoidf_fast(a0[3]);
                    v1[0] = bflo(x2.z) + bflo(e.z) * sigmoidf_fast(a1[0]); v1[1] = bfhi(x2.z) + bfhi(e.z) * sigmoidf_fast(a1[1]); v1[2] = bflo(x2.w) + bflo(e.w) * sigmoidf_fast(a1[2]); v1[3] = bfhi(x2.w) + bfhi(e.w) * sigmoidf_fast(a1[3]);
                    *(u32x4*)(XB + o) = pack8(v0, v1); s += sq4(v0) + sq4(v1);
                    if (P1_F8 && XQ) *(u32x2*)(XQ + o) = pk8_fp8(v0, v1); }
                s = fq_sum(s); if (fq == 0 && accum) atomic_addf(ss + row, s);
                if (m == 3) asm volatile("" ::: "memory"); }
    }
};
struct MoeTab { LAS int* P; LAS int* C; LAS int* R2E; };
__device__ __forceinline__ int ldsu(LAS int* p) { return __builtin_amdgcn_readfirstlane(*(volatile LAS int*)p); }
struct UpSched {
    MoeTab tb; const int* perm; const char* A; const char* B; int G, c;
    __device__ __forceinline__ bool next(int i, Unit& u) const {
        const int Lx = i * (G >> 3) + (c >> 3), rt = (Lx >> 3) * 8 + (c & 7), pn = Lx & 7; if (rt >= ldsu(tb.P + NE)) return false;
        const int e = ldsu(tb.R2E + rt);
        u.pm = rt; u.pn = pn; u.aux = e | ((rt - ldsu(tb.P + e)) << 8); u.A = A; u.B = B + ((size_t)e * 2048 + (size_t)pn * BM) * D * MOE_ES; return true; }
    __device__ __forceinline__ unsigned rowoff(const Unit& u, int r) const { const int e = u.aux & 255, slot = (u.aux >> 8) * BM + r; int tok = 0; if (slot < ldsu(tb.C + e)) tok = perm[e * ECAP + slot] >> 2; return (unsigned)tok * (unsigned)(D * MOE_ES); }
    __device__ __forceinline__ unsigned rowraw(const Unit& u, int r) const { const int e = u.aux & 255, slot = (u.aux >> 8) * BM + r; int pw = 0; if (slot < ldsu(tb.C + e)) pw = perm[e * ECAP + slot]; return (unsigned)pw; }
    __device__ __forceinline__ unsigned rawoff(unsigned raw) const { return (raw >> 2) * (unsigned)(D * MOE_ES); }
};
struct DownSched {
    MoeTab tb; const char* A; const char* B; int G, c;
    __device__ __forceinline__ bool next(int i, Unit& u) const {
        const int Lx = i * (G >> 3) + (c >> 3), x = c & 7, k = Lx >> 2, pn = Lx & 3, nrt = ldsu(tb.P + NE), kmax = (nrt - 1 - x) >> 3; if (nrt - 1 - x < 0 || k > kmax) return false;
        const int rt = (kmax - k) * 8 + x;
        const int e = ldsu(tb.R2E + rt);
        u.pm = rt; u.pn = pn; u.aux = e | ((rt - ldsu(tb.P + e)) << 8); u.A = A + (size_t)rt * BM * D * MOE_ES; u.B = B + ((size_t)e * D + (size_t)pn * BM) * D * MOE_ES; return true; }
    __device__ __forceinline__ unsigned rowoff(const Unit&, int r) const { return (unsigned)(r * D * MOE_ES); }
    __device__ __forceinline__ unsigned rowraw(const Unit&, int r) const { return (unsigned)(r * D * MOE_ES); }
    __device__ __forceinline__ unsigned rawoff(unsigned raw) const { return raw; }
};
struct EpiUp {
    static constexpr bool PERM = true;
    bf16* ACT; const float* rsl; const float* bup; MoeTab tb; LAS unsigned char* ldsb;
    static constexpr bool HAS_PRE = (EPI_PRE != 0) && (MOE_F8 != 0);
    __device__ __forceinline__ void pre(const Unit& u, LAS unsigned char* lds, int wid, int lane) const {
        const int e = u.aux & 255; if (wid < 4) __builtin_amdgcn_global_load_lds((const unsigned*)(bup + (size_t)e * 2048 + u.pn * BM + wid * 64 + lane), (LAS unsigned*)(lds + MISC_OFF + 8192 + wid * 256), 4, 0, 0);
    }
    __device__ __forceinline__ void operator()(const Acc& acc, const Unit& u, int wr, int wc, int fr, int fq) const {
        const int e = u.aux & 255, mt = u.aux >> 8, cnt = ldsu(tb.C + e); const int colh = wc * 32 + 8 * fq;
        const float* bp = bup + (size_t)e * 2048 + u.pn * BM + colh; LAS const float* sb = (LAS const float*)(ldsb + MISC_OFF + 8192) + colh;
        const f32x4 bg0 = HAS_PRE ? *(LAS const f32x4*)sb : *(const f32x4*)bp, bg1 = HAS_PRE ? *(LAS const f32x4*)(sb + 4) : *(const f32x4*)(bp + 4), bl0 = HAS_PRE ? *(LAS const f32x4*)(sb + HALF) : *(const f32x4*)(bp + HALF), bl1 = HAS_PRE ? *(LAS const f32x4*)(sb + HALF + 4) : *(const f32x4*)(bp + HALF + 4);
#pragma unroll
        for (int ai = 0; ai < 2; ++ai)
#pragma unroll
            for (int m = 0; m < 4; ++m) { const int r = ai * HALF + wr * 64 + m * 16 + fr, slot = mt * BM + r; float rs = 1.0f; if (MOE_F8) rs = WSC_INV; else if (slot < cnt) rs = rsl[e * ECAP + slot];
                f32x4 g[2], li[2], o[2]; g[0] = acc[ai][0][m][0] * rs + bg0; g[1] = acc[ai][0][m][1] * rs + bg1; li[0] = acc[ai][1][m][0] * rs + bl0; li[1] = acc[ai][1][m][1] * rs + bl1;
#pragma unroll
                for (int n = 0; n < 2; ++n)
#pragma unroll
                    for (int i = 0; i < 4; ++i) { const float xg = fminf(g[n][i], 7.0f), xl = fminf(fmaxf(li[n][i], -7.0f), 7.0f); o[n][i] = xg * sigmoidf_fast(1.702f * xg) * (xl + 1.0f); }
                if (MOE_F8) { u32x2 w; w.x = pk4_fp8(o[0][0], o[0][1], o[0][2], o[0][3]); w.y = pk4_fp8(o[1][0], o[1][1], o[1][2], o[1][3]); *(u32x2*)((unsigned char*)ACT + (size_t)(u.pm * BM + r) * D + u.pn * HALF + colh) = w; }
                else *(u32x4*)(ACT + (size_t)(u.pm * BM + r) * D + u.pn * HALF + colh) = pack8(o[0], o[1]); }
    }
};
struct EpiDown {
    static constexpr bool PERM = true; static constexpr bool PERM16 = Y_F8 != 0;
    bf16* Y; const float* bdn; const float* gsl; const int* perm; MoeTab tb; LAS unsigned char* ldsb;
    static constexpr bool HAS_PRE = (EPI_PRE != 0) && (Y_F8 != 0);
    __device__ __forceinline__ void pre(const Unit& u, LAS unsigned char* lds, int wid, int lane) const {
        const int e = u.aux & 255, mt = u.aux >> 8; LAS unsigned char* st = lds + MISC_OFF + 8192;
        if (wid < 4) { __builtin_amdgcn_global_load_lds((const unsigned*)(perm + e * ECAP + mt * BM + wid * 64 + lane), (LAS unsigned*)(st + wid * 256), 4, 0, 0);
                       __builtin_amdgcn_global_load_lds((const unsigned*)(bdn + (size_t)e * D + u.pn * BM + wid * 64 + lane), (LAS unsigned*)(st + 2048 + wid * 256), 4, 0, 0); }
        else __builtin_amdgcn_global_load_lds((const unsigned*)(gsl + e * ECAP + mt * BM + (wid - 4) * 64 + lane), (LAS unsigned*)(st + 1024 + (wid - 4) * 256), 4, 0, 0);
    }
    __device__ __forceinline__ void operator()(const Acc& acc, const Unit& u, int wr, int wc, int fr, int fq) const {
        const int e = u.aux & 255, mt = u.aux >> 8, cnt = ldsu(tb.C + e);
        if (PERM16) {
            const int col0 = u.pn * BM + wc * 64 + 16 * fq; const float* bp = bdn + (size_t)e * D + col0; f32x4 b[2][2]; LAS const unsigned char* st = ldsb + MISC_OFF + 8192;
#pragma unroll
            for (int bj = 0; bj < 2; ++bj) { if (HAS_PRE) { b[bj][0] = *(LAS const f32x4*)(st + 2048 + (wc * 64 + 16 * fq + bj * 8) * 4); b[bj][1] = *(LAS const f32x4*)(st + 2048 + (wc * 64 + 16 * fq + bj * 8 + 4) * 4); } else { b[bj][0] = *(const f32x4*)(bp + bj * 8); b[bj][1] = *(const f32x4*)(bp + bj * 8 + 4); } }
#pragma unroll
            for (int ai = 0; ai < 2; ++ai)
#pragma unroll
                for (int m = 0; m < 4; ++m) { const int r = ai * HALF + wr * 64 + m * 16 + fr, slot = mt * BM + r;
                    if (slot < cnt) { const int pair = HAS_PRE ? ((LAS const int*)st)[r] : perm[e * ECAP + slot]; const float gt = (HAS_PRE ? ((LAS const float*)(st + 1024))[r] : gsl[e * ECAP + slot]) * YSC; const float ws = MOE_F8 ? WSC_INV : 1.0f;
                        const u32x2 lo = pk8_fp8((acc[ai][0][m][0] * ws + b[0][0]) * gt, (acc[ai][0][m][1] * ws + b[0][1]) * gt), hh = pk8_fp8((acc[ai][1][m][0] * ws + b[1][0]) * gt, (acc[ai][1][m][1] * ws + b[1][1]) * gt);
                        *(u32x4*)((unsigned char*)Y + (size_t)pair * D + col0) = (u32x4){lo.x, lo.y, hh.x, hh.y}; } }
            return;
        }
        const int col0 = u.pn * BM + wc * 32 + 8 * fq;
        const float* bp = bdn + (size_t)e * D + col0; f32x4 b[2][2];
#pragma unroll
        for (int bj = 0; bj < 2; ++bj) { b[bj][0] = *(const f32x4*)(bp + bj * HALF); b[bj][1] = *(const f32x4*)(bp + bj * HALF + 4); }
#pragma unroll
        for (int ai = 0; ai < 2; ++ai)
#pragma unroll
            for (int m = 0; m < 4; ++m) { const int r = ai * HALF + wr * 64 + m * 16 + fr, slot = mt * BM + r;
                if (slot < cnt) { const int pair = perm[e * ECAP + slot]; const float gt = gsl[e * ECAP + slot] * (Y_F8 ? YSC : 1.0f); bf16* rowp = Y + (size_t)pair * D + col0; unsigned char* rowq = (unsigned char*)Y + (size_t)pair * D + col0;
#pragma unroll
                    for (int bj = 0; bj < 2; ++bj) { const float ws = MOE_F8 ? WSC_INV : 1.0f; const f32x4 y0 = (acc[ai][bj][m][0] * ws + b[bj][0]) * gt, y1 = (acc[ai][bj][m][1] * ws + b[bj][1]) * gt;
                        if (Y_F8) *(u32x2*)(rowq + bj * HALF) = pk8_fp8(y0, y1); else *(u32x4*)(rowp + bj * HALF) = pack8(y0, y1); } } }
    }
};
struct MlaSched {
    const char* Z; const char* Wq; const char* Wkv; int G, c;
    __device__ __forceinline__ bool next(int i, Unit& u) const {
        const int L = i * G + c; if (L >= 768) return false;
        const int kind = L / 384, rem = L - kind * 384, pm = rem / 3, pn = rem - pm * 3;
        u.pm = pm; u.pn = pn; u.aux = kind; u.A = Z + (size_t)pm * BM * ZQ * 2 + (kind ? 256 : 0); u.B = (kind ? Wkv : Wq) + (size_t)pn * BM * 256 * 2; return true; }
    __device__ __forceinline__ unsigned rowoff(const Unit&, int r) const { return (unsigned)(r * ZQ * 2); }
    __device__ __forceinline__ unsigned rowraw(const Unit&, int r) const { return (unsigned)(r * ZQ * 2); }
    __device__ __forceinline__ unsigned rawoff(unsigned raw) const { return raw; }
};
}

namespace at {
typedef LAS const char* lds_cptr;
__device__ __forceinline__ int crow(int r, int hi) { return (r & 3) + 8 * (r >> 2) + 4 * hi; }
__device__ __forceinline__ void glds16(const void* gsrc, unsigned lds_dst) { unsigned keep;
    asm volatile("s_mov_b32 %0, m0\n\ts_mov_b32 m0, %2\n\ts_nop 0\n\tglobal_load_lds_dwordx4 %1, off\n\ts_mov_b32 m0, %0" : "=&s"(keep) : "v"(gsrc), "s"(lds_dst) : "memory"); }
#define AT_WAIT_BAR(N) asm volatile("s_waitcnt vmcnt(" #N ") lgkmcnt(0)\n\ts_barrier" ::: "memory")
#define AT_MX3(a, b, c) __builtin_fmaxf(__builtin_fmaxf((a), (b)), (c))
__device__ __forceinline__ float rowmax(const f32x16& p0, const f32x16& p1) {
    float a = AT_MX3(p0[0], p0[1], p1[0]), b = AT_MX3(p0[2], p0[3], p1[1]); a = AT_MX3(a, p1[2], p1[3]);
#pragma unroll
    for (int r = 4; r < 16; r += 4) { a = AT_MX3(a, p0[r], p0[r + 1]); b = AT_MX3(b, p0[r + 2], p0[r + 3]); a = AT_MX3(a, p1[r], p1[r + 1]); b = AT_MX3(b, p1[r + 2], p1[r + 3]); }
    const float m = __builtin_fmaxf(a, b); auto rr = __builtin_amdgcn_permlane32_swap(__float_as_uint(m), __float_as_uint(m), false, false);
    return __builtin_fmaxf(__uint_as_float(rr[0]), __uint_as_float(rr[1]));
}
template <int DKC> __device__ __forceinline__ void qkt(f32x16& p0, f32x16& p1, lds_cptr Kslot, const bf16x8* qr, int r32, int hi) {
    lds_cptr kb = Kslot + hi * 1024 + r32 * 16; const f32x16 z = {};
#pragma unroll
    for (int d0 = 0; d0 < DKC; ++d0) {
        const bf16x8 b0 = *(const LAS bf16x8*)(kb + d0 * 2048), b1 = *(const LAS bf16x8*)(kb + d0 * 2048 + 512);
        if (d0 == 0) { p0 = __builtin_amdgcn_mfma_f32_32x32x16_bf16(b0, qr[0], z, 0, 0, 0); p1 = __builtin_amdgcn_mfma_f32_32x32x16_bf16(b1, qr[0], z, 0, 0, 0); }
        else { p0 = __builtin_amdgcn_mfma_f32_32x32x16_bf16(b0, qr[d0], p0, 0, 0, 0); p1 = __builtin_amdgcn_mfma_f32_32x32x16_bf16(b1, qr[d0], p1, 0, 0, 0); } }
}
__device__ __forceinline__ void pv(f32x16* o, int vb, bf16x8 pa0, bf16x8 pa1, bf16x8 pa2, bf16x8 pa3) {
#pragma unroll
    for (int d0 = 0; d0 < 2; ++d0) { s16x4 lo[4], hi[4];
#pragma unroll
        for (int ks = 0; ks < 4; ++ks) {
            asm volatile("ds_read_b64_tr_b16 %0,%1 offset:%c2" : "=&v"(lo[ks]) : "v"(vb), "i"(d0 * 4096 + ks * 1024) : "memory");
            asm volatile("ds_read_b64_tr_b16 %0,%1 offset:%c2" : "=&v"(hi[ks]) : "v"(vb), "i"(d0 * 4096 + ks * 1024 + 512) : "memory"); }
        asm volatile("s_waitcnt lgkmcnt(0)" ::: "memory"); __builtin_amdgcn_sched_barrier(0);
#define AT_PK(k) (bf16x8){lo[k][0], lo[k][1], lo[k][2], lo[k][3], hi[k][0], hi[k][1], hi[k][2], hi[k][3]}
        o[d0] = __builtin_amdgcn_mfma_f32_32x32x16_bf16(pa0, AT_PK(0), o[d0], 0, 0, 0);
        o[d0] = __builtin_amdgcn_mfma_f32_32x32x16_bf16(pa1, AT_PK(1), o[d0], 0, 0, 0);
        o[d0] = __builtin_amdgcn_mfma_f32_32x32x16_bf16(pa2, AT_PK(2), o[d0], 0, 0, 0);
        o[d0] = __builtin_amdgcn_mfma_f32_32x32x16_bf16(pa3, AT_PK(3), o[d0], 0, 0, 0);
#undef AT_PK
    }
}
template <int DKC> struct Lay { static constexpr int KSLOT = DKC * 2048, LDS_K = 0, LDS_V = 3 * KSLOT, LDS_WS = LDS_V + 3 * 8192, LDS_OST = LDS_WS + NWAVES * 256, BYTES = LDS_OST + NWAVES * 4096; };
template <int DKC, int MODE>
__device__ __forceinline__ void attn_unit(const bf16* Qu, int qp, const bf16* Kh, int kp, const bf16* Vh, int vp, bf16* Ou, int op, int t0, int t1, int qpos0, float sinkl2, char* shm) {
    typedef Lay<DKC> LY;
    const int tid = opaque_tid(), lane = tid & 63, r32 = lane & 31, hi = lane >> 5; const int wid = __builtin_amdgcn_readfirstlane(tid >> 6);
    const unsigned lds0 = (unsigned)(uintptr_t)shm;
    const lds_cptr shm3 = (lds_cptr)shm;
    LAS float* wsf = (LAS float*)(shm3 + LY::LDS_WS) + wid * 64;
    const bf16* Qw = Qu + (size_t)(wid * 32) * qp;
    const bool k2 = (wid + 8 < 2 * DKC);
    const bf16* ksrc = Kh + (size_t)lane * kp + wid * 8;
    const bf16* vsrc = Vh + (size_t)(16 * (wid & 3) + (lane >> 2)) * vp + (wid >> 2) * 32 + (lane & 3) * 8;
    const unsigned kdst = lds0 + LY::LDS_K + wid * 1024, vdst = lds0 + LY::LDS_V + wid * 1024;
#define AT_DMA(t, s) do { glds16(ksrc + (size_t)(t) * 64 * kp, (unsigned)__builtin_amdgcn_readfirstlane(kdst + (s) * LY::KSLOT)); \
        if (k2) glds16(ksrc + (size_t)(t) * 64 * kp + 64, (unsigned)__builtin_amdgcn_readfirstlane(kdst + (s) * LY::KSLOT + 8192)); \
        glds16(vsrc + (size_t)(t) * 64 * vp, (unsigned)__builtin_amdgcn_readfirstlane(vdst + (s) * 8192)); } while (0)
    const int vb0 = (int)(lds0 + LY::LDS_V) + ((lane >> 4) & 1) * 32 + (lane & 3) * 8 + (4 * hi + ((lane & 15) >> 2)) * 64;
    bf16x8 qr[DKC];
#pragma unroll
    for (int d0 = 0; d0 < DKC; ++d0) qr[d0] = *(const bf16x8*)(Qw + (size_t)r32 * qp + d0 * 16 + hi * 8);
    AT_DMA(t0, 0);
    float mrun = -INFINITY, l = 0.f; f32x16 o[2]; o[0] = f32x16{}; o[1] = f32x16{};
    const int qpos = qpos0 + wid * 32 + r32;
    int sl = 0;
    for (int t = t0; t < t1; ++t) {
        const bool more = (t + 1 < t1); const int sn = (sl == 2) ? 0 : sl + 1;
        if (more) { AT_DMA(t + 1, sn); if (k2) AT_WAIT_BAR(3); else AT_WAIT_BAR(2); } else AT_WAIT_BAR(0);
        f32x16 p0, p1;
        qkt<DKC>(p0, p1, shm3 + LY::LDS_K + sl * LY::KSLOT, qr, r32, hi);
        if (MODE == 1) { const int kb = t * 64 + 4 * hi;
#pragma unroll
            for (int r = 0; r < 16; ++r) { const int d0 = kb + (r & 3) + 8 * (r >> 2) - qpos, d1 = d0 + 32; if (d0 > 128 || d0 < -128) p0[r] = -INFINITY; if (d1 > 128 || d1 < -128) p1[r] = -INFINITY; } }
        const float rm = rowmax(p0, p1), mnew = __builtin_fmaxf(mrun, rm), mref = (mnew == -INFINITY) ? 0.f : mnew;
        const float alpha = __builtin_amdgcn_exp2f(mrun - mref); mrun = mnew;
        float s = 0.f;
#pragma unroll
        for (int r = 0; r < 16; ++r) { p0[r] = __builtin_amdgcn_exp2f(p0[r] - mref); p1[r] = __builtin_amdgcn_exp2f(p1[r] - mref); s += p0[r] + p1[r]; }
        l = l * alpha + s;
        if (__any(alpha != 1.0f)) { if (hi == 0) wsf[r32] = alpha; LDS_WAIT();
#pragma unroll
            for (int r = 0; r < 16; ++r) { const float f = wsf[crow(r, hi)]; o[0][r] *= f; o[1][r] *= f; } }
        u32x4 pw0, pw1, pw2, pw3;
        pw0 = (u32x4){cvt_pk_bf16(p0[0], p0[1]), cvt_pk_bf16(p0[2], p0[3]), cvt_pk_bf16(p0[4], p0[5]), cvt_pk_bf16(p0[6], p0[7])};
        pw1 = (u32x4){cvt_pk_bf16(p0[8], p0[9]), cvt_pk_bf16(p0[10], p0[11]), cvt_pk_bf16(p0[12], p0[13]), cvt_pk_bf16(p0[14], p0[15])};
        pw2 = (u32x4){cvt_pk_bf16(p1[0], p1[1]), cvt_pk_bf16(p1[2], p1[3]), cvt_pk_bf16(p1[4], p1[5]), cvt_pk_bf16(p1[6], p1[7])};
        pw3 = (u32x4){cvt_pk_bf16(p1[8], p1[9]), cvt_pk_bf16(p1[10], p1[11]), cvt_pk_bf16(p1[12], p1[13]), cvt_pk_bf16(p1[14], p1[15])};
        __builtin_amdgcn_sched_barrier(0);
        pv(o, vb0 + sl * 8192, __builtin_bit_cast(bf16x8, pw0), __builtin_bit_cast(bf16x8, pw1), __builtin_bit_cast(bf16x8, pw2), __builtin_bit_cast(bf16x8, pw3));
        sl = sn;
    }
    { auto rr = __builtin_amdgcn_permlane32_swap(__float_as_uint(l), __float_as_uint(l), false, false); l = __uint_as_float(rr[0]) + __uint_as_float(rr[1]); }
    if (MODE == 1) l += __builtin_amdgcn_exp2f(sinkl2 - mrun);
    if (hi == 0) wsf[32 + r32] = l; LDS_WAIT();
    float rli[16];
#pragma unroll
    for (int r = 0; r < 16; ++r) rli[r] = __builtin_amdgcn_rcpf(wsf[32 + crow(r, hi)]);
    bf16* Ow = Ou + (size_t)(wid * 32) * op;
    { LAS bf16* stg = (LAS bf16*)(shm3 + LY::LDS_OST) + wid * 2048;
#pragma unroll
        for (int r = 0; r < 16; ++r) { const int orow = crow(r, hi);
#pragma unroll
            for (int d0 = 0; d0 < 2; ++d0) stg[orow * 64 + d0 * 32 + r32] = (bf16)(cvt_pk_bf16(o[d0][r] * rli[r], 0.f) & 0xffffu); }
        LDS_WAIT();
#pragma unroll
        for (int i = 0; i < 4; ++i) { const int row = i * 8 + (lane >> 3), ch = lane & 7; const u32x4 v = *(const LAS u32x4*)(stg + row * 64 + ch * 8); *(u32x4*)(Ow + (size_t)row * op + ch * 8) = v; } }
    asm volatile("s_waitcnt lgkmcnt(0)\n\ts_barrier" ::: "memory");
#undef AT_DMA
}
typedef short v4i16_t __attribute__((ext_vector_type(4)));
__device__ __forceinline__ s16x4 vtr(lds_cptr p) { return __builtin_bit_cast(s16x4, __builtin_amdgcn_ds_read_tr16_b64_v4i16((LAS v4i16_t*)p)); }
template <int DKC> struct LayP { static constexpr int KSLOT = DKC * 2048, NS = 4, LDS_K = 0, LDS_V = NS * KSLOT, LDS_WS = LDS_V + NS * 8192, LDS_OST = LDS_WS + NWAVES * 256, BYTES = LDS_OST + NWAVES * 4096; };
#define AT_BAR_L() asm volatile("s_waitcnt lgkmcnt(0)\n\ts_barrier" ::: "memory")
template <int DKC, int MODE>
__device__ __forceinline__ void attn_unit_pp(const bf16* Qu, int qp, const bf16* Kh, int kp, const bf16* Vh, int vp, bf16* Ou, int op, int t0, int t1, int qpos0, float sinkl2, char* shm) {
    typedef LayP<DKC> LY; constexpr float THR = 8.0f;
    static_assert(LY::BYTES <= RING_BYTES, "attention LDS");
    const int tid = opaque_tid(), lane = tid & 63, r32 = lane & 31, hi = lane >> 5; const int wid = __builtin_amdgcn_readfirstlane(tid >> 6);
    const bool hb = (wid >= 4);
    const unsigned lds0 = (unsigned)(uintptr_t)shm;
    const lds_cptr shm3 = (lds_cptr)shm;
    LAS float* wsf = (LAS float*)(shm3 + LY::LDS_WS) + wid * 64;
    const bf16* Qw = Qu + (size_t)(wid * 32) * qp;
    const bool k2 = (wid + 8 < 2 * DKC);
    const bf16* ksrc = Kh + (size_t)lane * kp + wid * 8;
    const bf16* vsrc = Vh + (size_t)(16 * (wid & 3) + (lane >> 2)) * vp + (wid >> 2) * 32 + (lane & 3) * 8;
    const unsigned kdst = lds0 + LY::LDS_K + wid * 1024, vdst = lds0 + LY::LDS_V + wid * 1024;
#define AT_ISSUE(s) do { const int s_ = (s); if (s_ < t1) { const int sl_ = (s_ - t0) & 3; \
        glds16(ksrc + (size_t)s_ * 64 * kp, (unsigned)__builtin_amdgcn_readfirstlane(kdst + sl_ * LY::KSLOT)); \
        if (k2) glds16(ksrc + (size_t)s_ * 64 * kp + 64, (unsigned)__builtin_amdgcn_readfirstlane(kdst + sl_ * LY::KSLOT + 8192)); \
        glds16(vsrc + (size_t)s_ * 64 * vp, (unsigned)__builtin_amdgcn_readfirstlane(vdst + sl_ * 8192)); } } while (0)
#define AT_WAITBAR(young) do { if ((young) < t1) { if (k2) AT_WAIT_BAR(3); else AT_WAIT_BAR(2); } else AT_WAIT_BAR(0); } while (0)
    const int vb0 = (int)(lds0 + LY::LDS_V) + ((lane >> 4) & 1) * 32 + (lane & 3) * 8 + (4 * hi + ((lane & 15) >> 2)) * 64;
    bf16x8 qr[DKC];
#pragma unroll
    for (int d0 = 0; d0 < DKC; ++d0) qr[d0] = *(const bf16x8*)(Qw + (size_t)r32 * qp + d0 * 16 + hi * 8);
    AT_ISSUE(t0); AT_ISSUE(t0 + 1);
    float mhat = 0.f, l = 0.f; f32x16 o[2]; o[0] = f32x16{}; o[1] = f32x16{}; f32x16 negm = f32x16{};
    const int qpos = qpos0 + wid * 32 + r32;
    const int n = t1 - t0;
    AT_WAITBAR(t0 + 1);
    if (hb) { AT_ISSUE(t0 + 2); AT_BAR_L(); }
    u32x4 pw0 = {}, pw1 = {}, pw2 = {}, pw3 = {}; bf16x8 vf[8];
#pragma unroll
    for (int q = 0; q < 8; ++q) vf[q] = bf16x8{};
    for (int j = 0; j < n; ++j) {
        const int i = t0 + j, sl = j & 3;
        if (!hb) AT_ISSUE(i + 2);
        f32x16 p0, p1;
        { lds_cptr kb = shm3 + LY::LDS_K + sl * LY::KSLOT + hi * 1024 + r32 * 16; bf16x8 kf[2 * DKC];
#pragma unroll
          for (int d0 = 0; d0 < DKC; ++d0) { kf[2 * d0] = *(const LAS bf16x8*)(kb + d0 * 2048); kf[2 * d0 + 1] = *(const LAS bf16x8*)(kb + d0 * 2048 + 512); }
          __builtin_amdgcn_s_setprio(1);
          if (j > 0) {
#pragma unroll
              for (int ks = 0; ks < 4; ++ks) { const bf16x8 pa = __builtin_bit_cast(bf16x8, ks == 0 ? pw0 : ks == 1 ? pw1 : ks == 2 ? pw2 : pw3);
                  o[0] = __builtin_amdgcn_mfma_f32_32x32x16_bf16(pa, vf[ks], o[0], 0, 0, 0); o[1] = __builtin_amdgcn_mfma_f32_32x32x16_bf16(pa, vf[4 + ks], o[1], 0, 0, 0); } }
#pragma unroll
          for (int d0 = 0; d0 < DKC; ++d0) {
              if (d0 == 0) { p0 = __builtin_amdgcn_mfma_f32_32x32x16_bf16(kf[0], qr[0], negm, 0, 0, 0); p1 = __builtin_amdgcn_mfma_f32_32x32x16_bf16(kf[1], qr[0], negm, 0, 0, 0); }
              else { p0 = __builtin_amdgcn_mfma_f32_32x32x16_bf16(kf[2 * d0], qr[d0], p0, 0, 0, 0); p1 = __builtin_amdgcn_mfma_f32_32x32x16_bf16(kf[2 * d0 + 1], qr[d0], p1, 0, 0, 0); } }
          __builtin_amdgcn_s_setprio(0); }
        if (hb) AT_WAITBAR(i + 2); else AT_BAR_L();
        if (hb) AT_ISSUE(i + 3);
        { lds_cptr vp = shm3 + LY::LDS_V + sl * 8192 + ((lane >> 4) & 1) * 32 + (lane & 3) * 8 + (4 * hi + ((lane & 15) >> 2)) * 64;
#pragma unroll
          for (int q = 0; q < 8; ++q) { const s16x4 lo = vtr(vp + (q >> 2) * 4096 + (q & 3) * 1024), hh = vtr(vp + (q >> 2) * 4096 + (q & 3) * 1024 + 512); vf[q] = (bf16x8){lo[0], lo[1], lo[2], lo[3], hh[0], hh[1], hh[2], hh[3]}; } }
        if (MODE == 1) { const int kb = i * 64 + 4 * hi;
#pragma unroll
            for (int r = 0; r < 16; ++r) { const int d0 = kb + (r & 3) + 8 * (r >> 2) - qpos, d1 = d0 + 32; if (d0 > 128 || d0 < -128) p0[r] = -INFINITY; if (d1 > 128 || d1 < -128) p1[r] = -INFINITY; } }
        { const float rm = rowmax(p0, p1);
          if (j == 0 || __any(rm > THR)) {
              float dl = (j == 0) ? rm : __builtin_fmaxf(rm, 0.f); if (dl == -INFINITY) dl = 0.f;
              mhat += dl;
#pragma unroll
              for (int r = 0; r < 16; ++r) { p0[r] -= dl; p1[r] -= dl; }
#pragma unroll
              for (int r = 0; r < 16; ++r) negm[r] = -mhat;
              if (j > 0) { const float f = __builtin_amdgcn_exp2f(-dl); l *= f; if (hi == 0) wsf[r32] = f; LDS_WAIT();
#pragma unroll
                  for (int r = 0; r < 16; ++r) { const float g = wsf[crow(r, hi)]; o[0][r] *= g; o[1][r] *= g; } } } }
        { float sa = 0.f, sb = 0.f;
#pragma unroll
          for (int r = 0; r < 16; ++r) { p0[r] = __builtin_amdgcn_exp2f(p0[r]); p1[r] = __builtin_amdgcn_exp2f(p1[r]); sa += p0[r]; sb += p1[r]; }
          l += sa + sb; }
        pw0 = (u32x4){cvt_pk_bf16(p0[0], p0[1]), cvt_pk_bf16(p0[2], p0[3]), cvt_pk_bf16(p0[4], p0[5]), cvt_pk_bf16(p0[6], p0[7])};
        pw1 = (u32x4){cvt_pk_bf16(p0[8], p0[9]), cvt_pk_bf16(p0[10], p0[11]), cvt_pk_bf16(p0[12], p0[13]), cvt_pk_bf16(p0[14], p0[15])};
        pw2 = (u32x4){cvt_pk_bf16(p1[0], p1[1]), cvt_pk_bf16(p1[2], p1[3]), cvt_pk_bf16(p1[4], p1[5]), cvt_pk_bf16(p1[6], p1[7])};
        pw3 = (u32x4){cvt_pk_bf16(p1[8], p1[9]), cvt_pk_bf16(p1[10], p1[11]), cvt_pk_bf16(p1[12], p1[13]), cvt_pk_bf16(p1[14], p1[15])};
        if (!hb) AT_WAITBAR(i + 2); else AT_BAR_L();
    }
    __builtin_amdgcn_s_setprio(1);
#pragma unroll
    for (int ks = 0; ks < 4; ++ks) { const bf16x8 pa = __builtin_bit_cast(bf16x8, ks == 0 ? pw0 : ks == 1 ? pw1 : ks == 2 ? pw2 : pw3);
        o[0] = __builtin_amdgcn_mfma_f32_32x32x16_bf16(pa, vf[ks], o[0], 0, 0, 0); o[1] = __builtin_amdgcn_mfma_f32_32x32x16_bf16(pa, vf[4 + ks], o[1], 0, 0, 0); }
    __builtin_amdgcn_s_setprio(0);
    if (!hb) AT_BAR_L();
    { auto rr = __builtin_amdgcn_permlane32_swap(__float_as_uint(l), __float_as_uint(l), false, false); l = __uint_as_float(rr[0]) + __uint_as_float(rr[1]); }
    if (MODE == 1) l += __builtin_amdgcn_exp2f(sinkl2 - mhat);
    if (hi == 0) wsf[32 + r32] = l; LDS_WAIT();
    float rli[16];
#pragma unroll
    for (int r = 0; r < 16; ++r) rli[r] = __builtin_amdgcn_rcpf(wsf[32 + crow(r, hi)]);
    bf16* Ow = Ou + (size_t)(wid * 32) * op;
    { LAS bf16* stg = (LAS bf16*)(shm3 + LY::LDS_OST) + wid * 2048;
#pragma unroll
        for (int r = 0; r < 16; ++r) { const int orow = crow(r, hi);
#pragma unroll
            for (int d0 = 0; d0 < 2; ++d0) stg[orow * 64 + d0 * 32 + r32] = (bf16)(cvt_pk_bf16(o[d0][r] * rli[r], 0.f) & 0xffffu); }
        LDS_WAIT();
#pragma unroll
        for (int i = 0; i < 4; ++i) { const int row = i * 8 + (lane >> 3), ch = lane & 7; const u32x4 v = *(const LAS u32x4*)(stg + row * 64 + ch * 8); *(u32x4*)(Ow + (size_t)row * op + ch * 8) = v; } }
    AT_BAR_L();
#undef AT_ISSUE
#undef AT_WAITBAR
}
typedef int i32x8 __attribute__((ext_vector_type(8)));
template <int DKS> struct LayP8 { static constexpr int KSLOT = DKS * 4096, NS = 4, LDS_K = 0, LDS_V = NS * KSLOT, LDS_WS = LDS_V + NS * 8192, LDS_OST = LDS_WS + NWAVES * 256, BYTES = LDS_OST + NWAVES * 4096; };
template <int DKS, int NCH, int MODE>
__device__ __forceinline__ void attn_unit_f8(const unsigned char* Qu, int qp, const unsigned char* Kh, int kp, const bf16* Vh, int vp, bf16* Ou, int op, int t0, int t1, int qpos0, float sinkl2, char* shm) {
    typedef LayP8<DKS> LY; constexpr float THR = 8.0f;
    static_assert(LY::BYTES <= RING_BYTES, "attention LDS");
    const int tid = opaque_tid(), lane = tid & 63, r32 = lane & 31, hi = lane >> 5; const int wid = __builtin_amdgcn_readfirstlane(tid >> 6);
    const bool hb = (wid >= 4);
    const unsigned lds0 = (unsigned)(uintptr_t)shm;
    const lds_cptr shm3 = (lds_cptr)shm;
    LAS float* wsf = (LAS float*)(shm3 + LY::LDS_WS) + wid * 64;
    const unsigned char* Qw = Qu + (size_t)(wid * 32) * qp;
    const bool kw = (wid < NCH);
    const unsigned char* ksrc = Kh + (size_t)lane * kp + wid * 16;
    const bf16* vsrc = Vh + (size_t)(16 * (wid & 3) + (lane >> 2)) * vp + (wid >> 2) * 32 + (lane & 3) * 8;
    const unsigned kdst = lds0 + LY::LDS_K + wid * 1024, vdst = lds0 + LY::LDS_V + wid * 1024;
#define AT_ISSUE(s) do { const int s_ = (s); if (s_ < t1) { const int sl_ = (s_ - t0) & 3; \
        if (kw) glds16(ksrc + (size_t)s_ * 64 * kp, (unsigned)__builtin_amdgcn_readfirstlane(kdst + sl_ * LY::KSLOT)); \
        glds16(vsrc + (size_t)s_ * 64 * vp, (unsigned)__builtin_amdgcn_readfirstlane(vdst + sl_ * 8192)); } } while (0)
#define AT_WAITBAR(young) do { if ((young) < t1) { if (kw) AT_WAIT_BAR(2); else AT_WAIT_BAR(1); } else AT_WAIT_BAR(0); } while (0)
    if (NCH < DKS * 4) {
        for (int b = tid * 16; b < 4 * (DKS * 4 - NCH) * 1024; b += NWAVES * 64 * 16) { const int sl_ = b / ((DKS * 4 - NCH) * 1024), rem = b % ((DKS * 4 - NCH) * 1024);
            *(LAS u32x4*)(shm3 + LY::LDS_K + sl_ * LY::KSLOT + NCH * 1024 + rem) = zero4(); } }
    i32x8 qf[DKS];
#pragma unroll
    for (int s = 0; s < DKS; ++s) { const unsigned char* qa = Qw + (size_t)r32 * qp + s * 64 + hi * 32;
        if (s * 64 + hi * 32 < NCH * 16) { const u32x4 lo = *(const u32x4*)qa, hh = *(const u32x4*)(qa + 16); qf[s] = __builtin_bit_cast(i32x8, __builtin_shufflevector(lo, hh, 0, 1, 2, 3, 4, 5, 6, 7)); }
        else qf[s] = i32x8{}; }
    AT_ISSUE(t0); AT_ISSUE(t0 + 1);
    float mhat = 0.f, l = 0.f; f32x16 o[2]; o[0] = f32x16{}; o[1] = f32x16{}; f32x16 negm = f32x16{};
    const unsigned one_sc = 0x7f7f7f7fu;
    const int qpos = qpos0 + wid * 32 + r32;
    const int n = t1 - t0;
    AT_WAITBAR(t0 + 1);
    if (hb) { AT_ISSUE(t0 + 2); AT_BAR_L(); }
    u32x4 pw0 = {}, pw1 = {}, pw2 = {}, pw3 = {}; bf16x8 vf[8];
#pragma unroll
    for (int q = 0; q < 8; ++q) vf[q] = bf16x8{};
    for (int j = 0; j < n; ++j) {
        const int i = t0 + j, sl = j & 3;
        if (!hb) AT_ISSUE(i + 2);
        f32x16 p0 = negm, p1 = negm;
        { lds_cptr kb = shm3 + LY::LDS_K + sl * LY::KSLOT + hi * 2048 + r32 * 16; i32x8 kf[DKS][2];
#pragma unroll
          for (int s = 0; s < DKS; ++s)
#pragma unroll
              for (int h2 = 0; h2 < 2; ++h2) { const u32x4 lo = *(const LAS u32x4*)(kb + s * 4096 + h2 * 512), hh = *(const LAS u32x4*)(kb + s * 4096 + 1024 + h2 * 512);
                  kf[s][h2] = __builtin_bit_cast(i32x8, __builtin_shufflevector(lo, hh, 0, 1, 2, 3, 4, 5, 6, 7)); }
          __builtin_amdgcn_s_setprio(1);
          if (j > 0) {
#pragma unroll
              for (int ks = 0; ks < 4; ++ks) { const bf16x8 pa = __builtin_bit_cast(bf16x8, ks == 0 ? pw0 : ks == 1 ? pw1 : ks == 2 ? pw2 : pw3);
                  o[0] = __builtin_amdgcn_mfma_f32_32x32x16_bf16(pa, vf[ks], o[0], 0, 0, 0); o[1] = __builtin_amdgcn_mfma_f32_32x32x16_bf16(pa, vf[4 + ks], o[1], 0, 0, 0); } }
#pragma unroll
          for (int s = 0; s < DKS; ++s) {
              asm volatile("v_mfma_scale_f32_32x32x64_f8f6f4 %0, %1, %2, %0, %3, %3 op_sel_hi:[0,0,0]" : "+v"(p0) : "v"(kf[s][0]), "v"(qf[s]), "v"(one_sc));
              asm volatile("v_mfma_scale_f32_32x32x64_f8f6f4 %0, %1, %2, %0, %3, %3 op_sel_hi:[0,0,0]" : "+v"(p1) : "v"(kf[s][1]), "v"(qf[s]), "v"(one_sc)); }
          __builtin_amdgcn_s_setprio(0); }
        if (hb) AT_WAITBAR(i + 2); else AT_BAR_L();
        if (hb) AT_ISSUE(i + 3);
        asm volatile("s_nop 15\n\ts_nop 3" : "+v"(p0), "+v"(p1));
        { lds_cptr vp_ = shm3 + LY::LDS_V + sl * 8192 + ((lane >> 4) & 1) * 32 + (lane & 3) * 8 + (4 * hi + ((lane & 15) >> 2)) * 64;
#pragma unroll
          for (int q = 0; q < 8; ++q) { const s16x4 lo = vtr(vp_ + (q >> 2) * 4096 + (q & 3) * 1024), hh = vtr(vp_ + (q >> 2) * 4096 + (q & 3) * 1024 + 512); vf[q] = (bf16x8){lo[0], lo[1], lo[2], lo[3], hh[0], hh[1], hh[2], hh[3]}; } }
        if (MODE == 1) { const int kb2 = i * 64 + 4 * hi;
#pragma unroll
            for (int r = 0; r < 16; ++r) { const int d0 = kb2 + (r & 3) + 8 * (r >> 2) - qpos, d1 = d0 + 32; if (d0 > 128 || d0 < -128) p0[r] = -INFINITY; if (d1 > 128 || d1 < -128) p1[r] = -INFINITY; } }
        { const float rm = rowmax(p0, p1);
          if (j == 0 || __any(rm > THR)) {
              float dl = (j == 0) ? rm : __builtin_fmaxf(rm, 0.f); if (dl == -INFINITY) dl = 0.f;
              mhat += dl;
#pragma unroll
              for (int r = 0; r < 16; ++r) { p0[r] -= dl; p1[r] -= dl; }
#pragma unroll
              for (int r = 0; r < 16; ++r) negm[r] = -mhat;
              if (j > 0) { const float f = __builtin_amdgcn_exp2f(-dl); l *= f; if (hi == 0) wsf[r32] = f; LDS_WAIT();
#pragma unroll
                  for (int r = 0; r < 16; ++r) { const float g = wsf[crow(r, hi)]; o[0][r] *= g; o[1][r] *= g; } } } }
        { float sa = 0.f, sb = 0.f;
#pragma unroll
          for (int r = 0; r < 16; ++r) { p0[r] = __builtin_amdgcn_exp2f(p0[r]); p1[r] = __builtin_amdgcn_exp2f(p1[r]); sa += p0[r]; sb += p1[r]; }
          l += sa + sb; }
        pw0 = (u32x4){cvt_pk_bf16(p0[0], p0[1]), cvt_pk_bf16(p0[2], p0[3]), cvt_pk_bf16(p0[4], p0[5]), cvt_pk_bf16(p0[6], p0[7])};
        pw1 = (u32x4){cvt_pk_bf16(p0[8], p0[9]), cvt_pk_bf16(p0[10], p0[11]), cvt_pk_bf16(p0[12], p0[13]), cvt_pk_bf16(p0[14], p0[15])};
        pw2 = (u32x4){cvt_pk_bf16(p1[0], p1[1]), cvt_pk_bf16(p1[2], p1[3]), cvt_pk_bf16(p1[4], p1[5]), cvt_pk_bf16(p1[6], p1[7])};
        pw3 = (u32x4){cvt_pk_bf16(p1[8], p1[9]), cvt_pk_bf16(p1[10], p1[11]), cvt_pk_bf16(p1[12], p1[13]), cvt_pk_bf16(p1[14], p1[15])};
        if (!hb) AT_WAITBAR(i + 2); else AT_BAR_L();
    }
    __builtin_amdgcn_s_setprio(1);
#pragma unroll
    for (int ks = 0; ks < 4; ++ks) { const bf16x8 pa = __builtin_bit_cast(bf16x8, ks == 0 ? pw0 : ks == 1 ? pw1 : ks == 2 ? pw2 : pw3);
        o[0] = __builtin_amdgcn_mfma_f32_32x32x16_bf16(pa, vf[ks], o[0], 0, 0, 0); o[1] = __builtin_amdgcn_mfma_f32_32x32x16_bf16(pa, vf[4 + ks], o[1], 0, 0, 0); }
    __builtin_amdgcn_s_setprio(0);
    if (!hb) AT_BAR_L();
    { auto rr = __builtin_amdgcn_permlane32_swap(__float_as_uint(l), __float_as_uint(l), false, false); l = __uint_as_float(rr[0]) + __uint_as_float(rr[1]); }
    if (MODE == 1) l += __builtin_amdgcn_exp2f(sinkl2 - mhat);
    if (hi == 0) wsf[32 + r32] = l; LDS_WAIT();
    float rli[16];
#pragma unroll
    for (int r = 0; r < 16; ++r) rli[r] = __builtin_amdgcn_rcpf(wsf[32 + crow(r, hi)]);
    bf16* Ow = Ou + (size_t)(wid * 32) * op;
    { LAS bf16* stg = (LAS bf16*)(shm3 + LY::LDS_OST) + wid * 2048;
#pragma unroll
        for (int r = 0; r < 16; ++r) { const int orow = crow(r, hi);
#pragma unroll
            for (int d0 = 0; d0 < 2; ++d0) stg[orow * 64 + d0 * 32 + r32] = (bf16)(cvt_pk_bf16(o[d0][r] * rli[r], 0.f) & 0xffffu); }
        LDS_WAIT();
#pragma unroll
        for (int i2 = 0; i2 < 4; ++i2) { const int row = i2 * 8 + (lane >> 3), ch = lane & 7; const u32x4 v = *(const LAS u32x4*)(stg + row * 64 + ch * 8); *(u32x4*)(Ow + (size_t)row * op + ch * 8) = v; } }
    AT_BAR_L();
#undef AT_ISSUE
#undef AT_WAITBAR
}
struct AUnit { const unsigned char* Qu; const unsigned char* Kh; const bf16* Vh; bf16* Ou; int t0, t1, qpos0; float sinkl2; };
template <int DKS, int NCH, int MODE, class Dec>
__device__ __forceinline__ void attn_loop_f8(int idx0, int idx_end, int G, const Dec& dec, int qp, int kp, int vp, int op, char* shm) {
    if (idx0 >= idx_end) return;
    typedef LayP8<DKS> LY; constexpr float THR = 8.0f;
    static_assert(LY::BYTES <= RING_BYTES, "attention LDS");
    const int tid = opaque_tid(), lane = tid & 63, r32 = lane & 31, hi = lane >> 5; const int wid = __builtin_amdgcn_readfirstlane(tid >> 6);
    const bool hb = (wid >= 4);
    const unsigned lds0 = (unsigned)(uintptr_t)shm;
    const lds_cptr shm3 = (lds_cptr)shm;
    LAS float* wsf = (LAS float*)(shm3 + LY::LDS_WS) + wid * 64;
    const bool kw = (wid < NCH);
    AUnit u = dec(idx0); int t0 = u.t0, t1 = u.t1;
    const size_t koff = (size_t)lane * kp + wid * 16, voff = (size_t)(16 * (wid & 3) + (lane >> 2)) * vp + (wid >> 2) * 32 + (lane & 3) * 8;
    const unsigned char* ksrc = u.Kh + koff; const bf16* vsrc = u.Vh + voff;
    const unsigned kdst = lds0 + LY::LDS_K + wid * 1024, vdst = lds0 + LY::LDS_V + wid * 1024;
#define AT_ISSUE(s) do { const int s_ = (s); if (s_ < t1) { const int sl_ = (s_ - t0) & 3; \
        if (kw) glds16(ksrc + (size_t)s_ * 64 * kp, (unsigned)__builtin_amdgcn_readfirstlane(kdst + sl_ * LY::KSLOT)); \
        glds16(vsrc + (size_t)s_ * 64 * vp, (unsigned)__builtin_amdgcn_readfirstlane(vdst + sl_ * 8192)); } } while (0)
#define AT_WAITBAR(young) do { if ((young) < t1) { if (kw) AT_WAIT_BAR(2); else AT_WAIT_BAR(1); } else AT_WAIT_BAR(0); } while (0)
    if (NCH < DKS * 4) {
        for (int b = tid * 16; b < 4 * (DKS * 4 - NCH) * 1024; b += NWAVES * 64 * 16) { const int sl_ = b / ((DKS * 4 - NCH) * 1024), rem = b % ((DKS * 4 - NCH) * 1024);
            *(LAS u32x4*)(shm3 + LY::LDS_K + sl_ * LY::KSLOT + NCH * 1024 + rem) = zero4(); } }
    i32x8 qf[DKS], qfn[DKS];
#define AT_QLOAD(dst, Qu_) do { const unsigned char* Qw_ = (Qu_) + (size_t)(wid * 32) * qp; _Pragma("unroll") for (int s = 0; s < DKS; ++s) { const unsigned char* qa = Qw_ + (size_t)r32 * qp + s * 64 + hi * 32; \
        if (s * 64 + hi * 32 < NCH * 16) { const u32x4 lo = *(const u32x4*)qa, hh = *(const u32x4*)(qa + 16); (dst)[s] = __builtin_bit_cast(i32x8, __builtin_shufflevector(lo, hh, 0, 1, 2, 3, 4, 5, 6, 7)); } \
        else (dst)[s] = i32x8{}; } } while (0)
    AT_QLOAD(qf, u.Qu);
    AT_ISSUE(t0); AT_ISSUE(t0 + 1);
    const unsigned one_sc = 0x7f7f7f7fu;
    for (int idx = idx0;;) {
    const int idxn = idx + G; const bool has_next = idxn < idx_end; AUnit un = u;
    float mhat = 0.f, l = 0.f; f32x16 o[2]; o[0] = f32x16{}; o[1] = f32x16{}; f32x16 negm = f32x16{};
    const int qpos = u.qpos0 + wid * 32 + r32;
    const int n = t1 - t0;
    AT_WAITBAR(t0 + 1);
    if (hb) { AT_ISSUE(t0 + 2); AT_BAR_L(); }
    u32x4 pw0 = {}, pw1 = {}, pw2 = {}, pw3 = {}; bf16x8 vf[8];
#pragma unroll
    for (int q = 0; q < 8; ++q) vf[q] = bf16x8{};
    for (int j = 0; j < n; ++j) {
        const int i = t0 + j, sl = j & 3;
        if (!hb) AT_ISSUE(i + 2);
        f32x16 p0 = negm, p1 = negm;
        { lds_cptr kb = shm3 + LY::LDS_K + sl * LY::KSLOT + hi * 2048 + r32 * 16; i32x8 kf[DKS][2];
#pragma unroll
          for (int s = 0; s < DKS; ++s)
#pragma unroll
              for (int h2 = 0; h2 < 2; ++h2) { const u32x4 lo = *(const LAS u32x4*)(kb + s * 4096 + h2 * 512), hh = *(const LAS u32x4*)(kb + s * 4096 + 1024 + h2 * 512);
                  kf[s][h2] = __builtin_bit_cast(i32x8, __builtin_shufflevector(lo, hh, 0, 1, 2, 3, 4, 5, 6, 7)); }
          __builtin_amdgcn_s_setprio(1);
          if (j > 0) {
#pragma unroll
              for (int ks = 0; ks < 4; ++ks) { const bf16x8 pa = __builtin_bit_cast(bf16x8, ks == 0 ? pw0 : ks == 1 ? pw1 : ks == 2 ? pw2 : pw3);
                  o[0] = __builtin_amdgcn_mfma_f32_32x32x16_bf16(pa, vf[ks], o[0], 0, 0, 0); o[1] = __builtin_amdgcn_mfma_f32_32x32x16_bf16(pa, vf[4 + ks], o[1], 0, 0, 0); } }
#pragma unroll
          for (int s = 0; s < DKS; ++s) {
              asm volatile("v_mfma_scale_f32_32x32x64_f8f6f4 %0, %1, %2, %0, %3, %3 op_sel_hi:[0,0,0]" : "+v"(p0) : "v"(kf[s][0]), "v"(qf[s]), "v"(one_sc));
              asm volatile("v_mfma_scale_f32_32x32x64_f8f6f4 %0, %1, %2, %0, %3, %3 op_sel_hi:[0,0,0]" : "+v"(p1) : "v"(kf[s][1]), "v"(qf[s]), "v"(one_sc)); }
          __builtin_amdgcn_s_setprio(0); }
        if (hb) AT_WAITBAR(i + 2); else AT_BAR_L();
        if (hb) AT_ISSUE(i + 3);
        asm volatile("s_nop 15\n\ts_nop 3" : "+v"(p0), "+v"(p1));
        { lds_cptr vp_ = shm3 + LY::LDS_V + sl * 8192 + ((lane >> 4) & 1) * 32 + (lane & 3) * 8 + (4 * hi + ((lane & 15) >> 2)) * 64;
#pragma unroll
          for (int q = 0; q < 8; ++q) { const s16x4 lo = vtr(vp_ + (q >> 2) * 4096 + (q & 3) * 1024), hh = vtr(vp_ + (q >> 2) * 4096 + (q & 3) * 1024 + 512); vf[q] = (bf16x8){lo[0], lo[1], lo[2], lo[3], hh[0], hh[1], hh[2], hh[3]}; } }
        if (MODE == 1) { const int kb2 = i * 64 + 4 * hi;
#pragma unroll
            for (int r = 0; r < 16; ++r) { const int d0 = kb2 + (r & 3) + 8 * (r >> 2) - qpos, d1 = d0 + 32; if (d0 > 128 || d0 < -128) p0[r] = -INFINITY; if (d1 > 128 || d1 < -128) p1[r] = -INFINITY; } }
        { const float rm = rowmax(p0, p1);
          if (j == 0 || __any(rm > THR)) {
              float dl = (j == 0) ? rm : __builtin_fmaxf(rm, 0.f); if (dl == -INFINITY) dl = 0.f;
              mhat += dl;
#pragma unroll
              for (int r = 0; r < 16; ++r) { p0[r] -= dl; p1[r] -= dl; }
#pragma unroll
              for (int r = 0; r < 16; ++r) negm[r] = -mhat;
              if (j > 0) { const float f = __builtin_amdgcn_exp2f(-dl); l *= f; if (hi == 0) wsf[r32] = f; LDS_WAIT();
#pragma unroll
                  for (int r = 0; r < 16; ++r) { const float g = wsf[crow(r, hi)]; o[0][r] *= g; o[1][r] *= g; } } } }
        { float sa = 0.f, sb = 0.f;
#pragma unroll
          for (int r = 0; r < 16; ++r) { p0[r] = __builtin_amdgcn_exp2f(p0[r]); p1[r] = __builtin_amdgcn_exp2f(p1[r]); sa += p0[r]; sb += p1[r]; }
          l += sa + sb; }
        pw0 = (u32x4){cvt_pk_bf16(p0[0], p0[1]), cvt_pk_bf16(p0[2], p0[3]), cvt_pk_bf16(p0[4], p0[5]), cvt_pk_bf16(p0[6], p0[7])};
        pw1 = (u32x4){cvt_pk_bf16(p0[8], p0[9]), cvt_pk_bf16(p0[10], p0[11]), cvt_pk_bf16(p0[12], p0[13]), cvt_pk_bf16(p0[14], p0[15])};
        pw2 = (u32x4){cvt_pk_bf16(p1[0], p1[1]), cvt_pk_bf16(p1[2], p1[3]), cvt_pk_bf16(p1[4], p1[5]), cvt_pk_bf16(p1[6], p1[7])};
        pw3 = (u32x4){cvt_pk_bf16(p1[8], p1[9]), cvt_pk_bf16(p1[10], p1[11]), cvt_pk_bf16(p1[12], p1[13]), cvt_pk_bf16(p1[14], p1[15])};
        if (!hb) AT_WAITBAR(i + 2); else AT_BAR_L();
    }
#define AT_SEAM() do { if (has_next) { un = dec(idxn); ksrc = un.Kh + koff; vsrc = un.Vh + voff; t0 = un.t0; t1 = un.t1; AT_ISSUE(t0); AT_ISSUE(t0 + 1); AT_QLOAD(qfn, un.Qu); } } while (0)
    if (hb) AT_SEAM();
    __builtin_amdgcn_s_setprio(1);
#pragma unroll
    for (int ks = 0; ks < 4; ++ks) { const bf16x8 pa = __builtin_bit_cast(bf16x8, ks == 0 ? pw0 : ks == 1 ? pw1 : ks == 2 ? pw2 : pw3);
        o[0] = __builtin_amdgcn_mfma_f32_32x32x16_bf16(pa, vf[ks], o[0], 0, 0, 0); o[1] = __builtin_amdgcn_mfma_f32_32x32x16_bf16(pa, vf[4 + ks], o[1], 0, 0, 0); }
    __builtin_amdgcn_s_setprio(0);
    if (!hb) { AT_BAR_L(); AT_SEAM(); }
    { auto rr = __builtin_amdgcn_permlane32_swap(__float_as_uint(l), __float_as_uint(l), false, false); l = __uint_as_float(rr[0]) + __uint_as_float(rr[1]); }
    if (MODE == 1) l += __builtin_amdgcn_exp2f(u.sinkl2 - mhat);
    if (hi == 0) wsf[32 + r32] = l; LDS_WAIT();
    float rli[16];
#pragma unroll
    for (int r = 0; r < 16; ++r) rli[r] = __builtin_amdgcn_rcpf(wsf[32 + crow(r, hi)]);
    bf16* Ow = u.Ou + (size_t)(wid * 32) * op;
    { LAS bf16* stg = (LAS bf16*)(shm3 + LY::LDS_OST) + wid * 2048;
#pragma unroll
        for (int r = 0; r < 16; ++r) { const int orow = crow(r, hi);
#pragma unroll
            for (int d0 = 0; d0 < 2; ++d0) stg[orow * 64 + d0 * 32 + r32] = (bf16)(cvt_pk_bf16(o[d0][r] * rli[r], 0.f) & 0xffffu); }
        LDS_WAIT();
#pragma unroll
        for (int i2 = 0; i2 < 4; ++i2) { const int row = i2 * 8 + (lane >> 3), ch = lane & 7; const u32x4 v = *(const LAS u32x4*)(stg + row * 64 + ch * 8); *(u32x4*)(Ow + (size_t)row * op + ch * 8) = v; } }
    AT_BAR_L();
    if (!has_next) break;
    u = un; idx = idxn;
#pragma unroll
    for (int s = 0; s < DKS; ++s) qf[s] = qfn[s];
    }
#undef AT_SEAM
#undef AT_QLOAD
#undef AT_ISSUE
#undef AT_WAITBAR
}
template <int DKS, int NCH, int MODE, class Dec, bool PRIO = true, bool PP = true>
__device__ __forceinline__ void attn_loop_f8v(int idx0, int idx_end, int G, const Dec& dec, int qp, int kp, int op, char* shm) {
    if (idx0 >= idx_end) return;
    typedef LayP8<DKS> LY; constexpr float SH = 3.0f, SMAX = 448.0f;
    static_assert(LY::BYTES <= RING_BYTES, "attention LDS");
    const int tid = opaque_tid(), lane = tid & 63, r32 = lane & 31, hi = lane >> 5; const int wid = __builtin_amdgcn_readfirstlane(tid >> 6);
    const bool hb = PP && (wid >= 4);
    const unsigned lds0 = (unsigned)(uintptr_t)shm;
    const lds_cptr shm3 = (lds_cptr)shm;
    LAS float* wsf = (LAS float*)(shm3 + LY::LDS_WS) + wid * 64;
    const bool kw = (wid < NCH), vw = (wid >= 4);
    AUnit u = dec(idx0); int t0 = u.t0, t1 = u.t1;
    const int krow = 16 * (lane & 3) + 8 * ((lane >> 2) & 1) + ((lane & 31) >> 3) + 4 * (lane >> 5);
    const int vrow = ((wid & 3) * 64 + lane) >> 2;
    const size_t koff = (size_t)krow * kp + wid * 16, voff = (size_t)vrow * 64 + (((lane & 3) ^ ((vrow >> 2) & 3)) << 4);
    const unsigned char* ksrc = u.Kh + koff; const unsigned char* vsrc = (const unsigned char*)u.Vh + voff;
    const unsigned kdst = lds0 + LY::LDS_K + wid * 1024, vdst = lds0 + LY::LDS_V + (wid & 3) * 1024;
#define AT_ISSUE(s) do { const int s_ = (s); if (s_ < t1) { const int sl_ = (s_ - t0) & 3; \
        if (kw) glds16(ksrc + (size_t)s_ * 64 * kp, (unsigned)__builtin_amdgcn_readfirstlane(kdst + sl_ * LY::KSLOT)); \
        if (vw) glds16(vsrc + (size_t)s_ * 4096, (unsigned)__builtin_amdgcn_readfirstlane(vdst + sl_ * 8192)); } } while (0)
#define AT_WAITBAR(young) do { if ((young) < t1) { if (kw && vw) AT_WAIT_BAR(2); else if (kw || vw) AT_WAIT_BAR(1); else AT_WAIT_BAR(0); } else AT_WAIT_BAR(0); } while (0)
    if (NCH < DKS * 4) {
        for (int b = tid * 16; b < 4 * (DKS * 4 - NCH) * 1024; b += NWAVES * 64 * 16) { const int sl_ = b / ((DKS * 4 - NCH) * 1024), rem = b % ((DKS * 4 - NCH) * 1024);
            *(LAS u32x4*)(shm3 + LY::LDS_K + sl_ * LY::KSLOT + NCH * 1024 + rem) = zero4(); } }
    i32x8 qf[DKS], qfn[DKS];
#define AT_QLOAD(dst, Qu_) do { const unsigned char* Qw_ = (Qu_) + (size_t)(wid * 32) * qp; _Pragma("unroll") for (int s = 0; s < DKS; ++s) { const unsigned char* qa = Qw_ + (size_t)r32 * qp + s * 64 + hi * 32; \
        if (s * 64 + hi * 32 < NCH * 16) { const u32x4 lo = *(const u32x4*)qa, hh = *(const u32x4*)(qa + 16); (dst)[s] = __builtin_bit_cast(i32x8, __builtin_shufflevector(lo, hh, 0, 1, 2, 3, 4, 5, 6, 7)); } \
        else (dst)[s] = i32x8{}; } } while (0)
    AT_QLOAD(qf, u.Qu);
    AT_ISSUE(t0); AT_ISSUE(t0 + 1);
    const unsigned one_sc = 0x7f7f7f7fu;
    for (int idx = idx0;;) {
    const int idxn = idx + G; const bool has_next = idxn < idx_end; AUnit un = u;
    float mhat = 0.f, l = 0.f; f32x16 o[2]; o[0] = f32x16{}; o[1] = f32x16{}; f32x16 negm;
#pragma unroll
    for (int r = 0; r < 16; ++r) negm[r] = SH;
    const int qpos = u.qpos0 + wid * 32 + r32;
    const int n = t1 - t0;
    AT_WAITBAR(t0 + 1);
    if (hb) { AT_ISSUE(t0 + 2); AT_BAR_L(); }
    i32x8 pw = i32x8{}, vf[2]; vf[0] = i32x8{}; vf[1] = i32x8{};
    for (int j = 0; j < n; ++j) {
        const int i = t0 + j, sl = j & 3;
        if (PP && !hb) AT_ISSUE(i + 2);
        f32x16 p0, p1;
        { lds_cptr kb = shm3 + LY::LDS_K + sl * LY::KSLOT + hi * 2048 + r32 * 16; i32x8 kf[DKS][2];
#pragma unroll
          for (int s = 0; s < DKS; ++s)
#pragma unroll
              for (int h2 = 0; h2 < 2; ++h2) { const u32x4 lo = *(const LAS u32x4*)(kb + s * 4096 + h2 * 512), hh = *(const LAS u32x4*)(kb + s * 4096 + 1024 + h2 * 512);
                  kf[s][h2] = __builtin_bit_cast(i32x8, __builtin_shufflevector(lo, hh, 0, 1, 2, 3, 4, 5, 6, 7)); }
          if (!PP) AT_ISSUE(i + 2);
          if (PRIO) __builtin_amdgcn_s_setprio(1);
          if (PP && j > 0) {
              asm volatile("v_mfma_scale_f32_32x32x64_f8f6f4 %0, %1, %2, %0, %3, %3 op_sel_hi:[0,0,0]" : "+v"(o[0]) : "v"(pw), "v"(vf[0]), "v"(one_sc));
              asm volatile("v_mfma_scale_f32_32x32x64_f8f6f4 %0, %1, %2, %0, %3, %3 op_sel_hi:[0,0,0]" : "+v"(o[1]) : "v"(pw), "v"(vf[1]), "v"(one_sc)); }
          asm volatile("v_mfma_scale_f32_32x32x64_f8f6f4 %0, %1, %2, %3, %4, %4 op_sel_hi:[0,0,0]" : "=&v"(p0) : "v"(kf[0][0]), "v"(qf[0]), "v"(negm), "v"(one_sc));
          asm volatile("v_mfma_scale_f32_32x32x64_f8f6f4 %0, %1, %2, %3, %4, %4 op_sel_hi:[0,0,0]" : "=&v"(p1) : "v"(kf[0][1]), "v"(qf[0]), "v"(negm), "v"(one_sc));
#pragma unroll
          for (int s = 1; s < DKS; ++s) {
              asm volatile("v_mfma_scale_f32_32x32x64_f8f6f4 %0, %1, %2, %0, %3, %3 op_sel_hi:[0,0,0]" : "+v"(p0) : "v"(kf[s][0]), "v"(qf[s]), "v"(one_sc));
              asm volatile("v_mfma_scale_f32_32x32x64_f8f6f4 %0, %1, %2, %0, %3, %3 op_sel_hi:[0,0,0]" : "+v"(p1) : "v"(kf[s][1]), "v"(qf[s]), "v"(one_sc)); }
          if (!PP && j > 0) {
              asm volatile("v_mfma_scale_f32_32x32x64_f8f6f4 %0, %1, %2, %0, %3, %3 op_sel_hi:[0,0,0]" : "+v"(o[0]) : "v"(pw), "v"(vf[0]), "v"(one_sc));
              asm volatile("v_mfma_scale_f32_32x32x64_f8f6f4 %0, %1, %2, %0, %3, %3 op_sel_hi:[0,0,0]" : "+v"(o[1]) : "v"(pw), "v"(vf[1]), "v"(one_sc)); }
          if (PRIO) __builtin_amdgcn_s_setprio(0); }
        if (hb) AT_WAITBAR(i + 2); else if (PP) AT_BAR_L();
        if (hb) AT_ISSUE(i + 3);
        if (PP || j == 0) asm volatile("s_nop 15\n\ts_nop 3" : "+v"(p0), "+v"(p1));
        else asm volatile("s_nop 3" : "+v"(p0), "+v"(p1));
        { lds_cptr vp_ = shm3 + LY::LDS_V + sl * 8192 + r32 * 64; const int sw = (r32 >> 2) & 3, c0 = ((2 * hi) ^ sw) << 4, c1 = ((2 * hi + 1) ^ sw) << 4;
#pragma unroll
          for (int d0 = 0; d0 < 2; ++d0) { const u32x4 lo = *(const LAS u32x4*)(vp_ + d0 * 2048 + c0), hh = *(const LAS u32x4*)(vp_ + d0 * 2048 + c1);
              vf[d0] = __builtin_bit_cast(i32x8, __builtin_shufflevector(lo, hh, 0, 1, 2, 3, 4, 5, 6, 7)); } }
        if (MODE == 1) { const int kb2 = i * 64 + 8 * hi - qpos;
#pragma unroll
            for (int r = 0; r < 16; ++r) { const int d0 = kb2 + 16 * (r & 3) + (r >> 2), d1 = d0 + 4; if (d0 > 128 || d0 < -128) p0[r] = -INFINITY; if (d1 > 128 || d1 < -128) p1[r] = -INFINITY; } }
        f32x16 e0, e1; float S;
#define AT_EXPSUM() do { _Pragma("unroll") for (int r = 0; r < 16; ++r) { e0[r] = __builtin_amdgcn_exp2f(p0[r]); e1[r] = __builtin_amdgcn_exp2f(p1[r]); } \
          f32x2 s2 = (f32x2){e0[0], e0[1]} + (f32x2){e1[0], e1[1]}; _Pragma("unroll") for (int k = 1; k < 8; ++k) { s2 += (f32x2){e0[2 * k], e0[2 * k + 1]}; s2 += (f32x2){e1[2 * k], e1[2 * k + 1]}; } S = s2.x + s2.y; } while (0)
        AT_EXPSUM();
        if (j == 0 || __any(!(S <= SMAX))) {
            const float rm = rowmax(p0, p1);
            float dl = (j == 0) ? rm - SH : __builtin_fmaxf(rm - SH, 0.f); if (dl == -INFINITY) dl = 0.f;
            mhat += dl;
#pragma unroll
            for (int r = 0; r < 16; ++r) { p0[r] -= dl; p1[r] -= dl; }
#pragma unroll
            for (int r = 0; r < 16; ++r) negm[r] = SH - mhat;
            if (j > 0) { const float f = __builtin_amdgcn_exp2f(-dl); l *= f; if (hi == 0) wsf[r32] = f; LDS_WAIT();
                if (!PP) asm volatile("s_nop 15\n\ts_nop 15\n\ts_nop 15\n\ts_nop 15\n\ts_nop 15\n\ts_nop 15\n\ts_nop 15\n\ts_nop 15\n\ts_nop 15\n\ts_nop 15" : "+v"(o[0]), "+v"(o[1]));
#pragma unroll
                for (int r = 0; r < 16; ++r) { const float g = wsf[crow(r, hi)]; o[0][r] *= g; o[1][r] *= g; } }
            AT_EXPSUM();
        }
#undef AT_EXPSUM
        l += S;
#pragma unroll
        for (int k = 0; k < 4; ++k) { pw[k] = (int)pk4_fp8(e0[4 * k], e0[4 * k + 1], e0[4 * k + 2], e0[4 * k + 3]); pw[4 + k] = (int)pk4_fp8(e1[4 * k], e1[4 * k + 1], e1[4 * k + 2], e1[4 * k + 3]); }
        if (!hb) AT_WAITBAR(i + 2); else AT_BAR_L();
    }
#define AT_SEAM() do { if (has_next) { un = dec(idxn); ksrc = un.Kh + koff; vsrc = (const unsigned char*)un.Vh + voff; t0 = un.t0; t1 = un.t1; AT_ISSUE(t0); AT_ISSUE(t0 + 1); AT_QLOAD(qfn, un.Qu); } } while (0)
    if (hb) AT_SEAM();
    if (PRIO) __builtin_amdgcn_s_setprio(1);
    asm volatile("v_mfma_scale_f32_32x32x64_f8f6f4 %0, %1, %2, %0, %3, %3 op_sel_hi:[0,0,0]" : "+v"(o[0]) : "v"(pw), "v"(vf[0]), "v"(one_sc));
    asm volatile("v_mfma_scale_f32_32x32x64_f8f6f4 %0, %1, %2, %0, %3, %3 op_sel_hi:[0,0,0]" : "+v"(o[1]) : "v"(pw), "v"(vf[1]), "v"(one_sc));
    if (PRIO) __builtin_amdgcn_s_setprio(0);
    asm volatile("s_nop 15\n\ts_nop 3" : "+v"(o[0]), "+v"(o[1]));
    if (!hb) { AT_BAR_L(); AT_SEAM(); }
    { auto rr = __builtin_amdgcn_permlane32_swap(__float_as_uint(l), __float_as_uint(l), false, false); l = __uint_as_float(rr[0]) + __uint_as_float(rr[1]); }
    if (MODE == 1) l += __builtin_amdgcn_exp2f(u.sinkl2 - mhat + SH);
    if (hi == 0) wsf[32 + r32] = l; LDS_WAIT();
    float rli[16];
#pragma unroll
    for (int r = 0; r < 16; ++r) rli[r] = __builtin_amdgcn_rcpf(wsf[32 + crow(r, hi)]) * ((P4_F8 ? MSC : 1.0f) / VSC);
    if (P4_F8) {
        unsigned char* Ow = (unsigned char*)u.Ou + (size_t)(wid * 32) * op; LAS unsigned char* stg = (LAS unsigned char*)(shm3 + LY::LDS_OST) + wid * 4096;
#pragma unroll
        for (int r = 0; r < 16; ++r) { const int orow = crow(r, hi); const int w = __builtin_amdgcn_cvt_pk_fp8_f32(o[0][r] * rli[r], o[1][r] * rli[r], 0, false);
            stg[orow * 64 + r32] = (unsigned char)(w & 0xff); stg[orow * 64 + 32 + r32] = (unsigned char)((w >> 8) & 0xff); }
        LDS_WAIT();
#pragma unroll
        for (int i2 = 0; i2 < 2; ++i2) { const int row = i2 * 16 + (lane >> 2), ch = lane & 3; const u32x4 v = *(const LAS u32x4*)(stg + row * 64 + ch * 16); *(u32x4*)(Ow + (size_t)row * op + ch * 16) = v; }
    } else {
    bf16* Ow = u.Ou + (size_t)(wid * 32) * op;
    { LAS bf16* stg = (LAS bf16*)(shm3 + LY::LDS_OST) + wid * 2048;
#pragma unroll
        for (int r = 0; r < 16; ++r) { const int orow = crow(r, hi);
#pragma unroll
            for (int d0 = 0; d0 < 2; ++d0) stg[orow * 64 + d0 * 32 + r32] = (bf16)(cvt_pk_bf16(o[d0][r] * rli[r], 0.f) & 0xffffu); }
        LDS_WAIT();
#pragma unroll
        for (int i2 = 0; i2 < 4; ++i2) { const int row = i2 * 8 + (lane >> 3), ch = lane & 7; const u32x4 v = *(const LAS u32x4*)(stg + row * 64 + ch * 8); *(u32x4*)(Ow + (size_t)row * op + ch * 8) = v; } }
    }
    AT_BAR_L();
    if (!has_next) break;
    u = un; idx = idxn;
#pragma unroll
    for (int s = 0; s < DKS; ++s) qf[s] = qfn[s];
    }
#undef AT_SEAM
#undef AT_QLOAD
#undef AT_ISSUE
#undef AT_WAITBAR
}
struct DecA { const unsigned char* Q; const unsigned char* K; const bf16* V; bf16* MIX; bool vt;
    __device__ __forceinline__ AUnit operator()(int idx) const { const int b = idx / 96, h = (idx >> 4) % 6, qb = idx & 15; const size_t rb = (size_t)b * SEQ, rq = rb + qb * 256;
        AUnit u; u.Qu = Q + rq * QAP + h * 96; u.Kh = K + rb * KAP + h * 96; u.Vh = vt ? (const bf16*)((const unsigned char*)V + ((size_t)h * (T / 64) + b * 64) * 4096) : V + rb * VAP + h * 64; u.Ou = (P4_F8 && vt) ? (bf16*)((unsigned char*)MIX + rq * D + h * 64) : MIX + rq * D + h * 64; u.t0 = 0; u.t1 = SEQ / 64; u.qpos0 = qb * 256; u.sinkl2 = 0.f; return u; } };
struct DecB { const unsigned char* Q; const unsigned char* K; const bf16* V; bf16* MIX; bool vt;
    __device__ __forceinline__ AUnit operator()(int idx) const { const int b = idx / 96, h = (idx >> 4) % 6, qb = idx & 15, hk = h / 3; const size_t rb = (size_t)b * SEQ, rq = rb + qb * 256;
        AUnit u; u.Qu = Q + rq * QBP + h * 64; u.Kh = K + rb * KBP + hk * 64; u.Vh = vt ? (const bf16*)((const unsigned char*)V + ((size_t)hk * (T / 64) + b * 64) * 4096) : V + rb * VBP + hk * 64; u.Ou = (P4_F8 && vt) ? (bf16*)((unsigned char*)MIX + rq * D + 384 + h * 64) : MIX + rq * D + 384 + h * 64; u.t0 = 0; u.t1 = SEQ / 64; u.qpos0 = qb * 256; u.sinkl2 = 0.f; return u; } };
struct DecC { const unsigned char* Q; const unsigned char* K; const bf16* V; bf16* MIX; const float* sink; bool vt;
    __device__ __forceinline__ AUnit operator()(int idx) const { const int b = idx / 64, h = (idx >> 4) & 3, qb = idx & 15, hk = h >> 1; const size_t rb = (size_t)b * SEQ, rq = rb + qb * 256;
        AUnit u; u.Qu = Q + rq * QCP + h * 64; u.Kh = K + rb * KCP + hk * 64; u.Vh = vt ? (const bf16*)((const unsigned char*)V + ((size_t)hk * (T / 64) + b * 64) * 4096) : V + rb * VCP + hk * 64; u.Ou = (P4_F8 && vt) ? (bf16*)((unsigned char*)MIX + rq * D + 768 + h * 64) : MIX + rq * D + 768 + h * 64;
        u.t0 = (qb * 4 - 2 < 0) ? 0 : qb * 4 - 2; u.t1 = (qb * 4 + 6 > SEQ / 64) ? SEQ / 64 : qb * 4 + 6; u.qpos0 = qb * 256; u.sinkl2 = sink[h] * LOG2E; return u; } };
}

struct Args {
    const float *x, *p, *attn_norm, *w_in, *mla_q_norm, *mla_wq_up, *mla_kv_norm, *mla_wkv_up, *gqa_q_norm, *gqa_k_norm, *swa_sink, *w_out, *moe_norm, *router_w, *router_b,
        *w_up, *b_up, *w_down, *b_down, *ple_norm, *w_ple, *w_ple_gate, *final_norm;
    float* out; unsigned char* ws;
};
struct Ctx { LAS unsigned char* lds; int tid, lane, wave, vcu, G, gw, NGW; };

template <bool F8OUT = false, class RMap>
__device__ __forceinline__ void tr_item(const float* W, int N, bf16* WT, int ldo, int kofs, const float* gain, RMap rmap, LAS float* scr, int kb, int nb, int lane, float wsc = 1.0f) {
    const int k0 = 64 * kb, n0 = 32 * nb;
    float wv[32]; const float* src = W + (size_t)(k0 + (lane >> 5)) * N + n0 + (lane & 31);
#pragma unroll
    for (int i = 0; i < 32; ++i) wv[i] = src[(size_t)(2 * i) * N];
#pragma unroll
    for (int i = 0; i < 32; ++i) scr[(2 * i + (lane >> 5)) * 33 + (lane & 31)] = wv[i];
    LDS_WAIT(); asm volatile("" ::: "memory");
    const int c = lane & 7; float gs[8];
#pragma unroll
    for (int q = 0; q < 8; ++q) gs[q] = (gain ? gain[k0 + 8 * c + q] : 1.0f) * wsc;
#pragma unroll
    for (int j = 0; j < 4; ++j) { const int n = (lane >> 3) + 8 * j; const LAS float* s = scr + (8 * c) * 33 + n;
        if (F8OUT) { u32x2 o; o.x = pk4_fp8(s[0 * 33] * gs[0], s[1 * 33] * gs[1], s[2 * 33] * gs[2], s[3 * 33] * gs[3]); o.y = pk4_fp8(s[4 * 33] * gs[4], s[5 * 33] * gs[5], s[6 * 33] * gs[6], s[7 * 33] * gs[7]);
            *(u32x2*)((unsigned char*)WT + (size_t)rmap(n0 + n) * ldo + kofs + k0 + 8 * c) = o; }
        else { u32x4 o; o.x = cvt_pk_bf16(s[0 * 33] * gs[0], s[1 * 33] * gs[1]); o.y = cvt_pk_bf16(s[2 * 33] * gs[2], s[3 * 33] * gs[3]); o.z = cvt_pk_bf16(s[4 * 33] * gs[4], s[5 * 33] * gs[5]); o.w = cvt_pk_bf16(s[6 * 33] * gs[6], s[7 * 33] * gs[7]);
            *(u32x4*)(WT + (size_t)rmap(n0 + n) * ldo + kofs + k0 + 8 * c) = o; } }
    LDS_WAIT(); asm volatile("" ::: "memory");
}
struct MapId { __device__ __forceinline__ int operator()(int n) const { return n; } };
struct MapIn { __device__ __forceinline__ int operator()(int n) const {
    if (n < 384) return n;
    if (n < 416) { const int j = n - 384; return 384 + ((j < 16) ? 2 * j : 2 * (j - 16) + 1); }
    int hs, d; bool pairs; if (n < ZC) { const int q = n - ZB; hs = q >> 6; d = q & 63; pairs = (hs < 8); } else { const int q = n - ZC; hs = 10 + (q >> 6); d = q & 63; pairs = false; }
    const int bj = d >> 5, dd = d & 31, p = pairs ? ((dd & 15) * 2 + (dd >> 4)) : dd;
    return 256 * (2 + (hs >> 2)) + 128 * bj + 32 * (hs & 3) + p; } };
struct MapQ { __device__ __forceinline__ int operator()(int n) const { const int h = n / 96, d = n - h * 96; if (d < 64) return n; const int j = d - 64; return h * 96 + 64 + ((j < 16) ? 2 * j : 2 * (j - 16) + 1); } };
struct MapUp { __device__ __forceinline__ int operator()(int n) const { if (n < 1024) return (n >> 7) * 256 + (n & 127); const int m = n - 1024; return (m >> 7) * 256 + 128 + (m & 127); } };

__device__ __forceinline__ void zero16(bf16* base, size_t n16, const Ctx& C) {
    const u32x4 z = zero4();
    for (size_t i = (size_t)C.gw * 64 + C.lane; i < n16; i += (size_t)C.NGW * 64) ((u32x4*)base)[i] = z;
}

__device__ __forceinline__ void prologue(const Args& a, const Ctx& C) {
    unsigned char* ws = launder(a.ws);
    LAS float* scr = (LAS float*)(C.lds + C.wave * 16384);
    constexpr int I_UP = 16 * 64, I_DN = 16 * 32, I_IN = 16 * 49, I_OUT = 16 * 32, I_G = 16 * 32, I_Q = 4 * 18, I_KV = 2 * 24, I_PLE = 4 * 32;
    constexpr int N_UP = NL * NE * I_UP, N_DN = NL * NE * I_DN, N_IN = NL * I_IN, N_OUT = NL * I_OUT, N_G = NL * I_G, N_Q = NL * I_Q, N_KV = NL * I_KV, N_PLE = NL * I_PLE;
    constexpr int NITEMS = N_UP + N_DN + N_IN + N_OUT + N_G + N_Q + N_KV + N_PLE;
    for (int it = C.gw; it < NITEMS; it += C.NGW) {
        int r = it;
        if (r < N_UP) { const int le = r / I_UP, q = r - le * I_UP, l = le / NE; tr_item<MOE_F8 != 0>(a.w_up + (size_t)le * D * 2048, 2048, (bf16*)(ws + WS_WUP + (size_t)le * 2048 * D * MOE_ES), D, 0, a.moe_norm + l * D, MapUp(), scr, q / 64, q % 64, C.lane, WSC); continue; } r -= N_UP;
        if (r < N_DN) { const int le = r / I_DN, q = r - le * I_DN; tr_item<MOE_F8 != 0>(a.w_down + (size_t)le * D * D, D, (bf16*)(ws + WS_WDN + (size_t)le * D * D * MOE_ES), D, 0, nullptr, MapId(), scr, q / 32, q % 32, C.lane, WSC); continue; } r -= N_DN;
        if (r < N_IN) { const int l = r / I_IN, q = r - l * I_IN; tr_item<P1_F8 != 0>(a.w_in + (size_t)l * D * 1568, 1568, (bf16*)(ws + WS_WIN + (size_t)l * ZP * D * (P1_F8 ? 1 : 2)), D, 0, a.attn_norm + l * D, MapIn(), scr, q / 49, q % 49, C.lane, P1_F8 ? WSC : 1.0f); continue; } r -= N_IN;
        if (r < N_OUT) { const int l = r / I_OUT, q = r - l * I_OUT; tr_item<P4_F8 != 0>(a.w_out + (size_t)l * D * D, D, (bf16*)(ws + WS_WOUT + (size_t)l * D * D * (P4_F8 ? 1 : 2)), D, 0, nullptr, MapId(), scr, q / 32, q % 32, C.lane, P4_F8 ? WSC : 1.0f); continue; } r -= N_OUT;
        if (r < N_G) { const int l = r / I_G, q = r - l * I_G; tr_item<P9_F8 != 0>(a.w_ple_gate + (size_t)l * D * D, D, (bf16*)(ws + WS_WG + (size_t)l * D * D * (P9_F8 ? 1 : 2)), D, 0, a.ple_norm + l * D, MapId(), scr, q / 32, q % 32, C.lane, P9_F8 ? WSC : 1.0f); continue; } r -= N_G;
        if (r < N_Q) { const int l = r / I_Q, q = r - l * I_Q; tr_item(a.mla_wq_up + (size_t)l * 256 * 576, 576, (bf16*)(ws + WS_WQ) + (size_t)l * 768 * 256, 256, 0, a.mla_q_norm + l * 256, MapQ(), scr, q / 18, q % 18, C.lane); continue; } r -= N_Q;
        if (r < N_KV) { const int l = r / I_KV, q = r - l * I_KV; tr_item(a.mla_wkv_up + (size_t)l * 128 * 768, 768, (bf16*)(ws + WS_WKV) + (size_t)l * 768 * 256, 256, 128, a.mla_kv_norm + l * 128, MapId(), scr, q / 24, q % 24, C.lane); continue; } r -= N_KV;
        { const int l = r / I_PLE, q = r - l * I_PLE; tr_item(a.w_ple + (size_t)l * 256 * D, D, (bf16*)(ws + WS_WPLE) + (size_t)l * D * 256, 256, 0, nullptr, MapId(), scr, q / 32, q % 32, C.lane); }
    }
    for (int l = 0; l < NL; ++l) {
        constexpr int E1 = P1_F8 ? 1 : 2;
        zero16((bf16*)(ws + WS_WIN + ((size_t)l * ZP + 416) * D * E1), (size_t)96 * D * E1 / 16, C);
        zero16((bf16*)(ws + WS_WIN + ((size_t)l * ZP + 1600) * D * E1), (size_t)64 * D * E1 / 16, C);
        zero16((bf16*)(ws + WS_WIN + ((size_t)l * ZP + 1728) * D * E1), (size_t)64 * D * E1 / 16, C);
        zero16((bf16*)(ws + WS_WQ) + ((size_t)l * 768 + 576) * 256, (size_t)192 * 256 / 8, C);
    }
    for (int i = C.gw * 64 + C.lane; i < NL * 768 * 16; i += C.NGW * 64) { const int row = i >> 4, pc = i & 15; *(u32x4*)((bf16*)(ws + WS_WKV) + (size_t)row * 256 + pc * 8) = zero4(); }
    for (int m = 4 * C.gw; m < T; m += 4 * C.NGW) {
        f32x4 v[4][4]; float s[4];
#pragma unroll
        for (int q = 0; q < 4; ++q) { const f32x4* xr = (const f32x4*)(a.x + (size_t)(m + q) * D) + C.lane;
#pragma unroll
            for (int j = 0; j < 4; ++j) v[q][j] = xr[64 * j]; }
#pragma unroll
        for (int q = 0; q < 4; ++q) { s[q] = 0.f;
#pragma unroll
            for (int j = 0; j < 4; ++j) s[q] += (v[q][j][0] * v[q][j][0] + v[q][j][1] * v[q][j][1]) + (v[q][j][2] * v[q][j][2] + v[q][j][3] * v[q][j][3]);
            s[q] = wave_sum(s[q]);
            u32x2* o8 = (u32x2*)((bf16*)(ws + WS_XB) + (size_t)(m + q) * D) + C.lane;
            if (!P1_F8) { _Pragma("unroll") for (int j = 0; j < 4; ++j) { u32x2 w; w.x = cvt_pk_bf16(v[q][j][0], v[q][j][1]); w.y = cvt_pk_bf16(v[q][j][2], v[q][j][3]); o8[64 * j] = w; } }
            if (P1_F8) { unsigned* q8 = (unsigned*)(ws + WS_XQ + (size_t)(m + q) * D) + C.lane;
#pragma unroll
                for (int j = 0; j < 4; ++j) q8[64 * j] = pk4_fp8(v[q][j][0], v[q][j][1], v[q][j][2], v[q][j][3]); }
            if (C.lane == 0) __hip_atomic_store((u64*)(ws + WS_SS0) + m + q, fx_enc(s[q]), RLX_AGENT); }
    }
    for (size_t i0 = (size_t)C.gw * 256; i0 < (size_t)NL * T * 256 / 8; i0 += (size_t)C.NGW * 256) {
        f32x4 v[4][2];
#pragma unroll
        for (int q = 0; q < 4; ++q) { const size_t i = i0 + q * 64 + C.lane; v[q][0] = ((const f32x4*)a.p)[2 * i]; v[q][1] = ((const f32x4*)a.p)[2 * i + 1]; }
#pragma unroll
        for (int q = 0; q < 4; ++q) { const size_t i = i0 + q * 64 + C.lane;
            u32x4 w; w.x = cvt_pk_bf16(v[q][0][0], v[q][0][1]); w.y = cvt_pk_bf16(v[q][0][2], v[q][0][3]); w.z = cvt_pk_bf16(v[q][1][0], v[q][1][1]); w.w = cvt_pk_bf16(v[q][1][2], v[q][1][3]); ((u32x4*)(ws + WS_PB))[i] = w; }
    }
    for (int i = C.gw * 64 + C.lane; i < SEQ * 48; i += C.NGW * 64) {
        int pos, j; double ex; f32x2* dst;
        if (i < SEQ * 16) { pos = i >> 4; j = i & 15; ex = (double)j / 16.0; dst = (f32x2*)(ws + WS_TAB32) + i; }
        else { const int q = i - SEQ * 16; pos = q >> 5; j = q & 31; ex = (double)j / 32.0; dst = (f32x2*)(ws + WS_TAB64) + q; }
        const float inv = (float)exp2(-13.287712379549449 * ex);
        const float angf = (float)pos * inv;
        const double rev = (double)angf * 0.15915494309189535; const float fr = (float)(rev - floor(rev));
        *dst = (f32x2){__builtin_amdgcn_cosf(fr), __builtin_amdgcn_sinf(fr)};
    }
    for (int i = C.gw * 64 + C.lane; i < NL * D * NE; i += C.NGW * 64) { const int l = i / (D * NE), k = (i / NE) % D; ((float*)(ws + WS_WR))[i] = a.router_w[i] * a.moe_norm[l * D + k]; }
    for (int i = C.gw * 64 + C.lane; i < NL * NE * D; i += C.NGW * 64) { const int l = i / (NE * D), e = (i / D) % NE, k = i % D; const float w = a.router_w[((size_t)l * D + k) * NE + e] * a.moe_norm[l * D + k];
        const unsigned h = cvt_pk_bf16(w, 0.f) & 0xffffu; const float lo = w - __uint_as_float(h << 16);
        ((bf16*)(ws + WS_WR + 512 * 1024))[i] = (bf16)h; ((bf16*)(ws + WS_WR + 768 * 1024))[i] = (bf16)(cvt_pk_bf16(lo, 0.f) & 0xffffu); }
    for (int i = C.gw * 64 + C.lane; i < NL * NE * 2048; i += C.NGW * 64) { const int le = i / 2048, n = i % 2048; ((float*)(ws + WS_BUP))[(size_t)le * 2048 + MapUp()(n)] = a.b_up[i]; }
}
namespace gp { }
__device__ __forceinline__ float sq4g(f32x4 v) { return (v[0] * v[0] + v[1] * v[1]) + (v[2] * v[2] + v[3] * v[3]); }

__device__ __forceinline__ void rope_phase(const Args& a, const Ctx& C, int l) {
    unsigned char* ws = launder(a.ws);
    const bf16* Z = (const bf16*)(ws + WS_Z); const f32x2* tab32 = (const f32x2*)(ws + WS_TAB32); const f32x2* tab64 = (const f32x2*)(ws + WS_TAB64);
    bf16 *KA = (bf16*)(ws + WS_KA), *QB = (bf16*)(ws + WS_QB), *KB = (bf16*)(ws + WS_KB), *VB = (bf16*)(ws + WS_VB), *QC = (bf16*)(ws + WS_QC), *KC = (bf16*)(ws + WS_KC), *VC = (bf16*)(ws + WS_VC);
    const int lane = C.lane;
    const float gq = a.gqa_q_norm[l * 64 + lane], gk = a.gqa_k_norm[l * 64 + lane];
    for (int t = C.gw; t < T; t += C.NGW) {
        const int pos = t & (SEQ - 1), prow = pos >> 6, pcol = pos & 63; const bf16* zr = Z + (size_t)t * ZP;
        {
            const float v = bf2f(zr[384 + (lane & 31)]); const float pr = __shfl_xor(v, 16); const int j = lane & 15; const f32x2 cs = tab32[pos * 16 + j];
            const float o = (lane & 16) ? (v * cs.x + pr * cs.y) : (v * cs.x - pr * cs.y); const bf16 ob = (bf16)(cvt_pk_bf16(o, 0.f) & 0xffffu);
            if (lane < 32) { const int dest = 64 + 2 * j + ((lane >> 4) & 1);
#pragma unroll
                for (int h = 0; h < 6; ++h) KA[(size_t)t * KAP + h * 96 + dest] = ob; }
        }
#pragma unroll
        for (int hb = 0; hb < 10; ++hb) {
            float v = bf2f(zr[ZB + hb * 64 + lane]);
            if (hb < 8) { const float ss = wave_sum(v * v); const float n = v * __builtin_amdgcn_rsqf(ss * (1.0f / 64) + EPS) * (hb < 6 ? gq : gk);
                const float pr = __shfl_xor(n, 16); const int j = lane & 15; const f32x2 cs = tab32[((lane & 32) ? pcol : prow) * 16 + j];
                v = (lane & 16) ? (n * cs.x + pr * cs.y) : (n * cs.x - pr * cs.y); if (hb < 6) v *= C2B; }
            const bf16 ob = (bf16)(cvt_pk_bf16(v, 0.f) & 0xffffu);
            if (hb < 6) QB[(size_t)t * QBP + hb * 64 + lane] = ob; else if (hb < 8) KB[(size_t)t * KBP + (hb - 6) * 64 + lane] = ob; else VB[(size_t)t * VBP + (hb - 8) * 64 + lane] = ob;
        }
#pragma unroll
        for (int hc = 0; hc < 8; ++hc) {
            float v = bf2f(zr[ZC + hc * 64 + lane]);
            if (hc < 6) { const float pr = __shfl_xor(v, 32); const f32x2 cs = tab64[pos * 32 + (lane & 31)]; v = (lane & 32) ? (v * cs.x + pr * cs.y) : (v * cs.x - pr * cs.y); if (hc < 4) v *= C2B; }
            const bf16 ob = (bf16)(cvt_pk_bf16(v, 0.f) & 0xffffu);
            if (hc < 4) QC[(size_t)t * QCP + hc * 64 + lane] = ob; else if (hc < 6) KC[(size_t)t * KCP + (hc - 4) * 64 + lane] = ob; else VC[(size_t)t * VCP + (hc - 6) * 64 + lane] = ob;
        }
    }
}

__device__ __forceinline__ void router_phase(const Args& a, const Ctx& C, int l, bool commit) {
    unsigned char* ws = launder(a.ws);
    const float* XF = (const float*)(ws + WS_XF); const float* WR = (const float*)(ws + WS_WR) + (size_t)l * D * NE; const u64* ss1 = (const u64*)(ws + WS_CTL + (size_t)CW_SS * 4) + (size_t)(l * 4 + 2) * T;
    int* cnt = (int*)(ws + WS_CTL) + CW_CNT + l * NE; int* perm = (int*)(ws + WS_PERM); float* rsl = (float*)(ws + WS_RSL); float* gsl = (float*)(ws + WS_GSL);
    LAS float* part = (LAS float*)C.lds;
    LAS int* hist = (LAS int*)(C.lds + MISC_OFF + 1024); LAS int* base = hist + NE;
    const int lane = C.lane, r32 = lane & 31, hi = lane >> 5, tg = C.wave & 3, kh = C.wave >> 2;
    for (int blk = C.vcu; blk < T / 128; blk += C.G) {
        const int t0 = blk * 128;
        if (C.tid < NE) hist[C.tid] = 0;
        f32x16 acc = {};
        const float* xr = XF + (size_t)(t0 + tg * 32 + r32) * D + kh * 512 + hi * 4; const bf16* xrb = (const bf16*)(ws + WS_X1B) + (size_t)(t0 + tg * 32 + r32) * D + kh * 512 + hi * 4; const float* wr = WR + (size_t)(kh * 512 + hi * 4) * NE + r32;
        const float rs_l = __builtin_amdgcn_rsqf(fx_load(ss1 + t0 + tg * 32 + r32) * (1.0f / D) + EPS);
        unsigned char* xq = ws + WS_X1Q + (size_t)(t0 + tg * 32 + r32) * D + kh * 512 + hi * 4;
        if (X1_BF16) {
            const bf16* xb_ = (const bf16*)(ws + WS_X1B) + (size_t)(t0 + tg * 32 + r32) * D + kh * 512 + hi * 8;
            const bf16* wh_ = (const bf16*)(ws + WS_WR + 512 * 1024) + ((size_t)l * NE + r32) * D + kh * 512 + hi * 8; const bf16* wl_ = wh_ + (256 * 1024) / 2;
            unsigned char* xq8 = ws + WS_X1Q + (size_t)(t0 + tg * 32 + r32) * D + kh * 512 + hi * 8;
#pragma unroll 1
            for (int kb = 0; kb < 32; kb += 8) { u32x4 xb[8], ah[8], al[8];
#pragma unroll
                for (int q = 0; q < 8; ++q) { xb[q] = *(const u32x4*)(xb_ + (kb + q) * 16); ah[q] = *(const u32x4*)(wh_ + (kb + q) * 16); al[q] = *(const u32x4*)(wl_ + (kb + q) * 16); }
                __builtin_amdgcn_sched_barrier(0);
                if (MOE_F8) {
#pragma unroll
                    for (int q = 0; q < 8; ++q) { const u32x4 w = xb[q]; u32x2 o; o.x = pk4_fp8(bflo(w.x) * rs_l, bfhi(w.x) * rs_l, bflo(w.y) * rs_l, bfhi(w.y) * rs_l); o.y = pk4_fp8(bflo(w.z) * rs_l, bfhi(w.z) * rs_l, bflo(w.w) * rs_l, bfhi(w.w) * rs_l);
                        *(u32x2*)(xq8 + (kb + q) * 16) = o; } }
#pragma unroll
                for (int q = 0; q < 8; ++q) { acc = __builtin_amdgcn_mfma_f32_32x32x16_bf16(__builtin_bit_cast(bf16x8, ah[q]), __builtin_bit_cast(bf16x8, xb[q]), acc, 0, 0, 0);
                    acc = __builtin_amdgcn_mfma_f32_32x32x16_bf16(__builtin_bit_cast(bf16x8, al[q]), __builtin_bit_cast(bf16x8, xb[q]), acc, 0, 0, 0); } }
        } else {
#pragma unroll 1
        for (int kb = 0; kb < 64; kb += 8) { f32x4 xv[8]; float wv[8][4];
#pragma unroll
            for (int q = 0; q < 8; ++q) { if (X1_BF16) { const u32x2 w = *(const u32x2*)(xrb + (kb + q) * 8); xv[q] = (f32x4){bflo(w.x), bfhi(w.x), bflo(w.y), bfhi(w.y)}; } else xv[q] = *(const f32x4*)(xr + (kb + q) * 8);
#pragma unroll
                for (int i = 0; i < 4; ++i) wv[q][i] = wr[((kb + q) * 8 + i) * NE]; }
            __builtin_amdgcn_sched_barrier(0);
            if (MOE_F8) {
#pragma unroll
                for (int q = 0; q < 8; ++q) *(unsigned*)(xq + (kb + q) * 8) = pk4_fp8(xv[q][0] * rs_l, xv[q][1] * rs_l, xv[q][2] * rs_l, xv[q][3] * rs_l); }
#pragma unroll
            for (int q = 0; q < 8; ++q)
#pragma unroll
                for (int i = 0; i < 4; ++i) acc = __builtin_amdgcn_mfma_f32_32x32x2f32(wv[q][i], xv[q][i], acc, 0, 0, 0); }
        }
#pragma unroll
        for (int r = 0; r < 16; ++r) part[(kh * 128 + tg * 32 + r32) * 33 + at::crow(r, hi)] = acc[r];
        __syncthreads();
        int ek[4]; float wk[4]; int rk[4]; float rs_t = 1.0f; const int t = t0 + C.tid;
        if (C.tid < 128) {
            const float rs = __builtin_amdgcn_rsqf(fx_load(ss1 + t) * (1.0f / D) + EPS); float v[NE]; rs_t = rs;
#pragma unroll
            for (int e = 0; e < NE; ++e) v[e] = (part[C.tid * 33 + e] + part[(128 + C.tid) * 33 + e]) * rs + a.router_b[l * NE + e];
            unsigned used = 0u; float tv[4];
#pragma unroll
            for (int k = 0; k < 4; ++k) { float best = -INFINITY; int bi = 0;
#pragma unroll
                for (int e = 0; e < NE; ++e) { const bool ok = !((used >> e) & 1u) && (v[e] > best); best = ok ? v[e] : best; bi = ok ? e : bi; }
                used |= 1u << bi; ek[k] = bi; tv[k] = best; }
            float den = 0.f;
#pragma unroll
            for (int k = 0; k < 4; ++k) { wk[k] = __expf(tv[k] - tv[0]); den += wk[k]; }
            const float rd = 1.0f / den;
#pragma unroll
            for (int k = 0; k < 4; ++k) { wk[k] *= rd; rk[k] = commit ? atomicAdd((int*)(hist + ek[k]), 1) : 0; }
        }
        __syncthreads();
        if (C.tid < NE && commit) base[C.tid] = atomicAdd(cnt + C.tid, hist[C.tid]);
        __syncthreads();
        if (C.tid < 128 && commit) {
#pragma unroll
            for (int k = 0; k < 4; ++k) { const int sidx = ek[k] * ECAP + base[ek[k]] + rk[k]; __hip_atomic_store(perm + sidx, t * 4 + k, RLX_AGENT); __hip_atomic_store(rsl + sidx, rs_t, RLX_AGENT); __hip_atomic_store(gsl + sidx, wk[k], RLX_AGENT); }
        }
        __syncthreads();
    }
}

__device__ __forceinline__ void combine_phase(const Args& a, const Ctx& C) {
    unsigned char* ws = launder(a.ws); const float* XF = (const float*)(ws + WS_XF); const bf16* Y = (const bf16*)(ws + WS_Y); bf16* X2B = (bf16*)(ws + WS_X2B); float* rs2 = (float*)(ws + WS_RS2);
    for (int t0 = 2 * C.gw; t0 < T; t0 += 2 * C.NGW) {
        f32x4 v[2][4]; u32x2 y[2][4][4]; unsigned y8[2][4][4];
#pragma unroll
        for (int q = 0; q < 2; ++q) { const f32x4* xr = (const f32x4*)(XF + (size_t)(t0 + q) * D) + C.lane; const u32x2* xrb = (const u32x2*)((const bf16*)(ws + WS_X1B) + (size_t)(t0 + q) * D) + C.lane;
#pragma unroll
            for (int j = 0; j < 4; ++j) { if (X1_BF16) { const u32x2 w = xrb[64 * j]; v[q][j] = (f32x4){bflo(w.x), bfhi(w.x), bflo(w.y), bfhi(w.y)}; } else v[q][j] = xr[64 * j]; }
#pragma unroll
            for (int k = 0; k < 4; ++k) { const u32x2* yr = (const u32x2*)(Y + (size_t)((t0 + q) * 4 + k) * D) + C.lane; const unsigned* yq = (const unsigned*)((const unsigned char*)Y + (size_t)((t0 + q) * 4 + k) * D) + C.lane;
#pragma unroll
                for (int j = 0; j < 4; ++j) { if (Y_F8) y8[q][k][j] = yq[64 * j]; else y[q][k][j] = yr[64 * j]; } } }
#pragma unroll
        for (int q = 0; q < 2; ++q) { float s = 0.f;
#pragma unroll
            for (int k = 0; k < 4; ++k)
#pragma unroll
                for (int j = 0; j < 4; ++j) { if (Y_F8) { const f32x2 lo = __builtin_amdgcn_cvt_pk_f32_fp8((int)y8[q][k][j], false), hh = __builtin_amdgcn_cvt_pk_f32_fp8((int)y8[q][k][j], true);
                        v[q][j][0] += lo.x * (1.0f / YSC); v[q][j][1] += lo.y * (1.0f / YSC); v[q][j][2] += hh.x * (1.0f / YSC); v[q][j][3] += hh.y * (1.0f / YSC); }
                    else { const u32x2 w = y[q][k][j]; v[q][j][0] += bflo(w.x); v[q][j][1] += bfhi(w.x); v[q][j][2] += bflo(w.y); v[q][j][3] += bfhi(w.y); } }
            u32x2* o8 = (u32x2*)(X2B + (size_t)(t0 + q) * D) + C.lane;
#pragma unroll
            for (int j = 0; j < 4; ++j) { u32x2 w; w.x = cvt_pk_bf16(v[q][j][0], v[q][j][1]); w.y = cvt_pk_bf16(v[q][j][2], v[q][j][3]); o8[64 * j] = w; s += sq4g(v[q][j]); }
            if (P9_F8) { unsigned* q8 = (unsigned*)(ws + WS_X2Q + (size_t)(t0 + q) * D) + C.lane;
#pragma unroll
                for (int j = 0; j < 4; ++j) q8[64 * j] = pk4_fp8(v[q][j][0], v[q][j][1], v[q][j][2], v[q][j][3]); }
            s = wave_sum(s);
            if (C.lane == 0) __hip_atomic_store(rs2 + t0 + q, __builtin_amdgcn_rsqf(s * (1.0f / D) + EPS), RLX_AGENT); }
    }
}
__device__ __forceinline__ void final_phase(const Args& a, const Ctx& C) {
    const bf16* XB = (const bf16*)(launder(a.ws) + WS_XB);
    const f32x4* g = (const f32x4*)a.final_norm + C.lane; f32x4 gv[4];
#pragma unroll
    for (int j = 0; j < 4; ++j) gv[j] = g[64 * j];
    for (int t0 = 4 * C.gw; t0 < T; t0 += 4 * C.NGW) {
        u32x2 w[4][4];
#pragma unroll
        for (int q = 0; q < 4; ++q) { const u32x2* xr = (const u32x2*)(XB + (size_t)(t0 + q) * D) + C.lane;
#pragma unroll
            for (int j = 0; j < 4; ++j) w[q][j] = xr[64 * j]; }
#pragma unroll
        for (int q = 0; q < 4; ++q) { f32x4 v[4]; float s = 0.f;
#pragma unroll
            for (int j = 0; j < 4; ++j) { v[j] = (f32x4){bflo(w[q][j].x), bfhi(w[q][j].x), bflo(w[q][j].y), bfhi(w[q][j].y)}; s += sq4g(v[j]); }
            s = wave_sum(s); const float rs = 1.0f / sqrtf(s * (1.0f / D) + EPS);
            f32x4* o = (f32x4*)(a.out + (size_t)(t0 + q) * D) + C.lane;
#pragma unroll
            for (int j = 0; j < 4; ++j) o[64 * j] = v[j] * rs * gv[j]; }
    }
}
__device__ __forceinline__ Ctx make_ctx(LAS unsigned char* lds) {
    Ctx C; C.lds = lds; C.tid = opaque_tid(); C.lane = C.tid & 63; C.wave = __builtin_amdgcn_readfirstlane(C.tid >> 6);
    C.G = gridDim.x; const int bx = blockIdx.x; C.vcu = (C.G % 8 == 0) ? (bx % 8) * (C.G / 8) + bx / 8 : bx; C.gw = C.vcu * NWAVES + C.wave; C.NGW = C.G * NWAVES; return C;
}
#ifdef PROBE_A
#define STAMP(i) do { if (blockIdx.x == 0 && threadIdx.x == 0) ((LAS u64*)(lds + MISC_OFF + 3072))[(i)] = __builtin_amdgcn_s_memrealtime(); } while (0)
#else
#define STAMP(i) do { } while (0)
#endif
#define GRID_BAR() do { XcdBarrier b_; b_.bar = (unsigned*)(launder(a.ws) + WS_CTL) + CW_BAR; b_.x = xb_xcc_id(); b_.st = (volatile LAS unsigned*)(lds + MISC_OFF); xcd_barrier(b_); } while (0)
__global__ void __launch_bounds__(NWAVES * 64, 2) fwd(Args a) {
    extern __shared__ __attribute__((aligned(16))) unsigned char lds_raw[];
    LAS unsigned char* lds = (LAS unsigned char*)lds_raw;
    for (int u = threadIdx.x; u < (LDS_BYTES - MISC_OFF) / 4; u += NWAVES * 64) ((LAS unsigned*)(lds + MISC_OFF))[u] = 0u;
    __syncthreads();
    (void)xcd_barrier_post((unsigned*)(launder(a.ws) + WS_CTL) + CW_BAR, (volatile LAS unsigned*)(lds + MISC_OFF));
    const int bx = blockIdx.x;
    STAMP(0);
    PH(0) { const Ctx C = make_ctx(lds); prologue(a, C); }
    GRID_BAR(); STAMP(1);

#pragma unroll 1
    for (int l = 0; l < NL; ++l) {
        PH(1) { unsigned char* ws = launder(a.ws); u64* ssb = (u64*)(ws + WS_CTL + (size_t)CW_SS * 4) + (size_t)l * 4 * T;
          const u64* ssin = (l == 0) ? (const u64*)(ws + WS_SS0) : (const u64*)(ws + WS_CTL + (size_t)CW_SS * 4) + (size_t)((l - 1) * 4 + 3) * T;
          gp::DenseSched S; if (P1_F8) S.init(ws + WS_XQ, D / 2, ws + WS_WIN + (size_t)l * ZP * D, D / 2, T, ZP, gridDim.x, bx); else S.init(ws + WS_XB, D, (bf16*)(ws + WS_WIN) + (size_t)l * ZP * D, D, T, ZP, gridDim.x, bx);
          gp::EpiIn E{(bf16*)(ws + WS_Z), ssin, ssb, ssb + T, rep_ == 0, (bf16*)(ws + WS_KA), (bf16*)(ws + WS_QB), (bf16*)(ws + WS_KB), (bf16*)(ws + WS_VB), (bf16*)(ws + WS_QC), (bf16*)(ws + WS_KC), (bf16*)(ws + WS_VC),
                       (const f32x2*)(ws + WS_TAB32), (const f32x2*)(ws + WS_TAB64), a.gqa_q_norm + l * 64, a.gqa_k_norm + l * 64, ws + WS_VTB, ws + WS_VTC, PV_F8 != 0, lds};
          gp::gemm_phase<gp::EpiIn, gp::DenseSched, true, P1_F8 != 0>(lds, D, S, E); }
        GRID_BAR(); STAMP(2 + l * 9 + 0);
        PH(3) { unsigned char* ws = launder(a.ws); u64* ssb = (u64*)(ws + WS_CTL + (size_t)CW_SS * 4) + (size_t)l * 4 * T;
          gp::MlaSched S{(const char*)(ws + WS_Z), (const char*)((bf16*)(ws + WS_WQ) + (size_t)l * 768 * 256), (const char*)((bf16*)(ws + WS_WKV) + (size_t)l * 768 * 256), (int)gridDim.x, bx};
          gp::EpiMla E{(bf16*)(ws + WS_QA), (bf16*)(ws + WS_KA), (bf16*)(ws + WS_VA), ssb, ssb + T, (const f32x2*)(ws + WS_TAB32), ws + WS_VTA, PV_F8 != 0, lds};
          gp::gemm_phase<gp::EpiMla, gp::MlaSched, true>(lds, 256, S, E); }
        GRID_BAR(); STAMP(2 + l * 9 + 1);
#if PV_CHECK
        { unsigned char* ws = launder(a.ws); u64* ssb = (u64*)(ws + WS_CTL + (size_t)CW_SS * 4) + (size_t)l * 4 * T;
          const u64* ssin = (l == 0) ? (const u64*)(ws + WS_SS0) : (const u64*)(ws + WS_CTL + (size_t)CW_SS * 4) + (size_t)((l - 1) * 4 + 3) * T;
          gp::DenseSched S; if (P1_F8) S.init(ws + WS_XQ, D / 2, ws + WS_WIN + (size_t)l * ZP * D, D / 2, T, ZP, gridDim.x, bx); else S.init(ws + WS_XB, D, (bf16*)(ws + WS_WIN) + (size_t)l * ZP * D, D, T, ZP, gridDim.x, bx);
          gp::EpiIn E{(bf16*)(ws + WS_Z), ssin, ssb, ssb + T, false, (bf16*)(ws + WS_KA), (bf16*)(ws + WS_QB), (bf16*)(ws + WS_KB), (bf16*)(ws + WS_VB), (bf16*)(ws + WS_QC), (bf16*)(ws + WS_KC), (bf16*)(ws + WS_VC),
                       (const f32x2*)(ws + WS_TAB32), (const f32x2*)(ws + WS_TAB64), a.gqa_q_norm + l * 64, a.gqa_k_norm + l * 64, ws + WS_VTB, ws + WS_VTC, false, lds};
          gp::gemm_phase<gp::EpiIn, gp::DenseSched, true, P1_F8 != 0>(lds, D, S, E); }
        GRID_BAR();
        { unsigned char* ws = launder(a.ws); u64* ssb = (u64*)(ws + WS_CTL + (size_t)CW_SS * 4) + (size_t)l * 4 * T;
          gp::MlaSched S{(const char*)(ws + WS_Z), (const char*)((bf16*)(ws + WS_WQ) + (size_t)l * 768 * 256), (const char*)((bf16*)(ws + WS_WKV) + (size_t)l * 768 * 256), (int)gridDim.x, bx};
          gp::EpiMla E{(bf16*)(ws + WS_QA), (bf16*)(ws + WS_KA), (bf16*)(ws + WS_VA), ssb, ssb + T, (const f32x2*)(ws + WS_TAB32), ws + WS_VTA, false, lds};
          gp::gemm_phase<gp::EpiMla, gp::MlaSched, true>(lds, 256, S, E); }
        GRID_BAR();
#endif
        {
            char* shm = (char*)lds_raw; const int G = gridDim.x, vcu = (G % 8 == 0) ? (bx % 8) * (G / 8) + bx / 8 : bx;
#if PV_CHECK
            { unsigned char* ws = launder(a.ws); at::DecA dec{ws + WS_QA, ws + WS_KA, (const bf16*)(ws + WS_VA), (bf16*)(ws + WS_MIX), false};
              at::attn_loop_f8<2, 6, 0>(vcu, NB * 6 * 16, G, dec, QAP, KAP, VAP, D, shm); }
            { unsigned char* ws = launder(a.ws); at::DecB dec{ws + WS_QB, ws + WS_KB, (const bf16*)(ws + WS_VB), (bf16*)(ws + WS_MIX), false};
              at::attn_loop_f8<1, 4, 0>(vcu, NB * 6 * 16, G, dec, QBP, KBP, VBP, D, shm); }
            { unsigned char* ws = launder(a.ws); at::DecC dec{ws + WS_QC, ws + WS_KC, (const bf16*)(ws + WS_VC), (bf16*)(ws + WS_MIX), a.swa_sink + l * 4, false};
              at::attn_loop_f8<1, 4, 1>(vcu, NB * 4 * 16, G, dec, QCP, KCP, VCP, D, shm); }
            { unsigned char* ws = launder(a.ws); at::DecA dec{ws + WS_QA, ws + WS_KA, (const bf16*)(ws + WS_VTA), (bf16*)(ws + WS_MIX2), true};
              at::attn_loop_f8v<2, 6, 0, at::DecA, PP_A != 0, PP_A != 0>(vcu, NB * 6 * 16, G, dec, QAP, KAP, D, shm); }
            { unsigned char* ws = launder(a.ws); at::DecB dec{ws + WS_QB, ws + WS_KB, (const bf16*)(ws + WS_VTB), (bf16*)(ws + WS_MIX2), true};
              at::attn_loop_f8v<1, 4, 0, at::DecB, false, PP_B != 0>(vcu, NB * 6 * 16, G, dec, QBP, KBP, D, shm); }
            { unsigned char* ws = launder(a.ws); at::DecC dec{ws + WS_QC, ws + WS_KC, (const bf16*)(ws + WS_VTC), (bf16*)(ws + WS_MIX2), a.swa_sink + l * 4, true};
              at::attn_loop_f8v<1, 4, 1, at::DecC, false, PP_C != 0>(vcu, NB * 4 * 16, G, dec, QCP, KCP, D, shm); }
            GRID_BAR();
            { unsigned char* ws = launder(a.ws); const bf16* M1 = (const bf16*)(ws + WS_MIX); const bf16* M2 = (const bf16*)(ws + WS_MIX2); float d2 = 0.f, r2 = 0.f;
              const int tid_ = opaque_tid(), col = ((bx & 1) * 512 + tid_), mx = col < 384 ? 0 : col < 768 ? 1 : 2;
#pragma unroll 1
              for (int row = bx >> 1; row < T; row += (int)(gridDim.x >> 1)) { const size_t e = (size_t)row * D + col; const float v1 = (float)M1[e], v2 = (float)M2[e], df = v1 - v2; d2 += df * df; r2 += v1 * v1; }
              float* chk = (float*)(ws + WS_CTL) + CW_CHK;
              atomicAdd(chk + l * 8 + mx, d2); atomicAdd(chk + l * 8 + 4 + mx, r2); }
#else
            PH(4) { unsigned char* ws = launder(a.ws); at::DecA dec{ws + WS_QA, ws + WS_KA, (const bf16*)(ws + WS_VTA), (bf16*)(ws + WS_MIX), PV_F8 != 0};
              if (PV_F8) at::attn_loop_f8v<2, 6, 0, at::DecA, PP_A != 0, PP_A != 0>(vcu, NB * 6 * 16, G, dec, QAP, KAP, D, shm); else at::attn_loop_f8<2, 6, 0>(vcu, NB * 6 * 16, G, dec, QAP, KAP, VAP, D, shm); }
            PH(5) { unsigned char* ws = launder(a.ws); at::DecB dec{ws + WS_QB, ws + WS_KB, (const bf16*)(ws + WS_VTB), (bf16*)(ws + WS_MIX), PV_F8 != 0};
              if (PV_F8) at::attn_loop_f8v<1, 4, 0, at::DecB, false, PP_B != 0>(vcu, NB * 6 * 16, G, dec, QBP, KBP, D, shm); else at::attn_loop_f8<1, 4, 0>(vcu, NB * 6 * 16, G, dec, QBP, KBP, VBP, D, shm); }
            PH(6) { unsigned char* ws = launder(a.ws); at::DecC dec{ws + WS_QC, ws + WS_KC, (const bf16*)(ws + WS_VTC), (bf16*)(ws + WS_MIX), a.swa_sink + l * 4, PV_F8 != 0};
              if (PV_F8) at::attn_loop_f8v<1, 4, 1, at::DecC, false, PP_C != 0>(vcu, NB * 4 * 16, G, dec, QCP, KCP, D, shm); else at::attn_loop_f8<1, 4, 1>(vcu, NB * 4 * 16, G, dec, QCP, KCP, VCP, D, shm); }
#endif
        }
        GRID_BAR(); STAMP(2 + l * 9 + 2);
        for (int rep_ = 0; rep_ < 1 + (((REPMASK >> 7) & 1) && l == 0); ++rep_) { unsigned char* ws = launder(a.ws); u64* ssb = (u64*)(ws + WS_CTL + (size_t)CW_SS * 4) + (size_t)l * 4 * T; float* XF = (float*)(ws + WS_XF);
          gp::DenseSched S; if (P4_F8) S.init(ws + WS_MIX, D / 2, ws + WS_WOUT + (size_t)l * D * D, D / 2, T, D, gridDim.x, bx); else S.init(ws + WS_MIX, D, (bf16*)(ws + WS_WOUT) + (size_t)l * D * D, D, T, D, gridDim.x, bx);
          gp::EpiRes E{a.x, (l == 0) ? (const bf16*)nullptr : (const bf16*)(ws + WS_XB), XF, (bf16*)(ws + WS_X1B), ssb + 2 * T, rep_ == 0, ws + WS_X1Q, 1.0f / (MSC * WSC)};
          gp::gemm_phase<gp::EpiRes, gp::DenseSched, true, P4_F8 != 0>(lds, D, S, E); }
        GRID_BAR(); STAMP(2 + l * 9 + 3);
        PH(8) { const Ctx C = make_ctx(lds); router_phase(a, C, l, rep_ == 0); }
        PH(9) { unsigned char* ws = launder(a.ws);
          gp::DenseSched S; S.init((bf16*)(ws + WS_PB) + (size_t)l * T * 256, 256, (bf16*)(ws + WS_WPLE) + (size_t)l * D * 256, 256, T, D, gridDim.x, bx);
          gp::EpiPlain E{(bf16*)(ws + WS_EB), D};
          gp::gemm_phase<gp::EpiPlain, gp::DenseSched, true>(lds, 256, S, E); }
        GRID_BAR(); STAMP(2 + l * 9 + 4);
        gp::MoeTab tb; tb.P = (LAS int*)(lds + MISC_OFF + 2048); tb.C = tb.P + 64; tb.R2E = (LAS int*)(lds + MISC_OFF + 4096);
        if (threadIdx.x == 0) { const int* cnt = (const int*)(launder(a.ws) + WS_CTL) + CW_CNT + l * NE; int accp = 0;
            for (int e = 0; e < NE; ++e) { const int c = cnt[e]; tb.C[e] = c; tb.P[e] = accp; accp += (c + 255) >> 8; } tb.P[NE] = accp; }
        __syncthreads();
        { const int nrt = tb.P[NE];
#pragma unroll 1
          for (int rt = opaque_tid(); rt < nrt; rt += NWAVES * 64) { int e = 0;
#pragma unroll 1
              for (int j = 1; j < NE; ++j) e = (tb.P[j] <= rt) ? j : e;
              tb.R2E[rt] = e; } }
        __syncthreads();
        PH(10) { unsigned char* ws = launder(a.ws); u64* ssb = (u64*)(ws + WS_CTL + (size_t)CW_SS * 4) + (size_t)l * 4 * T; const int* perm = (const int*)(ws + WS_PERM);
          gp::UpSched S{tb, perm, (const char*)(ws + (MOE_F8 ? WS_X1Q : WS_X1B)), (const char*)(ws + WS_WUP + (size_t)l * NE * 2048 * D * MOE_ES), (int)gridDim.x, bx};
          gp::EpiUp E{(bf16*)(ws + WS_ACT), (const float*)(ws + WS_RSL), (const float*)(ws + WS_BUP) + (size_t)l * NE * 2048, tb, lds};
          gp::gemm_phase<gp::EpiUp, gp::UpSched, true, MOE_F8 != 0>(lds, D, S, E); }
        GRID_BAR(); STAMP(2 + l * 9 + 5);
        PH(11) { unsigned char* ws = launder(a.ws); const int* perm = (const int*)(ws + WS_PERM);
          gp::DownSched S{tb, (const char*)(ws + WS_ACT), (const char*)(ws + WS_WDN + (size_t)l * NE * D * D * MOE_ES), (int)gridDim.x, bx};
          gp::EpiDown E{(bf16*)(ws + WS_Y), a.b_down + (size_t)l * NE * D, (const float*)(ws + WS_GSL), perm, tb, lds};
          gp::gemm_phase<gp::EpiDown, gp::DownSched, true, MOE_F8 != 0>(lds, D, S, E); }
        GRID_BAR(); STAMP(2 + l * 9 + 6);
        PH(12) { const Ctx C = make_ctx(lds); combine_phase(a, C); }
        GRID_BAR(); STAMP(2 + l * 9 + 7);
        PH(13) { unsigned char* ws = launder(a.ws); u64* ssb = (u64*)(ws + WS_CTL + (size_t)CW_SS * 4) + (size_t)l * 4 * T;
          gp::DenseSched S; if (P9_F8) S.init(ws + WS_X2Q, D / 2, ws + WS_WG + (size_t)l * D * D, D / 2, T, D, gridDim.x, bx); else S.init(ws + WS_X2B, D, (bf16*)(ws + WS_WG) + (size_t)l * D * D, D, T, D, gridDim.x, bx);
          gp::EpiGate E{(const bf16*)(ws + WS_X2B), (bf16*)(ws + WS_XB), (const bf16*)(ws + WS_EB), (const float*)(ws + WS_RS2), ssb + 3 * T, rep_ == 0, (l + 1 < NL) ? ws + WS_XQ : (unsigned char*)nullptr, lds};
          gp::gemm_phase<gp::EpiGate, gp::DenseSched, true, P9_F8 != 0>(lds, D, S, E); }
        GRID_BAR(); STAMP(2 + l * 9 + 8);
    }
#ifdef PROBE_A
    if (blockIdx.x == 0 && threadIdx.x == 0) { LAS u64* st = (LAS u64*)(lds + MISC_OFF + 3072); const float ms = (float)(long long)(st[PROBE_B] - st[PROBE_A]) * 1e-5f;
        __hip_atomic_store((float*)(launder(a.ws) + WS_RS2) + T, 1.0f + ms, RLX_AGENT); }
    GRID_BAR();
#endif
    PH(14) { const Ctx C = make_ctx(lds); final_phase(a, C); }
#if PV_CHECK
    GRID_BAR();
    if (bx == 0 && threadIdx.x == 0) { const float* chk = (const float*)(launder(a.ws) + WS_CTL) + CW_CHK; bool bad = false;
        for (int l = 0; l < NL; ++l) for (int q = 0; q < 3; ++q) { const float d = __builtin_nontemporal_load(chk + l * 8 + q), r = __builtin_nontemporal_load(chk + l * 8 + 4 + q); if (!(r > 0.f) || !(d <= PV_TOL * r) || !(d >= PV_LOW * r)) bad = true; }
        if (bad) a.out[0] = __builtin_nanf(""); }
#endif
}

extern "C" void kernel_launch(void* const* d_in, const int* in_sizes, int n_in, void* d_out, int out_size, void* d_ws, size_t ws_size, hipStream_t stream) {
    static int grid = 0;
    if (grid == 0) {
        if (n_in != 23 || out_size != T * D || ws_size < WS_END) { fprintf(stderr, "kernel_launch: unexpected shapes (n_in %d out %d ws %zu)\n", n_in, out_size, ws_size); grid = -1; return; }
        int dev = 0, cus = 0, per_cu = 0;
        if (hipGetDevice(&dev) != hipSuccess || hipDeviceGetAttribute(&cus, hipDeviceAttributeMultiprocessorCount, dev) != hipSuccess) { grid = -1; return; }
        if (hipFuncSetAttribute((const void*)fwd, hipFuncAttributeMaxDynamicSharedMemorySize, LDS_BYTES) != hipSuccess) { fprintf(stderr, "kernel_launch: hipFuncSetAttribute failed\n"); grid = -1; return; }
        if (hipOccupancyMaxActiveBlocksPerMultiprocessor(&per_cu, (const void*)fwd, NWAVES * 64, LDS_BYTES) != hipSuccess || per_cu < 1) fprintf(stderr, "kernel_launch: occupancy query reports %d\n", per_cu);
        (void)hipGetLastError();
        grid = cus;
    }
    if (grid < 0) return;
    if (hipMemsetAsync((char*)d_ws + WS_CTL, 0, CTL_ZERO_BYTES, stream) != hipSuccess) return;
    Args a{};
    const float** ap = (const float**)&a;
    for (int i = 0; i < 23; ++i) ap[i] = (const float*)d_in[i];
    a.out = (float*)d_out; a.ws = (unsigned char*)d_ws;
    hipLaunchKernelGGL(fwd, dim3(grid), dim3(NWAVES * 64), LDS_BYTES, stream, a);
}
```
